# Optimizing an MI355X kernel written in HIP

```python
import math
import jax, jax.numpy as jnp
from jax import lax
import numpy as np

D_MODEL = 1024
BATCH = 16
SEQ = 2048
DEPTH = 1

MEM_LEN = 256
EPS = 1e-6

MIX_WIDTH = D_MODEL
ML_WIDTH = MIX_WIDTH // 2
DA_WIDTH = MIX_WIDTH - ML_WIDTH
ML_HEADS = 4
ML_HEAD_DIM = ML_WIDTH // ML_HEADS
ML_CHUNK = 64
CONV_WIDTH = 4
DA_HEADS = 4
DA_VDIM = DA_WIDTH // DA_HEADS
DA_QK_DIM = DA_VDIM // 2
Q_BLOCK = 128

CA_HEADS = 4
CA_HEAD_DIM = D_MODEL // CA_HEADS

PEER_HEADS = 8
PEER_KEYS = 128
PEER_EXPERTS = PEER_KEYS * PEER_KEYS
PEER_TOPK = 16
PEER_DKEY = 128
PEER_HALF = PEER_DKEY // 2
PEER_BLOCK = 128

IN_SPLITS = (2 * ML_WIDTH,
             ML_WIDTH,
             ML_WIDTH,
             ML_HEADS,
             ML_HEADS,
             2 * DA_HEADS * DA_QK_DIM,
             2 * DA_HEADS * DA_QK_DIM,
             DA_WIDTH)
IN_WIDTH = sum(IN_SPLITS)
SPLIT_IDX = tuple(int(c) for c in np.cumsum(IN_SPLITS)[:-1])

kernel_name = "hymba_mlstm_diffattn_peer_layer"


def rmsnorm(x, g):
    xf = x.astype(jnp.float32)
    y = xf * lax.rsqrt(jnp.mean(xf * xf, axis=-1, keepdims=True) + EPS)
    return (y * g.astype(jnp.float32)).astype(x.dtype)


def alibi_slopes(n_heads):
    return jnp.asarray(np.array([2.0 ** (-8.0 * (i + 1) / n_heads) for i in range(n_heads)], np.float32))


def causal_depthwise_conv(x, w):
    c = x.shape[-1]
    return lax.conv_general_dilated(x, w[:, None, :].astype(x.dtype), window_strides=(1,),
                                    padding=[(CONV_WIDTH - 1, 0)],
                                    dimension_numbers=('NWC', 'WIO', 'NWC'),
                                    feature_group_count=c)


def mlstm_chunkwise(q, k, v, ig, lf):
    b_, s_, h_, d_ = q.shape
    nc = s_ // ML_CHUNK
    k = k * (d_ ** -0.5)

    def chunks4(a):
        return a.reshape(b_, nc, ML_CHUNK, h_, d_).transpose(1, 0, 3, 2, 4)

    def chunks3(a):
        return a.reshape(b_, nc, ML_CHUNK, h_).transpose(1, 0, 3, 2)

    causal = jnp.tril(jnp.ones((ML_CHUNK, ML_CHUNK), dtype=bool))

    def step(carry, inp):
        c_st, n_st, m_st = carry
        qc, kc, vc, ic, fc = inp
        bcum = jnp.cumsum(fc, axis=-1)
        log_d = bcum[..., :, None] - bcum[..., None, :] + ic[..., None, :]
        log_d = jnp.where(causal, log_d, -jnp.inf)
        m_inter = bcum + m_st[..., None]
        m_t = jnp.maximum(m_inter, jnp.max(log_d, axis=-1))
        dmat = jnp.exp(log_d - m_t[..., None])
        sc = jnp.einsum('bhld,bhsd->bhls', qc, kc) * dmat
        inter = jnp.exp(m_inter - m_t)
        num = jnp.einsum('bhls,bhse->bhle', sc, vc) + inter[..., None] * jnp.einsum('bhld,bhde->bhle', qc, c_st)
        den = jnp.sum(sc, axis=-1) + inter * jnp.einsum('bhld,bhd->bhl', qc, n_st)
        h = num / jnp.maximum(jnp.abs(den), jnp.exp(-m_t))[..., None]
        g = bcum[..., -1:] - bcum + ic
        m_next = jnp.maximum(bcum[..., -1] + m_st, jnp.max(g, axis=-1))
        decay = jnp.exp(bcum[..., -1] + m_st - m_next)
        wgt = jnp.exp(g - m_next[..., None])
        c_next = decay[..., None, None] * c_st + jnp.einsum('bhs,bhsd,bhse->bhde', wgt, kc, vc)
        n_next = decay[..., None] * n_st + jnp.einsum('bhs,bhsd->bhd', wgt, kc)
        return (c_next, n_next, m_next), h

    init = (jnp.zeros((b_, h_, d_, d_), jnp.float32),
            jnp.zeros((b_, h_, d_), jnp.float32),
            jnp.zeros((b_, h_), jnp.float32))
    _, hs = lax.scan(step, init, (chunks4(q), chunks4(k), chunks4(v), chunks3(ig), chunks3(lf)))
    return hs.transpose(1, 0, 3, 2, 4).reshape(b_, s_, h_, d_)


def diff_attention(q, k, v, lam, lam_init, norm_g):
    b_, s_, h_, _, d_ = q.shape
    nb = s_ // Q_BLOCK
    qb = q.reshape(b_, nb, Q_BLOCK, h_, 2, d_).transpose(1, 0, 2, 3, 4, 5)
    starts = jnp.arange(nb, dtype=jnp.int32) * Q_BLOCK
    kpos = jnp.arange(s_, dtype=jnp.int32)
    slopes = alibi_slopes(h_)
    scale = d_ ** -0.5

    def block(args):
        qblk, start = args
        qpos = start + jnp.arange(Q_BLOCK, dtype=jnp.int32)
        dist = (qpos[:, None] - kpos[None, :]).astype(jnp.float32)
        sc = jnp.einsum('bqhcd,bkhcd->bhcqk', qblk, k).astype(jnp.float32) * scale
        sc = sc - slopes[None, :, None, None, None] * dist
        sc = jnp.where(dist >= 0, sc, -jnp.inf)
        p = jax.nn.softmax(sc, axis=-1)
        a = p[:, :, 0] - lam * p[:, :, 1]
        return jnp.einsum('bhqk,bkhe->bqhe', a.astype(v.dtype), v)

    o = lax.map(block, (qb, starts))
    o = o.transpose(1, 0, 2, 3, 4).reshape(b_, s_, h_, 2 * d_)
    return rmsnorm(o, norm_g.reshape(h_, 2 * d_)) * (1.0 - lam_init)


def parallel_mixer(h, w_in, conv_w, b_igate, b_fgate, ml_norm_g, lambda_q1, lambda_k1,
                   lambda_q2, lambda_k2, da_norm_g, w_out, layer_idx):
    b_, s_, _ = h.shape
    f32 = jnp.float32
    z = h @ w_in
    ml_qk, ml_v, ml_o, ml_i, ml_f, da_q, da_k, da_v = jnp.split(z, SPLIT_IDX, axis=-1)

    ml_qk = jax.nn.silu(causal_depthwise_conv(ml_qk, conv_w))
    ml_q, ml_k = jnp.split(ml_qk, 2, axis=-1)
    shp = (b_, s_, ML_HEADS, ML_HEAD_DIM)
    ig = (ml_i + b_igate).astype(f32)
    lf = jax.nn.log_sigmoid((ml_f + b_fgate).astype(f32))
    h_ml = mlstm_chunkwise(ml_q.reshape(shp).astype(f32), ml_k.reshape(shp).astype(f32),
                           ml_v.reshape(shp).astype(f32), ig, lf)
    h_ml = rmsnorm(h_ml, ml_norm_g.reshape(ML_HEADS, ML_HEAD_DIM)) * jax.nn.sigmoid(ml_o.astype(f32)).reshape(shp)
    h_ml = h_ml.reshape(b_, s_, ML_WIDTH).astype(h.dtype)

    lam_init = 0.8 - 0.6 * math.exp(-0.3 * layer_idx)
    lam = (jnp.exp(jnp.sum(lambda_q1.astype(f32) * lambda_k1.astype(f32)))
           - jnp.exp(jnp.sum(lambda_q2.astype(f32) * lambda_k2.astype(f32))) + lam_init)
    qk_shp = (b_, s_, DA_HEADS, 2, DA_QK_DIM)
    h_da = diff_attention(da_q.reshape(qk_shp), da_k.reshape(qk_shp),
                          da_v.reshape(b_, s_, DA_HEADS, DA_VDIM), lam, lam_init, da_norm_g)
    h_da = h_da.reshape(b_, s_, DA_WIDTH).astype(h.dtype)

    return jnp.concatenate([h_ml, h_da], axis=-1) @ w_out


def cross_attention(h, mem_n, w_cq, w_ck, w_cv, w_co):
    b_, s_, _ = h.shape
    m_ = mem_n.shape[1]
    q = (h @ w_cq).reshape(b_, s_, CA_HEADS, CA_HEAD_DIM)
    k = (mem_n @ w_ck).reshape(b_, m_, CA_HEADS, CA_HEAD_DIM)
    v = (mem_n @ w_cv).reshape(b_, m_, CA_HEADS, CA_HEAD_DIM)
    sc = jnp.einsum('bqhd,bmhd->bhqm', q, k).astype(jnp.float32) * (CA_HEAD_DIM ** -0.5)
    p = jax.nn.softmax(sc, axis=-1).astype(v.dtype)
    o = jnp.einsum('bhqm,bmhd->bqhd', p, v).reshape(b_, s_, D_MODEL)
    return o @ w_co


def peer(h, w_pq, sub_keys, peer_u, peer_v):
    b_, s_, d_ = h.shape
    xt = h.reshape((b_ * s_) // PEER_BLOCK, PEER_BLOCK, d_)

    def block(xb):
        q = (xb @ w_pq).reshape(PEER_BLOCK, PEER_HEADS, 2, PEER_HALF)
        sc = jnp.einsum('thcd,hcnd->thcn', q, sub_keys).astype(jnp.float32)
        top_v, top_i = lax.top_k(sc, PEER_TOPK)
        cand_v = top_v[:, :, 0, :, None] + top_v[:, :, 1, None, :]
        cand_i = top_i[:, :, 0, :, None] * PEER_KEYS + top_i[:, :, 1, None, :]
        cand_v = cand_v.reshape(PEER_BLOCK, PEER_HEADS, PEER_TOPK * PEER_TOPK)
        cand_i = cand_i.reshape(PEER_BLOCK, PEER_HEADS, PEER_TOPK * PEER_TOPK)
        best_v, best_j = lax.top_k(cand_v, PEER_TOPK)
        eidx = jnp.take_along_axis(cand_i, best_j, axis=-1)
        gate = jax.nn.softmax(best_v, axis=-1)
        u = peer_u[eidx]
        act = jax.nn.gelu(jnp.einsum('td,thkd->thk', xb, u).astype(jnp.float32), approximate=False)
        coef = (gate * act).astype(xb.dtype)
        return jnp.einsum('thk,thkd->td', coef, peer_v[eidx])

    return lax.map(block, xt).reshape(b_, s_, d_)


def setup_inputs(seed: int = 0) -> dict:
    key = jax.random.key(seed)
    ks = jax.random.split(key, 32)
    f32 = jnp.float32

    def nrm(k, shape, scale):
        return jax.random.normal(k, shape, f32) * scale

    def gain(k, shape):
        return 1.0 + 0.01 * jax.random.normal(k, shape, f32)

    return {
        "x": nrm(ks[0], (BATCH, SEQ, D_MODEL), 1.0),
        "mem": nrm(ks[1], (BATCH, MEM_LEN, D_MODEL), 1.0),
        "norm_mix_g": gain(ks[2], (DEPTH, D_MODEL)),
        "w_in": nrm(ks[3], (DEPTH, D_MODEL, IN_WIDTH), D_MODEL ** -0.5),
        "conv_w": nrm(ks[4], (DEPTH, CONV_WIDTH, 2 * ML_WIDTH), CONV_WIDTH ** -0.5),
        "b_igate": nrm(ks[5], (DEPTH, ML_HEADS), 0.1),
        "b_fgate": jnp.broadcast_to(jnp.linspace(3.0, 6.0, ML_HEADS, dtype=f32), (DEPTH, ML_HEADS))
                    + nrm(ks[6], (DEPTH, ML_HEADS), 0.01),
        "ml_norm_g": gain(ks[7], (DEPTH, ML_WIDTH)),
        "lambda_q1": nrm(ks[8], (DEPTH, DA_QK_DIM), 0.1),
        "lambda_k1": nrm(ks[9], (DEPTH, DA_QK_DIM), 0.1),
        "lambda_q2": nrm(ks[10], (DEPTH, DA_QK_DIM), 0.1),
        "lambda_k2": nrm(ks[11], (DEPTH, DA_QK_DIM), 0.1),
        "da_norm_g": gain(ks[12], (DEPTH, DA_WIDTH)),
        "w_out": nrm(ks[13], (DEPTH, MIX_WIDTH, D_MODEL), MIX_WIDTH ** -0.5),
        "norm_ca_g": gain(ks[14], (DEPTH, D_MODEL)),
        "norm_mem_g": gain(ks[15], (DEPTH, D_MODEL)),
        "w_cq": nrm(ks[16], (DEPTH, D_MODEL, D_MODEL), D_MODEL ** -0.5),
        "w_ck": nrm(ks[17], (DEPTH, D_MODEL, D_MODEL), D_MODEL ** -0.5),
        "w_cv": nrm(ks[18], (DEPTH, D_MODEL, D_MODEL), D_MODEL ** -0.5),
        "w_co": nrm(ks[19], (DEPTH, D_MODEL, D_MODEL), D_MODEL ** -0.5),
        "norm_ffn_g": gain(ks[20], (DEPTH, D_MODEL)),
        "w_pq": nrm(ks[21], (DEPTH, D_MODEL, PEER_HEADS * PEER_DKEY), D_MODEL ** -0.5),
        "sub_keys": nrm(ks[22], (DEPTH, PEER_HEADS, 2, PEER_KEYS, PEER_HALF), PEER_HALF ** -0.5),
        "peer_u": nrm(ks[23], (DEPTH, PEER_EXPERTS, D_MODEL), D_MODEL ** -0.5),
        "peer_v": nrm(ks[24], (DEPTH, PEER_EXPERTS, D_MODEL), PEER_HEADS ** -0.5),
        "final_norm_g": gain(ks[25], (D_MODEL,)),
    }


def reference(x, mem, norm_mix_g, w_in, conv_w, b_igate, b_fgate, ml_norm_g, lambda_q1, lambda_k1,
              lambda_q2, lambda_k2, da_norm_g, w_out, norm_ca_g, norm_mem_g, w_cq, w_ck, w_cv, w_co,
              norm_ffn_g, w_pq, sub_keys, peer_u, peer_v, final_norm_g):
    for l in range(DEPTH):
        x = x + parallel_mixer(rmsnorm(x, norm_mix_g[l]), w_in[l], conv_w[l], b_igate[l], b_fgate[l],
                               ml_norm_g[l], lambda_q1[l], lambda_k1[l], lambda_q2[l], lambda_k2[l],
                               da_norm_g[l], w_out[l], l)
        x = x + cross_attention(rmsnorm(x, norm_ca_g[l]), rmsnorm(mem, norm_mem_g[l]),
                                w_cq[l], w_ck[l], w_cv[l], w_co[l])
        x = x + peer(rmsnorm(x, norm_ffn_g[l]), w_pq[l], sub_keys[l], peer_u[l], peer_v[l])
    return rmsnorm(x, final_norm_g)
```

```cpp
#include <hip/hip_runtime.h>
#include <hip/hip_cooperative_groups.h>
#include <cstdio>
#include <cstdint>
namespace cg = cooperative_groups;

#define GAS __attribute__((address_space(1)))
#define LAS __attribute__((address_space(3)))
typedef unsigned short bf16_t;
typedef short bf16x8 __attribute__((ext_vector_type(8)));
typedef short s16x4 __attribute__((ext_vector_type(4)));
typedef float f32x4 __attribute__((ext_vector_type(4)));
typedef float f32x2 __attribute__((ext_vector_type(2)));
typedef float f32x16 __attribute__((ext_vector_type(16)));
typedef unsigned u32x4 __attribute__((ext_vector_type(4)));
typedef unsigned u32x2 __attribute__((ext_vector_type(2)));

constexpr int T_TOK = 32768, DM = 1024, NB = 16, SEQ = 2048, NZ = 3584, INW = 3592, MEML = 256, TMEM = NB * MEML;
constexpr float EPS = 1e-6f;
constexpr float LOG2E = 1.4426950408889634f;
constexpr int ZC_MLQ = 0, ZC_MLK = 512, ZC_MLV = 1024, ZC_MLO = 1536, ZC_DAQ = 2048, ZC_DAK = 2560, ZC_DAV = 3072;

constexpr size_t MiB = 1u << 20;
constexpr size_t WS_CTL = 0, CTL_BYTES = 1 * MiB;
constexpr size_t WS_WIN = 1 * MiB, WS_WOUT = 8 * MiB, WS_WCQ = 10 * MiB, WS_WKV = 12 * MiB, WS_WCO = 16 * MiB, WS_WPQ = 18 * MiB, WS_SK = 20 * MiB;
constexpr size_t WS_GATES = 21 * MiB, WS_MEMN = 22 * MiB, WS_KV = 30 * MiB, WS_MB = 46 * MiB, WS_VWB = 78 * MiB;
constexpr size_t WS_BUFA = 110 * MiB, WS_BUFB = 174 * MiB, WS_Z = 238 * MiB, WS_END = 462 * MiB;
constexpr int CW_Q2 = 64;
constexpr int CW_RSS1 = 16384;
constexpr int CW_RSS2 = 65536;
constexpr int CW_BAR = 131072;
constexpr int CW_DUMMY = 180224;

constexpr int LDS_BYTES = 147456;
constexpr int XCH_OFF = 131072;
constexpr int MISC_OFF = LDS_BYTES - 256;

__device__ __forceinline__ unsigned cvt_pk_bf16(float lo, float hi) { unsigned r; asm("v_cvt_pk_bf16_f32 %0, %1, %2" : "=v"(r) : "v"(lo), "v"(hi)); return r; }
__device__ __forceinline__ float bf_lo(unsigned u) { return __uint_as_float(u << 16); }
__device__ __forceinline__ float bf_hi(unsigned u) { return __uint_as_float(u & 0xffff0000u); }
__device__ __forceinline__ float wave_sum(float v) {
#pragma unroll
    for (int o = 1; o < 64; o <<= 1) v += __shfl_xor(v, o);
    return v;
}
__device__ __forceinline__ float fast_exp2(float x) { return __builtin_amdgcn_exp2f(x); }
__device__ __forceinline__ float fast_rcp(float x) { return __builtin_amdgcn_rcpf(x); }
#define LDS_WAIT() asm volatile("s_waitcnt lgkmcnt(0)" ::: "memory")
#define VM_WAIT() asm volatile("s_waitcnt vmcnt(0)" ::: "memory")

namespace pg8 {
constexpr int BM = 256, BK = 64, HALF = 128, HTB = HALF * BK * 2, STAGE_BYTES = 8 * HTB;
__device__ __forceinline__ int lds_byte(int r, int c) { const int st = (r >> 4) * 2 + (c >> 5), rr = r & 15, cc = c & 31, ob = rr * 64 + cc * 2; return st * 1024 + (ob ^ (((ob >> 9) & 1) << 5)); }
__device__ __forceinline__ void stage_rc(int b, int& R, int& C) { const int st = b / 1024, sb = b % 1024, swz = sb ^ (((sb >> 9) & 1) << 5); R = (st >> 1) * 16 + swz / 64; C = (st & 1) * 32 + (swz % 64) / 2; }
__device__ __forceinline__ int perm32(int rho) { const int n = rho >> 4, i = rho & 15; return 8 * (i >> 2) + 4 * n + (i & 3); }

struct Unit { const char* A; const char* B; char* O; int row0, col0, scol; };

template <class Epi, class Sched>
__device__ __forceinline__ void gemm_phase(LAS unsigned char* lds, const int K, const int lda, const int ldb, const Sched& S, const Epi& E) {
    int tid_l = threadIdx.x; asm volatile("" : "+v"(tid_l));
    const int tid = tid_l, wid = __builtin_amdgcn_readfirstlane(tid >> 6), lane = tid & 63, wr = wid >> 2, wc = wid & 3, fr = lane & 15, fq = lane >> 4;
    const int nt = K / BK;
    unsigned voffA[2], voffB[2];
#pragma unroll
    for (int i = 0; i < 2; ++i) { int R, C; stage_rc(tid * 16 + i * 8192, R, C); const int Rb = Epi::PERM ? ((R & ~31) + perm32(R & 31)) : R;
        voffA[i] = (unsigned)(R * lda + C) * 2u; voffB[i] = (unsigned)(Rb * ldb + C) * 2u; }
    const size_t kstep = (size_t)(BK * 2);
    const size_t hstepA = (size_t)HALF * lda * 2, hstepB = (size_t)HALF * ldb * 2;
    const unsigned ldsw = (unsigned)wid * 1024u;
    const int aoff = lds_byte(wr * 64 + fr, fq * 8), boff = lds_byte(wc * 32 + fr, fq * 8);
#define PG8_SA(b, h) (((b) * 2 + (h)) * HTB)
#define PG8_SB(b, h) ((4 + (b) * 2 + (h)) * HTB)
#define PG8_STAGE(bufoff, gbase, voff) do { _Pragma("unroll") for (int _i = 0; _i < 2; ++_i) \
        __builtin_amdgcn_global_load_lds((const unsigned*)((const char*)(gbase) + (voff)[_i]), (LAS unsigned*)(lds + (bufoff) + ldsw + _i * 8192), 16, 0, 0); } while (0)
#define PG8_LDA(dst, b, h) do { _Pragma("unroll") for (int m = 0; m < 4; ++m) _Pragma("unroll") for (int k = 0; k < 2; ++k) dst[m][k] = *(const LAS bf16x8*)(lds + PG8_SA(b, h) + aoff + m * 2048 + k * 1024); } while (0)
#define PG8_LDB(dst, b, h) do { _Pragma("unroll") for (int n = 0; n < 2; ++n) _Pragma("unroll") for (int k = 0; k < 2; ++k) dst[n][k] = *(const LAS bf16x8*)(lds + PG8_SB(b, h) + boff + n * 2048 + k * 1024); } while (0)
#define PG8_MMA(ai, bj, At, Bt) do { __builtin_amdgcn_s_setprio(1); _Pragma("unroll") for (int m = 0; m < 4; ++m) _Pragma("unroll") for (int n = 0; n < 2; ++n) _Pragma("unroll") for (int k = 0; k < 2; ++k) \
        acc[ai][bj][m][n] = __builtin_amdgcn_mfma_f32_16x16x32_bf16(Bt[n][k], At[m][k], acc[ai][bj][m][n], 0, 0, 0); __builtin_amdgcn_s_setprio(0); } while (0)
#define PG8_WAIT_V(n) asm volatile("s_waitcnt vmcnt(" #n ")" ::: "memory")
#define PG8_WAIT_L(n) asm volatile("s_waitcnt lgkmcnt(" #n ")" ::: "memory")
#define PG8_BAR __builtin_amdgcn_s_barrier()
#define PG8_SCHED __builtin_amdgcn_sched_barrier(0)
    Unit cur, nxt; int ui = 0;
    if (!S.next(0, cur)) return;
    f32x4 acc[2][2][4][2];
#pragma unroll
    for (int a = 0; a < 2; ++a)
#pragma unroll
        for (int b = 0; b < 2; ++b)
#pragma unroll
            for (int m = 0; m < 4; ++m)
#pragma unroll
                for (int n = 0; n < 2; ++n) acc[a][b][m][n] = (f32x4){0.f, 0.f, 0.f, 0.f};
    bf16x8 At[4][2], B0[2][2], B1[2][2];
    const char* cA = cur.A; const char* cB = cur.B;
    PG8_STAGE(PG8_SB(0, 0), cB, voffB); PG8_STAGE(PG8_SA(0, 0), cA, voffA); PG8_STAGE(PG8_SB(0, 1), cB + hstepB, voffB); PG8_STAGE(PG8_SA(0, 1), cA + hstepA, voffA);
    if (wr == 1) PG8_BAR;
    PG8_WAIT_V(4); PG8_BAR;
    PG8_STAGE(PG8_SB(1, 0), cB + kstep, voffB); PG8_STAGE(PG8_SA(1, 0), cA + kstep, voffA); PG8_STAGE(PG8_SB(1, 1), cB + hstepB + kstep, voffB);
    PG8_WAIT_V(6); PG8_BAR;
    for (;;) {
        const bool has_next = S.next(ui + 1, nxt);
        const char* nA = has_next ? nxt.A : cA; const char* nB = has_next ? nxt.B : cB;
        for (int t = 0; t < nt; t += 2) {
            const bool last = (t == nt - 2);
            const char* a1 = cA + (size_t)(t + 1) * kstep;
            const char* a2 = last ? nA : cA + (size_t)(t + 2) * kstep; const char* b2 = last ? nB : cB + (size_t)(t + 2) * kstep;
            const char* a3 = a2 + kstep; const char* b3 = b2 + kstep;
            PG8_LDB(B0, 0, 0); PG8_SCHED; PG8_LDA(At, 0, 0); PG8_STAGE(PG8_SA(1, 1), a1 + hstepA, voffA);
            PG8_WAIT_L(8); PG8_BAR; PG8_WAIT_L(0); PG8_MMA(0, 0, At, B0); PG8_BAR; PG8_SCHED;
            PG8_LDB(B1, 0, 1); PG8_STAGE(PG8_SB(0, 0), b2, voffB);
            PG8_BAR; PG8_WAIT_L(0); PG8_MMA(0, 1, At, B1); PG8_BAR;
            PG8_LDA(At, 0, 1); PG8_STAGE(PG8_SA(0, 0), a2, voffA);
            PG8_BAR; PG8_WAIT_L(0); PG8_MMA(1, 0, At, B0); PG8_BAR; PG8_SCHED;
            PG8_STAGE(PG8_SB(0, 1), b2 + hstepB, voffB);
            PG8_WAIT_V(6); PG8_BAR; PG8_MMA(1, 1, At, B1); PG8_BAR;
            PG8_LDB(B0, 1, 0); PG8_SCHED; PG8_LDA(At, 1, 0); PG8_STAGE(PG8_SA(0, 1), a2 + hstepA, voffA);
            PG8_WAIT_L(8); PG8_BAR; PG8_WAIT_L(0); PG8_MMA(0, 0, At, B0); PG8_BAR; PG8_SCHED;
            PG8_LDB(B1, 1, 1); PG8_STAGE(PG8_SB(1, 0), b3, voffB);
            PG8_BAR; PG8_WAIT_L(0); PG8_MMA(0, 1, At, B1); PG8_BAR;
            PG8_LDA(At, 1, 1); PG8_STAGE(PG8_SA(1, 0), a3, voffA);
            PG8_BAR; PG8_WAIT_L(0); PG8_MMA(1, 0, At, B0); PG8_BAR; PG8_SCHED;
            PG8_STAGE(PG8_SB(1, 1), b3 + hstepB, voffB);
            PG8_WAIT_V(6); PG8_BAR; PG8_MMA(1, 1, At, B1); PG8_BAR;
        }
        E(acc, cur, wr, wc, fr, fq, lds);
        if (!has_next) break;
#pragma unroll
        for (int a = 0; a < 2; ++a)
#pragma unroll
            for (int b = 0; b < 2; ++b)
#pragma unroll
                for (int m = 0; m < 4; ++m)
#pragma unroll
                    for (int n = 0; n < 2; ++n) acc[a][b][m][n] = (f32x4){0.f, 0.f, 0.f, 0.f};
        cur = nxt; cA = nA; cB = nB; ++ui;
    }
    PG8_WAIT_V(0);
    if (wr == 0) PG8_BAR;
    PG8_BAR;
#undef PG8_SA
#undef PG8_SB
#undef PG8_STAGE
#undef PG8_LDA
#undef PG8_LDB
#undef PG8_MMA
#undef PG8_WAIT_V
#undef PG8_WAIT_L
#undef PG8_BAR
#undef PG8_SCHED
}

struct Sched {
    int mode, nM, nN, nwg, G, c, tpb; const char* baseA; const char* baseB; char* baseO; size_t strideA, strideB, bstrideB; int ldo_bytes_per_el;
    __device__ __forceinline__ bool next(int i, Unit& u) const {
        const long L = (long)i * G + c; if (L >= nwg) return false;
        if (mode == 0) {
            int wgid = (int)L; { const int q = nwg / 8, r = nwg % 8, xcd = wgid % 8, off = wgid / 8; wgid = (xcd < r ? xcd * (q + 1) : r * (q + 1) + (xcd - r) * q) + off; }
            const int nig = 8 * nN, gid = wgid / nig, fm = gid * 8, gsz = (nM - fm) < 8 ? (nM - fm) : 8;
            const int pm = fm + ((wgid % nig) % gsz), pn = (wgid % nig) / gsz;
            u.A = baseA + (size_t)pm * strideA; u.B = baseB + (size_t)pn * strideB + (size_t)(pm / tpb) * bstrideB; u.O = baseO; u.row0 = pm * 256; u.col0 = pn * 256; u.scol = pn * 256;
        } else if (mode == 1) {
            const int l = (int)L, b = l >> 4, h = (l >> 2) & 3, kt = l & 3;
            u.A = baseA + ((size_t)(b * 256) * 2048 + h * 256) * 2; u.B = baseB + ((size_t)(kt * 256) * 1024 + h * 256) * 2;
            u.O = baseO + ((size_t)b * 1048576 + (size_t)(h * 256) * 1024 + kt * 256) * 2; u.row0 = 0; u.col0 = 0; u.scol = kt * 256;
        } else {
            const int l = (int)L, b = l >> 4, h = (l >> 2) & 3, ntile = l & 3;
            u.A = baseA + ((size_t)(ntile * 256) * 1024 + h * 256) * 2; u.B = baseB + ((size_t)(b * 256) * 2048 + 1024 + h * 256) * 2;
            u.O = baseO + ((size_t)b * 1048576 + (size_t)(ntile * 256) * 1024 + h * 256) * 2; u.row0 = 0; u.col0 = 0; u.scol = 0;
        }
        return true;
    }
};

struct EpiBf16 {
    static constexpr bool PERM = true;
    int ldc; float scale; const float* rss; const float* colscale;
    __device__ __forceinline__ void operator()(const f32x4 (&acc)[2][2][4][2], const Unit& u, int wr, int wc, int fr, int fq, LAS unsigned char*) const {
        bf16_t* base = (bf16_t*)u.O;
        f32x4 cs[2][2];
#pragma unroll
        for (int bj = 0; bj < 2; ++bj)
#pragma unroll
            for (int n = 0; n < 2; ++n) cs[bj][n] = colscale ? *(const f32x4*)(colscale + u.scol + wc * 32 + 8 * fq + bj * HALF + 4 * n) : (f32x4){1.f, 1.f, 1.f, 1.f};
#pragma unroll
        for (int ai = 0; ai < 2; ++ai)
#pragma unroll
            for (int m = 0; m < 4; ++m) {
                const int row = u.row0 + ai * HALF + wr * 64 + m * 16 + fr;
                float sc = scale; if (rss) sc *= rsqrtf(rss[row] * (1.0f / 1024.0f) + EPS);
                bf16_t* rowp = base + (size_t)row * ldc + u.col0 + wc * 32 + 8 * fq;
#pragma unroll
                for (int bj = 0; bj < 2; ++bj) { const f32x4 v0 = acc[ai][bj][m][0] * sc * cs[bj][0], v1 = acc[ai][bj][m][1] * sc * cs[bj][1];
                    u32x4 w; w.x = cvt_pk_bf16(v0[0], v0[1]); w.y = cvt_pk_bf16(v0[2], v0[3]); w.z = cvt_pk_bf16(v1[0], v1[1]); w.w = cvt_pk_bf16(v1[2], v1[3]);
                    *(u32x4*)(rowp + bj * HALF) = w; } }
    }
};
struct EpiResid {
    static constexpr bool PERM = false;
    const float* base; float* out; bf16_t* xg; const float* g; float* rss;
    __device__ __forceinline__ void operator()(const f32x4 (&acc)[2][2][4][2], const Unit& u, int wr, int wc, int fr, int fq, LAS unsigned char*) const {
        const int colb = u.col0 + wc * 32 + 4 * fq;
#pragma unroll
        for (int ai = 0; ai < 2; ++ai)
#pragma unroll
            for (int m = 0; m < 4; ++m) {
                const int row = u.row0 + ai * HALF + wr * 64 + m * 16 + fr; const size_t off = (size_t)row * DM + colb; float ss = 0.f;
#pragma unroll
                for (int bj = 0; bj < 2; ++bj)
#pragma unroll
                    for (int n = 0; n < 2; ++n) { const int co = bj * HALF + n * 16;
                        const f32x4 bs = *(const f32x4*)(base + off + co); const f32x4 v = bs + acc[ai][bj][m][n];
                        *(f32x4*)(out + off + co) = v; const f32x4 gv = *(const f32x4*)(g + colb + co); const f32x4 w = v * gv;
                        u32x2 pk; pk.x = cvt_pk_bf16(w[0], w[1]); pk.y = cvt_pk_bf16(w[2], w[3]); *(u32x2*)(xg + off + co) = pk;
                        ss += (v[0] * v[0] + v[1] * v[1]) + (v[2] * v[2] + v[3] * v[3]); }
                ss += __shfl_xor(ss, 16); ss += __shfl_xor(ss, 32);
                if (fq == 0) atomicAdd(rss + row, ss);
                asm volatile("" ::: "memory"); }
    }
};
template <bool BASE_BF16>
struct EpiResidB {
    static constexpr bool PERM = false;
    const void* base; bf16_t* out; float* rss;
    __device__ __forceinline__ void operator()(const f32x4 (&acc)[2][2][4][2], const Unit& u, int wr, int wc, int fr, int fq, LAS unsigned char*) const {
        const int colb = u.col0 + wc * 32 + 4 * fq;
#pragma unroll
        for (int ai = 0; ai < 2; ++ai)
#pragma unroll
            for (int m = 0; m < 4; ++m) {
                const int row = u.row0 + ai * HALF + wr * 64 + m * 16 + fr; const size_t off = (size_t)row * DM + colb; float ss = 0.f;
                f32x4 bs[2][2];
#pragma unroll
                for (int bj = 0; bj < 2; ++bj)
#pragma unroll
                    for (int n = 0; n < 2; ++n) { const int co = bj * HALF + n * 16;
                        if (BASE_BF16) { const u32x2 b2 = *(const u32x2*)((const bf16_t*)base + off + co); bs[bj][n] = (f32x4){bf_lo(b2.x), bf_hi(b2.x), bf_lo(b2.y), bf_hi(b2.y)}; }
                        else bs[bj][n] = *(const f32x4*)((const float*)base + off + co); }
#pragma unroll
                for (int bj = 0; bj < 2; ++bj)
#pragma unroll
                    for (int n = 0; n < 2; ++n) { const int co = bj * HALF + n * 16; const f32x4 v = bs[bj][n] + acc[ai][bj][m][n];
                        u32x2 pk; pk.x = cvt_pk_bf16(v[0], v[1]); pk.y = cvt_pk_bf16(v[2], v[3]); *(u32x2*)(out + off + co) = pk;
                        ss += (v[0] * v[0] + v[1] * v[1]) + (v[2] * v[2] + v[3] * v[3]); }
                ss += __shfl_xor(ss, 16); ss += __shfl_xor(ss, 32);
                if (fq == 0) atomicAdd(rss + row, ss);
                if (m & 1) asm volatile("" ::: "memory"); }
    }
};
struct EpiSoftmax {
    static constexpr bool PERM = true;
    const float* rss; bf16_t* P;
    __device__ __forceinline__ void operator()(f32x4 (&acc)[2][2][4][2], const Unit& u, int wr, int wc, int fr, int fq, LAS unsigned char* lds) const {
        LAS f32x2* X = (LAS f32x2*)(lds + XCH_OFF);
        float ml[2][4];
#pragma unroll
        for (int ai = 0; ai < 2; ++ai)
#pragma unroll
            for (int m = 0; m < 4; ++m) {
                const int r = ai * HALF + wr * 64 + m * 16 + fr;
                const float sc = rsqrtf(rss[u.row0 + r] * (1.0f / 1024.0f) + EPS) * LOG2E;
                float mx = -3.0e38f;
#pragma unroll
                for (int bj = 0; bj < 2; ++bj)
#pragma unroll
                    for (int n = 0; n < 2; ++n) { f32x4 v = acc[ai][bj][m][n] * sc; acc[ai][bj][m][n] = v; mx = fmaxf(mx, fmaxf(fmaxf(v[0], v[1]), fmaxf(v[2], v[3]))); }
                mx = fmaxf(mx, __shfl_xor(mx, 16)); mx = fmaxf(mx, __shfl_xor(mx, 32));
                float sm = 0.f;
#pragma unroll
                for (int bj = 0; bj < 2; ++bj)
#pragma unroll
                    for (int n = 0; n < 2; ++n) { f32x4 v = acc[ai][bj][m][n]; v[0] = fast_exp2(v[0] - mx); v[1] = fast_exp2(v[1] - mx); v[2] = fast_exp2(v[2] - mx); v[3] = fast_exp2(v[3] - mx);
                        acc[ai][bj][m][n] = v; sm += (v[0] + v[1]) + (v[2] + v[3]); }
                sm += __shfl_xor(sm, 16); sm += __shfl_xor(sm, 32);
                ml[ai][m] = mx;
                if (fq == 0) X[r * 4 + wc] = (f32x2){mx, sm};
            }
        LDS_WAIT(); __builtin_amdgcn_s_barrier(); asm volatile("" ::: "memory");
#pragma unroll
        for (int ai = 0; ai < 2; ++ai)
#pragma unroll
            for (int m = 0; m < 4; ++m) {
                const int r = ai * HALF + wr * 64 + m * 16 + fr;
                const f32x2 a = X[r * 4 + 0], b = X[r * 4 + 1], c = X[r * 4 + 2], d = X[r * 4 + 3];
                const float mg = fmaxf(fmaxf(a.x, b.x), fmaxf(c.x, d.x));
                const float lg = a.y * fast_exp2(a.x - mg) + b.y * fast_exp2(b.x - mg) + c.y * fast_exp2(c.x - mg) + d.y * fast_exp2(d.x - mg);
                const float f = fast_exp2(ml[ai][m] - mg) / lg;
                bf16_t* rowp = P + (size_t)(u.row0 + r) * DM + u.col0 + wc * 32 + 8 * fq;
#pragma unroll
                for (int bj = 0; bj < 2; ++bj) { const f32x4 v0 = acc[ai][bj][m][0] * f, v1 = acc[ai][bj][m][1] * f;
                    u32x4 w; w.x = cvt_pk_bf16(v0[0], v0[1]); w.y = cvt_pk_bf16(v0[2], v0[3]); w.z = cvt_pk_bf16(v1[0], v1[1]); w.w = cvt_pk_bf16(v1[2], v1[3]);
                    *(u32x4*)(rowp + bj * HALF) = w; } }
        LDS_WAIT();
    }
};
}
struct Args { const float* in[26]; float* out; unsigned char* ws; int ph_lo, ph_hi; };
enum { I_X = 0, I_MEM, I_GMIX, I_WIN, I_CONVW, I_BI, I_BF, I_GML, I_LQ1, I_LK1, I_LQ2, I_LK2, I_GDA, I_WOUT, I_GCA, I_GMEM, I_WCQ, I_WCK, I_WCV, I_WCO, I_GFFN, I_WPQ, I_SUBK, I_PU, I_PV, I_GFIN };

struct Frame {
    LAS unsigned char* lds;
    int tid, lane, wave, G, vcu;
    const Args* a;
    unsigned char* ws;
    unsigned* ctl;
};


#define XB_TMO      128
#define XB_XCNT(j)  (256  + 64 * (j))
#define XB_XSUB(j)  (1280 + 64 * (j))
#define XB_XGEN(j)  (2304 + 64 * (j))
#define XB_TOP      3328
#define XB_TOPGEN   3392
#define XCD_BAR_WORDS 3456
#define XB_SPIN_CAP (1u << 18)
__device__ __forceinline__ unsigned xb_ld(unsigned* p)              { return __hip_atomic_load(p, __ATOMIC_RELAXED, __HIP_MEMORY_SCOPE_AGENT); }
__device__ __forceinline__ unsigned xb_add(unsigned* p, unsigned v) { return __hip_atomic_fetch_add(p, v, __ATOMIC_RELAXED, __HIP_MEMORY_SCOPE_AGENT); }
__device__ __forceinline__ unsigned xb_xcc_id() { return (unsigned)__builtin_amdgcn_s_getreg((3 << 11) | 20) & 0xFu; }
#define XB_SPIN(cond, bar) do { unsigned _sp = 0; while (cond) { __builtin_amdgcn_s_sleep(1); \
    if ((++_sp & 255u) == 0u) { if (xb_ld(&(bar)[XB_TMO])) break; if (_sp > XB_SPIN_CAP) { atomicAdd(&(bar)[XB_TMO], 1u); break; } } } } while (0)
struct XcdBarrier { unsigned* bar; unsigned x; volatile LAS unsigned* st; };
__device__ __forceinline__ XcdBarrier xcd_barrier_post(unsigned* bar, volatile LAS unsigned* st) {
    XcdBarrier b; b.bar = bar; b.x = xb_xcc_id(); b.st = st;
    if (threadIdx.x == 0) (void)xb_add(&bar[XB_XCNT(b.x)], 1u);
    return b;
}
__device__ __forceinline__ void xcd_barrier_complete(unsigned* bar, unsigned x, unsigned& nloc, unsigned& nx) {
    const unsigned G = gridDim.x * gridDim.y * gridDim.z;
    unsigned sum, cnt, mine, sp = 0u;
    for (;;) {
        sum = 0u; cnt = 0u; mine = 0u;
#pragma unroll
        for (unsigned j = 0; j < 16; ++j) { const unsigned c = xb_ld(&bar[XB_XCNT(j)]); sum += c; cnt += (c > 0u) ? 1u : 0u; mine = (j == x) ? c : mine; }
        if (sum == G) break;
        __builtin_amdgcn_s_sleep(1);
        if ((++sp & 255u) == 0u) { if (xb_ld(&bar[XB_TMO])) break; if (sp > XB_SPIN_CAP) { atomicAdd(&bar[XB_TMO], 1u); break; } }
    }
    nloc = mine > 0u ? mine : 1u; nx = cnt > 0u ? cnt : 1u;
}
__device__ __forceinline__ void xcd_barrier(const XcdBarrier& b) {
    asm volatile("s_waitcnt vmcnt(0)" ::: "memory");
    __syncthreads();
    if (threadIdx.x == 0) {
        unsigned* bar = b.bar;
        __builtin_amdgcn_s_waitcnt(0);
        unsigned nloc = b.st[0], nx = b.st[1];
        if (nloc == 0u) { xcd_barrier_complete(bar, b.x, nloc, nx); b.st[0] = nloc; b.st[1] = nx; }
        const unsigned old = xb_add(&bar[XB_XSUB(b.x)], 1u);
        const unsigned gen = old / nloc;
        if (old + 1u == (gen + 1u) * nloc) {
            __builtin_amdgcn_fence(__ATOMIC_RELEASE, "agent");
            asm volatile("s_waitcnt vmcnt(0)" ::: "memory");
            const unsigned og = xb_add(&bar[XB_TOP], 1u);
            const unsigned tg = og / nx;
            if (og + 1u == (tg + 1u) * nx) xb_add(&bar[XB_TOPGEN], 1u);
            else XB_SPIN(xb_ld(&bar[XB_TOPGEN]) == tg, bar);
            __builtin_amdgcn_fence(__ATOMIC_ACQUIRE, "agent");
            xb_add(&bar[XB_XGEN(b.x)], 1u);
            asm volatile("s_waitcnt vmcnt(0)" ::: "memory");
        } else {
            XB_SPIN(xb_ld(&bar[XB_XGEN(b.x)]) == gen, bar);
            __builtin_amdgcn_fence(__ATOMIC_ACQUIRE, "agent");
            asm volatile("s_waitcnt vmcnt(0)" ::: "memory");
        }
    }
    __syncthreads();
}

__device__ __forceinline__ void p0_transpose_item(const float* W, int Nsrc, int K, int kb, int src_col0, bf16_t* WT, int dst_row0, LAS float* scr, int lane, const float* kscale = nullptr) {
    const int k0 = 64 * kb;
#pragma unroll 8
    for (int i = 0; i < 32; ++i) { const int kk = 2 * i + (lane >> 5); float wv = W[(size_t)(k0 + kk) * Nsrc + src_col0 + (lane & 31)]; if (kscale) wv *= kscale[k0 + kk]; scr[kk * 33 + (lane & 31)] = wv; }
    LDS_WAIT(); asm volatile("" ::: "memory");
    const int c = lane & 7;
#pragma unroll
    for (int j = 0; j < 4; ++j) { const int n = (lane >> 3) + 8 * j; const LAS float* s = scr + (8 * c) * 33 + n;
        u32x4 o; o.x = cvt_pk_bf16(s[0 * 33], s[1 * 33]); o.y = cvt_pk_bf16(s[2 * 33], s[3 * 33]); o.z = cvt_pk_bf16(s[4 * 33], s[5 * 33]); o.w = cvt_pk_bf16(s[6 * 33], s[7 * 33]);
        *(u32x4*)(WT + (size_t)(dst_row0 + n) * K + k0 + 8 * c) = o; }
    LDS_WAIT(); asm volatile("" ::: "memory");
}
__device__ __forceinline__ void rms_row_to_bf16(const float* xrow, const float* g, bf16_t* orow, int lane, f32x4 (&v)[4]) {
    const f32x4* xr = (const f32x4*)xrow + lane; float s = 0.f;
#pragma unroll
    for (int j = 0; j < 4; ++j) { v[j] = xr[64 * j]; s += (v[j].x * v[j].x + v[j].y * v[j].y) + (v[j].z * v[j].z + v[j].w * v[j].w); }
    const float rstd = rsqrtf(wave_sum(s) * (1.f / DM) + EPS);
    u32x2* o8 = (u32x2*)orow + lane;
#pragma unroll
    for (int j = 0; j < 4; ++j) { const f32x4 gv = *((const f32x4*)g + lane + 64 * j); v[j] = v[j] * rstd * gv; u32x2 pk; pk.x = cvt_pk_bf16(v[j].x, v[j].y); pk.y = cvt_pk_bf16(v[j].z, v[j].w); o8[64 * j] = pk; }
}

__device__ __forceinline__ void p0_prologue(Frame& F) {
    const Args& A = *F.a;
    LAS float* scr = (LAS float*)(F.lds + F.wave * 8448);
    LAS float* sG = (LAS float*)(F.lds + 67584);
    for (int k = F.tid; k < DM; k += 512) { const f32x4 w0 = *(const f32x4*)(A.in[I_WIN] + (size_t)k * INW + 2048), w1 = *(const f32x4*)(A.in[I_WIN] + (size_t)k * INW + 2052);
        sG[0 * DM + k] = w0.x; sG[1 * DM + k] = w0.y; sG[2 * DM + k] = w0.z; sG[3 * DM + k] = w0.w; sG[4 * DM + k] = w1.x; sG[5 * DM + k] = w1.y; sG[6 * DM + k] = w1.z; sG[7 * DM + k] = w1.w; }
    __syncthreads();
    const int gw = F.vcu * 8 + F.wave, NGW = F.G * 8;
    constexpr int KB = DM / 64;
    constexpr int I_IN = KB * (NZ / 32), I_SQ = KB * (DM / 32);
    constexpr int NITEMS = I_IN + 5 * I_SQ;
    bf16_t* WinT = (bf16_t*)(F.ws + WS_WIN); bf16_t* WoutT = (bf16_t*)(F.ws + WS_WOUT); bf16_t* WkvT = (bf16_t*)(F.ws + WS_WKV); bf16_t* WcoT = (bf16_t*)(F.ws + WS_WCO); bf16_t* WpqT = (bf16_t*)(F.ws + WS_WPQ);
    for (int it = gw; it < NITEMS; it += NGW) {
        int r = it;
        if (r < I_IN) { const int kb = r / (NZ / 32), nb = r % (NZ / 32), n0 = nb * 32; p0_transpose_item(A.in[I_WIN], INW, DM, kb, n0 + (n0 >= 2048 ? 8 : 0), WinT, n0, scr, F.lane); continue; } r -= I_IN;
        const int which = r / I_SQ; r -= which * I_SQ; const int kb = r / (DM / 32), n0 = (r % (DM / 32)) * 32;
        if (which == 0) p0_transpose_item(A.in[I_WOUT], DM, DM, kb, n0, WoutT, n0, scr, F.lane);
        else if (which == 1) p0_transpose_item(A.in[I_WCK], DM, DM, kb, n0, WkvT, n0, scr, F.lane);
        else if (which == 2) p0_transpose_item(A.in[I_WCV], DM, DM, kb, n0, WkvT, DM + n0, scr, F.lane);
        else if (which == 3) p0_transpose_item(A.in[I_WCO], DM, DM, kb, n0, WcoT, n0, scr, F.lane);
        else p0_transpose_item(A.in[I_WPQ], DM, DM, kb, n0, WpqT, n0, scr, F.lane, A.in[I_GFFN]);
    }
    {
        const int gt = F.vcu * 512 + F.tid, NT = F.G * 512;
        const f32x4* s0 = (const f32x4*)A.in[I_WCQ]; u32x2* d0 = (u32x2*)(F.ws + WS_WCQ);
        for (int i = gt; i < DM * DM / 4; i += NT) { const f32x4 v = s0[i]; u32x2 pk; pk.x = cvt_pk_bf16(v.x, v.y); pk.y = cvt_pk_bf16(v.z, v.w); d0[i] = pk; }
        const f32x4* s1 = (const f32x4*)A.in[I_SUBK]; u32x2* d1 = (u32x2*)(F.ws + WS_SK);
        for (int i = gt; i < 16 * 128 * 64 / 4; i += NT) { const f32x4 v = s1[i]; u32x2 pk; pk.x = cvt_pk_bf16(v.x, v.y); pk.y = cvt_pk_bf16(v.z, v.w); d1[i] = pk; }
    }
    {
        bf16_t* HN = (bf16_t*)(F.ws + WS_BUFA); float* GT = (float*)(F.ws + WS_GATES);
        for (int m = gw; m < T_TOK; m += NGW) {
            f32x4 v[4]; rms_row_to_bf16(A.in[I_X] + (size_t)m * DM, A.in[I_GMIX], HN + (size_t)m * DM, F.lane, v);
            float gacc[8];
#pragma unroll
            for (int j = 0; j < 8; ++j) gacc[j] = 0.f;
#pragma unroll
            for (int jj = 0; jj < 4; ++jj)
#pragma unroll
                for (int j = 0; j < 8; ++j) { const f32x4 wv = *(const LAS f32x4*)(sG + j * DM + 4 * F.lane + 256 * jj); gacc[j] += (v[jj].x * wv.x + v[jj].y * wv.y) + (v[jj].z * wv.z + v[jj].w * wv.w); }
            float r4[4], r2[2], r1;
            { const bool hi = (F.lane & 32) != 0;
#pragma unroll
              for (int i = 0; i < 4; ++i) { const float keep = hi ? gacc[i + 4] : gacc[i], send = hi ? gacc[i] : gacc[i + 4]; r4[i] = keep + __shfl_xor(send, 32); } }
            { const bool hi = (F.lane & 16) != 0;
#pragma unroll
              for (int i = 0; i < 2; ++i) { const float keep = hi ? r4[i + 2] : r4[i], send = hi ? r4[i] : r4[i + 2]; r2[i] = keep + __shfl_xor(send, 16); } }
            { const bool hi = (F.lane & 8) != 0; const float keep = hi ? r2[1] : r2[0], send = hi ? r2[0] : r2[1]; r1 = keep + __shfl_xor(send, 8); }
            r1 += __shfl_xor(r1, 4); r1 += __shfl_xor(r1, 2); r1 += __shfl_xor(r1, 1);
            if ((F.lane & 7) == 0) GT[(size_t)m * 8 + 4 * (F.lane >> 5) + 2 * ((F.lane >> 4) & 1) + ((F.lane >> 3) & 1)] = r1;
        }
        bf16_t* MN = (bf16_t*)(F.ws + WS_MEMN);
        for (int m = gw; m < TMEM; m += NGW) { f32x4 v[4]; rms_row_to_bf16(A.in[I_MEM] + (size_t)m * DM, A.in[I_GMEM], MN + (size_t)m * DM, F.lane, v); }
    }
}
#ifndef AT_DEPTH
#define AT_DEPTH 3
#endif
constexpr int AT_STAGE = 32768, AT_NST = 4;
__device__ __forceinline__ int swzf(int r) { return ((r & 3) << 2) | ((r >> 2) & 3); }

__device__ __forceinline__ void glds16_asm(const void* gsrc, unsigned lds_dst) {
    unsigned keep;
    asm volatile("s_mov_b32 %0, m0\n\ts_mov_b32 m0, %2\n\ts_nop 0\n\tglobal_load_lds_dwordx4 %1, off\n\ts_mov_b32 m0, %0" : "=&s"(keep) : "v"(gsrc), "s"(lds_dst) : "memory");
}

__device__ __forceinline__ s16x4 tr16(const LAS unsigned char* p) { return __builtin_amdgcn_ds_read_tr16_b64_v4i16((LAS s16x4*)p); }
__device__ __forceinline__ bf16x8 cat8(s16x4 lo, s16x4 hi) { return __builtin_shufflevector(lo, hi, 0, 1, 2, 3, 4, 5, 6, 7); }

template <int MODE>
__device__ __forceinline__ void attn_unit(Frame& F, const int b, const int h, const int qt, const float lam) {
    const Args& A = *F.a;
    const bf16_t* Z = (const bf16_t*)(F.ws + WS_Z);
    bf16_t* CAT = (bf16_t*)(F.ws + WS_BUFA);
    LAS unsigned char* lds = F.lds;
    int tid_l = F.tid; asm volatile("" : "+v"(tid_l));
    const int tid = tid_l, lane = tid & 63, w = F.wave, c = w & 1, qb = w >> 1, n = lane & 31, h2 = lane >> 5;
    const int q0 = qt * 128, r0 = q0 + 32 * qb, ntiles = 2 * qt + 2;
    const size_t rowbase = (size_t)b * SEQ;
    const float slope2 = __uint_as_float((unsigned)(127 - 2 * (h + 1)) << 23) * LOG2E, c1 = 0.125f * LOG2E;
    const float slope_hi = __uint_as_float(__float_as_uint(slope2) & 0xffff0000u), slope_lo = slope2 - slope_hi;
    bf16x8 Qf[4];
    { const bf16_t* qp = Z + (rowbase + r0 + n) * NZ + ZC_DAQ + h * 128 + c * 64 + 8 * h2;
#pragma unroll
      for (int kk = 0; kk < 4; ++kk) { const u32x4 q4_ = *(const u32x4*)(qp + 16 * kk); u32x4 o_;
          o_.x = cvt_pk_bf16(bf_lo(q4_.x) * c1, bf_hi(q4_.x) * c1); o_.y = cvt_pk_bf16(bf_lo(q4_.y) * c1, bf_hi(q4_.y) * c1); o_.z = cvt_pk_bf16(bf_lo(q4_.z) * c1, bf_hi(q4_.z) * c1); o_.w = cvt_pk_bf16(bf_lo(q4_.w) * c1, bf_hi(q4_.w) * c1);
          Qf[kk] = __builtin_bit_cast(bf16x8, o_); } }
    bf16x8 Qx, Kx[2];
    { u32x4 o_ = (u32x4){0u, 0u, 0u, 0u}; if (h2 == 0) o_.x = cvt_pk_bf16(slope_hi, slope_lo); Qx = __builtin_bit_cast(bf16x8, o_);
#pragma unroll
      for (int kb = 0; kb < 2; ++kb) { u32x4 k_ = (u32x4){0u, 0u, 0u, 0u}; if (h2 == 0) k_.x = cvt_pk_bf16((float)(32 * kb + n), (float)(32 * kb + n)); Kx[kb] = __builtin_bit_cast(bf16x8, k_); } }
    f32x16 O[4];
#pragma unroll
    for (int i = 0; i < 4; ++i)
#pragma unroll
        for (int j = 0; j < 16; ++j) O[i][j] = 0.f;
    float mrun = -3.0e38f, lsum = 0.f;
    const unsigned ldsbase = (unsigned)(size_t)lds;
#define AT_DMA(j_) do { if (MODE & 2) break; const int jj_ = (j_) < ntiles ? (j_) : ntiles - 1; \
        _Pragma("unroll") for (int m_ = 0; m_ < 4; ++m_) { const int i_ = w + 8 * m_, r_ = 4 * (i_ & 15) + (lane >> 4), gch_ = (lane & 15) ^ swzf(r_); \
            const bf16_t* src_ = Z + (rowbase + 64 * jj_ + r_) * NZ + ((i_ >= 16) ? ZC_DAV : ZC_DAK) + h * 128 + 8 * gch_; \
            glds16_asm(src_, ldsbase + (unsigned)(((j_) & 3) * AT_STAGE + i_ * 1024)); } } while (0)
#if AT_DEPTH == 3
    AT_DMA(0); AT_DMA(1); AT_DMA(2);
    asm volatile("s_waitcnt vmcnt(4)" ::: "memory");
#else
    AT_DMA(0); AT_DMA(1);
    VM_WAIT();
#endif
    __syncthreads();
    const int i16 = lane & 15, q4 = i16 >> 2, p4 = i16 & 3, blk = (lane >> 4) & 1;
#define AT_QK(S_, j_) do { const LAS unsigned char* Ks_ = lds + ((j_) & 3) * AT_STAGE; bf16x8 kf_[8]; \
        _Pragma("unroll") for (int kb = 0; kb < 2; ++kb) _Pragma("unroll") for (int kk = 0; kk < 4; ++kk) kf_[4 * kb + kk] = *(const LAS bf16x8*)(Ks_ + (32 * kb + n) * 256 + (((8 * c + 2 * kk + h2) ^ swzf(n)) << 4)); \
        _Pragma("unroll") for (int e = 0; e < 16; ++e) { (S_)[0][e] = 0.f; (S_)[1][e] = 0.f; } \
        _Pragma("unroll") for (int kb = 0; kb < 2; ++kb) { _Pragma("unroll") for (int kk = 0; kk < 4; ++kk) (S_)[kb] = __builtin_amdgcn_mfma_f32_32x32x16_bf16(kf_[4 * kb + kk], Qf[kk], (S_)[kb], 0, 0, 0); \
            (S_)[kb] = __builtin_amdgcn_mfma_f32_32x32x16_bf16(Kx[kb], Qx, (S_)[kb], 0, 0, 0); } } while (0)
#define AT_LOADV(buf_, dvb_) do { _Pragma("unroll") for (int kb = 0; kb < 2; ++kb) _Pragma("unroll") for (int s = 0; s < 2; ++s) { const int ch_ = 4 * (dvb_) + 2 * blk + (p4 >> 1); \
        const LAS unsigned char* vp = Vs + (32 * kb + 16 * s + 4 * h2 + q4) * 256 + 8 * (p4 & 1); \
        (buf_)[2 * kb + s] = cat8(tr16(vp + ((ch_ ^ swzf(4 * h2 + q4)) << 4)), tr16(vp + 8 * 256 + ((ch_ ^ swzf(8 + 4 * h2 + q4)) << 4))); } } while (0)
#define AT_PV(buf_, dvb_) do { _Pragma("unroll") for (int e = 0; e < 16; ++e) O[dvb_][e] *= alpha; \
        _Pragma("unroll") for (int kb = 0; kb < 2; ++kb) _Pragma("unroll") for (int s = 0; s < 2; ++s) O[dvb_] = __builtin_amdgcn_mfma_f32_32x32x16_bf16((buf_)[2 * kb + s], Pf[kb][s], O[dvb_], 0, 0, 0); } while (0)
#define AT_TILE(Sc_, Sn_, j_) do { \
        AT_DMA((j_) + AT_DEPTH); \
        const int k0 = 64 * (j_); \
        if (!(MODE & 1) && k0 <= r0 + 31) { \
            const LAS unsigned char* Vs = lds + ((j_) & 3) * AT_STAGE + 16384; \
            bf16x8 va[4], vb[4]; \
            if ((j_) + 1 < ntiles && k0 + 64 <= r0 + 31) AT_QK(Sn_, (j_) + 1); \
            AT_LOADV(va, 0); \
            const float D0 = (float)(r0 + n - k0 - 4 * h2); \
            const float tcon = slope2 * (float)(k0 - r0 - n);            \
            float mloc = -3.0e38f; \
            if (k0 + 63 > r0) { \
                _Pragma("unroll") for (int kb = 0; kb < 2; ++kb) _Pragma("unroll") for (int e = 0; e < 16; ++e) { const float off = (float)(32 * kb + (e & 3) + 8 * (e >> 2)); \
                    const float v = (off > D0) ? -INFINITY : (Sc_)[kb][e]; (Sc_)[kb][e] = v; mloc = fmaxf(mloc, v); } \
            } else { \
                _Pragma("unroll") for (int kb = 0; kb < 2; ++kb) _Pragma("unroll") for (int e = 0; e < 16; ++e) mloc = fmaxf(mloc, (Sc_)[kb][e]); \
            } \
            mloc = fmaxf(mloc, __shfl_xor(mloc, 32)) + tcon; \
            const float mnew = fmaxf(mrun, mloc), alpha = fast_exp2(mrun - mnew); \
            mrun = mnew; \
            const float mm = mnew - tcon; \
            float ps = 0.f; \
            _Pragma("unroll") for (int kb = 0; kb < 2; ++kb) _Pragma("unroll") for (int e = 0; e < 16; ++e) { const float pv = fast_exp2((Sc_)[kb][e] - mm); (Sc_)[kb][e] = pv; ps += pv; } \
            lsum = lsum * alpha + ps; \
            bf16x8 Pf[2][2]; \
            _Pragma("unroll") for (int kb = 0; kb < 2; ++kb) _Pragma("unroll") for (int s = 0; s < 2; ++s) { u32x4 pk; pk.x = cvt_pk_bf16((Sc_)[kb][8 * s + 0], (Sc_)[kb][8 * s + 1]); pk.y = cvt_pk_bf16((Sc_)[kb][8 * s + 2], (Sc_)[kb][8 * s + 3]); \
                pk.z = cvt_pk_bf16((Sc_)[kb][8 * s + 4], (Sc_)[kb][8 * s + 5]); pk.w = cvt_pk_bf16((Sc_)[kb][8 * s + 6], (Sc_)[kb][8 * s + 7]); Pf[kb][s] = __builtin_bit_cast(bf16x8, pk); } \
            AT_LOADV(vb, 1); AT_PV(va, 0); \
            AT_LOADV(va, 2); AT_PV(vb, 1); \
            AT_LOADV(vb, 3); AT_PV(va, 2); \
            AT_PV(vb, 3); \
        } \
        if (AT_DEPTH == 3) asm volatile("s_waitcnt vmcnt(4)" ::: "memory"); else asm volatile("s_waitcnt vmcnt(0)" ::: "memory"); \
        __syncthreads(); } while (0)
    f32x16 SA[2], SB[2];
    AT_QK(SA, 0);
    for (int j = 0; j < ntiles; j += 2) { AT_TILE(SA, SB, j); AT_TILE(SB, SA, j + 1); }
#undef AT_TILE
#undef AT_PV
#undef AT_LOADV
#undef AT_QK
    VM_WAIT();
    __syncthreads();
    { const float lt = lsum + __shfl_xor(lsum, 32); const float inv = (c == 0 ? 1.0f : lam) / lt;
#pragma unroll
      for (int dvb = 0; dvb < 4; ++dvb)
#pragma unroll
          for (int e = 0; e < 16; ++e) O[dvb][e] *= inv; }
    LAS float* cb = (LAS float*)lds + qb * 4096;
    if (c == 1) {
#pragma unroll
        for (int dvb = 0; dvb < 4; ++dvb)
#pragma unroll
            for (int e = 0; e < 16; ++e) cb[(dvb * 16 + e) * 64 + lane] = O[dvb][e];
    }
    __syncthreads();
    if (c == 0 && MODE == 0) {
        float ss = 0.f;
#pragma unroll
        for (int dvb = 0; dvb < 4; ++dvb)
#pragma unroll
            for (int e = 0; e < 16; ++e) { const float o = O[dvb][e] - cb[(dvb * 16 + e) * 64 + lane]; O[dvb][e] = o; ss += o * o; }
        ss += __shfl_xor(ss, 32);
        const float rstd = rsqrtf(ss * (1.0f / 128.0f) + EPS) * 0.8f;
        const float* g = A.in[I_GDA] + h * 128;
        bf16_t* op = CAT + (rowbase + r0 + n) * DM + 512 + h * 128;
#pragma unroll
        for (int dvb = 0; dvb < 4; ++dvb)
#pragma unroll
            for (int e4 = 0; e4 < 4; ++e4) { const int dv = 32 * dvb + 8 * e4 + 4 * h2; const f32x4 gv = *(const f32x4*)(g + dv);
                u32x2 pk; pk.x = cvt_pk_bf16(O[dvb][4 * e4 + 0] * rstd * gv.x, O[dvb][4 * e4 + 1] * rstd * gv.y); pk.y = cvt_pk_bf16(O[dvb][4 * e4 + 2] * rstd * gv.z, O[dvb][4 * e4 + 3] * rstd * gv.w);
                *(u32x2*)(op + dv) = pk; }
    }
    __syncthreads();
#undef AT_DMA
}
__device__ __forceinline__ void conv_prepass(Frame& F) {
    const Args& A = *F.a;
    const bf16_t* Z = (const bf16_t*)(F.ws + WS_Z);
    bf16_t* QKC = (bf16_t*)(F.ws + WS_BUFB);
    const int gt = F.vcu * 512 + F.tid, NT = F.G * 512;
    for (int it = gt; it < (T_TOK / 4) * 128; it += NT) {
        const int cg = it & 127, rb = it >> 7, row0 = 4 * rb, tl = row0 & (SEQ - 1), c0 = 8 * cg;
        float cw[4][8];
#pragma unroll
        for (int tp = 0; tp < 4; ++tp) { const f32x4 w0 = *(const f32x4*)(A.in[I_CONVW] + tp * 1024 + c0), w1 = *(const f32x4*)(A.in[I_CONVW] + tp * 1024 + c0 + 4);
            cw[tp][0] = w0.x; cw[tp][1] = w0.y; cw[tp][2] = w0.z; cw[tp][3] = w0.w; cw[tp][4] = w1.x; cw[tp][5] = w1.y; cw[tp][6] = w1.z; cw[tp][7] = w1.w; }
        u32x4 raw[7];
#pragma unroll
        for (int i = 0; i < 7; ++i) raw[i] = (tl - 3 + i >= 0) ? *(const u32x4*)(Z + (size_t)(row0 - 3 + i) * NZ + c0) : (u32x4){0u, 0u, 0u, 0u};
        const float ksc = (c0 >= 512) ? 0.08838834764831845f : 1.0f;
#pragma unroll
        for (int r = 0; r < 4; ++r) {
            float y[8];
#pragma unroll
            for (int ch = 0; ch < 8; ++ch) y[ch] = 0.f;
#pragma unroll
            for (int tp = 0; tp < 4; ++tp) { const u32x4 rv = raw[r + tp];
                y[0] += cw[tp][0] * bf_lo(rv.x); y[1] += cw[tp][1] * bf_hi(rv.x); y[2] += cw[tp][2] * bf_lo(rv.y); y[3] += cw[tp][3] * bf_hi(rv.y);
                y[4] += cw[tp][4] * bf_lo(rv.z); y[5] += cw[tp][5] * bf_hi(rv.z); y[6] += cw[tp][6] * bf_lo(rv.w); y[7] += cw[tp][7] * bf_hi(rv.w); }
#pragma unroll
            for (int ch = 0; ch < 8; ++ch) y[ch] = y[ch] * fast_rcp(1.0f + __expf(-y[ch])) * ksc;
            u32x4 pk; pk.x = cvt_pk_bf16(y[0], y[1]); pk.y = cvt_pk_bf16(y[2], y[3]); pk.z = cvt_pk_bf16(y[4], y[5]); pk.w = cvt_pk_bf16(y[6], y[7]);
            *(u32x4*)(QKC + (size_t)(row0 + r) * DM + c0) = pk;
        }
    }
}

#ifndef ML_TOUCH
#define ML_TOUCH 0
#endif
constexpr int ML_TB = 49152;
constexpr int ML_HB = 2 * ML_TB;
constexpr int ML_HP = 132;
constexpr int ML_SC = ML_HB + 64 * ML_HP * 4;

#define MFMA16(a, b, c) __builtin_amdgcn_mfma_f32_16x16x32_bf16((a), (b), (c), 0, 0, 0)

__device__ __forceinline__ void mlstm_unit(Frame& F, const int b, const int h) {
    const Args& A = *F.a;
    const bf16_t* Z = (const bf16_t*)(F.ws + WS_Z);
    const bf16_t* QKC = (const bf16_t*)(F.ws + WS_BUFB);
    const float* GT = (const float*)(F.ws + WS_GATES);
    bf16_t* CAT = (bf16_t*)(F.ws + WS_BUFA);
    LAS unsigned char* lds = F.lds;
    int tid_l = F.tid; asm volatile("" : "+v"(tid_l));
    const int tid = tid_l, lane = tid & 63, w = F.wave, n = lane & 15, g = lane >> 4, q4 = n >> 2, p4 = n & 3;
    const size_t rowbase = (size_t)b * SEQ;
    LAS float* sc = (LAS float*)(lds + ML_SC);
    LAS float* sA = sc; LAS float* sM = sc + 128; LAS float* sInter = sc + 256; LAS float* sMt = sc + 384; LAS float* sW = sc + 512; LAS float* sDi = sc + 640; LAS float* sQn = sc + 704; LAS float* sN = sc + 768;
    if (tid < 128) sN[tid] = 0.f;
    const unsigned ldsbase = (unsigned)(size_t)lds;
    const float bi = A.in[I_BI][h], bfg = A.in[I_BF][h];
    float gi_r, gf_r;
#define ML_DMA(cc, par_) do { const int t0_ = 64 * (cc); \
        _Pragma("unroll") for (int m_ = 0; m_ < 6; ++m_) { const int i_ = w + 8 * m_, tile_ = i_ >> 4, r_ = 4 * (i_ & 15) + (lane >> 4), gch_ = (lane & 15) ^ swzf(r_); \
            const bf16_t* src_ = (tile_ == 2) ? (Z + (rowbase + t0_ + r_) * NZ + ZC_MLV + 128 * h + 8 * gch_) : (QKC + (rowbase + t0_ + r_) * DM + 512 * tile_ + 128 * h + 8 * gch_); \
            glds16_asm(src_, ldsbase + (unsigned)((par_) * ML_TB + i_ * 1024)); } } while (0)
#define ML_GATES(cc) do { gi_r = GT[(rowbase + 64 * (cc) + lane) * 8 + h]; gf_r = GT[(rowbase + 64 * (cc) + lane) * 8 + 4 + h]; } while (0)
    float m_st = 0.f, decay_c = 1.f;
#define ML_SCALARS(par_) do { \
        const float gi = gi_r + bi, gfv = gf_r + bfg; \
        const float lf = fminf(gfv, 0.f) - __logf(1.0f + __expf(-fabsf(gfv))); \
        float bc = lf; \
        _Pragma("unroll") for (int o = 1; o < 64; o <<= 1) { const float t_ = __shfl_up(bc, o); if (lane >= o) bc += t_; } \
        const float av = gi - bc; float pm = av; \
        _Pragma("unroll") for (int o = 1; o < 64; o <<= 1) { const float t_ = __shfl_up(pm, o); if (lane >= o) pm = fmaxf(pm, t_); } \
        const float Mv = fmaxf(m_st, pm), inter = __expf(m_st - Mv), mt = bc + Mv; \
        const float M63 = __shfl(Mv, 63), bc63 = __shfl(bc, 63); \
        const float wg = __expf(av - M63); \
        decay_c = __shfl(inter, 63); m_st = bc63 + M63; \
        if (w == 0) { sA[(par_) * 64 + lane] = av; sM[(par_) * 64 + lane] = Mv; sInter[(par_) * 64 + lane] = inter; sMt[(par_) * 64 + lane] = mt; sW[(par_) * 64 + lane] = wg; } \
    } while (0)

    f32x4 Cacc[8];
#pragma unroll
    for (int dt = 0; dt < 8; ++dt) Cacc[dt] = (f32x4){0.f, 0.f, 0.f, 0.f};
    ML_GATES(0);
    ML_DMA(0, 0);
    ML_SCALARS(0);
    VM_WAIT(); LDS_WAIT();
    __syncthreads();
    const float* gml = A.in[I_GML] + 128 * h;
    const int e0 = 16 * w;
    unsigned touch = 0u;
#pragma unroll 1
    for (int c = 0; c < 32; ++c) {
        const float decay = decay_c; const int par = c & 1;
        const LAS unsigned char* TQ = lds + par * ML_TB; const LAS unsigned char* TK = TQ + 16384; const LAS unsigned char* TV = TQ + 32768;
        if (c + 1 < 32) { ML_DMA(c + 1, par ^ 1); ML_GATES(c + 1); }
        const int nrow = tid >> 3, nseg = tid & 7;
        { const int rr = 8 * w + (lane >> 3), seg = lane & 7, x = swzf(rr);
          const u32x4 qa = *(const LAS u32x4*)(TQ + rr * 256 + (((2 * seg) ^ x) << 4)), qb = *(const LAS u32x4*)(TQ + rr * 256 + (((2 * seg + 1) ^ x) << 4));
          const f32x4 n0 = *(const LAS f32x4*)(sN + 16 * seg), n1 = *(const LAS f32x4*)(sN + 16 * seg + 4), n2 = *(const LAS f32x4*)(sN + 16 * seg + 8), n3 = *(const LAS f32x4*)(sN + 16 * seg + 12);
          float d = bf_lo(qa.x) * n0.x + bf_hi(qa.x) * n0.y + bf_lo(qa.y) * n0.z + bf_hi(qa.y) * n0.w + bf_lo(qa.z) * n1.x + bf_hi(qa.z) * n1.y + bf_lo(qa.w) * n1.z + bf_hi(qa.w) * n1.w
                  + bf_lo(qb.x) * n2.x + bf_hi(qb.x) * n2.y + bf_lo(qb.y) * n2.z + bf_hi(qb.y) * n2.w + bf_lo(qb.z) * n3.x + bf_hi(qb.z) * n3.y + bf_lo(qb.w) * n3.z + bf_hi(qb.w) * n3.w;
          d += __shfl_xor(d, 1); d += __shfl_xor(d, 2); d += __shfl_xor(d, 4);
          if (seg == 0) sQn[rr] = d; }
        bf16x8 Vf[2], Cf[4];
#pragma unroll
        for (int ks = 0; ks < 2; ++ks) {
            const LAS unsigned char* vp = TV + (32 * ks + 4 * g + q4) * 256 + (((2 * w + (p4 >> 1)) ^ swzf(4 * g + q4)) << 4) + 8 * (p4 & 1);
            Vf[ks] = cat8(tr16(vp), tr16(vp + 16 * 256));
        }
#pragma unroll
        for (int kd = 0; kd < 4; ++kd) { const f32x4 c0 = Cacc[2 * kd], c1 = Cacc[2 * kd + 1]; u32x4 pk; pk.x = cvt_pk_bf16(c0[0], c0[1]); pk.y = cvt_pk_bf16(c0[2], c0[3]); pk.z = cvt_pk_bf16(c1[0], c1[1]); pk.w = cvt_pk_bf16(c1[2], c1[3]); Cf[kd] = __builtin_bit_cast(bf16x8, pk); }
#pragma unroll 1
        for (int lb = 0; lb < 4; ++lb) {
            u32x4 pk[2]; pk[0] = (u32x4){0u, 0u, 0u, 0u}; pk[1] = (u32x4){0u, 0u, 0u, 0u};
            float di = 0.f;
            const LAS unsigned char* qrow = TQ + (16 * lb + n) * 256;
            {
                bf16x8 Qf[4];
#pragma unroll
                for (int kk = 0; kk < 4; ++kk) Qf[kk] = *(const LAS bf16x8*)(qrow + (((4 * kk + g) ^ swzf(n)) << 4));
                const float Ml = sM[par * 64 + 16 * lb + n];
#pragma unroll
                for (int sb = 0; sb < 4; ++sb) if (sb <= lb) {
                    f32x4 acc = (f32x4){0.f, 0.f, 0.f, 0.f};
#pragma unroll
                    for (int kk = 0; kk < 4; ++kk) { const bf16x8 kf = *(const LAS bf16x8*)(TK + (16 * sb + n) * 256 + (((4 * kk + g) ^ swzf(n)) << 4)); acc = MFMA16(kf, Qf[kk], acc); }
                    const f32x4 av4 = *(const LAS f32x4*)(sA + par * 64 + 16 * sb + 4 * g);
                    float pv[4];
#pragma unroll
                    for (int r = 0; r < 4; ++r) { float e = acc[r] * fast_exp2((av4[r] - Ml) * LOG2E); if (sb == lb && (4 * g + r > n)) e = 0.f; pv[r] = e; di += e; }
                    const unsigned u0 = cvt_pk_bf16(pv[0], pv[1]), u1 = cvt_pk_bf16(pv[2], pv[3]);
                    if ((sb & 1) == 0) { pk[sb >> 1].x = u0; pk[sb >> 1].y = u1; } else { pk[sb >> 1].z = u0; pk[sb >> 1].w = u1; }
                }
            }
            di += __shfl_xor(di, 16); di += __shfl_xor(di, 32);
            if (w == 0 && g == 0) sDi[16 * lb + n] = di;
            f32x4 numI = (f32x4){0.f, 0.f, 0.f, 0.f}, accI = (f32x4){0.f, 0.f, 0.f, 0.f};
            numI = MFMA16(__builtin_bit_cast(bf16x8, pk[0]), Vf[0], numI);
            if (lb >= 2) numI = MFMA16(__builtin_bit_cast(bf16x8, pk[1]), Vf[1], numI);
#pragma unroll
            for (int kd = 0; kd < 4; ++kd) { const s16x4 lo = *(const LAS s16x4*)(qrow + (((4 * kd + (g >> 1)) ^ swzf(n)) << 4) + 8 * (g & 1)), hi = *(const LAS s16x4*)(qrow + (((4 * kd + 2 + (g >> 1)) ^ swzf(n)) << 4) + 8 * (g & 1));
                accI = MFMA16(cat8(lo, hi), Cf[kd], accI); }
            const f32x4 in4 = *(const LAS f32x4*)(sInter + par * 64 + 16 * lb + 4 * g);
#pragma unroll
            for (int r = 0; r < 4; ++r) *(LAS float*)(lds + ML_HB + ((16 * lb + 4 * g + r) * ML_HP + e0 + n) * 4) = numI[r] + in4[r] * accI[r];
            asm volatile("" ::: "memory");
        }
        const u32x4 og0 = *(const u32x4*)(Z + (rowbase + 64 * c + nrow) * NZ + ZC_MLO + 128 * h + 16 * nseg), og1 = *(const u32x4*)(Z + (rowbase + 64 * c + nrow) * NZ + ZC_MLO + 128 * h + 16 * nseg + 8);
        bf16x8 Vw[2], Wf[2];
#pragma unroll
        for (int ks = 0; ks < 2; ++ks) {
            const f32x4 wl = *(const LAS f32x4*)(sW + par * 64 + 32 * ks + 4 * g), wh = *(const LAS f32x4*)(sW + par * 64 + 32 * ks + 16 + 4 * g);
            const u32x4 v4 = __builtin_bit_cast(u32x4, Vf[ks]);
            u32x4 pw; pw.x = cvt_pk_bf16(bf_lo(v4.x) * wl.x, bf_hi(v4.x) * wl.y); pw.y = cvt_pk_bf16(bf_lo(v4.y) * wl.z, bf_hi(v4.y) * wl.w); pw.z = cvt_pk_bf16(bf_lo(v4.z) * wh.x, bf_hi(v4.z) * wh.y); pw.w = cvt_pk_bf16(bf_lo(v4.w) * wh.z, bf_hi(v4.w) * wh.w);
            Vw[ks] = __builtin_bit_cast(bf16x8, pw);
            u32x4 pf; pf.x = cvt_pk_bf16(wl.x, wl.y); pf.y = cvt_pk_bf16(wl.z, wl.w); pf.z = cvt_pk_bf16(wh.x, wh.y); pf.w = cvt_pk_bf16(wh.z, wh.w);
            if (n != 0) pf = (u32x4){0u, 0u, 0u, 0u};
            Wf[ks] = __builtin_bit_cast(bf16x8, pf);
        }
        f32x4 cn = (f32x4){0.f, 0.f, 0.f, 0.f};
#pragma unroll
        for (int dt = 0; dt < 8; ++dt) {
            f32x4 cacc = Cacc[dt] * decay;
#pragma unroll
            for (int ks = 0; ks < 2; ++ks) { const LAS unsigned char* kp = TK + (32 * ks + 4 * g + q4) * 256 + (((2 * dt + (p4 >> 1)) ^ swzf(4 * g + q4)) << 4) + 8 * (p4 & 1);
                const bf16x8 kt = cat8(tr16(kp), tr16(kp + 16 * 256)); cacc = MFMA16(kt, Vw[ks], cacc); if (dt == w) cn = MFMA16(kt, Wf[ks], cn); }
            Cacc[dt] = cacc;
        }
        LDS_WAIT();
        __syncthreads();
        if (n == 0) {
#pragma unroll
            for (int r = 0; r < 4; ++r) sN[16 * w + 4 * g + r] = decay * sN[16 * w + 4 * g + r] + cn[r]; }
        {
            const LAS float* hp = (const LAS float*)(lds + ML_HB) + nrow * ML_HP + 16 * nseg;
            f32x4 hv[4]; float ss = 0.f;
#pragma unroll
            for (int i = 0; i < 4; ++i) { hv[i] = *(const LAS f32x4*)(hp + 4 * i); ss += (hv[i].x * hv[i].x + hv[i].y * hv[i].y) + (hv[i].z * hv[i].z + hv[i].w * hv[i].w); }
            ss += __shfl_xor(ss, 1); ss += __shfl_xor(ss, 2); ss += __shfl_xor(ss, 4);
            const float den = sDi[nrow] + sInter[par * 64 + nrow] * sQn[nrow];
            const float dn = fmaxf(fabsf(den), __expf(-sMt[par * 64 + nrow]));
            const float rstd = rsqrtf(ss * (1.0f / 128.0f) + EPS * dn * dn);
            const unsigned ogw[8] = {og0.x, og0.y, og0.z, og0.w, og1.x, og1.y, og1.z, og1.w};
            unsigned outw[8];
#pragma unroll
            for (int i = 0; i < 4; ++i) { const f32x4 gv = *(const f32x4*)(gml + 16 * nseg + 4 * i);
                const float o0 = bf_lo(ogw[2 * i]), o1 = bf_hi(ogw[2 * i]), o2 = bf_lo(ogw[2 * i + 1]), o3 = bf_hi(ogw[2 * i + 1]);
                const float y0 = hv[i].x * rstd * gv.x * fast_rcp(1.0f + __expf(-o0)), y1 = hv[i].y * rstd * gv.y * fast_rcp(1.0f + __expf(-o1));
                const float y2 = hv[i].z * rstd * gv.z * fast_rcp(1.0f + __expf(-o2)), y3 = hv[i].w * rstd * gv.w * fast_rcp(1.0f + __expf(-o3));
                outw[2 * i] = cvt_pk_bf16(y0, y1); outw[2 * i + 1] = cvt_pk_bf16(y2, y3); }
            bf16_t* op = CAT + (rowbase + 64 * c + nrow) * DM + 128 * h + 16 * nseg;
            *(u32x4*)op = (u32x4){outw[0], outw[1], outw[2], outw[3]}; *(u32x4*)(op + 8) = (u32x4){outw[4], outw[5], outw[6], outw[7]};
        }
        if (c + 1 < 32) ML_SCALARS(par ^ 1);
        VM_WAIT(); LDS_WAIT();
#if ML_TOUCH
        asm volatile("" :: "v"(touch));
        if (c + 4 < 32 && tid < 384) { const int tl_ = tid >> 7, r_ = (tid & 127) >> 1, hf_ = tid & 1;
            const bf16_t* p_ = (tl_ == 2) ? (Z + (rowbase + 64 * (c + 4) + r_) * NZ + ZC_MLV + 128 * h + 64 * hf_) : (QKC + (rowbase + 64 * (c + 4) + r_) * DM + 512 * tl_ + 128 * h + 64 * hf_);
            touch = *(const volatile unsigned*)p_; }
#endif
        __syncthreads();
    }
#undef ML_DMA
#undef ML_GATES
#undef ML_SCALARS
}
#ifndef PROBE_HALF
#define PROBE_HALF 0
#endif
#ifndef Q_LPT
#define Q_LPT 0
#endif
#ifndef Q_PAIRED
#define Q_PAIRED 0
#endif
#if Q_PAIRED
#define QN_ATT 64
#else
#define QN_ATT 128
#endif
#ifndef ATT_MODE
#define ATT_MODE 0
#endif
#ifndef REPSUB
#define REPSUB 3
#endif
#ifndef PE_TOUCH
#define PE_TOUCH 0
#endif
#ifndef P7REP
#define P7REP 0
#endif
constexpr size_t WS_US = WS_END;
constexpr int PE_REP = 132;
constexpr int PE_RE = 0, PE_RG = 128 * PE_REP * 2;

__device__ __forceinline__ unsigned enc_f(float f) { const unsigned b = __float_as_uint(f); return b ^ ((unsigned)((int)b >> 31) | 0x80000000u); }
__device__ __forceinline__ float dec_f(unsigned e) { return __uint_as_float(e ^ ((~(unsigned)((int)e >> 31)) | 0x80000000u)); }
__device__ __forceinline__ unsigned umax3(unsigned a, unsigned b, unsigned c) { return max(max(a, b), c); }

#define CE_DESC(x, y) do { const unsigned hi_ = max((x), (y)), lo_ = min((x), (y)); (x) = hi_; (y) = lo_; } while (0)
__device__ __forceinline__ void sort16_desc(unsigned (&a)[16]) {
#pragma unroll
    for (int k = 2; k <= 16; k <<= 1)
#pragma unroll
        for (int j = k >> 1; j > 0; j >>= 1)
#pragma unroll
            for (int i = 0; i < 16; ++i) { const int l = i ^ j; if (l > i) { if ((i & k) == 0) CE_DESC(a[i], a[l]); else CE_DESC(a[l], a[i]); } }
}
__device__ __forceinline__ void bitonic_merge16_desc(unsigned (&a)[16]) {
#pragma unroll
    for (int j = 8; j > 0; j >>= 1)
#pragma unroll
        for (int i = 0; i < 16; ++i) { const int l = i ^ j; if (l > i) CE_DESC(a[i], a[l]); }
}
__device__ __forceinline__ void merge_top16(unsigned (&a)[16], const unsigned (&b)[16]) {
#pragma unroll
    for (int i = 0; i < 16; ++i) a[i] = max(a[i], b[15 - i]);
    bitonic_merge16_desc(a);
}
template <bool PAIR>
__device__ __forceinline__ void top16_of64(const unsigned (&key)[64], unsigned (&top)[16]) {
    unsigned q1[16], q2[16], q3[16];
#pragma unroll
    for (int i = 0; i < 16; ++i) { top[i] = key[i]; q1[i] = key[16 + i]; q2[i] = key[32 + i]; q3[i] = key[48 + i]; }
    sort16_desc(top); sort16_desc(q1); merge_top16(top, q1);
    sort16_desc(q2); sort16_desc(q3); merge_top16(q2, q3);
    merge_top16(top, q2);
    if (PAIR) {
        unsigned o[16];
#pragma unroll
        for (int i = 0; i < 16; ++i) o[i] = (unsigned)__shfl_xor((int)top[i], 32);
        merge_top16(top, o);
    }
}

__device__ __forceinline__ float gelu_exact(float v) { return 0.5f * v * (1.0f + erff(v * 0.70710678118654752f)); }
typedef __bf16 bf16x2_t __attribute__((ext_vector_type(2)));
__device__ __forceinline__ float dot2bf(unsigned a, unsigned b, float c) { return __builtin_amdgcn_fdot2_f32_bf16(__builtin_bit_cast(bf16x2_t, a), __builtin_bit_cast(bf16x2_t, b), c, false); }
__device__ __forceinline__ float dot8(const u32x4 a, const u32x4 b) { return dot2bf(a.x, b.x, dot2bf(a.y, b.y, dot2bf(a.z, b.z, dot2bf(a.w, b.w, 0.f)))); }
__device__ __forceinline__ float dpp_xor1(float v) { return __int_as_float(__builtin_amdgcn_update_dpp(0, __float_as_int(v), 0xB1, 0xF, 0xF, true)); }
__device__ __forceinline__ float dpp_xor2(float v) { return __int_as_float(__builtin_amdgcn_update_dpp(0, __float_as_int(v), 0x4E, 0xF, 0xF, true)); }
__device__ __forceinline__ float dpp_xor4(float v) { const int m = __builtin_amdgcn_update_dpp(0, __float_as_int(v), 0x141, 0xF, 0xF, true); return __int_as_float(__builtin_amdgcn_update_dpp(0, m, 0x1B, 0xF, 0xF, true)); }
__device__ __forceinline__ float reduce8x8(const float (&p)[8], const int j) {
    float r[4], q[2];
#pragma unroll
    for (int i = 0; i < 4; ++i) { const float keep = (j & 4) ? p[i + 4] : p[i], send = (j & 4) ? p[i] : p[i + 4]; r[i] = keep + __shfl_xor(send, 4); }
#pragma unroll
    for (int i = 0; i < 2; ++i) { const float keep = (j & 2) ? r[i + 2] : r[i], send = (j & 2) ? r[i] : r[i + 2]; q[i] = keep + __shfl_xor(send, 2); }
    const float keep = (j & 1) ? q[1] : q[0], send = (j & 1) ? q[0] : q[1];
    return keep + __shfl_xor(send, 1);
}

constexpr size_t WS_VS8 = WS_US + 16 * MiB, WS_SINV = WS_US + 32 * MiB;
__device__ __forceinline__ void peer_convert_rows(Frame& F, const int item) {
    const Args& A = *F.a;
    int lane_l = threadIdx.x & 63; asm volatile("" : "+v"(lane_l));
    const int lane = lane_l;
    float* SINV = (float*)(F.ws + WS_SINV);
    f32x4 gq[4];
    { const float* gp = A.in[I_GFFN] + 16 * lane; gq[0] = *(const f32x4*)gp; gq[1] = *(const f32x4*)(gp + 4); gq[2] = *(const f32x4*)(gp + 8); gq[3] = *(const f32x4*)(gp + 12); }
    for (int it0 = 64 * item + 4 * F.wave; it0 < 64 * item + 64; it0 += 32) {
        f32x4 v[4][4];
#pragma unroll
        for (int r = 0; r < 4; ++r) { const int it = it0 + r, tb = it >> 14, e = it & 16383;
            const float* src = (tb ? A.in[I_PV] : A.in[I_PU]) + (size_t)e * DM + 16 * lane;
#pragma unroll
            for (int q = 0; q < 4; ++q) v[r][q] = *(const f32x4*)(src + 4 * q); }
#pragma unroll
        for (int r = 0; r < 4; ++r) { const int it = it0 + r, tb = it >> 14, e = it & 16383;
            if (tb == 0) {
#pragma unroll
                for (int q = 0; q < 4; ++q) v[r][q] = v[r][q] * gq[q]; }
            float mx = 0.f;
#pragma unroll
            for (int q = 0; q < 4; ++q) mx = fmaxf(mx, fmaxf(fmaxf(fabsf(v[r][q].x), fabsf(v[r][q].y)), fmaxf(fabsf(v[r][q].z), fabsf(v[r][q].w))));
#pragma unroll
            for (int o = 1; o < 64; o <<= 1) mx = fmaxf(mx, __shfl_xor(mx, o));
            int k = (mx > 0.f) ? (int)floorf(log2f(416.0f / mx)) : 0; k = k > 60 ? 60 : (k < -60 ? -60 : k);
            const float sc = exp2f((float)k), sinv = exp2f((float)-k);
            u32x4 o; unsigned ow[4];
#pragma unroll
            for (int q = 0; q < 4; ++q) { int wd = __builtin_amdgcn_cvt_pk_fp8_f32(v[r][q].x * sc, v[r][q].y * sc, 0, false); wd = __builtin_amdgcn_cvt_pk_fp8_f32(v[r][q].z * sc, v[r][q].w * sc, wd, true); ow[q] = (unsigned)wd; }
            o.x = ow[0]; o.y = ow[1]; o.z = ow[2]; o.w = ow[3];
            unsigned char* dst = (unsigned char*)(F.ws + (tb ? WS_VS8 : WS_US)) + ((size_t)(lane >> 3) * 16384 + e) * 128 + 16 * (lane & 7);
            *(u32x4*)dst = o;
            if (lane == 0) SINV[tb * 16384 + e] = sinv;
        }
    }
}

template <bool DRY>
__device__ __forceinline__ void peer_tile(Frame& F, const int tile) {
    const Args& A = *F.a;
    const bf16_t* QP = (const bf16_t*)(F.ws + WS_BUFA); const bf16_t* XG = (const bf16_t*)(F.ws + WS_BUFB); bf16_t* XGW = (bf16_t*)(F.ws + WS_BUFB); const bf16_t* SK = (const bf16_t*)(F.ws + WS_SK);
    const float* rss2 = (const float*)(F.ctl + CW_RSS2);
    LAS unsigned short* RE = (LAS unsigned short*)(F.lds + PE_RE); LAS float* RG = (LAS float*)(F.lds + PE_RG);
    const int w = F.wave;
    {
        int lane = F.lane; asm volatile("" : "+v"(lane));
        const int tg = w & 3, hh = w >> 2, n = lane & 31, h2 = lane >> 5;
        const int tok = 32 * tg + n; const size_t trow = (size_t)tile * 128 + tok;
        for (int rrep = 0; rrep < ((P7REP & 1) ? 2 : 1); ++rrep)
        for (int hd = 4 * hh; hd < 4 * hh + 4; ++hd) {
            unsigned T2[2][16];
#pragma unroll
            for (int cc = 0; cc < 2; ++cc) {
                const int grp = 2 * hd + cc;
                bf16x8 Qf[4];
#pragma unroll
                for (int kk = 0; kk < 4; ++kk) Qf[kk] = *(const bf16x8*)(QP + trow * DM + 64 * grp + 16 * kk + 8 * h2);
                unsigned key[64];
                unsigned lowbase = 127u - 4u * (unsigned)h2; asm volatile("" : "+v"(lowbase));
#pragma unroll
                for (int kb = 0; kb < 4; ++kb) {
                    f32x16 S;
#pragma unroll
                    for (int e = 0; e < 16; ++e) S[e] = 0.f;
#pragma unroll
                    for (int kk = 0; kk < 4; ++kk) { const bf16x8 a = *(const bf16x8*)(SK + ((size_t)(grp * 128 + 32 * kb + n)) * 64 + 16 * kk + 8 * h2); S = __builtin_amdgcn_mfma_f32_32x32x16_bf16(a, Qf[kk], S, 0, 0, 0); }
#pragma unroll
                    for (int e = 0; e < 16; ++e) { const int idx0 = 32 * kb + (e & 3) + 8 * (e >> 2); key[16 * kb + e] = ((enc_f(S[e]) & ~127u) | lowbase) - (unsigned)idx0; }
                }
                top16_of64<true>(key, T2[cc]);
            }
            float va[16], vb[16];
#pragma unroll
            for (int i = 0; i < 16; ++i) { va[i] = dec_f(T2[0][i] & ~127u); vb[i] = dec_f(T2[1][i] & ~127u); }
            unsigned ck[64];
#pragma unroll
            for (int i = 50; i < 64; ++i) ck[i] = 0u;
            {
                int q = 0;
#pragma unroll
                for (int i = 0; i < 16; ++i)
#pragma unroll
                    for (int j = 0; j < 16; ++j) if ((i + 1) * (j + 1) <= 16) { ck[q] = (enc_f(va[i] + vb[j]) & ~255u) | (unsigned)(255 - (16 * i + j)); ++q; }
            }
            unsigned best[16];
            top16_of64<false>(ck, best);
            const float v0 = dec_f(best[0] & ~255u);
            float gw[16], zs = 0.f;
#pragma unroll
            for (int k = 0; k < 16; ++k) { gw[k] = __expf(dec_f(best[k] & ~255u) - v0); zs += gw[k]; }
            const float zinv = 1.0f / zs;
#pragma unroll
            for (int k = 0; k < 16; ++k) {
                const unsigned code = 255u - (best[k] & 255u); const unsigned ci = code >> 4, cj = code & 15u;
                unsigned ia = 0, ib = 0;
#pragma unroll
                for (int i = 0; i < 16; ++i) { ia = (ci == (unsigned)i) ? (127u - (T2[0][i] & 127u)) : ia; ib = (cj == (unsigned)i) ? (127u - (T2[1][i] & 127u)) : ib; }
                if (h2 == (k >> 3)) { RE[tok * PE_REP + hd * 16 + k] = (unsigned short)(ia * 128u + ib); RG[tok * PE_REP + hd * 16 + k] = gw[k] * zinv; }
            }
        }
    }
    __syncthreads();
    {
        int lane = F.lane; asm volatile("" : "+v"(lane));
        const unsigned char* US = (const unsigned char*)(F.ws + WS_US); const unsigned char* VS = (const unsigned char*)(F.ws + WS_VS8); const float* SINV = (const float*)(F.ws + WS_SINV);
        const int j = lane & 7, gid = 8 * w + (lane >> 3);
        const int tA = gid, tB = 64 + gid; const size_t rowA = (size_t)tile * 128 + tA, rowB = (size_t)tile * 128 + tB;
        const LAS unsigned short* reA = RE + tA * PE_REP; const LAS unsigned short* reB = RE + tB * PE_REP;
        LAS float* cfA = RG + tA * PE_REP; LAS float* cfB = RG + tB * PE_REP;
        float accA[16], accB[16];
#pragma unroll
        for (int i = 0; i < 16; ++i) { accA[i] = 0.f; accB[i] = 0.f; }
#define PE_DEC16(w4, f) do { const f32x2 d0 = __builtin_amdgcn_cvt_pk_f32_fp8((int)(w4).x, false), d1 = __builtin_amdgcn_cvt_pk_f32_fp8((int)(w4).x, true), d2 = __builtin_amdgcn_cvt_pk_f32_fp8((int)(w4).y, false), d3 = __builtin_amdgcn_cvt_pk_f32_fp8((int)(w4).y, true), \
            d4 = __builtin_amdgcn_cvt_pk_f32_fp8((int)(w4).z, false), d5 = __builtin_amdgcn_cvt_pk_f32_fp8((int)(w4).z, true), d6 = __builtin_amdgcn_cvt_pk_f32_fp8((int)(w4).w, false), d7 = __builtin_amdgcn_cvt_pk_f32_fp8((int)(w4).w, true); \
            (f)[0] = d0.x; (f)[1] = d0.y; (f)[2] = d1.x; (f)[3] = d1.y; (f)[4] = d2.x; (f)[5] = d2.y; (f)[6] = d3.x; (f)[7] = d3.y; (f)[8] = d4.x; (f)[9] = d4.y; (f)[10] = d5.x; (f)[11] = d5.y; (f)[12] = d6.x; (f)[13] = d6.y; (f)[14] = d7.x; (f)[15] = d7.y; } while (0)
#define PE_ISSUE(buf_, re_, kb_, base_) do { const u32x4 e4 = *(const LAS u32x4*)((re_) + 8 * (kb_)); const unsigned ew[4] = {e4.x, e4.y, e4.z, e4.w}; \
                _Pragma("unroll") for (int i = 0; i < 8; ++i) { const unsigned e0 = (i & 1) ? (ew[i >> 1] >> 16) : (ew[i >> 1] & 0xffffu); (buf_)[i] = *(const u32x4*)((base_) + (size_t)e0 * 128); } } while (0)
        u32x4 xra0 = *(const u32x4*)(XG + rowA * DM + 16 * j), xra1 = *(const u32x4*)(XG + rowA * DM + 16 * j + 8), xrb0 = *(const u32x4*)(XG + rowB * DM + 16 * j), xrb1 = *(const u32x4*)(XG + rowB * DM + 16 * j + 8);
        u32x4 bufA[8], bufB[8];
        PE_ISSUE(bufA, reA, 0, US + 16 * j);
#pragma unroll 1
        for (int s2 = 0; s2 < ((P7REP & 2) ? 16 : 8); ++s2) {
            const int s = s2 & 7;
            if (s2 == 8) {
#pragma unroll
                for (int i = 0; i < 16; ++i) { accA[i] = 0.f; accB[i] = 0.f; } }
            float xa[16], xb[16];
            { const unsigned aw[8] = {xra0.x, xra0.y, xra0.z, xra0.w, xra1.x, xra1.y, xra1.z, xra1.w}, bw[8] = {xrb0.x, xrb0.y, xrb0.z, xrb0.w, xrb1.x, xrb1.y, xrb1.z, xrb1.w};
#pragma unroll
              for (int i = 0; i < 8; ++i) { xa[2 * i] = bf_lo(aw[i]); xa[2 * i + 1] = bf_hi(aw[i]); xb[2 * i] = bf_lo(bw[i]); xb[2 * i + 1] = bf_hi(bw[i]); } }
            { const int sn = (s + 1) & 7;
              xra0 = *(const u32x4*)(XG + rowA * DM + 128 * sn + 16 * j); xra1 = *(const u32x4*)(XG + rowA * DM + 128 * sn + 16 * j + 8); xrb0 = *(const u32x4*)(XG + rowB * DM + 128 * sn + 16 * j); xrb1 = *(const u32x4*)(XG + rowB * DM + 128 * sn + 16 * j + 8); }
            const unsigned char* Us = US + (size_t)s * (16384 * 128) + 16 * j; const unsigned char* Usn = US + (size_t)((s + 1) & 7) * (16384 * 128) + 16 * j;
#if PE_TOUCH
            const unsigned tchu = *(const volatile unsigned*)(US + (size_t)((s + 1) & 7) * (16384 * 128) + ((size_t)(((blockIdx.x >> 3) & 31) * 512 + F.tid)) * 128);
#endif
#define PE_UCOMP(buf_, x_, acc_, kb_) do { float pp[8]; _Pragma("unroll") for (int i = 0; i < 8; ++i) { float f[16]; PE_DEC16((buf_)[i], f); float d = 0.f; _Pragma("unroll") for (int c = 0; c < 16; ++c) d = fmaf(f[c], (x_)[c], d); pp[i] = d; } \
                (acc_)[kb_] += reduce8x8(pp, j); asm volatile("" : "+v"((acc_)[kb_]) :: "memory"); } while (0)
#pragma unroll
            for (int kb = 0; kb < 16; ++kb) {
                PE_ISSUE(bufB, reB, kb, Us);
                PE_UCOMP(bufA, xa, accA, kb);
                if (kb + 1 < 16) PE_ISSUE(bufA, reA, kb + 1, Us); else PE_ISSUE(bufA, reA, 0, Usn);
                PE_UCOMP(bufB, xb, accB, kb);
            }
#if PE_TOUCH
            asm volatile("" :: "v"(tchu));
#endif
        }
#undef PE_UCOMP
        {
            const float rsA = rsqrtf(rss2[rowA] * (1.0f / DM) + EPS), rsB = rsqrtf(rss2[rowB] * (1.0f / DM) + EPS);
#pragma unroll
            for (int kb = 0; kb < 16; ++kb) { const int eA = reA[8 * kb + j], eB = reB[8 * kb + j];
                cfA[8 * kb + j] = cfA[8 * kb + j] * gelu_exact(accA[kb] * rsA * SINV[eA]) * SINV[16384 + eA]; cfB[8 * kb + j] = cfB[8 * kb + j] * gelu_exact(accB[kb] * rsB * SINV[eB]) * SINV[16384 + eB]; }
        }
        LDS_WAIT();
        float ssA = 0.f, ssB = 0.f;
        float* xoA = A.out + rowA * DM + 16 * j; float* xoB = A.out + rowB * DM + 16 * j;
        PE_ISSUE(bufA, reA, 0, VS + 16 * j);
#pragma unroll 1
        for (int s2 = 0; s2 < ((P7REP & 4) ? 16 : 8); ++s2) {
            const int s = s2 & 7; const bool dry = (P7REP & 4) && s2 < 8;
            const unsigned char* Vs = VS + (size_t)s * (16384 * 128) + 16 * j; const unsigned char* Vsn = VS + (size_t)((s + 1) & 7) * (16384 * 128) + 16 * j;
#if PE_TOUCH
            const unsigned tchv = *(const volatile unsigned*)(VS + (size_t)((s + 1) & 7) * (16384 * 128) + ((size_t)(((blockIdx.x >> 3) & 31) * 512 + F.tid)) * 128);
#endif
            u32x2 x2a[4], x2b[4];
#pragma unroll
            for (int q = 0; q < 4; ++q) { x2a[q] = *(const u32x2*)(XG + rowA * DM + 128 * s + 16 * j + 4 * q); x2b[q] = *(const u32x2*)(XG + rowB * DM + 128 * s + 16 * j + 4 * q); }
            float oa[16], ob[16];
#pragma unroll
            for (int i = 0; i < 16; ++i) { oa[i] = 0.f; ob[i] = 0.f; }
#define PE_VCOMP(buf_, cf_, o_, kb_) do { const f32x4 c0_ = *(const LAS f32x4*)((cf_) + 8 * (kb_)), c1_ = *(const LAS f32x4*)((cf_) + 8 * (kb_) + 4); const float cw_[8] = {c0_.x, c0_.y, c0_.z, c0_.w, c1_.x, c1_.y, c1_.z, c1_.w}; \
                _Pragma("unroll") for (int i = 0; i < 8; ++i) { const float c = cw_[i]; float f[16]; PE_DEC16((buf_)[i], f); _Pragma("unroll") for (int q = 0; q < 16; ++q) (o_)[q] = fmaf(c, f[q], (o_)[q]); } \
                asm volatile("" : "+v"((o_)[0]), "+v"((o_)[1]), "+v"((o_)[2]), "+v"((o_)[3]), "+v"((o_)[4]), "+v"((o_)[5]), "+v"((o_)[6]), "+v"((o_)[7]), "+v"((o_)[8]), "+v"((o_)[9]), "+v"((o_)[10]), "+v"((o_)[11]), "+v"((o_)[12]), "+v"((o_)[13]), "+v"((o_)[14]), "+v"((o_)[15]) :: "memory"); } while (0)
#pragma unroll
            for (int kb = 0; kb < 16; ++kb) {
                PE_ISSUE(bufB, reB, kb, Vs);
                PE_VCOMP(bufA, cfA, oa, kb);
                if (kb + 1 < 16) PE_ISSUE(bufA, reA, kb + 1, Vs); else PE_ISSUE(bufA, reA, 0, Vsn);
                PE_VCOMP(bufB, cfB, ob, kb);
            }
#if PE_TOUCH
            asm volatile("" :: "v"(tchv));
#endif
#undef PE_VCOMP
#pragma unroll
            for (int q = 0; q < 4; ++q) {
                const u32x2 xa2 = x2a[q], xb2 = x2b[q];
                f32x4 a0 = (f32x4){bf_lo(xa2.x), bf_hi(xa2.x), bf_lo(xa2.y), bf_hi(xa2.y)}, b0 = (f32x4){bf_lo(xb2.x), bf_hi(xb2.x), bf_lo(xb2.y), bf_hi(xb2.y)};
                a0 = a0 + (f32x4){oa[4 * q], oa[4 * q + 1], oa[4 * q + 2], oa[4 * q + 3]}; b0 = b0 + (f32x4){ob[4 * q], ob[4 * q + 1], ob[4 * q + 2], ob[4 * q + 3]};
                if (!dry && !DRY) { ssA += (a0.x * a0.x + a0.y * a0.y) + (a0.z * a0.z + a0.w * a0.w); ssB += (b0.x * b0.x + b0.y * b0.y) + (b0.z * b0.z + b0.w * b0.w);
                u32x2 pa, pb; pa.x = cvt_pk_bf16(a0.x, a0.y); pa.y = cvt_pk_bf16(a0.z, a0.w); pb.x = cvt_pk_bf16(b0.x, b0.y); pb.y = cvt_pk_bf16(b0.z, b0.w);
                *(u32x2*)(XGW + rowA * DM + 128 * s + 16 * j + 4 * q) = pa; *(u32x2*)(XGW + rowB * DM + 128 * s + 16 * j + 4 * q) = pb; } }
        }
#undef PE_DEC16
#undef PE_ISSUE
        ssA += __shfl_xor(ssA, 1); ssA += __shfl_xor(ssA, 2); ssA += __shfl_xor(ssA, 4);
        ssB += __shfl_xor(ssB, 1); ssB += __shfl_xor(ssB, 2); ssB += __shfl_xor(ssB, 4);
        const float rfA = rsqrtf(ssA * (1.0f / DM) + EPS), rfB = rsqrtf(ssB * (1.0f / DM) + EPS);
        VM_WAIT();
        __builtin_amdgcn_fence(__ATOMIC_ACQUIRE, "agent");
        VM_WAIT();
        const float* gfin = A.in[I_GFIN] + 16 * j;
#pragma unroll 2
        for (int s = 0; s < 8; ++s)
#pragma unroll
            for (int q = 0; q < 4; ++q) {
                const f32x4 g0 = *(const f32x4*)(gfin + 128 * s + 4 * q);
                const u32x2 xa2 = *(const u32x2*)(XGW + rowA * DM + 128 * s + 16 * j + 4 * q), xb2 = *(const u32x2*)(XGW + rowB * DM + 128 * s + 16 * j + 4 * q);
                const f32x4 a0 = (f32x4){bf_lo(xa2.x), bf_hi(xa2.x), bf_lo(xa2.y), bf_hi(xa2.y)}, b0 = (f32x4){bf_lo(xb2.x), bf_hi(xb2.x), bf_lo(xb2.y), bf_hi(xb2.y)};
                if (!DRY) { *(f32x4*)(xoA + 128 * s + 4 * q) = a0 * rfA * g0; *(f32x4*)(xoB + 128 * s + 4 * q) = b0 * rfB * g0; } else { asm volatile("" :: "v"(a0 * rfA * g0), "v"(b0 * rfB * g0)); } }
    }
    __syncthreads();
}

#ifndef USE_COOP_LAUNCH
#define USE_COOP_LAUNCH 1
#endif
#ifndef USE_CG_SYNC
#define USE_CG_SYNC 0
#endif
#ifndef DBG_SRC
#define DBG_SRC 0
#endif
#ifndef DBG_ZC
#define DBG_ZC 0
#endif
#ifndef DBG_C0
#define DBG_C0 0
#endif
#ifndef DBG_C1
#define DBG_C1 1024
#endif
__global__ void __launch_bounds__(512, 2) mk_fwd(Args args) {
    extern __shared__ __attribute__((aligned(16))) unsigned char lds_raw[];
    Frame F;
    F.lds = (LAS unsigned char*)lds_raw;
    F.tid = threadIdx.x; F.lane = F.tid & 63; F.wave = __builtin_amdgcn_readfirstlane(F.tid >> 6);
    F.G = gridDim.x; { const int bx = blockIdx.x; F.vcu = (F.G % 8 == 0) ? (bx % 8) * (F.G / 8) + bx / 8 : bx; }
    F.a = &args; F.ws = args.ws; F.ctl = (unsigned*)(args.ws + WS_CTL);
    const int lo = args.ph_lo, hi = args.ph_hi;
#if USE_CG_SYNC
    cg::grid_group grid = cg::this_grid();
#define GRID_BAR() grid.sync()
#else
    { volatile LAS unsigned* st0 = (volatile LAS unsigned*)(F.lds + MISC_OFF); if (F.tid < 8) st0[F.tid] = 0u; }
    __syncthreads();
    XcdBarrier xbar; xbar.bar = F.ctl + CW_BAR; xbar.x = 0; xbar.st = nullptr;
    if (hi - lo > 1) xbar = xcd_barrier_post(F.ctl + CW_BAR, (volatile LAS unsigned*)(F.lds + MISC_OFF));
#define GRID_BAR() xcd_barrier(xbar)
#endif
#define IN(k) (lo <= (k) && (k) < hi)
#ifndef PHMASK
#define PHMASK 0x1FF
#endif
#ifndef P2SUB
#define P2SUB 7
#endif
#define PHON(k) (((PHMASK) >> (k)) & 1)
#ifndef REPMASK
#define REPMASK 0
#endif
#define NREP(k) ((((REPMASK) >> (k)) & 1) ? 2 : 1)
#define PHASE_BEGIN() do { int t_ = threadIdx.x; asm volatile("" : "+v"(t_)); F.tid = t_; F.lane = t_ & 63; } while (0)
#define SEAM(k) do { if (IN(k) && IN((k) + 1)) GRID_BAR(); } while (0)
    unsigned char* ws = args.ws;
    const int bx = blockIdx.x;

    if (PHON(0) && IN(0)) { for (int rep = 0; rep < NREP(0); ++rep) { PHASE_BEGIN(); p0_prologue(F); } }
    SEAM(0);
    if (PHON(1) && IN(1)) for (int rep = 0; rep < NREP(1); ++rep) {
        PHASE_BEGIN();
        { pg8::Sched S{0, T_TOK / 256, NZ / 256, (T_TOK / 256) * (NZ / 256), F.G, bx, 1, (const char*)(ws + WS_BUFA), (const char*)(ws + WS_WIN), (char*)(ws + WS_Z), (size_t)256 * DM * 2, (size_t)256 * DM * 2, 0, 2};
          pg8::EpiBf16 E{NZ, 1.0f, nullptr, nullptr};
          pg8::gemm_phase(F.lds, DM, DM, DM, S, E); }
        { pg8::Sched S{0, TMEM / 256, 2048 / 256, (TMEM / 256) * (2048 / 256), F.G, bx, 1, (const char*)(ws + WS_MEMN), (const char*)(ws + WS_WKV), (char*)(ws + WS_KV), (size_t)256 * DM * 2, (size_t)256 * DM * 2, 0, 2};
          pg8::EpiBf16 E{2048, 1.0f, nullptr, nullptr};
          pg8::gemm_phase(F.lds, DM, DM, DM, S, E); }
    }
    SEAM(1);
    if (PHON(2) && IN(2)) for (int rep = 0; rep < NREP(2); ++rep) {
        PHASE_BEGIN();
        conv_prepass(F);
    }
    SEAM(2);
    if (PHON(3) && IN(3)) for (int rep = 0; rep < NREP(3); ++rep) {
        PHASE_BEGIN();
        float lam;
        { float s1 = 0.f, s2 = 0.f;
          for (int i = 0; i < 64; ++i) { s1 += args.in[I_LQ1][i] * args.in[I_LK1][i]; s2 += args.in[I_LQ2][i] * args.in[I_LK2][i]; }
          lam = __expf(s1) - __expf(s2) + 0.2f; }
        LAS int* qslot = (LAS int*)(F.lds + MISC_OFF + 16);
        int qx = bx & 7, tried = 0;
        for (;;) {
            if (F.tid == 0) *qslot = (int)atomicAdd(F.ctl + CW_Q2 + 64 * (qx + 8 * rep), 1u);
            __syncthreads();
            const int u = *qslot;
            __syncthreads();
            if (u >= 8 + QN_ATT + 64 + 64) { if (++tried == 8) break; qx = (qx + 1) & 7; continue; }
            const int submask = (rep + 1 < NREP(3)) ? (REPSUB) : (P2SUB);
            if (u < 8) { const int p = qx + 8 * u; if ((submask & 1) && !((rep + 1 < NREP(3)) && (PROBE_HALF & 1) && u >= 4)) mlstm_unit(F, p >> 2, p & 3); }
            else if (u >= 8 + QN_ATT + 64) { if (rep + 1 == NREP(3)) peer_convert_rows(F, qx + 8 * (u - (8 + QN_ATT + 64))); }
            else if (u >= 8 + QN_ATT) { if (rep + 1 == NREP(3)) {
                const int gi = qx + 8 * (u - (8 + QN_ATT));
                if (gi < 256) { pg8::Sched S{1, 0, 0, 256, 1 << 30, gi, 1, (const char*)(ws + WS_KV), (const char*)(ws + WS_WCQ), (char*)(ws + WS_MB), 0, 0, 0, 2};
                    pg8::EpiBf16 E{DM, 0.0625f, nullptr, args.in[I_GCA]};
                    pg8::gemm_phase(F.lds, 256, 2048, DM, S, E); }
                else { pg8::Sched S{2, 0, 0, 256, 1 << 30, gi - 256, 1, (const char*)(ws + WS_WCO), (const char*)(ws + WS_KV), (char*)(ws + WS_VWB), 0, 0, 0, 2};
                    pg8::EpiBf16 E{DM, 1.0f, nullptr, nullptr};
                    pg8::gemm_phase(F.lds, 256, DM, 2048, S, E); } } }
            else if ((submask & 2) && !((rep + 1 < NREP(3)) && (PROBE_HALF & 2) && ((u - 8) >> 4) >= 4)) { const int j = u - 8;
#if Q_PAIRED
                { const int p = qx + 8 * (j >> 3), g_ = j & 7;
#pragma unroll 1
                  for (int hf = 0; hf < 2; ++hf) { const int qt_ = hf ? g_ : 15 - g_;
                      if (rep + 1 < NREP(3)) attn_unit<ATT_MODE>(F, p >> 2, p & 3, qt_, lam); else attn_unit<0>(F, p >> 2, p & 3, qt_, lam); } }
#elif Q_LPT
                const int p = qx + 8 * (j & 7), qt_ = 15 - (j >> 3);
#else
                const int p = qx + 8 * (j >> 4), qt_ = 15 - (j & 15);
#endif
#if !Q_PAIRED
                if (rep + 1 < NREP(3)) attn_unit<ATT_MODE>(F, p >> 2, p & 3, qt_, lam); else attn_unit<0>(F, p >> 2, p & 3, qt_, lam);
#endif
            }
        }
    }
    SEAM(3);
    if (PHON(4) && IN(4)) for (int rep = 0; rep < NREP(4); ++rep) {
        PHASE_BEGIN();
        pg8::Sched S{0, T_TOK / 256, 4, (T_TOK / 256) * 4, F.G, bx, 1, (const char*)(ws + WS_BUFA), (const char*)(ws + WS_WOUT), nullptr, (size_t)256 * DM * 2, (size_t)256 * DM * 2, 0, 2};
        pg8::EpiResidB<false> E{args.in[I_X], (bf16_t*)(ws + WS_BUFB), (float*)(F.ctl + ((rep + 1 < NREP(4)) ? CW_DUMMY : CW_RSS1))};
        pg8::gemm_phase(F.lds, DM, DM, DM, S, E);
    }
    SEAM(4);
    if (PHON(5) && IN(5)) for (int rep = 0; rep < NREP(5); ++rep) {
        PHASE_BEGIN();
        pg8::Sched S{0, T_TOK / 256, 4, (T_TOK / 256) * 4, F.G, bx, 8, (const char*)(ws + WS_BUFB), (const char*)(ws + WS_MB), nullptr, (size_t)256 * DM * 2, (size_t)256 * DM * 2, (size_t)DM * DM * 2, 2};
        pg8::EpiSoftmax E{(const float*)(F.ctl + CW_RSS1), (bf16_t*)(ws + WS_BUFA)};
        pg8::gemm_phase(F.lds, DM, DM, DM, S, E);
    }
    SEAM(5);
    if (PHON(6) && IN(6)) {
        PHASE_BEGIN();
        pg8::Sched S{0, T_TOK / 256, 4, (T_TOK / 256) * 4, F.G, bx, 8, (const char*)(ws + WS_BUFA), (const char*)(ws + WS_VWB), nullptr, (size_t)256 * DM * 2, (size_t)256 * DM * 2, (size_t)DM * DM * 2, 2};
        pg8::EpiResidB<true> E{(const void*)(ws + WS_BUFB), (bf16_t*)(ws + WS_BUFB), (float*)(F.ctl + CW_RSS2)};
        pg8::gemm_phase(F.lds, DM, DM, DM, S, E);
    }
    SEAM(6);
    if (PHON(7) && IN(7)) for (int rep = 0; rep < NREP(7); ++rep) {
        PHASE_BEGIN();
        pg8::Sched S{0, T_TOK / 256, 4, (T_TOK / 256) * 4, F.G, bx, 1, (const char*)(ws + WS_BUFB), (const char*)(ws + WS_WPQ), (char*)(ws + WS_BUFA), (size_t)256 * DM * 2, (size_t)256 * DM * 2, 0, 2};
        pg8::EpiBf16 E{DM, 1.0f, (const float*)(F.ctl + CW_RSS2), nullptr};
        pg8::gemm_phase(F.lds, DM, DM, DM, S, E);
    }
    SEAM(7);
    if (PHON(8) && IN(8)) {
        PHASE_BEGIN();
        if (NREP(8) > 1) { for (int tile = bx; tile < T_TOK / 128; tile += F.G) peer_tile<true>(F, tile); }
        for (int tile = bx; tile < T_TOK / 128; tile += F.G) peer_tile<false>(F, tile);
    }
    if (lo <= 9 && 9 < hi) {
        const bf16_t* src = (const bf16_t*)(ws + (DBG_SRC ? WS_Z : WS_BUFA));
        for (size_t i = (size_t)bx * 512 + F.tid; i < (size_t)T_TOK * DM / 2; i += (size_t)F.G * 512) { const size_t row_ = (2 * i) >> 10, col_ = (2 * i) & 1023; const unsigned u = DBG_SRC ? *(const unsigned*)(src + row_ * NZ + DBG_ZC + col_) : ((const unsigned*)src)[i]; const int col = (int)((2 * i) & 1023); const bool on = (col >= DBG_C0 && col < DBG_C1); args.out[2 * i] = on ? bf_lo(u) : 0.f; args.out[2 * i + 1] = on ? bf_hi(u) : 0.f; }
    }
#undef IN
#undef SEAM
}

#ifndef MK_N_LAUNCHES
#define MK_N_LAUNCHES 1
#endif
extern "C" void kernel_launch(void* const* d_in, const int* in_sizes, int n_in, void* d_out, int out_size, void* d_ws, size_t ws_size, hipStream_t stream) {
    static int grid = 0;
    if (grid == 0) {
        if (n_in != 26 || out_size != T_TOK * DM || ws_size < WS_END + 34 * MiB) { fprintf(stderr, "kernel_launch: unexpected shapes (n_in %d out %d ws %zu)\n", n_in, out_size, ws_size); grid = -1; return; }
        int dev = 0, cus = 0, per_cu = 0;
        hipGetDevice(&dev); hipDeviceGetAttribute(&cus, hipDeviceAttributeMultiprocessorCount, dev);
        if (hipFuncSetAttribute((const void*)mk_fwd, hipFuncAttributeMaxDynamicSharedMemorySize, LDS_BYTES) != hipSuccess) { fprintf(stderr, "kernel_launch: hipFuncSetAttribute failed\n"); grid = -1; return; }
        if (hipOccupancyMaxActiveBlocksPerMultiprocessor(&per_cu, (const void*)mk_fwd, 512, LDS_BYTES) != hipSuccess || per_cu < 1) { fprintf(stderr, "kernel_launch: occupancy query says %d\n", per_cu); per_cu = 1; }
        (void)hipGetLastError();
        grid = cus;
    }
    if (grid < 0) return;
    hipMemsetAsync((char*)d_ws + WS_CTL, 0, CTL_BYTES, stream);
    Args a{};
    for (int i = 0; i < 26; ++i) a.in[i] = (const float*)d_in[i];
    a.out = (float*)d_out; a.ws = (unsigned char*)d_ws;
    if (MK_N_LAUNCHES == 1) {
        a.ph_lo = 0; a.ph_hi = 9;
        void* kargs[] = {&a};
#if USE_COOP_LAUNCH
        hipError_t e = hipLaunchCooperativeKernel((const void*)mk_fwd, dim3(grid), dim3(512), kargs, LDS_BYTES, stream);
        if (e != hipSuccess) fprintf(stderr, "cooperative launch failed: %s (grid %d)\n", hipGetErrorString(e), grid);
#else
        (void)kargs; hipLaunchKernelGGL(mk_fwd, dim3(grid), dim3(512), LDS_BYTES, stream, a);
#endif
    } else {
#ifndef DBG_STOP
#define DBG_STOP 9
#endif
#ifndef DBG_DUMP
#define DBG_DUMP 0
#endif
        for (int p = 0; p < DBG_STOP; ++p) { a.ph_lo = p; a.ph_hi = p + 1; hipLaunchKernelGGL(mk_fwd, dim3(grid), dim3(512), LDS_BYTES, stream, a); }
        if (DBG_DUMP) { a.ph_lo = 9; a.ph_hi = 10; hipLaunchKernelGGL(mk_fwd, dim3(grid), dim3(512), LDS_BYTES, stream, a); }
    }
}
```

```cpp
#include <hip/hip_runtime.h>
#include <hip/hip_cooperative_groups.h>
#include <cstdio>
#include <cstdint>
namespace cg = cooperative_groups;

#define GAS __attribute__((address_space(1)))
#define LAS __attribute__((address_space(3)))
typedef unsigned short bf16_t;
typedef short bf16x8 __attribute__((ext_vector_type(8)));
typedef short s16x4 __attribute__((ext_vector_type(4)));
typedef float f32x4 __attribute__((ext_vector_type(4)));
typedef float f32x2 __attribute__((ext_vector_type(2)));
typedef float f32x16 __attribute__((ext_vector_type(16)));
typedef unsigned u32x4 __attribute__((ext_vector_type(4)));
typedef unsigned u32x2 __attribute__((ext_vector_type(2)));

constexpr int T_TOK = 32768, DM = 1024, NB = 16, SEQ = 2048, NZ = 3584, INW = 3592, MEML = 256, TMEM = NB * MEML;
constexpr float EPS = 1e-6f;
constexpr float LOG2E = 1.4426950408889634f;
constexpr int ZC_MLQ = 0, ZC_MLK = 512, ZC_MLV = 1024, ZC_MLO = 1536, ZC_DAQ = 2048, ZC_DAK = 2560, ZC_DAV = 3072;

constexpr size_t MiB = 1u << 20;
constexpr size_t WS_CTL = 0, CTL_BYTES = 1 * MiB;
constexpr size_t WS_WIN = 1 * MiB, WS_WOUT = 8 * MiB, WS_WCQ = 10 * MiB, WS_WKV = 12 * MiB, WS_WCO = 16 * MiB, WS_WPQ = 18 * MiB, WS_SK = 20 * MiB;
constexpr size_t WS_GATES = 21 * MiB, WS_MEMN = 22 * MiB, WS_KV = 30 * MiB, WS_MB = 46 * MiB, WS_VWB = 78 * MiB;
constexpr size_t WS_BUFA = 110 * MiB, WS_BUFB = 174 * MiB, WS_Z = 238 * MiB, WS_END = 462 * MiB;
constexpr int CW_Q2 = 64;
constexpr int CW_RSS1 = 16384;
constexpr int CW_RSS2 = 65536;
constexpr int CW_BAR = 131072;
constexpr int CW_DUMMY = 180224;

constexpr int LDS_BYTES = 147456;
constexpr int XCH_OFF = 131072;
constexpr int MISC_OFF = LDS_BYTES - 256;

__device__ __forceinline__ unsigned cvt_pk_bf16(float lo, float hi) { unsigned r; asm("v_cvt_pk_bf16_f32 %0, %1, %2" : "=v"(r) : "v"(lo), "v"(hi)); return r; }
__device__ __forceinline__ float bf_lo(unsigned u) { return __uint_as_float(u << 16); }
__device__ __forceinline__ float bf_hi(unsigned u) { return __uint_as_float(u & 0xffff0000u); }
__device__ __forceinline__ float wave_sum(float v) {
#pragma unroll
    for (int o = 1; o < 64; o <<= 1) v += __shfl_xor(v, o);
    return v;
}
__device__ __forceinline__ float fast_exp2(float x) { return __builtin_amdgcn_exp2f(x); }
__device__ __forceinline__ float fast_rcp(float x) { return __builtin_amdgcn_rcpf(x); }
#define LDS_WAIT() asm volatile("s_waitcnt lgkmcnt(0)" ::: "memory")
#define VM_WAIT() asm volatile("s_waitcnt vmcnt(0)" ::: "memory")

namespace pg8 {
constexpr int BM = 256, BK = 64, HALF = 128, HTB = HALF * BK * 2, STAGE_BYTES = 8 * HTB;
__device__ __forceinline__ int lds_byte(int r, int c) { const int st = (r >> 4) * 2 + (c >> 5), rr = r & 15, cc = c & 31, ob = rr * 64 + cc * 2; return st * 1024 + (ob ^ (((ob >> 9) & 1) << 5)); }
__device__ __forceinline__ void stage_rc(int b, int& R, int& C) { const int st = b / 1024, sb = b % 1024, swz = sb ^ (((sb >> 9) & 1) << 5); R = (st >> 1) * 16 + swz / 64; C = (st & 1) * 32 + (swz % 64) / 2; }
__device__ __forceinline__ int perm32(int rho) { const int n = rho >> 4, i = rho & 15; return 8 * (i >> 2) + 4 * n + (i & 3); }

struct Unit { const char* A; const char* B; char* O; int row0, col0, scol; };

template <class Epi, class Sched>
__device__ __forceinline__ void gemm_phase(LAS unsigned char* lds, const int K, const int lda, const int ldb, const Sched& S, const Epi& E) {
    int tid_l = threadIdx.x; asm volatile("" : "+v"(tid_l));
    const int tid = tid_l, wid = __builtin_amdgcn_readfirstlane(tid >> 6), lane = tid & 63, wr = wid >> 2, wc = wid & 3, fr = lane & 15, fq = lane >> 4;
    const int nt = K / BK;
    unsigned voffA[2], voffB[2];
#pragma unroll
    for (int i = 0; i < 2; ++i) { int R, C; stage_rc(tid * 16 + i * 8192, R, C); const int Rb = Epi::PERM ? ((R & ~31) + perm32(R & 31)) : R;
        voffA[i] = (unsigned)(R * lda + C) * 2u; voffB[i] = (unsigned)(Rb * ldb + C) * 2u; }
    const size_t kstep = (size_t)(BK * 2);
    const size_t hstepA = (size_t)HALF * lda * 2, hstepB = (size_t)HALF * ldb * 2;
    const unsigned ldsw = (unsigned)wid * 1024u;
    const int aoff = lds_byte(wr * 64 + fr, fq * 8), boff = lds_byte(wc * 32 + fr, fq * 8);
#define PG8_SA(b, h) (((b) * 2 + (h)) * HTB)
#define PG8_SB(b, h) ((4 + (b) * 2 + (h)) * HTB)
#define PG8_STAGE(bufoff, gbase, voff) do { _Pragma("unroll") for (int _i = 0; _i < 2; ++_i) \
        __builtin_amdgcn_global_load_lds((const unsigned*)((const char*)(gbase) + (voff)[_i]), (LAS unsigned*)(lds + (bufoff) + ldsw + _i * 8192), 16, 0, 0); } while (0)
#define PG8_LDA(dst, b, h) do { _Pragma("unroll") for (int m = 0; m < 4; ++m) _Pragma("unroll") for (int k = 0; k < 2; ++k) dst[m][k] = *(const LAS bf16x8*)(lds + PG8_SA(b, h) + aoff + m * 2048 + k * 1024); } while (0)
#define PG8_LDB(dst, b, h) do { _Pragma("unroll") for (int n = 0; n < 2; ++n) _Pragma("unroll") for (int k = 0; k < 2; ++k) dst[n][k] = *(const LAS bf16x8*)(lds + PG8_SB(b, h) + boff + n * 2048 + k * 1024); } while (0)
#define PG8_MMA(ai, bj, At, Bt) do { __builtin_amdgcn_s_setprio(1); _Pragma("unroll") for (int m = 0; m < 4; ++m) _Pragma("unroll") for (int n = 0; n < 2; ++n) _Pragma("unroll") for (int k = 0; k < 2; ++k) \
        acc[ai][bj][m][n] = __builtin_amdgcn_mfma_f32_16x16x32_bf16(Bt[n][k], At[m][k], acc[ai][bj][m][n], 0, 0, 0); __builtin_amdgcn_s_setprio(0); } while (0)
#define PG8_WAIT_V(n) asm volatile("s_waitcnt vmcnt(" #n ")" ::: "memory")
#define PG8_WAIT_L(n) asm volatile("s_waitcnt lgkmcnt(" #n ")" ::: "memory")
#define PG8_BAR __builtin_amdgcn_s_barrier()
#define PG8_SCHED __builtin_amdgcn_sched_barrier(0)
    Unit cur, nxt; int ui = 0;
    if (!S.next(0, cur)) return;
    f32x4 acc[2][2][4][2];
#pragma unroll
    for (int a = 0; a < 2; ++a)
#pragma unroll
        for (int b = 0; b < 2; ++b)
#pragma unroll
            for (int m = 0; m < 4; ++m)
#pragma unroll
                for (int n = 0; n < 2; ++n) acc[a][b][m][n] = (f32x4){0.f, 0.f, 0.f, 0.f};
    bf16x8 At[4][2], B0[2][2], B1[2][2];
    const char* cA = cur.A; const char* cB = cur.B;
    PG8_STAGE(PG8_SB(0, 0), cB, voffB); PG8_STAGE(PG8_SA(0, 0), cA, voffA); PG8_STAGE(PG8_SB(0, 1), cB + hstepB, voffB); PG8_STAGE(PG8_SA(0, 1), cA + hstepA, voffA);
    if (wr == 1) PG8_BAR;
    PG8_WAIT_V(4); PG8_BAR;
    PG8_STAGE(PG8_SB(1, 0), cB + kstep, voffB); PG8_STAGE(PG8_SA(1, 0), cA + kstep, voffA); PG8_STAGE(PG8_SB(1, 1), cB + hstepB + kstep, voffB);
    PG8_WAIT_V(6); PG8_BAR;
    for (;;) {
        const bool has_next = S.next(ui + 1, nxt);
        const char* nA = has_next ? nxt.A : cA; const char* nB = has_next ? nxt.B : cB;
        for (int t = 0; t < nt; t += 2) {
            const bool last = (t == nt - 2);
            const char* a1 = cA + (size_t)(t + 1) * kstep;
            const char* a2 = last ? nA : cA + (size_t)(t + 2) * kstep; const char* b2 = last ? nB : cB + (size_t)(t + 2) * kstep;
            const char* a3 = a2 + kstep; const char* b3 = b2 + kstep;
            PG8_LDB(B0, 0, 0); PG8_SCHED; PG8_LDA(At, 0, 0); PG8_STAGE(PG8_SA(1, 1), a1 + hstepA, voffA);
            PG8_WAIT_L(8); PG8_BAR; PG8_WAIT_L(0); PG8_MMA(0, 0, At, B0); PG8_BAR; PG8_SCHED;
            PG8_LDB(B1, 0, 1); PG8_STAGE(PG8_SB(0, 0), b2, voffB);
            PG8_BAR; PG8_WAIT_L(0); PG8_MMA(0, 1, At, B1); PG8_BAR;
            PG8_LDA(At, 0, 1); PG8_STAGE(PG8_SA(0, 0), a2, voffA);
            PG8_BAR; PG8_WAIT_L(0); PG8_MMA(1, 0, At, B0); PG8_BAR; PG8_SCHED;
            PG8_STAGE(PG8_SB(0, 1), b2 + hstepB, voffB);
            PG8_WAIT_V(6); PG8_BAR; PG8_MMA(1, 1, At, B1); PG8_BAR;
            PG8_LDB(B0, 1, 0); PG8_SCHED; PG8_LDA(At, 1, 0); PG8_STAGE(PG8_SA(0, 1), a2 + hstepA, voffA);
            PG8_WAIT_L(8); PG8_BAR; PG8_WAIT_L(0); PG8_MMA(0, 0, At, B0); PG8_BAR; PG8_SCHED;
            PG8_LDB(B1, 1, 1); PG8_STAGE(PG8_SB(1, 0), b3, voffB);
            PG8_BAR; PG8_WAIT_L(0); PG8_MMA(0, 1, At, B1); PG8_BAR;
            PG8_LDA(At, 1, 1); PG8_STAGE(PG8_SA(1, 0), a3, voffA);
            PG8_BAR; PG8_WAIT_L(0); PG8_MMA(1, 0, At, B0); PG8_BAR; PG8_SCHED;
            PG8_STAGE(PG8_SB(1, 1), b3 + hstepB, voffB);
            PG8_WAIT_V(6); PG8_BAR; PG8_MMA(1, 1, At, B1); PG8_BAR;
        }
        E(acc, cur, wr, wc, fr, fq, lds);
        if (!has_next) break;
#pragma unroll
        for (int a = 0; a < 2; ++a)
#pragma unroll
            for (int b = 0; b < 2; ++b)
#pragma unroll
                for (int m = 0; m < 4; ++m)
#pragma unroll
                    for (int n = 0; n < 2; ++n) acc[a][b][m][n] = (f32x4){0.f, 0.f, 0.f, 0.f};
        cur = nxt; cA = nA; cB = nB; ++ui;
    }
    PG8_WAIT_V(0);
    if (wr == 0) PG8_BAR;
    PG8_BAR;
#undef PG8_SA
#undef PG8_SB
#undef PG8_STAGE
#undef PG8_LDA
#undef PG8_LDB
#undef PG8_MMA
#undef PG8_WAIT_V
#undef PG8_WAIT_L
#undef PG8_BAR
#undef PG8_SCHED
}

struct Sched {
    int mode, nM, nN, nwg, G, c, tpb; const char* baseA; const char* baseB; char* baseO; size_t strideA, strideB, bstrideB; int ldo_bytes_per_el;
    __device__ __forceinline__ bool next(int i, Unit& u) const {
        const long L = (long)i * G + c; if (L >= nwg) return false;
        if (mode == 0) {
            int wgid = (int)L; { const int q = nwg / 8, r = nwg % 8, xcd = wgid % 8, off = wgid / 8; wgid = (xcd < r ? xcd * (q + 1) : r * (q + 1) + (xcd - r) * q) + off; }
            const int nig = 8 * nN, gid = wgid / nig, fm = gid * 8, gsz = (nM - fm) < 8 ? (nM - fm) : 8;
            const int pm = fm + ((wgid % nig) % gsz), pn = (wgid % nig) / gsz;
            u.A = baseA + (size_t)pm * strideA; u.B = baseB + (size_t)pn * strideB + (size_t)(pm / tpb) * bstrideB; u.O = baseO; u.row0 = pm * 256; u.col0 = pn * 256; u.scol = pn * 256;
        } else if (mode == 1) {
            const int l = (int)L, b = l >> 4, h = (l >> 2) & 3, kt = l & 3;
            u.A = baseA + ((size_t)(b * 256) * 2048 + h * 256) * 2; u.B = baseB + ((size_t)(kt * 256) * 1024 + h * 256) * 2;
            u.O = baseO + ((size_t)b * 1048576 + (size_t)(h * 256) * 1024 + kt * 256) * 2; u.row0 = 0; u.col0 = 0; u.scol = kt * 256;
        } else {
            const int l = (int)L, b = l >> 4, h = (l >> 2) & 3, ntile = l & 3;
            u.A = baseA + ((size_t)(ntile * 256) * 1024 + h * 256) * 2; u.B = baseB + ((size_t)(b * 256) * 2048 + 1024 + h * 256) * 2;
            u.O = baseO + ((size_t)b * 1048576 + (size_t)(ntile * 256) * 1024 + h * 256) * 2; u.row0 = 0; u.col0 = 0; u.scol = 0;
        }
        return true;
    }
};

struct EpiBf16 {
    static constexpr bool PERM = true;
    int ldc; float scale; const float* rss; const float* colscale;
    __device__ __forceinline__ void operator()(const f32x4 (&acc)[2][2][4][2], const Unit& u, int wr, int wc, int fr, int fq, LAS unsigned char*) const {
        bf16_t* base = (bf16_t*)u.O;
        f32x4 cs[2][2];
#pragma unroll
        for (int bj = 0; bj < 2; ++bj)
#pragma unroll
            for (int n = 0; n < 2; ++n) cs[bj][n] = colscale ? *(const f32x4*)(colscale + u.scol + wc * 32 + 8 * fq + bj * HALF + 4 * n) : (f32x4){1.f, 1.f, 1.f, 1.f};
#pragma unroll
        for (int ai = 0; ai < 2; ++ai)
#pragma unroll
            for (int m = 0; m < 4; ++m) {
                const int row = u.row0 + ai * HALF + wr * 64 + m * 16 + fr;
                float sc = scale; if (rss) sc *= rsqrtf(rss[row] * (1.0f / 1024.0f) + EPS);
                bf16_t* rowp = base + (size_t)row * ldc + u.col0 + wc * 32 + 8 * fq;
#pragma unroll
                for (int bj = 0; bj < 2; ++bj) { const f32x4 v0 = acc[ai][bj][m][0] * sc * cs[bj][0], v1 = acc[ai][bj][m][1] * sc * cs[bj][1];
                    u32x4 w; w.x = cvt_pk_bf16(v0[0], v0[1]); w.y = cvt_pk_bf16(v0[2], v0[3]); w.z = cvt_pk_bf16(v1[0], v1[1]); w.w = cvt_pk_bf16(v1[2], v1[3]);
                    *(u32x4*)(rowp + bj * HALF) = w; } }
    }
};
struct EpiResid {
    static constexpr bool PERM = false;
    const float* base; float* out; bf16_t* xg; const float* g; float* rss;
    __device__ __forceinline__ void operator()(const f32x4 (&acc)[2][2][4][2], const Unit& u, int wr, int wc, int fr, int fq, LAS unsigned char*) const {
        const int colb = u.col0 + wc * 32 + 4 * fq;
#pragma unroll
        for (int ai = 0; ai < 2; ++ai)
#pragma unroll
            for (int m = 0; m < 4; ++m) {
                const int row = u.row0 + ai * HALF + wr * 64 + m * 16 + fr; const size_t off = (size_t)row * DM + colb; float ss = 0.f;
#pragma unroll
                for (int bj = 0; bj < 2; ++bj)
#pragma unroll
                    for (int n = 0; n < 2; ++n) { const int co = bj * HALF + n * 16;
                        const f32x4 bs = *(const f32x4*)(base + off + co); const f32x4 v = bs + acc[ai][bj][m][n];
                        *(f32x4*)(out + off + co) = v; const f32x4 gv = *(const f32x4*)(g + colb + co); const f32x4 w = v * gv;
                        u32x2 pk; pk.x = cvt_pk_bf16(w[0], w[1]); pk.y = cvt_pk_bf16(w[2], w[3]); *(u32x2*)(xg + off + co) = pk;
                        ss += (v[0] * v[0] + v[1] * v[1]) + (v[2] * v[2] + v[3] * v[3]); }
                ss += __shfl_xor(ss, 16); ss += __shfl_xor(ss, 32);
                if (fq == 0) atomicAdd(rss + row, ss);
                asm volatile("" ::: "memory"); }
    }
};
template <bool BASE_BF16>
struct EpiResidB {
    static constexpr bool PERM = false;
    const void* base; bf16_t* out; float* rss;
    __device__ __forceinline__ void operator()(const f32x4 (&acc)[2][2][4][2], const Unit& u, int wr, int wc, int fr, int fq, LAS unsigned char*) const {
        const int colb = u.col0 + wc * 32 + 4 * fq;
#pragma unroll
        for (int ai = 0; ai < 2; ++ai)
#pragma unroll
            for (int m = 0; m < 4; ++m) {
                const int row = u.row0 + ai * HALF + wr * 64 + m * 16 + fr; const size_t off = (size_t)row * DM + colb; float ss = 0.f;
                f32x4 bs[2][2];
#pragma unroll
                for (int bj = 0; bj < 2; ++bj)
#pragma unroll
                    for (int n = 0; n < 2; ++n) { const int co = bj * HALF + n * 16;
                        if (BASE_BF16) { const u32x2 b2 = *(const u32x2*)((const bf16_t*)base + off + co); bs[bj][n] = (f32x4){bf_lo(b2.x), bf_hi(b2.x), bf_lo(b2.y), bf_hi(b2.y)}; }
                        else bs[bj][n] = *(const f32x4*)((const float*)base + off + co); }
#pragma unroll
                for (int bj = 0; bj < 2; ++bj)
#pragma unroll
                    for (int n = 0; n < 2; ++n) { const int co = bj * HALF + n * 16; const f32x4 v = bs[bj][n] + acc[ai][bj][m][n];
                        u32x2 pk; pk.x = cvt_pk_bf16(v[0], v[1]); pk.y = cvt_pk_bf16(v[2], v[3]); *(u32x2*)(out + off + co) = pk;
                        ss += (v[0] * v[0] + v[1] * v[1]) + (v[2] * v[2] + v[3] * v[3]); }
                ss += __shfl_xor(ss, 16); ss += __shfl_xor(ss, 32);
                if (fq == 0) atomicAdd(rss + row, ss);
                if (m & 1) asm volatile("" ::: "memory"); }
    }
};
struct EpiSoftmax {
    static constexpr bool PERM = true;
    const float* rss; bf16_t* P;
    __device__ __forceinline__ void operator()(f32x4 (&acc)[2][2][4][2], const Unit& u, int wr, int wc, int fr, int fq, LAS unsigned char* lds) const {
        LAS f32x2* X = (LAS f32x2*)(lds + XCH_OFF);
        float ml[2][4];
#pragma unroll
        for (int ai = 0; ai < 2; ++ai)
#pragma unroll
            for (int m = 0; m < 4; ++m) {
                const int r = ai * HALF + wr * 64 + m * 16 + fr;
                const float sc = rsqrtf(rss[u.row0 + r] * (1.0f / 1024.0f) + EPS) * LOG2E;
                float mx = -3.0e38f;
#pragma unroll
                for (int bj = 0; bj < 2; ++bj)
#pragma unroll
                    for (int n = 0; n < 2; ++n) { f32x4 v = acc[ai][bj][m][n] * sc; acc[ai][bj][m][n] = v; mx = fmaxf(mx, fmaxf(fmaxf(v[0], v[1]), fmaxf(v[2], v[3]))); }
                mx = fmaxf(mx, __shfl_xor(mx, 16)); mx = fmaxf(mx, __shfl_xor(mx, 32));
                float sm = 0.f;
#pragma unroll
                for (int bj = 0; bj < 2; ++bj)
#pragma unroll
                    for (int n = 0; n < 2; ++n) { f32x4 v = acc[ai][bj][m][n]; v[0] = fast_exp2(v[0] - mx); v[1] = fast_exp2(v[1] - mx); v[2] = fast_exp2(v[2] - mx); v[3] = fast_exp2(v[3] - mx);
                        acc[ai][bj][m][n] = v; sm += (v[0] + v[1]) + (v[2] + v[3]); }
                sm += __shfl_xor(sm, 16); sm += __shfl_xor(sm, 32);
                ml[ai][m] = mx;
                if (fq == 0) X[r * 4 + wc] = (f32x2){mx, sm};
            }
        LDS_WAIT(); __builtin_amdgcn_s_barrier(); asm volatile("" ::: "memory");
#pragma unroll
        for (int ai = 0; ai < 2; ++ai)
#pragma unroll
            for (int m = 0; m < 4; ++m) {
                const int r = ai * HALF + wr * 64 + m * 16 + fr;
                const f32x2 a = X[r * 4 + 0], b = X[r * 4 + 1], c = X[r * 4 + 2], d = X[r * 4 + 3];
                const float mg = fmaxf(fmaxf(a.x, b.x), fmaxf(c.x, d.x));
                const float lg = a.y * fast_exp2(a.x - mg) + b.y * fast_exp2(b.x - mg) + c.y * fast_exp2(c.x - mg) + d.y * fast_exp2(d.x - mg);
                const float f = fast_exp2(ml[ai][m] - mg) / lg;
                bf16_t* rowp = P + (size_t)(u.row0 + r) * DM + u.col0 + wc * 32 + 8 * fq;
#pragma unroll
                for (int bj = 0; bj < 2; ++bj) { const f32x4 v0 = acc[ai][bj][m][0] * f, v1 = acc[ai][bj][m][1] * f;
                    u32x4 w; w.x = cvt_pk_bf16(v0[0], v0[1]); w.y = cvt_pk_bf16(v0[2], v0[3]); w.z = cvt_pk_bf16(v1[0], v1[1]); w.w = cvt_pk_bf16(v1[2], v1[3]);
                    *(u32x4*)(rowp + bj * HALF) = w; } }
        LDS_WAIT();
    }
};
}
struct Args { const float* in[26]; float* out; unsigned char* ws; int ph_lo, ph_hi; };
enum { I_X = 0, I_MEM, I_GMIX, I_WIN, I_CONVW, I_BI, I_BF, I_GML, I_LQ1, I_LK1, I_LQ2, I_LK2, I_GDA, I_WOUT, I_GCA, I_GMEM, I_WCQ, I_WCK, I_WCV, I_WCO, I_GFFN, I_WPQ, I_SUBK, I_PU, I_PV, I_GFIN };

struct Frame {
    LAS unsigned char* lds;
    int tid, lane, wave, G, vcu;
    const Args* a;
    unsigned char* ws;
    unsigned* ctl;
};


#define XB_TMO      128
#define XB_XCNT(j)  (256  + 64 * (j))
#define XB_XSUB(j)  (1280 + 64 * (j))
#define XB_XGEN(j)  (2304 + 64 * (j))
#define XB_TOP      3328
#define XB_TOPGEN   3392
#define XCD_BAR_WORDS 3456
#define XB_SPIN_CAP (1u << 18)
__device__ __forceinline__ unsigned xb_ld(unsigned* p)              { return __hip_atomic_load(p, __ATOMIC_RELAXED, __HIP_MEMORY_SCOPE_AGENT); }
__device__ __forceinline__ unsigned xb_add(unsigned* p, unsigned v) { return __hip_atomic_fetch_add(p, v, __ATOMIC_RELAXED, __HIP_MEMORY_SCOPE_AGENT); }
__device__ __forceinline__ unsigned xb_xcc_id() { return (unsigned)__builtin_amdgcn_s_getreg((3 << 11) | 20) & 0xFu; }
#define XB_SPIN(cond, bar) do { unsigned _sp = 0; while (cond) { __builtin_amdgcn_s_sleep(1); \
    if ((++_sp & 255u) == 0u) { if (xb_ld(&(bar)[XB_TMO])) break; if (_sp > XB_SPIN_CAP) { atomicAdd(&(bar)[XB_TMO], 1u); break; } } } } while (0)
struct XcdBarrier { unsigned* bar; unsigned x; volatile LAS unsigned* st; };
__device__ __forceinline__ XcdBarrier xcd_barrier_post(unsigned* bar, volatile LAS unsigned* st) {
    XcdBarrier b; b.bar = bar; b.x = xb_xcc_id(); b.st = st;
    if (threadIdx.x == 0) (void)xb_add(&bar[XB_XCNT(b.x)], 1u);
    return b;
}
__device__ __forceinline__ void xcd_barrier_complete(unsigned* bar, unsigned x, unsigned& nloc, unsigned& nx) {
    const unsigned G = gridDim.x * gridDim.y * gridDim.z;
    unsigned sum, cnt, mine, sp = 0u;
    for (;;) {
        sum = 0u; cnt = 0u; mine = 0u;
#pragma unroll
        for (unsigned j = 0; j < 16; ++j) { const unsigned c = xb_ld(&bar[XB_XCNT(j)]); sum += c; cnt += (c > 0u) ? 1u : 0u; mine = (j == x) ? c : mine; }
        if (sum == G) break;
        __builtin_amdgcn_s_sleep(1);
        if ((++sp & 255u) == 0u) { if (xb_ld(&bar[XB_TMO])) break; if (sp > XB_SPIN_CAP) { atomicAdd(&bar[XB_TMO], 1u); break; } }
    }
    nloc = mine > 0u ? mine : 1u; nx = cnt > 0u ? cnt : 1u;
}
__device__ __forceinline__ void xcd_barrier(const XcdBarrier& b) {
    asm volatile("s_waitcnt vmcnt(0)" ::: "memory");
    __syncthreads();
    if (threadIdx.x == 0) {
        unsigned* bar = b.bar;
        __builtin_amdgcn_s_waitcnt(0);
        unsigned nloc = b.st[0], nx = b.st[1];
        if (nloc == 0u) { xcd_barrier_complete(bar, b.x, nloc, nx); b.st[0] = nloc; b.st[1] = nx; }
        const unsigned old = xb_add(&bar[XB_XSUB(b.x)], 1u);
        const unsigned gen = old / nloc;
        if (old + 1u == (gen + 1u) * nloc) {
            __builtin_amdgcn_fence(__ATOMIC_RELEASE, "agent");
            asm volatile("s_waitcnt vmcnt(0)" ::: "memory");
            const unsigned og = xb_add(&bar[XB_TOP], 1u);
            const unsigned tg = og / nx;
            if (og + 1u == (tg + 1u) * nx) xb_add(&bar[XB_TOPGEN], 1u);
            else XB_SPIN(xb_ld(&bar[XB_TOPGEN]) == tg, bar);
            __builtin_amdgcn_fence(__ATOMIC_ACQUIRE, "agent");
            xb_add(&bar[XB_XGEN(b.x)], 1u);
            asm volatile("s_waitcnt vmcnt(0)" ::: "memory");
        } else {
            XB_SPIN(xb_ld(&bar[XB_XGEN(b.x)]) == gen, bar);
            __builtin_amdgcn_fence(__ATOMIC_ACQUIRE, "agent");
            asm volatile("s_waitcnt vmcnt(0)" ::: "memory");
        }
    }
    __syncthreads();
}

__device__ __forceinline__ void p0_transpose_item(const float* W, int Nsrc, int K, int kb, int src_col0, bf16_t* WT, int dst_row0, LAS float* scr, int lane, const float* kscale = nullptr) {
    const int k0 = 64 * kb;
#pragma unroll 8
    for (int i = 0; i < 32; ++i) { const int kk = 2 * i + (lane >> 5); float wv = W[(size_t)(k0 + kk) * Nsrc + src_col0 + (lane & 31)]; if (kscale) wv *= kscale[k0 + kk]; scr[kk * 33 + (lane & 31)] = wv; }
    LDS_WAIT(); asm volatile("" ::: "memory");
    const int c = lane & 7;
#pragma unroll
    for (int j = 0; j < 4; ++j) { const int n = (lane >> 3) + 8 * j; const LAS float* s = scr + (8 * c) * 33 + n;
        u32x4 o; o.x = cvt_pk_bf16(s[0 * 33], s[1 * 33]); o.y = cvt_pk_bf16(s[2 * 33], s[3 * 33]); o.z = cvt_pk_bf16(s[4 * 33], s[5 * 33]); o.w = cvt_pk_bf16(s[6 * 33], s[7 * 33]);
        *(u32x4*)(WT + (size_t)(dst_row0 + n) * K + k0 + 8 * c) = o; }
    LDS_WAIT(); asm volatile("" ::: "memory");
}
__device__ __forceinline__ void rms_row_to_bf16(const float* xrow, const float* g, bf16_t* orow, int lane, f32x4 (&v)[4]) {
    const f32x4* xr = (const f32x4*)xrow + lane; float s = 0.f;
#pragma unroll
    for (int j = 0; j < 4; ++j) { v[j] = xr[64 * j]; s += (v[j].x * v[j].x + v[j].y * v[j].y) + (v[j].z * v[j].z + v[j].w * v[j].w); }
    const float rstd = rsqrtf(wave_sum(s) * (1.f / DM) + EPS);
    u32x2* o8 = (u32x2*)orow + lane;
#pragma unroll
    for (int j = 0; j < 4; ++j) { const f32x4 gv = *((const f32x4*)g + lane + 64 * j); v[j] = v[j] * rstd * gv; u32x2 pk; pk.x = cvt_pk_bf16(v[j].x, v[j].y); pk.y = cvt_pk_bf16(v[j].z, v[j].w); o8[64 * j] = pk; }
}

__device__ __forceinline__ void p0_prologue(Frame& F) {
    const Args& A = *F.a;
    LAS float* scr = (LAS float*)(F.lds + F.wave * 8448);
    LAS float* sG = (LAS float*)(F.lds + 67584);
    for (int k = F.tid; k < DM; k += 512) { const f32x4 w0 = *(const f32x4*)(A.in[I_WIN] + (size_t)k * INW + 2048), w1 = *(const f32x4*)(A.in[I_WIN] + (size_t)k * INW + 2052);
        sG[0 * DM + k] = w0.x; sG[1 * DM + k] = w0.y; sG[2 * DM + k] = w0.z; sG[3 * DM + k] = w0.w; sG[4 * DM + k] = w1.x; sG[5 * DM + k] = w1.y; sG[6 * DM + k] = w1.z; sG[7 * DM + k] = w1.w; }
    __syncthreads();
    const int gw = F.vcu * 8 + F.wave, NGW = F.G * 8;
    constexpr int KB = DM / 64;
    constexpr int I_IN = KB * (NZ / 32), I_SQ = KB * (DM / 32);
    constexpr int NITEMS = I_IN + 5 * I_SQ;
    bf16_t* WinT = (bf16_t*)(F.ws + WS_WIN); bf16_t* WoutT = (bf16_t*)(F.ws + WS_WOUT); bf16_t* WkvT = (bf16_t*)(F.ws + WS_WKV); bf16_t* WcoT = (bf16_t*)(F.ws + WS_WCO); bf16_t* WpqT = (bf16_t*)(F.ws + WS_WPQ);
    for (int it = gw; it < NITEMS; it += NGW) {
        int r = it;
        if (r < I_IN) { const int kb = r / (NZ / 32), nb = r % (NZ / 32), n0 = nb * 32; p0_transpose_item(A.in[I_WIN], INW, DM, kb, n0 + (n0 >= 2048 ? 8 : 0), WinT, n0, scr, F.lane); continue; } r -= I_IN;
        const int which = r / I_SQ; r -= which * I_SQ; const int kb = r / (DM / 32), n0 = (r % (DM / 32)) * 32;
        if (which == 0) p0_transpose_item(A.in[I_WOUT], DM, DM, kb, n0, WoutT, n0, scr, F.lane);
        else if (which == 1) p0_transpose_item(A.in[I_WCK], DM, DM, kb, n0, WkvT, n0, scr, F.lane);
        else if (which == 2) p0_transpose_item(A.in[I_WCV], DM, DM, kb, n0, WkvT, DM + n0, scr, F.lane);
        else if (which == 3) p0_transpose_item(A.in[I_WCO], DM, DM, kb, n0, WcoT, n0, scr, F.lane);
        else p0_transpose_item(A.in[I_WPQ], DM, DM, kb, n0, WpqT, n0, scr, F.lane, A.in[I_GFFN]);
    }
    {
        const int gt = F.vcu * 512 + F.tid, NT = F.G * 512;
        const f32x4* s0 = (const f32x4*)A.in[I_WCQ]; u32x2* d0 = (u32x2*)(F.ws + WS_WCQ);
        for (int i = gt; i < DM * DM / 4; i += NT) { const f32x4 v = s0[i]; u32x2 pk; pk.x = cvt_pk_bf16(v.x, v.y); pk.y = cvt_pk_bf16(v.z, v.w); d0[i] = pk; }
        const f32x4* s1 = (const f32x4*)A.in[I_SUBK]; u32x2* d1 = (u32x2*)(F.ws + WS_SK);
        for (int i = gt; i < 16 * 128 * 64 / 4; i += NT) { const f32x4 v = s1[i]; u32x2 pk; pk.x = cvt_pk_bf16(v.x, v.y); pk.y = cvt_pk_bf16(v.z, v.w); d1[i] = pk; }
    }
    {
        bf16_t* HN = (bf16_t*)(F.ws + WS_BUFA); float* GT = (float*)(F.ws + WS_GATES);
        for (int m = gw; m < T_TOK; m += NGW) {
            f32x4 v[4]; rms_row_to_bf16(A.in[I_X] + (size_t)m * DM, A.in[I_GMIX], HN + (size_t)m * DM, F.lane, v);
            float gacc[8];
#pragma unroll
            for (int j = 0; j < 8; ++j) gacc[j] = 0.f;
#pragma unroll
            for (int jj = 0; jj < 4; ++jj)
#pragma unroll
                for (int j = 0; j < 8; ++j) { const f32x4 wv = *(const LAS f32x4*)(sG + j * DM + 4 * F.lane + 256 * jj); gacc[j] += (v[jj].x * wv.x + v[jj].y * wv.y) + (v[jj].z * wv.z + v[jj].w * wv.w); }
            float r4[4], r2[2], r1;
            { const bool hi = (F.lane & 32) != 0;
#pragma unroll
              for (int i = 0; i < 4; ++i) { const float keep = hi ? gacc[i + 4] : gacc[i], send = hi ? gacc[i] : gacc[i + 4]; r4[i] = keep + __shfl_xor(send, 32); } }
            { const bool hi = (F.lane & 16) != 0;
#pragma unroll
              for (int i = 0; i < 2; ++i) { const float keep = hi ? r4[i + 2] : r4[i], send = hi ? r4[i] : r4[i + 2]; r2[i] = keep + __shfl_xor(send, 16); } }
            { const bool hi = (F.lane & 8) != 0; const float keep = hi ? r2[1] : r2[0], send = hi ? r2[0] : r2[1]; r1 = keep + __shfl_xor(send, 8); }
            r1 += __shfl_xor(r1, 4); r1 += __shfl_xor(r1, 2); r1 += __shfl_xor(r1, 1);
            if ((F.lane & 7) == 0) GT[(size_t)m * 8 + 4 * (F.lane >> 5) + 2 * ((F.lane >> 4) & 1) + ((F.lane >> 3) & 1)] = r1;
        }
        bf16_t* MN = (bf16_t*)(F.ws + WS_MEMN);
        for (int m = gw; m < TMEM; m += NGW) { f32x4 v[4]; rms_row_to_bf16(A.in[I_MEM] + (size_t)m * DM, A.in[I_GMEM], MN + (size_t)m * DM, F.lane, v); }
    }
}
#ifndef AT_DEPTH
#define AT_DEPTH 3
#endif
constexpr int AT_STAGE = 32768, AT_NST = 4;
__device__ __forceinline__ int swzf(int r) { return ((r & 3) << 2) | ((r >> 2) & 3); }

__device__ __forceinline__ void glds16_asm(const void* gsrc, unsigned lds_dst) {
    unsigned keep;
    asm volatile("s_mov_b32 %0, m0\n\ts_mov_b32 m0, %2\n\ts_nop 0\n\tglobal_load_lds_dwordx4 %1, off\n\ts_mov_b32 m0, %0" : "=&s"(keep) : "v"(gsrc), "s"(lds_dst) : "memory");
}

__device__ __forceinline__ s16x4 tr16(const LAS unsigned char* p) { return __builtin_amdgcn_ds_read_tr16_b64_v4i16((LAS s16x4*)p); }
__device__ __forceinline__ bf16x8 cat8(s16x4 lo, s16x4 hi) { return __builtin_shufflevector(lo, hi, 0, 1, 2, 3, 4, 5, 6, 7); }

template <int MODE>
__device__ __forceinline__ void attn_unit(Frame& F, const int b, const int h, const int qt, const float lam) {
    const Args& A = *F.a;
    const bf16_t* Z = (const bf16_t*)(F.ws + WS_Z);
    bf16_t* CAT = (bf16_t*)(F.ws + WS_BUFA);
    LAS unsigned char* lds = F.lds;
    int tid_l = F.tid; asm volatile("" : "+v"(tid_l));
    const int tid = tid_l, lane = tid & 63, w = F.wave, c = w & 1, qb = w >> 1, n = lane & 31, h2 = lane >> 5;
    const int q0 = qt * 128, r0 = q0 + 32 * qb, ntiles = 2 * qt + 2;
    const size_t rowbase = (size_t)b * SEQ;
    const float slope2 = __uint_as_float((unsigned)(127 - 2 * (h + 1)) << 23) * LOG2E, c1 = 0.125f * LOG2E;
    const float slope_hi = __uint_as_float(__float_as_uint(slope2) & 0xffff0000u), slope_lo = slope2 - slope_hi;
    bf16x8 Qf[4];
    { const bf16_t* qp = Z + (rowbase + r0 + n) * NZ + ZC_DAQ + h * 128 + c * 64 + 8 * h2;
#pragma unroll
      for (int kk = 0; kk < 4; ++kk) { const u32x4 q4_ = *(const u32x4*)(qp + 16 * kk); u32x4 o_;
          o_.x = cvt_pk_bf16(bf_lo(q4_.x) * c1, bf_hi(q4_.x) * c1); o_.y = cvt_pk_bf16(bf_lo(q4_.y) * c1, bf_hi(q4_.y) * c1); o_.z = cvt_pk_bf16(bf_lo(q4_.z) * c1, bf_hi(q4_.z) * c1); o_.w = cvt_pk_bf16(bf_lo(q4_.w) * c1, bf_hi(q4_.w) * c1);
          Qf[kk] = __builtin_bit_cast(bf16x8, o_); } }
    bf16x8 Qx, Kx[2];
    { u32x4 o_ = (u32x4){0u, 0u, 0u, 0u}; if (h2 == 0) o_.x = cvt_pk_bf16(slope_hi, slope_lo); Qx = __builtin_bit_cast(bf16x8, o_);
#pragma unroll
      for (int kb = 0; kb < 2; ++kb) { u32x4 k_ = (u32x4){0u, 0u, 0u, 0u}; if (h2 == 0) k_.x = cvt_pk_bf16((float)(32 * kb + n), (float)(32 * kb + n)); Kx[kb] = __builtin_bit_cast(bf16x8, k_); } }
    f32x16 O[4];
#pragma unroll
    for (int i = 0; i < 4; ++i)
#pragma unroll
        for (int j = 0; j < 16; ++j) O[i][j] = 0.f;
    float mrun = -3.0e38f, lsum = 0.f;
    const unsigned ldsbase = (unsigned)(size_t)lds;
#define AT_DMA(j_) do { if (MODE & 2) break; const int jj_ = (j_) < ntiles ? (j_) : ntiles - 1; \
        _Pragma("unroll") for (int m_ = 0; m_ < 4; ++m_) { const int i_ = w + 8 * m_, r_ = 4 * (i_ & 15) + (lane >> 4), gch_ = (lane & 15) ^ swzf(r_); \
            const bf16_t* src_ = Z + (rowbase + 64 * jj_ + r_) * NZ + ((i_ >= 16) ? ZC_DAV : ZC_DAK) + h * 128 + 8 * gch_; \
            glds16_asm(src_, ldsbase + (unsigned)(((j_) & 3) * AT_STAGE + i_ * 1024)); } } while (0)
#if AT_DEPTH == 3
    AT_DMA(0); AT_DMA(1); AT_DMA(2);
    asm volatile("s_waitcnt vmcnt(4)" ::: "memory");
#else
    AT_DMA(0); AT_DMA(1);
    VM_WAIT();
#endif
    __syncthreads();
    const int i16 = lane & 15, q4 = i16 >> 2, p4 = i16 & 3, blk = (lane >> 4) & 1;
#define AT_QK(S_, j_) do { const LAS unsigned char* Ks_ = lds + ((j_) & 3) * AT_STAGE; bf16x8 kf_[8]; \
        _Pragma("unroll") for (int kb = 0; kb < 2; ++kb) _Pragma("unroll") for (int kk = 0; kk < 4; ++kk) kf_[4 * kb + kk] = *(const LAS bf16x8*)(Ks_ + (32 * kb + n) * 256 + (((8 * c + 2 * kk + h2) ^ swzf(n)) << 4)); \
        _Pragma("unroll") for (int e = 0; e < 16; ++e) { (S_)[0][e] = 0.f; (S_)[1][e] = 0.f; } \
        _Pragma("unroll") for (int kb = 0; kb < 2; ++kb) { _Pragma("unroll") for (int kk = 0; kk < 4; ++kk) (S_)[kb] = __builtin_amdgcn_mfma_f32_32x32x16_bf16(kf_[4 * kb + kk], Qf[kk], (S_)[kb], 0, 0, 0); \
            (S_)[kb] = __builtin_amdgcn_mfma_f32_32x32x16_bf16(Kx[kb], Qx, (S_)[kb], 0, 0, 0); } } while (0)
#define AT_LOADV(buf_, dvb_) do { _Pragma("unroll") for (int kb = 0; kb < 2; ++kb) _Pragma("unroll") for (int s = 0; s < 2; ++s) { const int ch_ = 4 * (dvb_) + 2 * blk + (p4 >> 1); \
        const LAS unsigned char* vp = Vs + (32 * kb + 16 * s + 4 * h2 + q4) * 256 + 8 * (p4 & 1); \
        (buf_)[2 * kb + s] = cat8(tr16(vp + ((ch_ ^ swzf(4 * h2 + q4)) << 4)), tr16(vp + 8 * 256 + ((ch_ ^ swzf(8 + 4 * h2 + q4)) << 4))); } } while (0)
#define AT_PV(buf_, dvb_) do { _Pragma("unroll") for (int e = 0; e < 16; ++e) O[dvb_][e] *= alpha; \
        _Pragma("unroll") for (int kb = 0; kb < 2; ++kb) _Pragma("unroll") for (int s = 0; s < 2; ++s) O[dvb_] = __builtin_amdgcn_mfma_f32_32x32x16_bf16((buf_)[2 * kb + s], Pf[kb][s], O[dvb_], 0, 0, 0); } while (0)
#define AT_TILE(Sc_, Sn_, j_) do { \
        AT_DMA((j_) + AT_DEPTH); \
        const int k0 = 64 * (j_); \
        if (!(MODE & 1) && k0 <= r0 + 31) { \
            const LAS unsigned char* Vs = lds + ((j_) & 3) * AT_STAGE + 16384; \
            bf16x8 va[4], vb[4]; \
            if ((j_) + 1 < ntiles && k0 + 64 <= r0 + 31) AT_QK(Sn_, (j_) + 1); \
            AT_LOADV(va, 0); \
            const float D0 = (float)(r0 + n - k0 - 4 * h2); \
            const float tcon = slope2 * (float)(k0 - r0 - n);            \
            float mloc = -3.0e38f; \
            if (k0 + 63 > r0) { \
                _Pragma("unroll") for (int kb = 0; kb < 2; ++kb) _Pragma("unroll") for (int e = 0; e < 16; ++e) { const float off = (float)(32 * kb + (e & 3) + 8 * (e >> 2)); \
                    const float v = (off > D0) ? -INFINITY : (Sc_)[kb][e]; (Sc_)[kb][e] = v; mloc = fmaxf(mloc, v); } \
            } else { \
                _Pragma("unroll") for (int kb = 0; kb < 2; ++kb) _Pragma("unroll") for (int e = 0; e < 16; ++e) mloc = fmaxf(mloc, (Sc_)[kb][e]); \
            } \
            mloc = fmaxf(mloc, __shfl_xor(mloc, 32)) + tcon; \
            const float mnew = fmaxf(mrun, mloc), alpha = fast_exp2(mrun - mnew); \
            mrun = mnew; \
            const float mm = mnew - tcon; \
            float ps = 0.f; \
            _Pragma("unroll") for (int kb = 0; kb < 2; ++kb) _Pragma("unroll") for (int e = 0; e < 16; ++e) { const float pv = fast_exp2((Sc_)[kb][e] - mm); (Sc_)[kb][e] = pv; ps += pv; } \
            lsum = lsum * alpha + ps; \
            bf16x8 Pf[2][2]; \
            _Pragma("unroll") for (int kb = 0; kb < 2; ++kb) _Pragma("unroll") for (int s = 0; s < 2; ++s) { u32x4 pk; pk.x = cvt_pk_bf16((Sc_)[kb][8 * s + 0], (Sc_)[kb][8 * s + 1]); pk.y = cvt_pk_bf16((Sc_)[kb][8 * s + 2], (Sc_)[kb][8 * s + 3]); \
                pk.z = cvt_pk_bf16((Sc_)[kb][8 * s + 4], (Sc_)[kb][8 * s + 5]); pk.w = cvt_pk_bf16((Sc_)[kb][8 * s + 6], (Sc_)[kb][8 * s + 7]); Pf[kb][s] = __builtin_bit_cast(bf16x8, pk); } \
            AT_LOADV(vb, 1); AT_PV(va, 0); \
            AT_LOADV(va, 2); AT_PV(vb, 1); \
            AT_LOADV(vb, 3); AT_PV(va, 2); \
            AT_PV(vb, 3); \
        } \
        if (AT_DEPTH == 3) asm volatile("s_waitcnt vmcnt(4)" ::: "memory"); else asm volatile("s_waitcnt vmcnt(0)" ::: "memory"); \
        __syncthreads(); } while (0)
    f32x16 SA[2], SB[2];
    AT_QK(SA, 0);
    for (int j = 0; j < ntiles; j += 2) { AT_TILE(SA, SB, j); AT_TILE(SB, SA, j + 1); }
#undef AT_TILE
#undef AT_PV
#undef AT_LOADV
#undef AT_QK
    VM_WAIT();
    __syncthreads();
    { const float lt = lsum + __shfl_xor(lsum, 32); const float inv = (c == 0 ? 1.0f : lam) / lt;
#pragma unroll
      for (int dvb = 0; dvb < 4; ++dvb)
#pragma unroll
          for (int e = 0; e < 16; ++e) O[dvb][e] *= inv; }
    LAS float* cb = (LAS float*)lds + qb * 4096;
    if (c == 1) {
#pragma unroll
        for (int dvb = 0; dvb < 4; ++dvb)
#pragma unroll
            for (int e = 0; e < 16; ++e) cb[(dvb * 16 + e) * 64 + lane] = O[dvb][e];
    }
    __syncthreads();
    if (c == 0 && MODE == 0) {
        float ss = 0.f;
#pragma unroll
        for (int dvb = 0; dvb < 4; ++dvb)
#pragma unroll
            for (int e = 0; e < 16; ++e) { const float o = O[dvb][e] - cb[(dvb * 16 + e) * 64 + lane]; O[dvb][e] = o; ss += o * o; }
        ss += __shfl_xor(ss, 32);
        const float rstd = rsqrtf(ss * (1.0f / 128.0f) + EPS) * 0.8f;
        const float* g = A.in[I_GDA] + h * 128;
        bf16_t* op = CAT + (rowbase + r0 + n) * DM + 512 + h * 128;
#pragma unroll
        for (int dvb = 0; dvb < 4; ++dvb)
#pragma unroll
            for (int e4 = 0; e4 < 4; ++e4) { const int dv = 32 * dvb + 8 * e4 + 4 * h2; const f32x4 gv = *(const f32x4*)(g + dv);
                u32x2 pk; pk.x = cvt_pk_bf16(O[dvb][4 * e4 + 0] * rstd * gv.x, O[dvb][4 * e4 + 1] * rstd * gv.y); pk.y = cvt_pk_bf16(O[dvb][4 * e4 + 2] * rstd * gv.z, O[dvb][4 * e4 + 3] * rstd * gv.w);
                *(u32x2*)(op + dv) = pk; }
    }
    __syncthreads();
#undef AT_DMA
}
__device__ __forceinline__ void conv_prepass(Frame& F) {
    const Args& A = *F.a;
    const bf16_t* Z = (const bf16_t*)(F.ws + WS_Z);
    bf16_t* QKC = (bf16_t*)(F.ws + WS_BUFB);
    const int gt = F.vcu * 512 + F.tid, NT = F.G * 512;
    for (int it = gt; it < (T_TOK / 4) * 128; it += NT) {
        const int cg = it & 127, rb = it >> 7, row0 = 4 * rb, tl = row0 & (SEQ - 1), c0 = 8 * cg;
        float cw[4][8];
#pragma unroll
        for (int tp = 0; tp < 4; ++tp) { const f32x4 w0 = *(const f32x4*)(A.in[I_CONVW] + tp * 1024 + c0), w1 = *(const f32x4*)(A.in[I_CONVW] + tp * 1024 + c0 + 4);
            cw[tp][0] = w0.x; cw[tp][1] = w0.y; cw[tp][2] = w0.z; cw[tp][3] = w0.w; cw[tp][4] = w1.x; cw[tp][5] = w1.y; cw[tp][6] = w1.z; cw[tp][7] = w1.w; }
        u32x4 raw[7];
#pragma unroll
        for (int i = 0; i < 7; ++i) raw[i] = (tl - 3 + i >= 0) ? *(const u32x4*)(Z + (size_t)(row0 - 3 + i) * NZ + c0) : (u32x4){0u, 0u, 0u, 0u};
        const float ksc = (c0 >= 512) ? 0.08838834764831845f : 1.0f;
#pragma unroll
        for (int r = 0; r < 4; ++r) {
            float y[8];
#pragma unroll
            for (int ch = 0; ch < 8; ++ch) y[ch] = 0.f;
#pragma unroll
            for (int tp = 0; tp < 4; ++tp) { const u32x4 rv = raw[r + tp];
                y[0] += cw[tp][0] * bf_lo(rv.x); y[1] += cw[tp][1] * bf_hi(rv.x); y[2] += cw[tp][2] * bf_lo(rv.y); y[3] += cw[tp][3] * bf_hi(rv.y);
                y[4] += cw[tp][4] * bf_lo(rv.z); y[5] += cw[tp][5] * bf_hi(rv.z); y[6] += cw[tp][6] * bf_lo(rv.w); y[7] += cw[tp][7] * bf_hi(rv.w); }
#pragma unroll
            for (int ch = 0; ch < 8; ++ch) y[ch] = y[ch] * fast_rcp(1.0f + __expf(-y[ch])) * ksc;
            u32x4 pk; pk.x = cvt_pk_bf16(y[0], y[1]); pk.y = cvt_pk_bf16(y[2], y[3]); pk.z = cvt_pk_bf16(y[4], y[5]); pk.w = cvt_pk_bf16(y[6], y[7]);
            *(u32x4*)(QKC + (size_t)(row0 + r) * DM + c0) = pk;
        }
    }
}

#ifndef ML_TOUCH
#define ML_TOUCH 0
#endif
constexpr int ML_TB = 49152;
constexpr int ML_HB = 2 * ML_TB;
constexpr int ML_HP = 132;
constexpr int ML_SC = ML_HB + 64 * ML_HP * 4;

#define MFMA16(a, b, c) __builtin_amdgcn_mfma_f32_16x16x32_bf16((a), (b), (c), 0, 0, 0)

__device__ __forceinline__ void mlstm_unit(Frame& F, const int b, const int h) {
    const Args& A = *F.a;
    const bf16_t* Z = (const bf16_t*)(F.ws + WS_Z);
    const bf16_t* QKC = (const bf16_t*)(F.ws + WS_BUFB);
    const float* GT = (const float*)(F.ws + WS_GATES);
    bf16_t* CAT = (bf16_t*)(F.ws + WS_BUFA);
    LAS unsigned char* lds = F.lds;
    int tid_l = F.tid; asm volatile("" : "+v"(tid_l));
    const int tid = tid_l, lane = tid & 63, w = F.wave, n = lane & 15, g = lane >> 4, q4 = n >> 2, p4 = n & 3;
    const size_t rowbase = (size_t)b * SEQ;
    LAS float* sc = (LAS float*)(lds + ML_SC);
    LAS float* sA = sc; LAS float* sM = sc + 128; LAS float* sInter = sc + 256; LAS float* sMt = sc + 384; LAS float* sW = sc + 512; LAS float* sDi = sc + 640; LAS float* sQn = sc + 704; LAS float* sN = sc + 768;
    if (tid < 128) sN[tid] = 0.f;
    const unsigned ldsbase = (unsigned)(size_t)lds;
    const float bi = A.in[I_BI][h], bfg = A.in[I_BF][h];
    float gi_r, gf_r;
#define ML_DMA(cc, par_) do { const int t0_ = 64 * (cc); \
        _Pragma("unroll") for (int m_ = 0; m_ < 6; ++m_) { const int i_ = w + 8 * m_, tile_ = i_ >> 4, r_ = 4 * (i_ & 15) + (lane >> 4), gch_ = (lane & 15) ^ swzf(r_); \
            const bf16_t* src_ = (tile_ == 2) ? (Z + (rowbase + t0_ + r_) * NZ + ZC_MLV + 128 * h + 8 * gch_) : (QKC + (rowbase + t0_ + r_) * DM + 512 * tile_ + 128 * h + 8 * gch_); \
            glds16_asm(src_, ldsbase + (unsigned)((par_) * ML_TB + i_ * 1024)); } } while (0)
#define ML_GATES(cc) do { gi_r = GT[(rowbase + 64 * (cc) + lane) * 8 + h]; gf_r = GT[(rowbase + 64 * (cc) + lane) * 8 + 4 + h]; } while (0)
    float m_st = 0.f, decay_c = 1.f;
#define ML_SCALARS(par_) do { \
        const float gi = gi_r + bi, gfv = gf_r + bfg; \
        const float lf = fminf(gfv, 0.f) - __logf(1.0f + __expf(-fabsf(gfv))); \
        float bc = lf; \
        _Pragma("unroll") for (int o = 1; o < 64; o <<= 1) { const float t_ = __shfl_up(bc, o); if (lane >= o) bc += t_; } \
        const float av = gi - bc; float pm = av; \
        _Pragma("unroll") for (int o = 1; o < 64; o <<= 1) { const float t_ = __shfl_up(pm, o); if (lane >= o) pm = fmaxf(pm, t_); } \
        const float Mv = fmaxf(m_st, pm), inter = __expf(m_st - Mv), mt = bc + Mv; \
        const float M63 = __shfl(Mv, 63), bc63 = __shfl(bc, 63); \
        const float wg = __expf(av - M63); \
        decay_c = __shfl(inter, 63); m_st = bc63 + M63; \
        if (w == 0) { sA[(par_) * 64 + lane] = av; sM[(par_) * 64 + lane] = Mv; sInter[(par_) * 64 + lane] = inter; sMt[(par_) * 64 + lane] = mt; sW[(par_) * 64 + lane] = wg; } \
    } while (0)

    f32x4 Cacc[8];
#pragma unroll
    for (int dt = 0; dt < 8; ++dt) Cacc[dt] = (f32x4){0.f, 0.f, 0.f, 0.f};
    ML_GATES(0);
    ML_DMA(0, 0);
    ML_SCALARS(0);
    VM_WAIT(); LDS_WAIT();
    __syncthreads();
    const float* gml = A.in[I_GML] + 128 * h;
    const int e0 = 16 * w;
    unsigned touch = 0u;
#pragma unroll 1
    for (int c = 0; c < 32; ++c) {
        const float decay = decay_c; const int par = c & 1;
        const LAS unsigned char* TQ = lds + par * ML_TB; const LAS unsigned char* TK = TQ + 16384; const LAS unsigned char* TV = TQ + 32768;
        if (c + 1 < 32) { ML_DMA(c + 1, par ^ 1); ML_GATES(c + 1); }
        const int nrow = tid >> 3, nseg = tid & 7;
        { const int rr = 8 * w + (lane >> 3), seg = lane & 7, x = swzf(rr);
          const u32x4 qa = *(const LAS u32x4*)(TQ + rr * 256 + (((2 * seg) ^ x) << 4)), qb = *(const LAS u32x4*)(TQ + rr * 256 + (((2 * seg + 1) ^ x) << 4));
          const f32x4 n0 = *(const LAS f32x4*)(sN + 16 * seg), n1 = *(const LAS f32x4*)(sN + 16 * seg + 4), n2 = *(const LAS f32x4*)(sN + 16 * seg + 8), n3 = *(const LAS f32x4*)(sN + 16 * seg + 12);
          float d = bf_lo(qa.x) * n0.x + bf_hi(qa.x) * n0.y + bf_lo(qa.y) * n0.z + bf_hi(qa.y) * n0.w + bf_lo(qa.z) * n1.x + bf_hi(qa.z) * n1.y + bf_lo(qa.w) * n1.z + bf_hi(qa.w) * n1.w
                  + bf_lo(qb.x) * n2.x + bf_hi(qb.x) * n2.y + bf_lo(qb.y) * n2.z + bf_hi(qb.y) * n2.w + bf_lo(qb.z) * n3.x + bf_hi(qb.z) * n3.y + bf_lo(qb.w) * n3.z + bf_hi(qb.w) * n3.w;
          d += __shfl_xor(d, 1); d += __shfl_xor(d, 2); d += __shfl_xor(d, 4);
          if (seg == 0) sQn[rr] = d; }
        bf16x8 Vf[2], Cf[4];
#pragma unroll
        for (int ks = 0; ks < 2; ++ks) {
            const LAS unsigned char* vp = TV + (32 * ks + 4 * g + q4) * 256 + (((2 * w + (p4 >> 1)) ^ swzf(4 * g + q4)) << 4) + 8 * (p4 & 1);
            Vf[ks] = cat8(tr16(vp), tr16(vp + 16 * 256));
        }
#pragma unroll
        for (int kd = 0; kd < 4; ++kd) { const f32x4 c0 = Cacc[2 * kd], c1 = Cacc[2 * kd + 1]; u32x4 pk; pk.x = cvt_pk_bf16(c0[0], c0[1]); pk.y = cvt_pk_bf16(c0[2], c0[3]); pk.z = cvt_pk_bf16(c1[0], c1[1]); pk.w = cvt_pk_bf16(c1[2], c1[3]); Cf[kd] = __builtin_bit_cast(bf16x8, pk); }
#pragma unroll 1
        for (int lb = 0; lb < 4; ++lb) {
            u32x4 pk[2]; pk[0] = (u32x4){0u, 0u, 0u, 0u}; pk[1] = (u32x4){0u, 0u, 0u, 0u};
            float di = 0.f;
            const LAS unsigned char* qrow = TQ + (16 * lb + n) * 256;
            {
                bf16x8 Qf[4];
#pragma unroll
                for (int kk = 0; kk < 4; ++kk) Qf[kk] = *(const LAS bf16x8*)(qrow + (((4 * kk + g) ^ swzf(n)) << 4));
                const float Ml = sM[par * 64 + 16 * lb + n];
#pragma unroll
                for (int sb = 0; sb < 4; ++sb) if (sb <= lb) {
                    f32x4 acc = (f32x4){0.f, 0.f, 0.f, 0.f};
#pragma unroll
                    for (int kk = 0; kk < 4; ++kk) { const bf16x8 kf = *(const LAS bf16x8*)(TK + (16 * sb + n) * 256 + (((4 * kk + g) ^ swzf(n)) << 4)); acc = MFMA16(kf, Qf[kk], acc); }
                    const f32x4 av4 = *(const LAS f32x4*)(sA + par * 64 + 16 * sb + 4 * g);
                    float pv[4];
#pragma unroll
                    for (int r = 0; r < 4; ++r) { float e = acc[r] * fast_exp2((av4[r] - Ml) * LOG2E); if (sb == lb && (4 * g + r > n)) e = 0.f; pv[r] = e; di += e; }
                    const unsigned u0 = cvt_pk_bf16(pv[0], pv[1]), u1 = cvt_pk_bf16(pv[2], pv[3]);
                    if ((sb & 1) == 0) { pk[sb >> 1].x = u0; pk[sb >> 1].y = u1; } else { pk[sb >> 1].z = u0; pk[sb >> 1].w = u1; }
                }
            }
            di += __shfl_xor(di, 16); di += __shfl_xor(di, 32);
            if (w == 0 && g == 0) sDi[16 * lb + n] = di;
            f32x4 numI = (f32x4){0.f, 0.f, 0.f, 0.f}, accI = (f32x4){0.f, 0.f, 0.f, 0.f};
            numI = MFMA16(__builtin_bit_cast(bf16x8, pk[0]), Vf[0], numI);
            if (lb >= 2) numI = MFMA16(__builtin_bit_cast(bf16x8, pk[1]), Vf[1], numI);
#pragma unroll
            for (int kd = 0; kd < 4; ++kd) { const s16x4 lo = *(const LAS s16x4*)(qrow + (((4 * kd + (g >> 1)) ^ swzf(n)) << 4) + 8 * (g & 1)), hi = *(const LAS s16x4*)(qrow + (((4 * kd + 2 + (g >> 1)) ^ swzf(n)) << 4) + 8 * (g & 1));
                accI = MFMA16(cat8(lo, hi), Cf[kd], accI); }
            const f32x4 in4 = *(const LAS f32x4*)(sInter + par * 64 + 16 * lb + 4 * g);
#pragma unroll
            for (int r = 0; r < 4; ++r) *(LAS float*)(lds + ML_HB + ((16 * lb + 4 * g + r) * ML_HP + e0 + n) * 4) = numI[r] + in4[r] * accI[r];
            asm volatile("" ::: "memory");
        }
        const u32x4 og0 = *(const u32x4*)(Z + (rowbase + 64 * c + nrow) * NZ + ZC_MLO + 128 * h + 16 * nseg), og1 = *(const u32x4*)(Z + (rowbase + 64 * c + nrow) * NZ + ZC_MLO + 128 * h + 16 * nseg + 8);
        bf16x8 Vw[2], Wf[2];
#pragma unroll
        for (int ks = 0; ks < 2; ++ks) {
            const f32x4 wl = *(const LAS f32x4*)(sW + par * 64 + 32 * ks + 4 * g), wh = *(const LAS f32x4*)(sW + par * 64 + 32 * ks + 16 + 4 * g);
            const u32x4 v4 = __builtin_bit_cast(u32x4, Vf[ks]);
            u32x4 pw; pw.x = cvt_pk_bf16(bf_lo(v4.x) * wl.x, bf_hi(v4.x) * wl.y); pw.y = cvt_pk_bf16(bf_lo(v4.y) * wl.z, bf_hi(v4.y) * wl.w); pw.z = cvt_pk_bf16(bf_lo(v4.z) * wh.x, bf_hi(v4.z) * wh.y); pw.w = cvt_pk_bf16(bf_lo(v4.w) * wh.z, bf_hi(v4.w) * wh.w);
            Vw[ks] = __builtin_bit_cast(bf16x8, pw);
            u32x4 pf; pf.x = cvt_pk_bf16(wl.x, wl.y); pf.y = cvt_pk_bf16(wl.z, wl.w); pf.z = cvt_pk_bf16(wh.x, wh.y); pf.w = cvt_pk_bf16(wh.z, wh.w);
            if (n != 0) pf = (u32x4){0u, 0u, 0u, 0u};
            Wf[ks] = __builtin_bit_cast(bf16x8, pf);
        }
        f32x4 cn = (f32x4){0.f, 0.f, 0.f, 0.f};
#pragma unroll
        for (int dt = 0; dt < 8; ++dt) {
            f32x4 cacc = Cacc[dt] * decay;
#pragma unroll
            for (int ks = 0; ks < 2; ++ks) { const LAS unsigned char* kp = TK + (32 * ks + 4 * g + q4) * 256 + (((2 * dt + (p4 >> 1)) ^ swzf(4 * g + q4)) << 4) + 8 * (p4 & 1);
                const bf16x8 kt = cat8(tr16(kp), tr16(kp + 16 * 256)); cacc = MFMA16(kt, Vw[ks], cacc); if (dt == w) cn = MFMA16(kt, Wf[ks], cn); }
            Cacc[dt] = cacc;
        }
        LDS_WAIT();
        __syncthreads();
        if (n == 0) {
#pragma unroll
            for (int r = 0; r < 4; ++r) sN[16 * w + 4 * g + r] = decay * sN[16 * w + 4 * g + r] + cn[r]; }
        {
            const LAS float* hp = (const LAS float*)(lds + ML_HB) + nrow * ML_HP + 16 * nseg;
            f32x4 hv[4]; float ss = 0.f;
#pragma unroll
            for (int i = 0; i < 4; ++i) { hv[i] = *(const LAS f32x4*)(hp + 4 * i); ss += (hv[i].x * hv[i].x + hv[i].y * hv[i].y) + (hv[i].z * hv[i].z + hv[i].w * hv[i].w); }
            ss += __shfl_xor(ss, 1); ss += __shfl_xor(ss, 2); ss += __shfl_xor(ss, 4);
            const float den = sDi[nrow] + sInter[par * 64 + nrow] * sQn[nrow];
            const float dn = fmaxf(fabsf(den), __expf(-sMt[par * 64 + nrow]));
            const float rstd = rsqrtf(ss * (1.0f / 128.0f) + EPS * dn * dn);
            const unsigned ogw[8] = {og0.x, og0.y, og0.z, og0.w, og1.x, og1.y, og1.z, og1.w};
            unsigned outw[8];
#pragma unroll
            for (int i = 0; i < 4; ++i) { const f32x4 gv = *(const f32x4*)(gml + 16 * nseg + 4 * i);
                const float o0 = bf_lo(ogw[2 * i]), o1 = bf_hi(ogw[2 * i]), o2 = bf_lo(ogw[2 * i + 1]), o3 = bf_hi(ogw[2 * i + 1]);
                const float y0 = hv[i].x * rstd * gv.x * fast_rcp(1.0f + __expf(-o0)), y1 = hv[i].y * rstd * gv.y * fast_rcp(1.0f + __expf(-o1));
                const float y2 = hv[i].z * rstd * gv.z * fast_rcp(1.0f + __expf(-o2)), y3 = hv[i].w * rstd * gv.w * fast_rcp(1.0f + __expf(-o3));
                outw[2 * i] = cvt_pk_bf16(y0, y1); outw[2 * i + 1] = cvt_pk_bf16(y2, y3); }
            bf16_t* op = CAT + (rowbase + 64 * c + nrow) * DM + 128 * h + 16 * nseg;
            *(u32x4*)op = (u32x4){outw[0], outw[1], outw[2], outw[3]}; *(u32x4*)(op + 8) = (u32x4){outw[4], outw[5], outw[6], outw[7]};
        }
        if (c + 1 < 32) ML_SCALARS(par ^ 1);
        VM_WAIT(); LDS_WAIT();
#if ML_TOUCH
        asm volatile("" :: "v"(touch));
        if (c + 4 < 32 && tid < 384) { const int tl_ = tid >> 7, r_ = (tid & 127) >> 1, hf_ = tid & 1;
            const bf16_t* p_ = (tl_ == 2) ? (Z + (rowbase + 64 * (c + 4) + r_) * NZ + ZC_MLV + 128 * h + 64 * hf_) : (QKC + (rowbase + 64 * (c + 4) + r_) * DM + 512 * tl_ + 128 * h + 64 * hf_);
            touch = *(const volatile unsigned*)p_; }
#endif
        __syncthreads();
    }
#undef ML_DMA
#undef ML_GATES
#undef ML_SCALARS
}
#ifndef PROBE_HALF
#define PROBE_HALF 0
#endif
#ifndef Q_LPT
#define Q_LPT 0
#endif
#ifndef Q_PAIRED
#define Q_PAIRED 0
#endif
#if Q_PAIRED
#define QN_ATT 64
#else
#define QN_ATT 128
#endif
#ifndef ATT_MODE
#define ATT_MODE 0
#endif
#ifndef REPSUB
#define REPSUB 3
#endif
#ifndef PE_TOUCH
#define PE_TOUCH 0
#endif
#ifndef P7REP
#define P7REP 0
#endif
constexpr size_t WS_US = WS_END;
constexpr int PE_REP = 132;
constexpr int PE_RE = 0, PE_RG = 128 * PE_REP * 2;

__device__ __forceinline__ unsigned enc_f(float f) { const unsigned b = __float_as_uint(f); return b ^ ((unsigned)((int)b >> 31) | 0x80000000u); }
__device__ __forceinline__ float dec_f(unsigned e) { return __uint_as_float(e ^ ((~(unsigned)((int)e >> 31)) | 0x80000000u)); }
__device__ __forceinline__ unsigned umax3(unsigned a, unsigned b, unsigned c) { return max(max(a, b), c); }

#define CE_DESC(x, y) do { const unsigned hi_ = max((x), (y)), lo_ = min((x), (y)); (x) = hi_; (y) = lo_; } while (0)
__device__ __forceinline__ void sort16_desc(unsigned (&a)[16]) {
#pragma unroll
    for (int k = 2; k <= 16; k <<= 1)
#pragma unroll
        for (int j = k >> 1; j > 0; j >>= 1)
#pragma unroll
            for (int i = 0; i < 16; ++i) { const int l = i ^ j; if (l > i) { if ((i & k) == 0) CE_DESC(a[i], a[l]); else CE_DESC(a[l], a[i]); } }
}
__device__ __forceinline__ void bitonic_merge16_desc(unsigned (&a)[16]) {
#pragma unroll
    for (int j = 8; j > 0; j >>= 1)
#pragma unroll
        for (int i = 0; i < 16; ++i) { const int l = i ^ j; if (l > i) CE_DESC(a[i], a[l]); }
}
__device__ __forceinline__ void merge_top16(unsigned (&a)[16], const unsigned (&b)[16]) {
#pragma unroll
    for (int i = 0; i < 16; ++i) a[i] = max(a[i], b[15 - i]);
    bitonic_merge16_desc(a);
}
template <bool PAIR>
__device__ __forceinline__ void top16_of64(const unsigned (&key)[64], unsigned (&top)[16]) {
    unsigned q1[16], q2[16], q3[16];
#pragma unroll
    for (int i = 0; i < 16; ++i) { top[i] = key[i]; q1[i] = key[16 + i]; q2[i] = key[32 + i]; q3[i] = key[48 + i]; }
    sort16_desc(top); sort16_desc(q1); merge_top16(top, q1);
    sort16_desc(q2); sort16_desc(q3); merge_top16(q2, q3);
    merge_top16(top, q2);
    if (PAIR) {
        unsigned o[16];
#pragma unroll
        for (int i = 0; i < 16; ++i) o[i] = (unsigned)__shfl_xor((int)top[i], 32);
        merge_top16(top, o);
    }
}

__device__ __forceinline__ float gelu_exact(float v) { return 0.5f * v * (1.0f + erff(v * 0.70710678118654752f)); }
typedef __bf16 bf16x2_t __attribute__((ext_vector_type(2)));
__device__ __forceinline__ float dot2bf(unsigned a, unsigned b, float c) { return __builtin_amdgcn_fdot2_f32_bf16(__builtin_bit_cast(bf16x2_t, a), __builtin_bit_cast(bf16x2_t, b), c, false); }
__device__ __forceinline__ float dot8(const u32x4 a, const u32x4 b) { return dot2bf(a.x, b.x, dot2bf(a.y, b.y, dot2bf(a.z, b.z, dot2bf(a.w, b.w, 0.f)))); }
__device__ __forceinline__ float dpp_xor1(float v) { return __int_as_float(__builtin_amdgcn_update_dpp(0, __float_as_int(v), 0xB1, 0xF, 0xF, true)); }
__device__ __forceinline__ float dpp_xor2(float v) { return __int_as_float(__builtin_amdgcn_update_dpp(0, __float_as_int(v), 0x4E, 0xF, 0xF, true)); }
__device__ __forceinline__ float dpp_xor4(float v) { const int m = __builtin_amdgcn_update_dpp(0, __float_as_int(v), 0x141, 0xF, 0xF, true); return __int_as_float(__builtin_amdgcn_update_dpp(0, m, 0x1B, 0xF, 0xF, true)); }
__device__ __forceinline__ float reduce8x8(const float (&p)[8], const int j) {
    float r[4], q[2];
#pragma unroll
    for (int i = 0; i < 4; ++i) { const float keep = (j & 4) ? p[i + 4] : p[i], send = (j & 4) ? p[i] : p[i + 4]; r[i] = keep + __shfl_xor(send, 4); }
#pragma unroll
    for (int i = 0; i < 2; ++i) { const float keep = (j & 2) ? r[i + 2] : r[i], send = (j & 2) ? r[i] : r[i + 2]; q[i] = keep + __shfl_xor(send, 2); }
    const float keep = (j & 1) ? q[1] : q[0], send = (j & 1) ? q[0] : q[1];
    return keep + __shfl_xor(send, 1);
}

constexpr size_t WS_VS8 = WS_US + 16 * MiB, WS_SINV = WS_US + 32 * MiB;
__device__ __forceinline__ void peer_convert_rows(Frame& F, const int item) {
    const Args& A = *F.a;
    int lane_l = threadIdx.x & 63; asm volatile("" : "+v"(lane_l));
    const int lane = lane_l;
    float* SINV = (float*)(F.ws + WS_SINV);
    f32x4 gq[4];
    { const float* gp = A.in[I_GFFN] + 16 * lane; gq[0] = *(const f32x4*)gp; gq[1] = *(const f32x4*)(gp + 4); gq[2] = *(const f32x4*)(gp + 8); gq[3] = *(const f32x4*)(gp + 12); }
    for (int it0 = 64 * item + 4 * F.wave; it0 < 64 * item + 64; it0 += 32) {
        f32x4 v[4][4];
#pragma unroll
        for (int r = 0; r < 4; ++r) { const int it = it0 + r, tb = it >> 14, e = it & 16383;
            const float* src = (tb ? A.in[I_PV] : A.in[I_PU]) + (size_t)e * DM + 16 * lane;
#pragma unroll
            for (int q = 0; q < 4; ++q) v[r][q] = *(const f32x4*)(src + 4 * q); }
#pragma unroll
        for (int r = 0; r < 4; ++r) { const int it = it0 + r, tb = it >> 14, e = it & 16383;
            if (tb == 0) {
#pragma unroll
                for (int q = 0; q < 4; ++q) v[r][q] = v[r][q] * gq[q]; }
            float mx = 0.f;
#pragma unroll
            for (int q = 0; q < 4; ++q) mx = fmaxf(mx, fmaxf(fmaxf(fabsf(v[r][q].x), fabsf(v[r][q].y)), fmaxf(fabsf(v[r][q].z), fabsf(v[r][q].w))));
#pragma unroll
            for (int o = 1; o < 64; o <<= 1) mx = fmaxf(mx, __shfl_xor(mx, o));
            int k = (mx > 0.f) ? (int)floorf(log2f(416.0f / mx)) : 0; k = k > 60 ? 60 : (k < -60 ? -60 : k);
            const float sc = exp2f((float)k), sinv = exp2f((float)-k);
            u32x4 o; unsigned ow[4];
#pragma unroll
            for (int q = 0; q < 4; ++q) { int wd = __builtin_amdgcn_cvt_pk_fp8_f32(v[r][q].x * sc, v[r][q].y * sc, 0, false); wd = __builtin_amdgcn_cvt_pk_fp8_f32(v[r][q].z * sc, v[r][q].w * sc, wd, true); ow[q] = (unsigned)wd; }
            o.x = ow[0]; o.y = ow[1]; o.z = ow[2]; o.w = ow[3];
            unsigned char* dst = (unsigned char*)(F.ws + (tb ? WS_VS8 : WS_US)) + ((size_t)(lane >> 3) * 16384 + e) * 128 + 16 * (lane & 7);
            *(u32x4*)dst = o;
            if (lane == 0) SINV[tb * 16384 + e] = sinv;
        }
    }
}

template <bool DRY>
__device__ __forceinline__ void peer_tile(Frame& F, const int tile) {
    const Args& A = *F.a;
    const bf16_t* QP = (const bf16_t*)(F.ws + WS_BUFA); const bf16_t* XG = (const bf16_t*)(F.ws + WS_BUFB); bf16_t* XGW = (bf16_t*)(F.ws + WS_BUFB); const bf16_t* SK = (const bf16_t*)(F.ws + WS_SK);
    const float* rss2 = (const float*)(F.ctl + CW_RSS2);
    LAS unsigned short* RE = (LAS unsigned short*)(F.lds + PE_RE); LAS float* RG = (LAS float*)(F.lds + PE_RG);
    const int w = F.wave;
    {
        int lane = F.lane; asm volatile("" : "+v"(lane));
        const int tg = w & 3, hh = w >> 2, n = lane & 31, h2 = lane >> 5;
        const int tok = 32 * tg + n; const size_t trow = (size_t)tile * 128 + tok;
        for (int rrep = 0; rrep < ((P7REP & 1) ? 2 : 1); ++rrep)
        for (int hd = 4 * hh; hd < 4 * hh + 4; ++hd) {
            unsigned T2[2][16];
#pragma unroll
            for (int cc = 0; cc < 2; ++cc) {
                const int grp = 2 * hd + cc;
                bf16x8 Qf[4];
#pragma unroll
                for (int kk = 0; kk < 4; ++kk) Qf[kk] = *(const bf16x8*)(QP + trow * DM + 64 * grp + 16 * kk + 8 * h2);
                unsigned key[64];
                unsigned lowbase = 127u - 4u * (unsigned)h2; asm volatile("" : "+v"(lowbase));
#pragma unroll
                for (int kb = 0; kb < 4; ++kb) {
                    f32x16 S;
#pragma unroll
                    for (int e = 0; e < 16; ++e) S[e] = 0.f;
#pragma unroll
                    for (int kk = 0; kk < 4; ++kk) { const bf16x8 a = *(const bf16x8*)(SK + ((size_t)(grp * 128 + 32 * kb + n)) * 64 + 16 * kk + 8 * h2); S = __builtin_amdgcn_mfma_f32_32x32x16_bf16(a, Qf[kk], S, 0, 0, 0); }
#pragma unroll
                    for (int e = 0; e < 16; ++e) { const int idx0 = 32 * kb + (e & 3) + 8 * (e >> 2); key[16 * kb + e] = ((enc_f(S[e]) & ~127u) | lowbase) - (unsigned)idx0; }
                }
                top16_of64<true>(key, T2[cc]);
            }
            float va[16], vb[16];
#pragma unroll
            for (int i = 0; i < 16; ++i) { va[i] = dec_f(T2[0][i] & ~127u); vb[i] = dec_f(T2[1][i] & ~127u); }
            unsigned ck[64];
#pragma unroll
            for (int i = 50; i < 64; ++i) ck[i] = 0u;
            {
                int q = 0;
#pragma unroll
                for (int i = 0; i < 16; ++i)
#pragma unroll
                    for (int j = 0; j < 16; ++j) if ((i + 1) * (j + 1) <= 16) { ck[q] = (enc_f(va[i] + vb[j]) & ~255u) | (unsigned)(255 - (16 * i + j)); ++q; }
            }
            unsigned best[16];
            top16_of64<false>(ck, best);
            const float v0 = dec_f(best[0] & ~255u);
            float gw[16], zs = 0.f;
#pragma unroll
            for (int k = 0; k < 16; ++k) { gw[k] = __expf(dec_f(best[k] & ~255u) - v0); zs += gw[k]; }
            const float zinv = 1.0f / zs;
#pragma unroll
            for (int k = 0; k < 16; ++k) {
                const unsigned code = 255u - (best[k] & 255u); const unsigned ci = code >> 4, cj = code & 15u;
                unsigned ia = 0, ib = 0;
#pragma unroll
                for (int i = 0; i < 16; ++i) { ia = (ci == (unsigned)i) ? (127u - (T2[0][i] & 127u)) : ia; ib = (cj == (unsigned)i) ? (127u - (T2[1][i] & 127u)) : ib; }
                if (h2 == (k >> 3)) { RE[tok * PE_REP + hd * 16 + k] = (unsigned short)(ia * 128u + ib); RG[tok * PE_REP + hd * 16 + k] = gw[k] * zinv; }
            }
        }
    }
    __syncthreads();
    {
        int lane = F.lane; asm volatile("" : "+v"(lane));
        const unsigned char* US = (const unsigned char*)(F.ws + WS_US); const unsigned char* VS = (const unsigned char*)(F.ws + WS_VS8); const float* SINV = (const float*)(F.ws + WS_SINV);
        const int j = lane & 7, gid = 8 * w + (lane >> 3);
        const int tA = gid, tB = 64 + gid; const size_t rowA = (size_t)tile * 128 + tA, rowB = (size_t)tile * 128 + tB;
        const LAS unsigned short* reA = RE + tA * PE_REP; const LAS unsigned short* reB = RE + tB * PE_REP;
        LAS float* cfA = RG + tA * PE_REP; LAS float* cfB = RG + tB * PE_REP;
        float accA[16], accB[16];
#pragma unroll
        for (int i = 0; i < 16; ++i) { accA[i] = 0.f; accB[i] = 0.f; }
#define PE_DEC16P(w4, f2) do { (f2)[0] = __builtin_amdgcn_cvt_pk_f32_fp8((int)(w4).x, false); (f2)[1] = __builtin_amdgcn_cvt_pk_f32_fp8((int)(w4).x, true); (f2)[2] = __builtin_amdgcn_cvt_pk_f32_fp8((int)(w4).y, false); (f2)[3] = __builtin_amdgcn_cvt_pk_f32_fp8((int)(w4).y, true); \
            (f2)[4] = __builtin_amdgcn_cvt_pk_f32_fp8((int)(w4).z, false); (f2)[5] = __builtin_amdgcn_cvt_pk_f32_fp8((int)(w4).z, true); (f2)[6] = __builtin_amdgcn_cvt_pk_f32_fp8((int)(w4).w, false); (f2)[7] = __builtin_amdgcn_cvt_pk_f32_fp8((int)(w4).w, true); } while (0)
#define PE_ISSUE(buf_, re_, kb_, base_) do { const u32x4 e4 = *(const LAS u32x4*)((re_) + 8 * (kb_)); const unsigned ew[4] = {e4.x, e4.y, e4.z, e4.w}; \
                _Pragma("unroll") for (int i = 0; i < 8; ++i) { const unsigned e0 = (i & 1) ? (ew[i >> 1] >> 16) : (ew[i >> 1] & 0xffffu); (buf_)[i] = *(const u32x4*)((base_) + (size_t)e0 * 128); } } while (0)
        u32x4 xra0 = *(const u32x4*)(XG + rowA * DM + 16 * j), xra1 = *(const u32x4*)(XG + rowA * DM + 16 * j + 8), xrb0 = *(const u32x4*)(XG + rowB * DM + 16 * j), xrb1 = *(const u32x4*)(XG + rowB * DM + 16 * j + 8);
        u32x4 bufA[8], bufB[8];
        PE_ISSUE(bufA, reA, 0, US + 16 * j);
#pragma unroll 1
        for (int s2 = 0; s2 < ((P7REP & 2) ? 16 : 8); ++s2) {
            const int s = s2 & 7;
            if (s2 == 8) {
#pragma unroll
                for (int i = 0; i < 16; ++i) { accA[i] = 0.f; accB[i] = 0.f; } }
            f32x2 xa[8], xb[8];
            { const unsigned aw[8] = {xra0.x, xra0.y, xra0.z, xra0.w, xra1.x, xra1.y, xra1.z, xra1.w}, bw[8] = {xrb0.x, xrb0.y, xrb0.z, xrb0.w, xrb1.x, xrb1.y, xrb1.z, xrb1.w};
#pragma unroll
              for (int i = 0; i < 8; ++i) { xa[i] = (f32x2){bf_lo(aw[i]), bf_hi(aw[i])}; xb[i] = (f32x2){bf_lo(bw[i]), bf_hi(bw[i])}; } }
            { const int sn = (s + 1) & 7;
              xra0 = *(const u32x4*)(XG + rowA * DM + 128 * sn + 16 * j); xra1 = *(const u32x4*)(XG + rowA * DM + 128 * sn + 16 * j + 8); xrb0 = *(const u32x4*)(XG + rowB * DM + 128 * sn + 16 * j); xrb1 = *(const u32x4*)(XG + rowB * DM + 128 * sn + 16 * j + 8); }
            const unsigned char* Us = US + (size_t)s * (16384 * 128) + 16 * j; const unsigned char* Usn = US + (size_t)((s + 1) & 7) * (16384 * 128) + 16 * j;
#if PE_TOUCH
            const unsigned tchu = *(const volatile unsigned*)(US + (size_t)((s + 1) & 7) * (16384 * 128) + ((size_t)(((blockIdx.x >> 3) & 31) * 512 + F.tid)) * 128);
#endif
#define PE_UCOMP(buf_, x_, acc_, kb_) do { float pp[8]; _Pragma("unroll") for (int i = 0; i < 8; ++i) { f32x2 f2[8]; PE_DEC16P((buf_)[i], f2); f32x2 d2 = f2[0] * (x_)[0]; _Pragma("unroll") for (int c = 1; c < 8; ++c) d2 = __builtin_elementwise_fma(f2[c], (x_)[c], d2); pp[i] = d2.x + d2.y; } \
                (acc_)[kb_] += reduce8x8(pp, j); asm volatile("" : "+v"((acc_)[kb_]) :: "memory"); } while (0)
#pragma unroll
            for (int kb = 0; kb < 16; ++kb) {
                PE_ISSUE(bufB, reB, kb, Us);
                PE_UCOMP(bufA, xa, accA, kb);
                if (kb + 1 < 16) PE_ISSUE(bufA, reA, kb + 1, Us); else PE_ISSUE(bufA, reA, 0, Usn);
                PE_UCOMP(bufB, xb, accB, kb);
            }
#if PE_TOUCH
            asm volatile("" :: "v"(tchu));
#endif
        }
#undef PE_UCOMP
        {
            const float rsA = rsqrtf(rss2[rowA] * (1.0f / DM) + EPS), rsB = rsqrtf(rss2[rowB] * (1.0f / DM) + EPS);
#pragma unroll
            for (int kb = 0; kb < 16; ++kb) { const int eA = reA[8 * kb + j], eB = reB[8 * kb + j];
                cfA[8 * kb + j] = cfA[8 * kb + j] * gelu_exact(accA[kb] * rsA * SINV[eA]) * SINV[16384 + eA]; cfB[8 * kb + j] = cfB[8 * kb + j] * gelu_exact(accB[kb] * rsB * SINV[eB]) * SINV[16384 + eB]; }
        }
        LDS_WAIT();
        float ssA = 0.f, ssB = 0.f;
        float* xoA = A.out + rowA * DM + 16 * j; float* xoB = A.out + rowB * DM + 16 * j;
        PE_ISSUE(bufA, reA, 0, VS + 16 * j);
#pragma unroll 1
        for (int s2 = 0; s2 < ((P7REP & 4) ? 16 : 8); ++s2) {
            const int s = s2 & 7; const bool dry = (P7REP & 4) && s2 < 8;
            const unsigned char* Vs = VS + (size_t)s * (16384 * 128) + 16 * j; const unsigned char* Vsn = VS + (size_t)((s + 1) & 7) * (16384 * 128) + 16 * j;
#if PE_TOUCH
            const unsigned tchv = *(const volatile unsigned*)(VS + (size_t)((s + 1) & 7) * (16384 * 128) + ((size_t)(((blockIdx.x >> 3) & 31) * 512 + F.tid)) * 128);
#endif
            u32x2 x2a[4], x2b[4];
#pragma unroll
            for (int q = 0; q < 4; ++q) { x2a[q] = *(const u32x2*)(XG + rowA * DM + 128 * s + 16 * j + 4 * q); x2b[q] = *(const u32x2*)(XG + rowB * DM + 128 * s + 16 * j + 4 * q); }
            f32x2 oa[8], ob[8];
#pragma unroll
            for (int i = 0; i < 8; ++i) { oa[i] = (f32x2){0.f, 0.f}; ob[i] = (f32x2){0.f, 0.f}; }
#define PE_VCOMP(buf_, cf_, o_, kb_) do { const f32x4 c0_ = *(const LAS f32x4*)((cf_) + 8 * (kb_)), c1_ = *(const LAS f32x4*)((cf_) + 8 * (kb_) + 4); const float cw_[8] = {c0_.x, c0_.y, c0_.z, c0_.w, c1_.x, c1_.y, c1_.z, c1_.w}; \
                _Pragma("unroll") for (int i = 0; i < 8; ++i) { const f32x2 c2 = (f32x2){cw_[i], cw_[i]}; f32x2 f2[8]; PE_DEC16P((buf_)[i], f2); _Pragma("unroll") for (int q = 0; q < 8; ++q) (o_)[q] = __builtin_elementwise_fma(c2, f2[q], (o_)[q]); } \
                asm volatile("" : "+v"((o_)[0]), "+v"((o_)[1]), "+v"((o_)[2]), "+v"((o_)[3]), "+v"((o_)[4]), "+v"((o_)[5]), "+v"((o_)[6]), "+v"((o_)[7]) :: "memory"); } while (0)
#pragma unroll
            for (int kb = 0; kb < 16; ++kb) {
                PE_ISSUE(bufB, reB, kb, Vs);
                PE_VCOMP(bufA, cfA, oa, kb);
                if (kb + 1 < 16) PE_ISSUE(bufA, reA, kb + 1, Vs); else PE_ISSUE(bufA, reA, 0, Vsn);
                PE_VCOMP(bufB, cfB, ob, kb);
            }
#if PE_TOUCH
            asm volatile("" :: "v"(tchv));
#endif
#undef PE_VCOMP
#pragma unroll
            for (int q = 0; q < 4; ++q) {
                const u32x2 xa2 = x2a[q], xb2 = x2b[q];
                f32x4 a0 = (f32x4){bf_lo(xa2.x), bf_hi(xa2.x), bf_lo(xa2.y), bf_hi(xa2.y)}, b0 = (f32x4){bf_lo(xb2.x), bf_hi(xb2.x), bf_lo(xb2.y), bf_hi(xb2.y)};
                a0 = a0 + (f32x4){oa[2 * q].x, oa[2 * q].y, oa[2 * q + 1].x, oa[2 * q + 1].y}; b0 = b0 + (f32x4){ob[2 * q].x, ob[2 * q].y, ob[2 * q + 1].x, ob[2 * q + 1].y};
                if (!dry && !DRY) { ssA += (a0.x * a0.x + a0.y * a0.y) + (a0.z * a0.z + a0.w * a0.w); ssB += (b0.x * b0.x + b0.y * b0.y) + (b0.z * b0.z + b0.w * b0.w);
                u32x2 pa, pb; pa.x = cvt_pk_bf16(a0.x, a0.y); pa.y = cvt_pk_bf16(a0.z, a0.w); pb.x = cvt_pk_bf16(b0.x, b0.y); pb.y = cvt_pk_bf16(b0.z, b0.w);
                *(u32x2*)(XGW + rowA * DM + 128 * s + 16 * j + 4 * q) = pa; *(u32x2*)(XGW + rowB * DM + 128 * s + 16 * j + 4 * q) = pb; } }
        }
#undef PE_DEC16P
#undef PE_ISSUE
        ssA += __shfl_xor(ssA, 1); ssA += __shfl_xor(ssA, 2); ssA += __shfl_xor(ssA, 4);
        ssB += __shfl_xor(ssB, 1); ssB += __shfl_xor(ssB, 2); ssB += __shfl_xor(ssB, 4);
        const float rfA = rsqrtf(ssA * (1.0f / DM) + EPS), rfB = rsqrtf(ssB * (1.0f / DM) + EPS);
        VM_WAIT();
        __builtin_amdgcn_fence(__ATOMIC_ACQUIRE, "agent");
        VM_WAIT();
        const float* gfin = A.in[I_GFIN] + 16 * j;
#pragma unroll 2
        for (int s = 0; s < 8; ++s)
#pragma unroll
            for (int q = 0; q < 4; ++q) {
                const f32x4 g0 = *(const f32x4*)(gfin + 128 * s + 4 * q);
                const u32x2 xa2 = *(const u32x2*)(XGW + rowA * DM + 128 * s + 16 * j + 4 * q), xb2 = *(const u32x2*)(XGW + rowB * DM + 128 * s + 16 * j + 4 * q);
                const f32x4 a0 = (f32x4){bf_lo(xa2.x), bf_hi(xa2.x), bf_lo(xa2.y), bf_hi(xa2.y)}, b0 = (f32x4){bf_lo(xb2.x), bf_hi(xb2.x), bf_lo(xb2.y), bf_hi(xb2.y)};
                if (!DRY) { *(f32x4*)(xoA + 128 * s + 4 * q) = a0 * rfA * g0; *(f32x4*)(xoB + 128 * s + 4 * q) = b0 * rfB * g0; } else { asm volatile("" :: "v"(a0 * rfA * g0), "v"(b0 * rfB * g0)); } }
    }
    __syncthreads();
}

#ifndef USE_COOP_LAUNCH
#define USE_COOP_LAUNCH 1
#endif
#ifndef USE_CG_SYNC
#define USE_CG_SYNC 0
#endif
#ifndef DBG_SRC
#define DBG_SRC 0
#endif
#ifndef DBG_ZC
#define DBG_ZC 0
#endif
#ifndef DBG_C0
#define DBG_C0 0
#endif
#ifndef DBG_C1
#define DBG_C1 1024
#endif
__global__ void __launch_bounds__(512, 2) mk_fwd(Args args) {
    extern __shared__ __attribute__((aligned(16))) unsigned char lds_raw[];
    Frame F;
    F.lds = (LAS unsigned char*)lds_raw;
    F.tid = threadIdx.x; F.lane = F.tid & 63; F.wave = __builtin_amdgcn_readfirstlane(F.tid >> 6);
    F.G = gridDim.x; { const int bx = blockIdx.x; F.vcu = (F.G % 8 == 0) ? (bx % 8) * (F.G / 8) + bx / 8 : bx; }
    F.a = &args; F.ws = args.ws; F.ctl = (unsigned*)(args.ws + WS_CTL);
    const int lo = args.ph_lo, hi = args.ph_hi;
#if USE_CG_SYNC
    cg::grid_group grid = cg::this_grid();
#define GRID_BAR() grid.sync()
#else
    { volatile LAS unsigned* st0 = (volatile LAS unsigned*)(F.lds + MISC_OFF); if (F.tid < 8) st0[F.tid] = 0u; }
    __syncthreads();
    XcdBarrier xbar; xbar.bar = F.ctl + CW_BAR; xbar.x = 0; xbar.st = nullptr;
    if (hi - lo > 1) xbar = xcd_barrier_post(F.ctl + CW_BAR, (volatile LAS unsigned*)(F.lds + MISC_OFF));
#define GRID_BAR() xcd_barrier(xbar)
#endif
#define IN(k) (lo <= (k) && (k) < hi)
#ifndef PHMASK
#define PHMASK 0x1FF
#endif
#ifndef P2SUB
#define P2SUB 7
#endif
#define PHON(k) (((PHMASK) >> (k)) & 1)
#ifndef REPMASK
#define REPMASK 0
#endif
#define NREP(k) ((((REPMASK) >> (k)) & 1) ? 2 : 1)
#define PHASE_BEGIN() do { int t_ = threadIdx.x; asm volatile("" : "+v"(t_)); F.tid = t_; F.lane = t_ & 63; } while (0)
#define SEAM(k) do { if (IN(k) && IN((k) + 1)) GRID_BAR(); } while (0)
    unsigned char* ws = args.ws;
    const int bx = blockIdx.x;

    if (PHON(0) && IN(0)) { for (int rep = 0; rep < NREP(0); ++rep) { PHASE_BEGIN(); p0_prologue(F); } }
    SEAM(0);
    if (PHON(1) && IN(1)) for (int rep = 0; rep < NREP(1); ++rep) {
        PHASE_BEGIN();
        { pg8::Sched S{0, T_TOK / 256, NZ / 256, (T_TOK / 256) * (NZ / 256), F.G, bx, 1, (const char*)(ws + WS_BUFA), (const char*)(ws + WS_WIN), (char*)(ws + WS_Z), (size_t)256 * DM * 2, (size_t)256 * DM * 2, 0, 2};
          pg8::EpiBf16 E{NZ, 1.0f, nullptr, nullptr};
          pg8::gemm_phase(F.lds, DM, DM, DM, S, E); }
        { pg8::Sched S{0, TMEM / 256, 2048 / 256, (TMEM / 256) * (2048 / 256), F.G, bx, 1, (const char*)(ws + WS_MEMN), (const char*)(ws + WS_WKV), (char*)(ws + WS_KV), (size_t)256 * DM * 2, (size_t)256 * DM * 2, 0, 2};
          pg8::EpiBf16 E{2048, 1.0f, nullptr, nullptr};
          pg8::gemm_phase(F.lds, DM, DM, DM, S, E); }
    }
    SEAM(1);
    if (PHON(2) && IN(2)) for (int rep = 0; rep < NREP(2); ++rep) {
        PHASE_BEGIN();
        conv_prepass(F);
    }
    SEAM(2);
    if (PHON(3) && IN(3)) for (int rep = 0; rep < NREP(3); ++rep) {
        PHASE_BEGIN();
        float lam;
        { float s1 = 0.f, s2 = 0.f;
          for (int i = 0; i < 64; ++i) { s1 += args.in[I_LQ1][i] * args.in[I_LK1][i]; s2 += args.in[I_LQ2][i] * args.in[I_LK2][i]; }
          lam = __expf(s1) - __expf(s2) + 0.2f; }
        LAS int* qslot = (LAS int*)(F.lds + MISC_OFF + 16);
        int qx = bx & 7, tried = 0;
        for (;;) {
            if (F.tid == 0) *qslot = (int)atomicAdd(F.ctl + CW_Q2 + 64 * (qx + 8 * rep), 1u);
            __syncthreads();
            const int u = *qslot;
            __syncthreads();
            if (u >= 8 + QN_ATT + 64 + 64) { if (++tried == 8) break; qx = (qx + 1) & 7; continue; }
            const int submask = (rep + 1 < NREP(3)) ? (REPSUB) : (P2SUB);
            if (u < 8) { const int p = qx + 8 * u; if ((submask & 1) && !((rep + 1 < NREP(3)) && (PROBE_HALF & 1) && u >= 4)) mlstm_unit(F, p >> 2, p & 3); }
            else if (u >= 8 + QN_ATT + 64) { if (rep + 1 == NREP(3)) peer_convert_rows(F, qx + 8 * (u - (8 + QN_ATT + 64))); }
            else if (u >= 8 + QN_ATT) { if (rep + 1 == NREP(3)) {
                const int gi = qx + 8 * (u - (8 + QN_ATT));
                if (gi < 256) { pg8::Sched S{1, 0, 0, 256, 1 << 30, gi, 1, (const char*)(ws + WS_KV), (const char*)(ws + WS_WCQ), (char*)(ws + WS_MB), 0, 0, 0, 2};
                    pg8::EpiBf16 E{DM, 0.0625f, nullptr, args.in[I_GCA]};
                    pg8::gemm_phase(F.lds, 256, 2048, DM, S, E); }
                else { pg8::Sched S{2, 0, 0, 256, 1 << 30, gi - 256, 1, (const char*)(ws + WS_WCO), (const char*)(ws + WS_KV), (char*)(ws + WS_VWB), 0, 0, 0, 2};
                    pg8::EpiBf16 E{DM, 1.0f, nullptr, nullptr};
                    pg8::gemm_phase(F.lds, 256, DM, 2048, S, E); } } }
            else if ((submask & 2) && !((rep + 1 < NREP(3)) && (PROBE_HALF & 2) && ((u - 8) >> 4) >= 4)) { const int j = u - 8;
#if Q_PAIRED
                { const int p = qx + 8 * (j >> 3), g_ = j & 7;
#pragma unroll 1
                  for (int hf = 0; hf < 2; ++hf) { const int qt_ = hf ? g_ : 15 - g_;
                      if (rep + 1 < NREP(3)) attn_unit<ATT_MODE>(F, p >> 2, p & 3, qt_, lam); else attn_unit<0>(F, p >> 2, p & 3, qt_, lam); } }
#elif Q_LPT
                const int p = qx + 8 * (j & 7), qt_ = 15 - (j >> 3);
#else
                const int p = qx + 8 * (j >> 4), qt_ = 15 - (j & 15);
#endif
#if !Q_PAIRED
                if (rep + 1 < NREP(3)) attn_unit<ATT_MODE>(F, p >> 2, p & 3, qt_, lam); else attn_unit<0>(F, p >> 2, p & 3, qt_, lam);
#endif
            }
        }
    }
    SEAM(3);
    if (PHON(4) && IN(4)) for (int rep = 0; rep < NREP(4); ++rep) {
        PHASE_BEGIN();
        pg8::Sched S{0, T_TOK / 256, 4, (T_TOK / 256) * 4, F.G, bx, 1, (const char*)(ws + WS_BUFA), (const char*)(ws + WS_WOUT), nullptr, (size_t)256 * DM * 2, (size_t)256 * DM * 2, 0, 2};
        pg8::EpiResidB<false> E{args.in[I_X], (bf16_t*)(ws + WS_BUFB), (float*)(F.ctl + ((rep + 1 < NREP(4)) ? CW_DUMMY : CW_RSS1))};
        pg8::gemm_phase(F.lds, DM, DM, DM, S, E);
    }
    SEAM(4);
    if (PHON(5) && IN(5)) for (int rep = 0; rep < NREP(5); ++rep) {
        PHASE_BEGIN();
        pg8::Sched S{0, T_TOK / 256, 4, (T_TOK / 256) * 4, F.G, bx, 8, (const char*)(ws + WS_BUFB), (const char*)(ws + WS_MB), nullptr, (size_t)256 * DM * 2, (size_t)256 * DM * 2, (size_t)DM * DM * 2, 2};
        pg8::EpiSoftmax E{(const float*)(F.ctl + CW_RSS1), (bf16_t*)(ws + WS_BUFA)};
        pg8::gemm_phase(F.lds, DM, DM, DM, S, E);
    }
    SEAM(5);
    if (PHON(6) && IN(6)) {
        PHASE_BEGIN();
        pg8::Sched S{0, T_TOK / 256, 4, (T_TOK / 256) * 4, F.G, bx, 8, (const char*)(ws + WS_BUFA), (const char*)(ws + WS_VWB), nullptr, (size_t)256 * DM * 2, (size_t)256 * DM * 2, (size_t)DM * DM * 2, 2};
        pg8::EpiResidB<true> E{(const void*)(ws + WS_BUFB), (bf16_t*)(ws + WS_BUFB), (float*)(F.ctl + CW_RSS2)};
        pg8::gemm_phase(F.lds, DM, DM, DM, S, E);
    }
    SEAM(6);
    if (PHON(7) && IN(7)) for (int rep = 0; rep < NREP(7); ++rep) {
        PHASE_BEGIN();
        pg8::Sched S{0, T_TOK / 256, 4, (T_TOK / 256) * 4, F.G, bx, 1, (const char*)(ws + WS_BUFB), (const char*)(ws + WS_WPQ), (char*)(ws + WS_BUFA), (size_t)256 * DM * 2, (size_t)256 * DM * 2, 0, 2};
        pg8::EpiBf16 E{DM, 1.0f, (const float*)(F.ctl + CW_RSS2), nullptr};
        pg8::gemm_phase(F.lds, DM, DM, DM, S, E);
    }
    SEAM(7);
    if (PHON(8) && IN(8)) {
        PHASE_BEGIN();
        if (NREP(8) > 1) { for (int tile = bx; tile < T_TOK / 128; tile += F.G) peer_tile<true>(F, tile); }
        for (int tile = bx; tile < T_TOK / 128; tile += F.G) peer_tile<false>(F, tile);
    }
    if (lo <= 9 && 9 < hi) {
        const bf16_t* src = (const bf16_t*)(ws + (DBG_SRC ? WS_Z : WS_BUFA));
        for (size_t i = (size_t)bx * 512 + F.tid; i < (size_t)T_TOK * DM / 2; i += (size_t)F.G * 512) { const size_t row_ = (2 * i) >> 10, col_ = (2 * i) & 1023; const unsigned u = DBG_SRC ? *(const unsigned*)(src + row_ * NZ + DBG_ZC + col_) : ((const unsigned*)src)[i]; const int col = (int)((2 * i) & 1023); const bool on = (col >= DBG_C0 && col < DBG_C1); args.out[2 * i] = on ? bf_lo(u) : 0.f; args.out[2 * i + 1] = on ? bf_hi(u) : 0.f; }
    }
#undef IN
#undef SEAM
}

#ifndef MK_N_LAUNCHES
#define MK_N_LAUNCHES 1
#endif
extern "C" void kernel_launch(void* const* d_in, const int* in_sizes, int n_in, void* d_out, int out_size, void* d_ws, size_t ws_size, hipStream_t stream) {
    static int grid = 0;
    if (grid == 0) {
        if (n_in != 26 || out_size != T_TOK * DM || ws_size < WS_END + 34 * MiB) { fprintf(stderr, "kernel_launch: unexpected shapes (n_in %d out %d ws %zu)\n", n_in, out_size, ws_size); grid = -1; return; }
        int dev = 0, cus = 0, per_cu = 0;
        hipGetDevice(&dev); hipDeviceGetAttribute(&cus, hipDeviceAttributeMultiprocessorCount, dev);
        if (hipFuncSetAttribute((const void*)mk_fwd, hipFuncAttributeMaxDynamicSharedMemorySize, LDS_BYTES) != hipSuccess) { fprintf(stderr, "kernel_launch: hipFuncSetAttribute failed\n"); grid = -1; return; }
        if (hipOccupancyMaxActiveBlocksPerMultiprocessor(&per_cu, (const void*)mk_fwd, 512, LDS_BYTES) != hipSuccess || per_cu < 1) { fprintf(stderr, "kernel_launch: occupancy query says %d\n", per_cu); per_cu = 1; }
        (void)hipGetLastError();
        grid = cus;
    }
    if (grid < 0) return;
    hipMemsetAsync((char*)d_ws + WS_CTL, 0, CTL_BYTES, stream);
    Args a{};
    for (int i = 0; i < 26; ++i) a.in[i] = (const float*)d_in[i];
    a.out = (float*)d_out; a.ws = (unsigned char*)d_ws;
    if (MK_N_LAUNCHES == 1) {
        a.ph_lo = 0; a.ph_hi = 9;
        void* kargs[] = {&a};
#if USE_COOP_LAUNCH
        hipError_t e = hipLaunchCooperativeKernel((const void*)mk_fwd, dim3(grid), dim3(512), kargs, LDS_BYTES, stream);
        if (e != hipSuccess) fprintf(stderr, "cooperative launch failed: %s (grid %d)\n", hipGetErrorString(e), grid);
#else
        (void)kargs; hipLaunchKernelGGL(mk_fwd, dim3(grid), dim3(512), LDS_BYTES, stream, a);
#endif
    } else {
#ifndef DBG_STOP
#define DBG_STOP 9
#endif
#ifndef DBG_DUMP
#define DBG_DUMP 0
#endif
        for (int p = 0; p < DBG_STOP; ++p) { a.ph_lo = p; a.ph_hi = p + 1; hipLaunchKernelGGL(mk_fwd, dim3(grid), dim3(512), LDS_BYTES, stream, a); }
        if (DBG_DUMP) { a.ph_lo = 9; a.ph_hi = 10; hipLaunchKernelGGL(mk_fwd, dim3(grid), dim3(512), LDS_BYTES, stream, a); }
    }
}
```

```cpp
#include <hip/hip_runtime.h>
#include <hip/hip_cooperative_groups.h>
#include <cstdio>
#include <cstdint>
namespace cg = cooperative_groups;

#define GAS __attribute__((address_space(1)))
#define LAS __attribute__((address_space(3)))
typedef unsigned short bf16_t;
typedef short bf16x8 __attribute__((ext_vector_type(8)));
typedef short s16x4 __attribute__((ext_vector_type(4)));
typedef float f32x4 __attribute__((ext_vector_type(4)));
typedef float f32x2 __attribute__((ext_vector_type(2)));
typedef float f32x16 __attribute__((ext_vector_type(16)));
typedef unsigned u32x4 __attribute__((ext_vector_type(4)));
typedef unsigned u32x2 __attribute__((ext_vector_type(2)));

constexpr int T_TOK = 32768, DM = 1024, NB = 16, SEQ = 2048, NZ = 3584, INW = 3592, MEML = 256, TMEM = NB * MEML;
constexpr float EPS = 1e-6f;
constexpr float LOG2E = 1.4426950408889634f;
constexpr int ZC_MLQ = 0, ZC_MLK = 512, ZC_MLV = 1024, ZC_MLO = 1536, ZC_DAQ = 2048, ZC_DAK = 2560, ZC_DAV = 3072;

constexpr size_t MiB = 1u << 20;
constexpr size_t WS_CTL = 0, CTL_BYTES = 1 * MiB;
constexpr size_t WS_WIN = 1 * MiB, WS_WOUT = 8 * MiB, WS_WCQ = 10 * MiB, WS_WKV = 12 * MiB, WS_WCO = 16 * MiB, WS_WPQ = 18 * MiB, WS_SK = 20 * MiB;
constexpr size_t WS_GATES = 21 * MiB, WS_MEMN = 22 * MiB, WS_KV = 30 * MiB, WS_MB = 46 * MiB, WS_VWB = 78 * MiB;
constexpr size_t WS_BUFA = 110 * MiB, WS_BUFB = 174 * MiB, WS_Z = 238 * MiB, WS_END = 462 * MiB;
constexpr int CW_Q2 = 64;
constexpr int CW_RSS1 = 16384;
constexpr int CW_RSS2 = 65536;
constexpr int CW_BAR = 131072;
constexpr int CW_DUMMY = 180224;

constexpr int LDS_BYTES = 147456;
constexpr int XCH_OFF = 131072;
constexpr int MISC_OFF = LDS_BYTES - 256;

__device__ __forceinline__ unsigned cvt_pk_bf16(float lo, float hi) { unsigned r; asm("v_cvt_pk_bf16_f32 %0, %1, %2" : "=v"(r) : "v"(lo), "v"(hi)); return r; }
__device__ __forceinline__ float bf_lo(unsigned u) { return __uint_as_float(u << 16); }
__device__ __forceinline__ float bf_hi(unsigned u) { return __uint_as_float(u & 0xffff0000u); }
__device__ __forceinline__ float wave_sum(float v) {
#pragma unroll
    for (int o = 1; o < 64; o <<= 1) v += __shfl_xor(v, o);
    return v;
}
__device__ __forceinline__ float fast_exp2(float x) { return __builtin_amdgcn_exp2f(x); }
__device__ __forceinline__ float fast_rcp(float x) { return __builtin_amdgcn_rcpf(x); }
#define LDS_WAIT() asm volatile("s_waitcnt lgkmcnt(0)" ::: "memory")
#define VM_WAIT() asm volatile("s_waitcnt vmcnt(0)" ::: "memory")

namespace pg8 {
constexpr int BM = 256, BK = 64, HALF = 128, HTB = HALF * BK * 2, STAGE_BYTES = 8 * HTB;
__device__ __forceinline__ int lds_byte(int r, int c) { const int st = (r >> 4) * 2 + (c >> 5), rr = r & 15, cc = c & 31, ob = rr * 64 + cc * 2; return st * 1024 + (ob ^ (((ob >> 9) & 1) << 5)); }
__device__ __forceinline__ void stage_rc(int b, int& R, int& C) { const int st = b / 1024, sb = b % 1024, swz = sb ^ (((sb >> 9) & 1) << 5); R = (st >> 1) * 16 + swz / 64; C = (st & 1) * 32 + (swz % 64) / 2; }
__device__ __forceinline__ int perm32(int rho) { const int n = rho >> 4, i = rho & 15; return 8 * (i >> 2) + 4 * n + (i & 3); }

struct Unit { const char* A; const char* B; char* O; int row0, col0, scol; };

template <class Epi, class Sched>
__device__ __forceinline__ void gemm_phase(LAS unsigned char* lds, const int K, const int lda, const int ldb, const Sched& S, const Epi& E) {
    int tid_l = threadIdx.x; asm volatile("" : "+v"(tid_l));
    const int tid = tid_l, wid = __builtin_amdgcn_readfirstlane(tid >> 6), lane = tid & 63, wr = wid >> 2, wc = wid & 3, fr = lane & 15, fq = lane >> 4;
    const int nt = K / BK;
    unsigned voffA[2], voffB[2];
#pragma unroll
    for (int i = 0; i < 2; ++i) { int R, C; stage_rc(tid * 16 + i * 8192, R, C); const int Rb = Epi::PERM ? ((R & ~31) + perm32(R & 31)) : R;
        voffA[i] = (unsigned)(R * lda + C) * 2u; voffB[i] = (unsigned)(Rb * ldb + C) * 2u; }
    const size_t kstep = (size_t)(BK * 2);
    const size_t hstepA = (size_t)HALF * lda * 2, hstepB = (size_t)HALF * ldb * 2;
    const unsigned ldsw = (unsigned)wid * 1024u;
    const int aoff = lds_byte(wr * 64 + fr, fq * 8), boff = lds_byte(wc * 32 + fr, fq * 8);
#define PG8_SA(b, h) (((b) * 2 + (h)) * HTB)
#define PG8_SB(b, h) ((4 + (b) * 2 + (h)) * HTB)
#define PG8_STAGE(bufoff, gbase, voff) do { _Pragma("unroll") for (int _i = 0; _i < 2; ++_i) \
        __builtin_amdgcn_global_load_lds((const unsigned*)((const char*)(gbase) + (voff)[_i]), (LAS unsigned*)(lds + (bufoff) + ldsw + _i * 8192), 16, 0, 0); } while (0)
#define PG8_LDA(dst, b, h) do { _Pragma("unroll") for (int m = 0; m < 4; ++m) _Pragma("unroll") for (int k = 0; k < 2; ++k) dst[m][k] = *(const LAS bf16x8*)(lds + PG8_SA(b, h) + aoff + m * 2048 + k * 1024); } while (0)
#define PG8_LDB(dst, b, h) do { _Pragma("unroll") for (int n = 0; n < 2; ++n) _Pragma("unroll") for (int k = 0; k < 2; ++k) dst[n][k] = *(const LAS bf16x8*)(lds + PG8_SB(b, h) + boff + n * 2048 + k * 1024); } while (0)
#define PG8_MMA(ai, bj, At, Bt) do { __builtin_amdgcn_s_setprio(1); _Pragma("unroll") for (int m = 0; m < 4; ++m) _Pragma("unroll") for (int n = 0; n < 2; ++n) _Pragma("unroll") for (int k = 0; k < 2; ++k) \
        acc[ai][bj][m][n] = __builtin_amdgcn_mfma_f32_16x16x32_bf16(Bt[n][k], At[m][k], acc[ai][bj][m][n], 0, 0, 0); __builtin_amdgcn_s_setprio(0); } while (0)
#define PG8_WAIT_V(n) asm volatile("s_waitcnt vmcnt(" #n ")" ::: "memory")
#define PG8_WAIT_L(n) asm volatile("s_waitcnt lgkmcnt(" #n ")" ::: "memory")
#define PG8_BAR __builtin_amdgcn_s_barrier()
#define PG8_SCHED __builtin_amdgcn_sched_barrier(0)
    Unit cur, nxt; int ui = 0;
    if (!S.next(0, cur)) return;
    f32x4 acc[2][2][4][2];
#pragma unroll
    for (int a = 0; a < 2; ++a)
#pragma unroll
        for (int b = 0; b < 2; ++b)
#pragma unroll
            for (int m = 0; m < 4; ++m)
#pragma unroll
                for (int n = 0; n < 2; ++n) acc[a][b][m][n] = (f32x4){0.f, 0.f, 0.f, 0.f};
    bf16x8 At[4][2], B0[2][2], B1[2][2];
    const char* cA = cur.A; const char* cB = cur.B;
    PG8_STAGE(PG8_SB(0, 0), cB, voffB); PG8_STAGE(PG8_SA(0, 0), cA, voffA); PG8_STAGE(PG8_SB(0, 1), cB + hstepB, voffB); PG8_STAGE(PG8_SA(0, 1), cA + hstepA, voffA);
    if (wr == 1) PG8_BAR;
    PG8_WAIT_V(4); PG8_BAR;
    PG8_STAGE(PG8_SB(1, 0), cB + kstep, voffB); PG8_STAGE(PG8_SA(1, 0), cA + kstep, voffA); PG8_STAGE(PG8_SB(1, 1), cB + hstepB + kstep, voffB);
    PG8_WAIT_V(6); PG8_BAR;
    for (;;) {
        const bool has_next = S.next(ui + 1, nxt);
        const char* nA = has_next ? nxt.A : cA; const char* nB = has_next ? nxt.B : cB;
        for (int t = 0; t < nt; t += 2) {
            const bool last = (t == nt - 2);
            const char* a1 = cA + (size_t)(t + 1) * kstep;
            const char* a2 = last ? nA : cA + (size_t)(t + 2) * kstep; const char* b2 = last ? nB : cB + (size_t)(t + 2) * kstep;
            const char* a3 = a2 + kstep; const char* b3 = b2 + kstep;
            PG8_LDB(B0, 0, 0); PG8_SCHED; PG8_LDA(At, 0, 0); PG8_STAGE(PG8_SA(1, 1), a1 + hstepA, voffA);
            PG8_WAIT_L(8); PG8_BAR; PG8_WAIT_L(0); PG8_MMA(0, 0, At, B0); PG8_BAR; PG8_SCHED;
            PG8_LDB(B1, 0, 1); PG8_STAGE(PG8_SB(0, 0), b2, voffB);
            PG8_BAR; PG8_WAIT_L(0); PG8_MMA(0, 1, At, B1); PG8_BAR;
            PG8_LDA(At, 0, 1); PG8_STAGE(PG8_SA(0, 0), a2, voffA);
            PG8_BAR; PG8_WAIT_L(0); PG8_MMA(1, 0, At, B0); PG8_BAR; PG8_SCHED;
            PG8_STAGE(PG8_SB(0, 1), b2 + hstepB, voffB);
            PG8_WAIT_V(6); PG8_BAR; PG8_MMA(1, 1, At, B1); PG8_BAR;
            PG8_LDB(B0, 1, 0); PG8_SCHED; PG8_LDA(At, 1, 0); PG8_STAGE(PG8_SA(0, 1), a2 + hstepA, voffA);
            PG8_WAIT_L(8); PG8_BAR; PG8_WAIT_L(0); PG8_MMA(0, 0, At, B0); PG8_BAR; PG8_SCHED;
            PG8_LDB(B1, 1, 1); PG8_STAGE(PG8_SB(1, 0), b3, voffB);
            PG8_BAR; PG8_WAIT_L(0); PG8_MMA(0, 1, At, B1); PG8_BAR;
            PG8_LDA(At, 1, 1); PG8_STAGE(PG8_SA(1, 0), a3, voffA);
            PG8_BAR; PG8_WAIT_L(0); PG8_MMA(1, 0, At, B0); PG8_BAR; PG8_SCHED;
            PG8_STAGE(PG8_SB(1, 1), b3 + hstepB, voffB);
            PG8_WAIT_V(6); PG8_BAR; PG8_MMA(1, 1, At, B1); PG8_BAR;
        }
        E(acc, cur, wr, wc, fr, fq, lds);
        if (!has_next) break;
#pragma unroll
        for (int a = 0; a < 2; ++a)
#pragma unroll
            for (int b = 0; b < 2; ++b)
#pragma unroll
                for (int m = 0; m < 4; ++m)
#pragma unroll
                    for (int n = 0; n < 2; ++n) acc[a][b][m][n] = (f32x4){0.f, 0.f, 0.f, 0.f};
        cur = nxt; cA = nA; cB = nB; ++ui;
    }
    PG8_WAIT_V(0);
    if (wr == 0) PG8_BAR;
    PG8_BAR;
#undef PG8_SA
#undef PG8_SB
#undef PG8_STAGE
#undef PG8_LDA
#undef PG8_LDB
#undef PG8_MMA
#undef PG8_WAIT_V
#undef PG8_WAIT_L
#undef PG8_BAR
#undef PG8_SCHED
}

struct Sched {
    int mode, nM, nN, nwg, G, c, tpb; const char* baseA; const char* baseB; char* baseO; size_t strideA, strideB, bstrideB; int ldo_bytes_per_el;
    __device__ __forceinline__ bool next(int i, Unit& u) const {
        const long L = (long)i * G + c; if (L >= nwg) return false;
        if (mode == 0) {
            int wgid = (int)L; { const int q = nwg / 8, r = nwg % 8, xcd = wgid % 8, off = wgid / 8; wgid = (xcd < r ? xcd * (q + 1) : r * (q + 1) + (xcd - r) * q) + off; }
            const int nig = 8 * nN, gid = wgid / nig, fm = gid * 8, gsz = (nM - fm) < 8 ? (nM - fm) : 8;
            const int pm = fm + ((wgid % nig) % gsz), pn = (wgid % nig) / gsz;
            u.A = baseA + (size_t)pm * strideA; u.B = baseB + (size_t)pn * strideB + (size_t)(pm / tpb) * bstrideB; u.O = baseO; u.row0 = pm * 256; u.col0 = pn * 256; u.scol = pn * 256;
        } else if (mode == 1) {
            const int l = (int)L, b = l >> 4, h = (l >> 2) & 3, kt = l & 3;
            u.A = baseA + ((size_t)(b * 256) * 2048 + h * 256) * 2; u.B = baseB + ((size_t)(kt * 256) * 1024 + h * 256) * 2;
            u.O = baseO + ((size_t)b * 1048576 + (size_t)(h * 256) * 1024 + kt * 256) * 2; u.row0 = 0; u.col0 = 0; u.scol = kt * 256;
        } else {
            const int l = (int)L, b = l >> 4, h = (l >> 2) & 3, ntile = l & 3;
            u.A = baseA + ((size_t)(ntile * 256) * 1024 + h * 256) * 2; u.B = baseB + ((size_t)(b * 256) * 2048 + 1024 + h * 256) * 2;
            u.O = baseO + ((size_t)b * 1048576 + (size_t)(ntile * 256) * 1024 + h * 256) * 2; u.row0 = 0; u.col0 = 0; u.scol = 0;
        }
        return true;
    }
};

struct EpiBf16 {
    static constexpr bool PERM = true;
    int ldc; float scale; const float* rss; const float* colscale;
    __device__ __forceinline__ void operator()(const f32x4 (&acc)[2][2][4][2], const Unit& u, int wr, int wc, int fr, int fq, LAS unsigned char*) const {
        bf16_t* base = (bf16_t*)u.O;
        f32x4 cs[2][2];
#pragma unroll
        for (int bj = 0; bj < 2; ++bj)
#pragma unroll
            for (int n = 0; n < 2; ++n) cs[bj][n] = colscale ? *(const f32x4*)(colscale + u.scol + wc * 32 + 8 * fq + bj * HALF + 4 * n) : (f32x4){1.f, 1.f, 1.f, 1.f};
#pragma unroll
        for (int ai = 0; ai < 2; ++ai)
#pragma unroll
            for (int m = 0; m < 4; ++m) {
                const int row = u.row0 + ai * HALF + wr * 64 + m * 16 + fr;
                float sc = scale; if (rss) sc *= rsqrtf(rss[row] * (1.0f / 1024.0f) + EPS);
                bf16_t* rowp = base + (size_t)row * ldc + u.col0 + wc * 32 + 8 * fq;
#pragma unroll
                for (int bj = 0; bj < 2; ++bj) { const f32x4 v0 = acc[ai][bj][m][0] * sc * cs[bj][0], v1 = acc[ai][bj][m][1] * sc * cs[bj][1];
                    u32x4 w; w.x = cvt_pk_bf16(v0[0], v0[1]); w.y = cvt_pk_bf16(v0[2], v0[3]); w.z = cvt_pk_bf16(v1[0], v1[1]); w.w = cvt_pk_bf16(v1[2], v1[3]);
                    *(u32x4*)(rowp + bj * HALF) = w; } }
    }
};
struct EpiResid {
    static constexpr bool PERM = false;
    const float* base; float* out; bf16_t* xg; const float* g; float* rss;
    __device__ __forceinline__ void operator()(const f32x4 (&acc)[2][2][4][2], const Unit& u, int wr, int wc, int fr, int fq, LAS unsigned char*) const {
        const int colb = u.col0 + wc * 32 + 4 * fq;
#pragma unroll
        for (int ai = 0; ai < 2; ++ai)
#pragma unroll
            for (int m = 0; m < 4; ++m) {
                const int row = u.row0 + ai * HALF + wr * 64 + m * 16 + fr; const size_t off = (size_t)row * DM + colb; float ss = 0.f;
#pragma unroll
                for (int bj = 0; bj < 2; ++bj)
#pragma unroll
                    for (int n = 0; n < 2; ++n) { const int co = bj * HALF + n * 16;
                        const f32x4 bs = *(const f32x4*)(base + off + co); const f32x4 v = bs + acc[ai][bj][m][n];
                        *(f32x4*)(out + off + co) = v; const f32x4 gv = *(const f32x4*)(g + colb + co); const f32x4 w = v * gv;
                        u32x2 pk; pk.x = cvt_pk_bf16(w[0], w[1]); pk.y = cvt_pk_bf16(w[2], w[3]); *(u32x2*)(xg + off + co) = pk;
                        ss += (v[0] * v[0] + v[1] * v[1]) + (v[2] * v[2] + v[3] * v[3]); }
                ss += __shfl_xor(ss, 16); ss += __shfl_xor(ss, 32);
                if (fq == 0) atomicAdd(rss + row, ss);
                asm volatile("" ::: "memory"); }
    }
};
template <bool BASE_BF16>
struct EpiResidB {
    static constexpr bool PERM = false;
    const void* base; bf16_t* out; float* rss;
    __device__ __forceinline__ void operator()(const f32x4 (&acc)[2][2][4][2], const Unit& u, int wr, int wc, int fr, int fq, LAS unsigned char*) const {
        const int colb = u.col0 + wc * 32 + 4 * fq;
#pragma unroll
        for (int ai = 0; ai < 2; ++ai)
#pragma unroll
            for (int m = 0; m < 4; ++m) {
                const int row = u.row0 + ai * HALF + wr * 64 + m * 16 + fr; const size_t off = (size_t)row * DM + colb; float ss = 0.f;
                f32x4 bs[2][2];
#pragma unroll
                for (int bj = 0; bj < 2; ++bj)
#pragma unroll
                    for (int n = 0; n < 2; ++n) { const int co = bj * HALF + n * 16;
                        if (BASE_BF16) { const u32x2 b2 = *(const u32x2*)((const bf16_t*)base + off + co); bs[bj][n] = (f32x4){bf_lo(b2.x), bf_hi(b2.x), bf_lo(b2.y), bf_hi(b2.y)}; }
                        else bs[bj][n] = *(const f32x4*)((const float*)base + off + co); }
#pragma unroll
                for (int bj = 0; bj < 2; ++bj)
#pragma unroll
                    for (int n = 0; n < 2; ++n) { const int co = bj * HALF + n * 16; const f32x4 v = bs[bj][n] + acc[ai][bj][m][n];
                        u32x2 pk; pk.x = cvt_pk_bf16(v[0], v[1]); pk.y = cvt_pk_bf16(v[2], v[3]); *(u32x2*)(out + off + co) = pk;
                        ss += (v[0] * v[0] + v[1] * v[1]) + (v[2] * v[2] + v[3] * v[3]); }
                ss += __shfl_xor(ss, 16); ss += __shfl_xor(ss, 32);
                if (fq == 0) atomicAdd(rss + row, ss);
                if (m & 1) asm volatile("" ::: "memory"); }
    }
};
struct EpiSoftmax {
    static constexpr bool PERM = true;
    const float* rss; bf16_t* P;
    __device__ __forceinline__ void operator()(f32x4 (&acc)[2][2][4][2], const Unit& u, int wr, int wc, int fr, int fq, LAS unsigned char* lds) const {
        LAS f32x2* X = (LAS f32x2*)(lds + XCH_OFF);
        float ml[2][4];
#pragma unroll
        for (int ai = 0; ai < 2; ++ai)
#pragma unroll
            for (int m = 0; m < 4; ++m) {
                const int r = ai * HALF + wr * 64 + m * 16 + fr;
                const float sc = rsqrtf(rss[u.row0 + r] * (1.0f / 1024.0f) + EPS) * LOG2E;
                float mx = -3.0e38f;
#pragma unroll
                for (int bj = 0; bj < 2; ++bj)
#pragma unroll
                    for (int n = 0; n < 2; ++n) { f32x4 v = acc[ai][bj][m][n] * sc; acc[ai][bj][m][n] = v; mx = fmaxf(mx, fmaxf(fmaxf(v[0], v[1]), fmaxf(v[2], v[3]))); }
                mx = fmaxf(mx, __shfl_xor(mx, 16)); mx = fmaxf(mx, __shfl_xor(mx, 32));
                float sm = 0.f;
#pragma unroll
                for (int bj = 0; bj < 2; ++bj)
#pragma unroll
                    for (int n = 0; n < 2; ++n) { f32x4 v = acc[ai][bj][m][n]; v[0] = fast_exp2(v[0] - mx); v[1] = fast_exp2(v[1] - mx); v[2] = fast_exp2(v[2] - mx); v[3] = fast_exp2(v[3] - mx);
                        acc[ai][bj][m][n] = v; sm += (v[0] + v[1]) + (v[2] + v[3]); }
                sm += __shfl_xor(sm, 16); sm += __shfl_xor(sm, 32);
                ml[ai][m] = mx;
                if (fq == 0) X[r * 4 + wc] = (f32x2){mx, sm};
            }
        LDS_WAIT(); __builtin_amdgcn_s_barrier(); asm volatile("" ::: "memory");
#pragma unroll
        for (int ai = 0; ai < 2; ++ai)
#pragma unroll
            for (int m = 0; m < 4; ++m) {
                const int r = ai * HALF + wr * 64 + m * 16 + fr;
                const f32x2 a = X[r * 4 + 0], b = X[r * 4 + 1], c = X[r * 4 + 2], d = X[r * 4 + 3];
                const float mg = fmaxf(fmaxf(a.x, b.x), fmaxf(c.x, d.x));
                const float lg = a.y * fast_exp2(a.x - mg) + b.y * fast_exp2(b.x - mg) + c.y * fast_exp2(c.x - mg) + d.y * fast_exp2(d.x - mg);
                const float f = fast_exp2(ml[ai][m] - mg) / lg;
                bf16_t* rowp = P + (size_t)(u.row0 + r) * DM + u.col0 + wc * 32 + 8 * fq;
#pragma unroll
                for (int bj = 0; bj < 2; ++bj) { const f32x4 v0 = acc[ai][bj][m][0] * f, v1 = acc[ai][bj][m][1] * f;
                    u32x4 w; w.x = cvt_pk_bf16(v0[0], v0[1]); w.y = cvt_pk_bf16(v0[2], v0[3]); w.z = cvt_pk_bf16(v1[0], v1[1]); w.w = cvt_pk_bf16(v1[2], v1[3]);
                    *(u32x4*)(rowp + bj * HALF) = w; } }
        LDS_WAIT();
    }
};
}
struct Args { const float* in[26]; float* out; unsigned char* ws; int ph_lo, ph_hi; };
enum { I_X = 0, I_MEM, I_GMIX, I_WIN, I_CONVW, I_BI, I_BF, I_GML, I_LQ1, I_LK1, I_LQ2, I_LK2, I_GDA, I_WOUT, I_GCA, I_GMEM, I_WCQ, I_WCK, I_WCV, I_WCO, I_GFFN, I_WPQ, I_SUBK, I_PU, I_PV, I_GFIN };

struct Frame {
    LAS unsigned char* lds;
    int tid, lane, wave, G, vcu;
    const Args* a;
    unsigned char* ws;
    unsigned* ctl;
};


#define XB_TMO      128
#define XB_XCNT(j)  (256  + 64 * (j))
#define XB_XSUB(j)  (1280 + 64 * (j))
#define XB_XGEN(j)  (2304 + 64 * (j))
#define XB_TOP      3328
#define XB_TOPGEN   3392
#define XCD_BAR_WORDS 3456
#define XB_SPIN_CAP (1u << 18)
__device__ __forceinline__ unsigned xb_ld(unsigned* p)              { return __hip_atomic_load(p, __ATOMIC_RELAXED, __HIP_MEMORY_SCOPE_AGENT); }
__device__ __forceinline__ unsigned xb_add(unsigned* p, unsigned v) { return __hip_atomic_fetch_add(p, v, __ATOMIC_RELAXED, __HIP_MEMORY_SCOPE_AGENT); }
__device__ __forceinline__ unsigned xb_xcc_id() { return (unsigned)__builtin_amdgcn_s_getreg((3 << 11) | 20) & 0xFu; }
#define XB_SPIN(cond, bar) do { unsigned _sp = 0; while (cond) { __builtin_amdgcn_s_sleep(1); \
    if ((++_sp & 255u) == 0u) { if (xb_ld(&(bar)[XB_TMO])) break; if (_sp > XB_SPIN_CAP) { atomicAdd(&(bar)[XB_TMO], 1u); break; } } } } while (0)
struct XcdBarrier { unsigned* bar; unsigned x; volatile LAS unsigned* st; };
__device__ __forceinline__ XcdBarrier xcd_barrier_post(unsigned* bar, volatile LAS unsigned* st) {
    XcdBarrier b; b.bar = bar; b.x = xb_xcc_id(); b.st = st;
    if (threadIdx.x == 0) (void)xb_add(&bar[XB_XCNT(b.x)], 1u);
    return b;
}
__device__ __forceinline__ void xcd_barrier_complete(unsigned* bar, unsigned x, unsigned& nloc, unsigned& nx) {
    const unsigned G = gridDim.x * gridDim.y * gridDim.z;
    unsigned sum, cnt, mine, sp = 0u;
    for (;;) {
        sum = 0u; cnt = 0u; mine = 0u;
#pragma unroll
        for (unsigned j = 0; j < 16; ++j) { const unsigned c = xb_ld(&bar[XB_XCNT(j)]); sum += c; cnt += (c > 0u) ? 1u : 0u; mine = (j == x) ? c : mine; }
        if (sum == G) break;
        __builtin_amdgcn_s_sleep(1);
        if ((++sp & 255u) == 0u) { if (xb_ld(&bar[XB_TMO])) break; if (sp > XB_SPIN_CAP) { atomicAdd(&bar[XB_TMO], 1u); break; } }
    }
    nloc = mine > 0u ? mine : 1u; nx = cnt > 0u ? cnt : 1u;
}
__device__ __forceinline__ void xcd_barrier(const XcdBarrier& b) {
    asm volatile("s_waitcnt vmcnt(0)" ::: "memory");
    __syncthreads();
    if (threadIdx.x == 0) {
        unsigned* bar = b.bar;
        __builtin_amdgcn_s_waitcnt(0);
        unsigned nloc = b.st[0], nx = b.st[1];
        if (nloc == 0u) { xcd_barrier_complete(bar, b.x, nloc, nx); b.st[0] = nloc; b.st[1] = nx; }
        const unsigned old = xb_add(&bar[XB_XSUB(b.x)], 1u);
        const unsigned gen = old / nloc;
        if (old + 1u == (gen + 1u) * nloc) {
            __builtin_amdgcn_fence(__ATOMIC_RELEASE, "agent");
            asm volatile("s_waitcnt vmcnt(0)" ::: "memory");
            const unsigned og = xb_add(&bar[XB_TOP], 1u);
            const unsigned tg = og / nx;
            if (og + 1u == (tg + 1u) * nx) xb_add(&bar[XB_TOPGEN], 1u);
            else XB_SPIN(xb_ld(&bar[XB_TOPGEN]) == tg, bar);
            __builtin_amdgcn_fence(__ATOMIC_ACQUIRE, "agent");
            xb_add(&bar[XB_XGEN(b.x)], 1u);
            asm volatile("s_waitcnt vmcnt(0)" ::: "memory");
        } else {
            XB_SPIN(xb_ld(&bar[XB_XGEN(b.x)]) == gen, bar);
            __builtin_amdgcn_fence(__ATOMIC_ACQUIRE, "agent");
            asm volatile("s_waitcnt vmcnt(0)" ::: "memory");
        }
    }
    __syncthreads();
}

__device__ __forceinline__ void p0_transpose_item(const float* W, int Nsrc, int K, int kb, int src_col0, bf16_t* WT, int dst_row0, LAS float* scr, int lane, const float* kscale = nullptr) {
    const int k0 = 64 * kb;
#pragma unroll 8
    for (int i = 0; i < 32; ++i) { const int kk = 2 * i + (lane >> 5); float wv = W[(size_t)(k0 + kk) * Nsrc + src_col0 + (lane & 31)]; if (kscale) wv *= kscale[k0 + kk]; scr[kk * 33 + (lane & 31)] = wv; }
    LDS_WAIT(); asm volatile("" ::: "memory");
    const int c = lane & 7;
#pragma unroll
    for (int j = 0; j < 4; ++j) { const int n = (lane >> 3) + 8 * j; const LAS float* s = scr + (8 * c) * 33 + n;
        u32x4 o; o.x = cvt_pk_bf16(s[0 * 33], s[1 * 33]); o.y = cvt_pk_bf16(s[2 * 33], s[3 * 33]); o.z = cvt_pk_bf16(s[4 * 33], s[5 * 33]); o.w = cvt_pk_bf16(s[6 * 33], s[7 * 33]);
        *(u32x4*)(WT + (size_t)(dst_row0 + n) * K + k0 + 8 * c) = o; }
    LDS_WAIT(); asm volatile("" ::: "memory");
}
__device__ __forceinline__ void rms_row_to_bf16(const float* xrow, const float* g, bf16_t* orow, int lane, f32x4 (&v)[4]) {
    const f32x4* xr = (const f32x4*)xrow + lane; float s = 0.f;
#pragma unroll
    for (int j = 0; j < 4; ++j) { v[j] = xr[64 * j]; s += (v[j].x * v[j].x + v[j].y * v[j].y) + (v[j].z * v[j].z + v[j].w * v[j].w); }
    const float rstd = rsqrtf(wave_sum(s) * (1.f / DM) + EPS);
    u32x2* o8 = (u32x2*)orow + lane;
#pragma unroll
    for (int j = 0; j < 4; ++j) { const f32x4 gv = *((const f32x4*)g + lane + 64 * j); v[j] = v[j] * rstd * gv; u32x2 pk; pk.x = cvt_pk_bf16(v[j].x, v[j].y); pk.y = cvt_pk_bf16(v[j].z, v[j].w); o8[64 * j] = pk; }
}

__device__ __forceinline__ void p0_prologue(Frame& F) {
    const Args& A = *F.a;
    LAS float* scr = (LAS float*)(F.lds + F.wave * 8448);
    LAS float* sG = (LAS float*)(F.lds + 67584);
    for (int k = F.tid; k < DM; k += 512) { const f32x4 w0 = *(const f32x4*)(A.in[I_WIN] + (size_t)k * INW + 2048), w1 = *(const f32x4*)(A.in[I_WIN] + (size_t)k * INW + 2052);
        sG[0 * DM + k] = w0.x; sG[1 * DM + k] = w0.y; sG[2 * DM + k] = w0.z; sG[3 * DM + k] = w0.w; sG[4 * DM + k] = w1.x; sG[5 * DM + k] = w1.y; sG[6 * DM + k] = w1.z; sG[7 * DM + k] = w1.w; }
    __syncthreads();
    const int gw = F.vcu * 8 + F.wave, NGW = F.G * 8;
    constexpr int KB = DM / 64;
    constexpr int I_IN = KB * (NZ / 32), I_SQ = KB * (DM / 32);
    constexpr int NITEMS = I_IN + 5 * I_SQ;
    bf16_t* WinT = (bf16_t*)(F.ws + WS_WIN); bf16_t* WoutT = (bf16_t*)(F.ws + WS_WOUT); bf16_t* WkvT = (bf16_t*)(F.ws + WS_WKV); bf16_t* WcoT = (bf16_t*)(F.ws + WS_WCO); bf16_t* WpqT = (bf16_t*)(F.ws + WS_WPQ);
    for (int it = gw; it < NITEMS; it += NGW) {
        int r = it;
        if (r < I_IN) { const int kb = r / (NZ / 32), nb = r % (NZ / 32), n0 = nb * 32; p0_transpose_item(A.in[I_WIN], INW, DM, kb, n0 + (n0 >= 2048 ? 8 : 0), WinT, n0, scr, F.lane); continue; } r -= I_IN;
        const int which = r / I_SQ; r -= which * I_SQ; const int kb = r / (DM / 32), n0 = (r % (DM / 32)) * 32;
        if (which == 0) p0_transpose_item(A.in[I_WOUT], DM, DM, kb, n0, WoutT, n0, scr, F.lane);
        else if (which == 1) p0_transpose_item(A.in[I_WCK], DM, DM, kb, n0, WkvT, n0, scr, F.lane);
        else if (which == 2) p0_transpose_item(A.in[I_WCV], DM, DM, kb, n0, WkvT, DM + n0, scr, F.lane);
        else if (which == 3) p0_transpose_item(A.in[I_WCO], DM, DM, kb, n0, WcoT, n0, scr, F.lane);
        else p0_transpose_item(A.in[I_WPQ], DM, DM, kb, n0, WpqT, n0, scr, F.lane, A.in[I_GFFN]);
    }
    {
        const int gt = F.vcu * 512 + F.tid, NT = F.G * 512;
        const f32x4* s0 = (const f32x4*)A.in[I_WCQ]; u32x2* d0 = (u32x2*)(F.ws + WS_WCQ);
        for (int i = gt; i < DM * DM / 4; i += NT) { const f32x4 v = s0[i]; u32x2 pk; pk.x = cvt_pk_bf16(v.x, v.y); pk.y = cvt_pk_bf16(v.z, v.w); d0[i] = pk; }
        const f32x4* s1 = (const f32x4*)A.in[I_SUBK]; u32x2* d1 = (u32x2*)(F.ws + WS_SK);
        for (int i = gt; i < 16 * 128 * 64 / 4; i += NT) { const f32x4 v = s1[i]; u32x2 pk; pk.x = cvt_pk_bf16(v.x, v.y); pk.y = cvt_pk_bf16(v.z, v.w); d1[i] = pk; }
    }
    {
        bf16_t* HN = (bf16_t*)(F.ws + WS_BUFA); float* GT = (float*)(F.ws + WS_GATES);
        for (int m = gw; m < T_TOK; m += NGW) {
            f32x4 v[4]; rms_row_to_bf16(A.in[I_X] + (size_t)m * DM, A.in[I_GMIX], HN + (size_t)m * DM, F.lane, v);
            float gacc[8];
#pragma unroll
            for (int j = 0; j < 8; ++j) gacc[j] = 0.f;
#pragma unroll
            for (int jj = 0; jj < 4; ++jj)
#pragma unroll
                for (int j = 0; j < 8; ++j) { const f32x4 wv = *(const LAS f32x4*)(sG + j * DM + 4 * F.lane + 256 * jj); gacc[j] += (v[jj].x * wv.x + v[jj].y * wv.y) + (v[jj].z * wv.z + v[jj].w * wv.w); }
            float r4[4], r2[2], r1;
            { const bool hi = (F.lane & 32) != 0;
#pragma unroll
              for (int i = 0; i < 4; ++i) { const float keep = hi ? gacc[i + 4] : gacc[i], send = hi ? gacc[i] : gacc[i + 4]; r4[i] = keep + __shfl_xor(send, 32); } }
            { const bool hi = (F.lane & 16) != 0;
#pragma unroll
              for (int i = 0; i < 2; ++i) { const float keep = hi ? r4[i + 2] : r4[i], send = hi ? r4[i] : r4[i + 2]; r2[i] = keep + __shfl_xor(send, 16); } }
            { const bool hi = (F.lane & 8) != 0; const float keep = hi ? r2[1] : r2[0], send = hi ? r2[0] : r2[1]; r1 = keep + __shfl_xor(send, 8); }
            r1 += __shfl_xor(r1, 4); r1 += __shfl_xor(r1, 2); r1 += __shfl_xor(r1, 1);
            if ((F.lane & 7) == 0) GT[(size_t)m * 8 + 4 * (F.lane >> 5) + 2 * ((F.lane >> 4) & 1) + ((F.lane >> 3) & 1)] = r1;
        }
        bf16_t* MN = (bf16_t*)(F.ws + WS_MEMN);
        for (int m = gw; m < TMEM; m += NGW) { f32x4 v[4]; rms_row_to_bf16(A.in[I_MEM] + (size_t)m * DM, A.in[I_GMEM], MN + (size_t)m * DM, F.lane, v); }
    }
}
#ifndef AT_DEPTH
#define AT_DEPTH 3
#endif
constexpr int AT_STAGE = 32768, AT_NST = 4;
__device__ __forceinline__ int swzf(int r) { return ((r & 3) << 2) | ((r >> 2) & 3); }

__device__ __forceinline__ void glds16_asm(const void* gsrc, unsigned lds_dst) {
    unsigned keep;
    asm volatile("s_mov_b32 %0, m0\n\ts_mov_b32 m0, %2\n\ts_nop 0\n\tglobal_load_lds_dwordx4 %1, off\n\ts_mov_b32 m0, %0" : "=&s"(keep) : "v"(gsrc), "s"(lds_dst) : "memory");
}

__device__ __forceinline__ s16x4 tr16(const LAS unsigned char* p) { return __builtin_amdgcn_ds_read_tr16_b64_v4i16((LAS s16x4*)p); }
__device__ __forceinline__ bf16x8 cat8(s16x4 lo, s16x4 hi) { return __builtin_shufflevector(lo, hi, 0, 1, 2, 3, 4, 5, 6, 7); }

template <int MODE>
__device__ __forceinline__ void attn_unit(Frame& F, const int b, const int h, const int qt, const float lam) {
    const Args& A = *F.a;
    const bf16_t* Z = (const bf16_t*)(F.ws + WS_Z);
    bf16_t* CAT = (bf16_t*)(F.ws + WS_BUFA);
    LAS unsigned char* lds = F.lds;
    int tid_l = F.tid; asm volatile("" : "+v"(tid_l));
    const int tid = tid_l, lane = tid & 63, w = F.wave, c = w & 1, qb = w >> 1, n = lane & 31, h2 = lane >> 5;
    const int q0 = qt * 128, r0 = q0 + 32 * qb, ntiles = 2 * qt + 2;
    const size_t rowbase = (size_t)b * SEQ;
    const float slope2 = __uint_as_float((unsigned)(127 - 2 * (h + 1)) << 23) * LOG2E, c1 = 0.125f * LOG2E;
    const float slope_hi = __uint_as_float(__float_as_uint(slope2) & 0xffff0000u), slope_lo = slope2 - slope_hi;
    bf16x8 Qf[4];
    { const bf16_t* qp = Z + (rowbase + r0 + n) * NZ + ZC_DAQ + h * 128 + c * 64 + 8 * h2;
#pragma unroll
      for (int kk = 0; kk < 4; ++kk) { const u32x4 q4_ = *(const u32x4*)(qp + 16 * kk); u32x4 o_;
          o_.x = cvt_pk_bf16(bf_lo(q4_.x) * c1, bf_hi(q4_.x) * c1); o_.y = cvt_pk_bf16(bf_lo(q4_.y) * c1, bf_hi(q4_.y) * c1); o_.z = cvt_pk_bf16(bf_lo(q4_.z) * c1, bf_hi(q4_.z) * c1); o_.w = cvt_pk_bf16(bf_lo(q4_.w) * c1, bf_hi(q4_.w) * c1);
          Qf[kk] = __builtin_bit_cast(bf16x8, o_); } }
    bf16x8 Qx, Kx[2];
    { u32x4 o_ = (u32x4){0u, 0u, 0u, 0u}; if (h2 == 0) o_.x = cvt_pk_bf16(slope_hi, slope_lo); Qx = __builtin_bit_cast(bf16x8, o_);
#pragma unroll
      for (int kb = 0; kb < 2; ++kb) { u32x4 k_ = (u32x4){0u, 0u, 0u, 0u}; if (h2 == 0) k_.x = cvt_pk_bf16((float)(32 * kb + n), (float)(32 * kb + n)); Kx[kb] = __builtin_bit_cast(bf16x8, k_); } }
    f32x16 O[4];
#pragma unroll
    for (int i = 0; i < 4; ++i)
#pragma unroll
        for (int j = 0; j < 16; ++j) O[i][j] = 0.f;
    float mrun = -3.0e38f, lsum = 0.f;
    const unsigned ldsbase = (unsigned)(size_t)lds;
#define AT_DMA(j_) do { if (MODE & 2) break; const int jj_ = (j_) < ntiles ? (j_) : ntiles - 1; \
        _Pragma("unroll") for (int m_ = 0; m_ < 4; ++m_) { const int i_ = w + 8 * m_, r_ = 4 * (i_ & 15) + (lane >> 4), gch_ = (lane & 15) ^ swzf(r_); \
            const bf16_t* src_ = Z + (rowbase + 64 * jj_ + r_) * NZ + ((i_ >= 16) ? ZC_DAV : ZC_DAK) + h * 128 + 8 * gch_; \
            glds16_asm(src_, ldsbase + (unsigned)(((j_) & 3) * AT_STAGE + i_ * 1024)); } } while (0)
#if AT_DEPTH == 3
    AT_DMA(0); AT_DMA(1); AT_DMA(2);
    asm volatile("s_waitcnt vmcnt(4)" ::: "memory");
#else
    AT_DMA(0); AT_DMA(1);
    VM_WAIT();
#endif
    __syncthreads();
    const int i16 = lane & 15, q4 = i16 >> 2, p4 = i16 & 3, blk = (lane >> 4) & 1;
#define AT_QK(S_, j_) do { const LAS unsigned char* Ks_ = lds + ((j_) & 3) * AT_STAGE; bf16x8 kf_[8]; \
        _Pragma("unroll") for (int kb = 0; kb < 2; ++kb) _Pragma("unroll") for (int kk = 0; kk < 4; ++kk) kf_[4 * kb + kk] = *(const LAS bf16x8*)(Ks_ + (32 * kb + n) * 256 + (((8 * c + 2 * kk + h2) ^ swzf(n)) << 4)); \
        _Pragma("unroll") for (int e = 0; e < 16; ++e) { (S_)[0][e] = 0.f; (S_)[1][e] = 0.f; } \
        _Pragma("unroll") for (int kb = 0; kb < 2; ++kb) { _Pragma("unroll") for (int kk = 0; kk < 4; ++kk) (S_)[kb] = __builtin_amdgcn_mfma_f32_32x32x16_bf16(kf_[4 * kb + kk], Qf[kk], (S_)[kb], 0, 0, 0); \
            (S_)[kb] = __builtin_amdgcn_mfma_f32_32x32x16_bf16(Kx[kb], Qx, (S_)[kb], 0, 0, 0); } } while (0)
#define AT_LOADV(buf_, dvb_) do { _Pragma("unroll") for (int kb = 0; kb < 2; ++kb) _Pragma("unroll") for (int s = 0; s < 2; ++s) { const int ch_ = 4 * (dvb_) + 2 * blk + (p4 >> 1); \
        const LAS unsigned char* vp = Vs + (32 * kb + 16 * s + 4 * h2 + q4) * 256 + 8 * (p4 & 1); \
        (buf_)[2 * kb + s] = cat8(tr16(vp + ((ch_ ^ swzf(4 * h2 + q4)) << 4)), tr16(vp + 8 * 256 + ((ch_ ^ swzf(8 + 4 * h2 + q4)) << 4))); } } while (0)
#define AT_PV(buf_, dvb_) do { _Pragma("unroll") for (int e = 0; e < 16; ++e) O[dvb_][e] *= alpha; \
        _Pragma("unroll") for (int kb = 0; kb < 2; ++kb) _Pragma("unroll") for (int s = 0; s < 2; ++s) O[dvb_] = __builtin_amdgcn_mfma_f32_32x32x16_bf16((buf_)[2 * kb + s], Pf[kb][s], O[dvb_], 0, 0, 0); } while (0)
#define AT_TILE(Sc_, Sn_, j_) do { \
        AT_DMA((j_) + AT_DEPTH); \
        const int k0 = 64 * (j_); \
        if (!(MODE & 1) && k0 <= r0 + 31) { \
            const LAS unsigned char* Vs = lds + ((j_) & 3) * AT_STAGE + 16384; \
            bf16x8 va[4], vb[4]; \
            if ((j_) + 1 < ntiles && k0 + 64 <= r0 + 31) AT_QK(Sn_, (j_) + 1); \
            AT_LOADV(va, 0); \
            const float D0 = (float)(r0 + n - k0 - 4 * h2); \
            const float tcon = slope2 * (float)(k0 - r0 - n);            \
            float mloc = -3.0e38f; \
            if (k0 + 63 > r0) { \
                _Pragma("unroll") for (int kb = 0; kb < 2; ++kb) _Pragma("unroll") for (int e = 0; e < 16; ++e) { const float off = (float)(32 * kb + (e & 3) + 8 * (e >> 2)); \
                    const float v = (off > D0) ? -INFINITY : (Sc_)[kb][e]; (Sc_)[kb][e] = v; mloc = fmaxf(mloc, v); } \
            } else { \
                _Pragma("unroll") for (int kb = 0; kb < 2; ++kb) _Pragma("unroll") for (int e = 0; e < 16; ++e) mloc = fmaxf(mloc, (Sc_)[kb][e]); \
            } \
            mloc = fmaxf(mloc, __shfl_xor(mloc, 32)) + tcon; \
            const float mnew = fmaxf(mrun, mloc), alpha = fast_exp2(mrun - mnew); \
            mrun = mnew; \
            const float mm = mnew - tcon; \
            float ps = 0.f; \
            _Pragma("unroll") for (int kb = 0; kb < 2; ++kb) _Pragma("unroll") for (int e = 0; e < 16; ++e) { const float pv = fast_exp2((Sc_)[kb][e] - mm); (Sc_)[kb][e] = pv; ps += pv; } \
            lsum = lsum * alpha + ps; \
            bf16x8 Pf[2][2]; \
            _Pragma("unroll") for (int kb = 0; kb < 2; ++kb) _Pragma("unroll") for (int s = 0; s < 2; ++s) { u32x4 pk; pk.x = cvt_pk_bf16((Sc_)[kb][8 * s + 0], (Sc_)[kb][8 * s + 1]); pk.y = cvt_pk_bf16((Sc_)[kb][8 * s + 2], (Sc_)[kb][8 * s + 3]); \
                pk.z = cvt_pk_bf16((Sc_)[kb][8 * s + 4], (Sc_)[kb][8 * s + 5]); pk.w = cvt_pk_bf16((Sc_)[kb][8 * s + 6], (Sc_)[kb][8 * s + 7]); Pf[kb][s] = __builtin_bit_cast(bf16x8, pk); } \
            AT_LOADV(vb, 1); AT_PV(va, 0); \
            AT_LOADV(va, 2); AT_PV(vb, 1); \
            AT_LOADV(vb, 3); AT_PV(va, 2); \
            AT_PV(vb, 3); \
        } \
        if (AT_DEPTH == 3) asm volatile("s_waitcnt vmcnt(4)" ::: "memory"); else asm volatile("s_waitcnt vmcnt(0)" ::: "memory"); \
        __syncthreads(); } while (0)
    f32x16 SA[2], SB[2];
    AT_QK(SA, 0);
    for (int j = 0; j < ntiles; j += 2) { AT_TILE(SA, SB, j); AT_TILE(SB, SA, j + 1); }
#undef AT_TILE
#undef AT_PV
#undef AT_LOADV
#undef AT_QK
    VM_WAIT();
    __syncthreads();
    { const float lt = lsum + __shfl_xor(lsum, 32); const float inv = (c == 0 ? 1.0f : lam) / lt;
#pragma unroll
      for (int dvb = 0; dvb < 4; ++dvb)
#pragma unroll
          for (int e = 0; e < 16; ++e) O[dvb][e] *= inv; }
    LAS float* cb = (LAS float*)lds + qb * 4096;
    if (c == 1) {
#pragma unroll
        for (int dvb = 0; dvb < 4; ++dvb)
#pragma unroll
            for (int e = 0; e < 16; ++e) cb[(dvb * 16 + e) * 64 + lane] = O[dvb][e];
    }
    __syncthreads();
    if (c == 0 && MODE == 0) {
        float ss = 0.f;
#pragma unroll
        for (int dvb = 0; dvb < 4; ++dvb)
#pragma unroll
            for (int e = 0; e < 16; ++e) { const float o = O[dvb][e] - cb[(dvb * 16 + e) * 64 + lane]; O[dvb][e] = o; ss += o * o; }
        ss += __shfl_xor(ss, 32);
        const float rstd = rsqrtf(ss * (1.0f / 128.0f) + EPS) * 0.8f;
        const float* g = A.in[I_GDA] + h * 128;
        bf16_t* op = CAT + (rowbase + r0 + n) * DM + 512 + h * 128;
#pragma unroll
        for (int dvb = 0; dvb < 4; ++dvb)
#pragma unroll
            for (int e4 = 0; e4 < 4; ++e4) { const int dv = 32 * dvb + 8 * e4 + 4 * h2; const f32x4 gv = *(const f32x4*)(g + dv);
                u32x2 pk; pk.x = cvt_pk_bf16(O[dvb][4 * e4 + 0] * rstd * gv.x, O[dvb][4 * e4 + 1] * rstd * gv.y); pk.y = cvt_pk_bf16(O[dvb][4 * e4 + 2] * rstd * gv.z, O[dvb][4 * e4 + 3] * rstd * gv.w);
                *(u32x2*)(op + dv) = pk; }
    }
    __syncthreads();
#undef AT_DMA
}
__device__ __forceinline__ void conv_prepass(Frame& F) {
    const Args& A = *F.a;
    const bf16_t* Z = (const bf16_t*)(F.ws + WS_Z);
    bf16_t* QKC = (bf16_t*)(F.ws + WS_BUFB);
    const int gt = F.vcu * 512 + F.tid, NT = F.G * 512;
    for (int it = gt; it < (T_TOK / 4) * 128; it += NT) {
        const int cg = it & 127, rb = it >> 7, row0 = 4 * rb, tl = row0 & (SEQ - 1), c0 = 8 * cg;
        float cw[4][8];
#pragma unroll
        for (int tp = 0; tp < 4; ++tp) { const f32x4 w0 = *(const f32x4*)(A.in[I_CONVW] + tp * 1024 + c0), w1 = *(const f32x4*)(A.in[I_CONVW] + tp * 1024 + c0 + 4);
            cw[tp][0] = w0.x; cw[tp][1] = w0.y; cw[tp][2] = w0.z; cw[tp][3] = w0.w; cw[tp][4] = w1.x; cw[tp][5] = w1.y; cw[tp][6] = w1.z; cw[tp][7] = w1.w; }
        u32x4 raw[7];
#pragma unroll
        for (int i = 0; i < 7; ++i) raw[i] = (tl - 3 + i >= 0) ? *(const u32x4*)(Z + (size_t)(row0 - 3 + i) * NZ + c0) : (u32x4){0u, 0u, 0u, 0u};
        const float ksc = (c0 >= 512) ? 0.08838834764831845f : 1.0f;
#pragma unroll
        for (int r = 0; r < 4; ++r) {
            float y[8];
#pragma unroll
            for (int ch = 0; ch < 8; ++ch) y[ch] = 0.f;
#pragma unroll
            for (int tp = 0; tp < 4; ++tp) { const u32x4 rv = raw[r + tp];
                y[0] += cw[tp][0] * bf_lo(rv.x); y[1] += cw[tp][1] * bf_hi(rv.x); y[2] += cw[tp][2] * bf_lo(rv.y); y[3] += cw[tp][3] * bf_hi(rv.y);
                y[4] += cw[tp][4] * bf_lo(rv.z); y[5] += cw[tp][5] * bf_hi(rv.z); y[6] += cw[tp][6] * bf_lo(rv.w); y[7] += cw[tp][7] * bf_hi(rv.w); }
#pragma unroll
            for (int ch = 0; ch < 8; ++ch) y[ch] = y[ch] * fast_rcp(1.0f + __expf(-y[ch])) * ksc;
            u32x4 pk; pk.x = cvt_pk_bf16(y[0], y[1]); pk.y = cvt_pk_bf16(y[2], y[3]); pk.z = cvt_pk_bf16(y[4], y[5]); pk.w = cvt_pk_bf16(y[6], y[7]);
            *(u32x4*)(QKC + (size_t)(row0 + r) * DM + c0) = pk;
        }
    }
}

#ifndef ML_TOUCH
#define ML_TOUCH 0
#endif
constexpr int ML_TB = 49152;
constexpr int ML_HB = 2 * ML_TB;
constexpr int ML_HP = 132;
constexpr int ML_SC = ML_HB + 64 * ML_HP * 4;

#define MFMA16(a, b, c) __builtin_amdgcn_mfma_f32_16x16x32_bf16((a), (b), (c), 0, 0, 0)

__device__ __forceinline__ void mlstm_unit(Frame& F, const int b, const int h) {
    const Args& A = *F.a;
    const bf16_t* Z = (const bf16_t*)(F.ws + WS_Z);
    const bf16_t* QKC = (const bf16_t*)(F.ws + WS_BUFB);
    const float* GT = (const float*)(F.ws + WS_GATES);
    bf16_t* CAT = (bf16_t*)(F.ws + WS_BUFA);
    LAS unsigned char* lds = F.lds;
    int tid_l = F.tid; asm volatile("" : "+v"(tid_l));
    const int tid = tid_l, lane = tid & 63, w = F.wave, n = lane & 15, g = lane >> 4, q4 = n >> 2, p4 = n & 3;
    const size_t rowbase = (size_t)b * SEQ;
    LAS float* sc = (LAS float*)(lds + ML_SC);
    LAS float* sA = sc; LAS float* sM = sc + 128; LAS float* sInter = sc + 256; LAS float* sMt = sc + 384; LAS float* sW = sc + 512; LAS float* sDi = sc + 640; LAS float* sQn = sc + 704; LAS float* sN = sc + 768;
    if (tid < 128) sN[tid] = 0.f;
    const unsigned ldsbase = (unsigned)(size_t)lds;
    const float bi = A.in[I_BI][h], bfg = A.in[I_BF][h];
    float gi_r, gf_r;
#define ML_DMA(cc, par_) do { const int t0_ = 64 * (cc); \
        _Pragma("unroll") for (int m_ = 0; m_ < 6; ++m_) { const int i_ = w + 8 * m_, tile_ = i_ >> 4, r_ = 4 * (i_ & 15) + (lane >> 4), gch_ = (lane & 15) ^ swzf(r_); \
            const bf16_t* src_ = (tile_ == 2) ? (Z + (rowbase + t0_ + r_) * NZ + ZC_MLV + 128 * h + 8 * gch_) : (QKC + (rowbase + t0_ + r_) * DM + 512 * tile_ + 128 * h + 8 * gch_); \
            glds16_asm(src_, ldsbase + (unsigned)((par_) * ML_TB + i_ * 1024)); } } while (0)
#define ML_GATES(cc) do { gi_r = GT[(rowbase + 64 * (cc) + lane) * 8 + h]; gf_r = GT[(rowbase + 64 * (cc) + lane) * 8 + 4 + h]; } while (0)
    float m_st = 0.f, decay_c = 1.f;
#define ML_SCALARS(par_) do { \
        const float gi = gi_r + bi, gfv = gf_r + bfg; \
        const float lf = fminf(gfv, 0.f) - __logf(1.0f + __expf(-fabsf(gfv))); \
        float bc = lf; \
        _Pragma("unroll") for (int o = 1; o < 64; o <<= 1) { const float t_ = __shfl_up(bc, o); if (lane >= o) bc += t_; } \
        const float av = gi - bc; float pm = av; \
        _Pragma("unroll") for (int o = 1; o < 64; o <<= 1) { const float t_ = __shfl_up(pm, o); if (lane >= o) pm = fmaxf(pm, t_); } \
        const float Mv = fmaxf(m_st, pm), inter = __expf(m_st - Mv), mt = bc + Mv; \
        const float M63 = __shfl(Mv, 63), bc63 = __shfl(bc, 63); \
        const float wg = __expf(av - M63); \
        decay_c = __shfl(inter, 63); m_st = bc63 + M63; \
        if (w == 0) { sA[(par_) * 64 + lane] = av; sM[(par_) * 64 + lane] = Mv; sInter[(par_) * 64 + lane] = inter; sMt[(par_) * 64 + lane] = mt; sW[(par_) * 64 + lane] = wg; } \
    } while (0)

    f32x4 Cacc[8];
#pragma unroll
    for (int dt = 0; dt < 8; ++dt) Cacc[dt] = (f32x4){0.f, 0.f, 0.f, 0.f};
    ML_GATES(0);
    ML_DMA(0, 0);
    ML_SCALARS(0);
    VM_WAIT(); LDS_WAIT();
    __syncthreads();
    const float* gml = A.in[I_GML] + 128 * h;
    const int e0 = 16 * w;
    unsigned touch = 0u;
#pragma unroll 1
    for (int c = 0; c < 32; ++c) {
        const float decay = decay_c; const int par = c & 1;
        const LAS unsigned char* TQ = lds + par * ML_TB; const LAS unsigned char* TK = TQ + 16384; const LAS unsigned char* TV = TQ + 32768;
        if (c + 1 < 32) { ML_DMA(c + 1, par ^ 1); ML_GATES(c + 1); }
        const int nrow = tid >> 3, nseg = tid & 7;
        { const int rr = 8 * w + (lane >> 3), seg = lane & 7, x = swzf(rr);
          const u32x4 qa = *(const LAS u32x4*)(TQ + rr * 256 + (((2 * seg) ^ x) << 4)), qb = *(const LAS u32x4*)(TQ + rr * 256 + (((2 * seg + 1) ^ x) << 4));
          const f32x4 n0 = *(const LAS f32x4*)(sN + 16 * seg), n1 = *(const LAS f32x4*)(sN + 16 * seg + 4), n2 = *(const LAS f32x4*)(sN + 16 * seg + 8), n3 = *(const LAS f32x4*)(sN + 16 * seg + 12);
          float d = bf_lo(qa.x) * n0.x + bf_hi(qa.x) * n0.y + bf_lo(qa.y) * n0.z + bf_hi(qa.y) * n0.w + bf_lo(qa.z) * n1.x + bf_hi(qa.z) * n1.y + bf_lo(qa.w) * n1.z + bf_hi(qa.w) * n1.w
                  + bf_lo(qb.x) * n2.x + bf_hi(qb.x) * n2.y + bf_lo(qb.y) * n2.z + bf_hi(qb.y) * n2.w + bf_lo(qb.z) * n3.x + bf_hi(qb.z) * n3.y + bf_lo(qb.w) * n3.z + bf_hi(qb.w) * n3.w;
          d += __shfl_xor(d, 1); d += __shfl_xor(d, 2); d += __shfl_xor(d, 4);
          if (seg == 0) sQn[rr] = d; }
        bf16x8 Vf[2], Cf[4];
#pragma unroll
        for (int ks = 0; ks < 2; ++ks) {
            const LAS unsigned char* vp = TV + (32 * ks + 4 * g + q4) * 256 + (((2 * w + (p4 >> 1)) ^ swzf(4 * g + q4)) << 4) + 8 * (p4 & 1);
            Vf[ks] = cat8(tr16(vp), tr16(vp + 16 * 256));
        }
#pragma unroll
        for (int kd = 0; kd < 4; ++kd) { const f32x4 c0 = Cacc[2 * kd], c1 = Cacc[2 * kd + 1]; u32x4 pk; pk.x = cvt_pk_bf16(c0[0], c0[1]); pk.y = cvt_pk_bf16(c0[2], c0[3]); pk.z = cvt_pk_bf16(c1[0], c1[1]); pk.w = cvt_pk_bf16(c1[2], c1[3]); Cf[kd] = __builtin_bit_cast(bf16x8, pk); }
#pragma unroll 1
        for (int lb = 0; lb < 4; ++lb) {
            u32x4 pk[2]; pk[0] = (u32x4){0u, 0u, 0u, 0u}; pk[1] = (u32x4){0u, 0u, 0u, 0u};
            float di = 0.f;
            const LAS unsigned char* qrow = TQ + (16 * lb + n) * 256;
            {
                bf16x8 Qf[4];
#pragma unroll
                for (int kk = 0; kk < 4; ++kk) Qf[kk] = *(const LAS bf16x8*)(qrow + (((4 * kk + g) ^ swzf(n)) << 4));
                const float Ml = sM[par * 64 + 16 * lb + n];
#pragma unroll
                for (int sb = 0; sb < 4; ++sb) if (sb <= lb) {
                    f32x4 acc = (f32x4){0.f, 0.f, 0.f, 0.f};
#pragma unroll
                    for (int kk = 0; kk < 4; ++kk) { const bf16x8 kf = *(const LAS bf16x8*)(TK + (16 * sb + n) * 256 + (((4 * kk + g) ^ swzf(n)) << 4)); acc = MFMA16(kf, Qf[kk], acc); }
                    const f32x4 av4 = *(const LAS f32x4*)(sA + par * 64 + 16 * sb + 4 * g);
                    float pv[4];
#pragma unroll
                    for (int r = 0; r < 4; ++r) { float e = acc[r] * fast_exp2((av4[r] - Ml) * LOG2E); if (sb == lb && (4 * g + r > n)) e = 0.f; pv[r] = e; di += e; }
                    const unsigned u0 = cvt_pk_bf16(pv[0], pv[1]), u1 = cvt_pk_bf16(pv[2], pv[3]);
                    if ((sb & 1) == 0) { pk[sb >> 1].x = u0; pk[sb >> 1].y = u1; } else { pk[sb >> 1].z = u0; pk[sb >> 1].w = u1; }
                }
            }
            di += __shfl_xor(di, 16); di += __shfl_xor(di, 32);
            if (w == 0 && g == 0) sDi[16 * lb + n] = di;
            f32x4 numI = (f32x4){0.f, 0.f, 0.f, 0.f}, accI = (f32x4){0.f, 0.f, 0.f, 0.f};
            numI = MFMA16(__builtin_bit_cast(bf16x8, pk[0]), Vf[0], numI);
            if (lb >= 2) numI = MFMA16(__builtin_bit_cast(bf16x8, pk[1]), Vf[1], numI);
#pragma unroll
            for (int kd = 0; kd < 4; ++kd) { const s16x4 lo = *(const LAS s16x4*)(qrow + (((4 * kd + (g >> 1)) ^ swzf(n)) << 4) + 8 * (g & 1)), hi = *(const LAS s16x4*)(qrow + (((4 * kd + 2 + (g >> 1)) ^ swzf(n)) << 4) + 8 * (g & 1));
                accI = MFMA16(cat8(lo, hi), Cf[kd], accI); }
            const f32x4 in4 = *(const LAS f32x4*)(sInter + par * 64 + 16 * lb + 4 * g);
#pragma unroll
            for (int r = 0; r < 4; ++r) *(LAS float*)(lds + ML_HB + ((16 * lb + 4 * g + r) * ML_HP + e0 + n) * 4) = numI[r] + in4[r] * accI[r];
            asm volatile("" ::: "memory");
        }
        const u32x4 og0 = *(const u32x4*)(Z + (rowbase + 64 * c + nrow) * NZ + ZC_MLO + 128 * h + 16 * nseg), og1 = *(const u32x4*)(Z + (rowbase + 64 * c + nrow) * NZ + ZC_MLO + 128 * h + 16 * nseg + 8);
        bf16x8 Vw[2], Wf[2];
#pragma unroll
        for (int ks = 0; ks < 2; ++ks) {
            const f32x4 wl = *(const LAS f32x4*)(sW + par * 64 + 32 * ks + 4 * g), wh = *(const LAS f32x4*)(sW + par * 64 + 32 * ks + 16 + 4 * g);
            const u32x4 v4 = __builtin_bit_cast(u32x4, Vf[ks]);
            u32x4 pw; pw.x = cvt_pk_bf16(bf_lo(v4.x) * wl.x, bf_hi(v4.x) * wl.y); pw.y = cvt_pk_bf16(bf_lo(v4.y) * wl.z, bf_hi(v4.y) * wl.w); pw.z = cvt_pk_bf16(bf_lo(v4.z) * wh.x, bf_hi(v4.z) * wh.y); pw.w = cvt_pk_bf16(bf_lo(v4.w) * wh.z, bf_hi(v4.w) * wh.w);
            Vw[ks] = __builtin_bit_cast(bf16x8, pw);
            u32x4 pf; pf.x = cvt_pk_bf16(wl.x, wl.y); pf.y = cvt_pk_bf16(wl.z, wl.w); pf.z = cvt_pk_bf16(wh.x, wh.y); pf.w = cvt_pk_bf16(wh.z, wh.w);
            if (n != 0) pf = (u32x4){0u, 0u, 0u, 0u};
            Wf[ks] = __builtin_bit_cast(bf16x8, pf);
        }
        f32x4 cn = (f32x4){0.f, 0.f, 0.f, 0.f};
#pragma unroll
        for (int dt = 0; dt < 8; ++dt) {
            f32x4 cacc = Cacc[dt] * decay;
#pragma unroll
            for (int ks = 0; ks < 2; ++ks) { const LAS unsigned char* kp = TK + (32 * ks + 4 * g + q4) * 256 + (((2 * dt + (p4 >> 1)) ^ swzf(4 * g + q4)) << 4) + 8 * (p4 & 1);
                const bf16x8 kt = cat8(tr16(kp), tr16(kp + 16 * 256)); cacc = MFMA16(kt, Vw[ks], cacc); if (dt == w) cn = MFMA16(kt, Wf[ks], cn); }
            Cacc[dt] = cacc;
        }
        LDS_WAIT();
        __syncthreads();
        if (n == 0) {
#pragma unroll
            for (int r = 0; r < 4; ++r) sN[16 * w + 4 * g + r] = decay * sN[16 * w + 4 * g + r] + cn[r]; }
        {
            const LAS float* hp = (const LAS float*)(lds + ML_HB) + nrow * ML_HP + 16 * nseg;
            f32x4 hv[4]; float ss = 0.f;
#pragma unroll
            for (int i = 0; i < 4; ++i) { hv[i] = *(const LAS f32x4*)(hp + 4 * i); ss += (hv[i].x * hv[i].x + hv[i].y * hv[i].y) + (hv[i].z * hv[i].z + hv[i].w * hv[i].w); }
            ss += __shfl_xor(ss, 1); ss += __shfl_xor(ss, 2); ss += __shfl_xor(ss, 4);
            const float den = sDi[nrow] + sInter[par * 64 + nrow] * sQn[nrow];
            const float dn = fmaxf(fabsf(den), __expf(-sMt[par * 64 + nrow]));
            const float rstd = rsqrtf(ss * (1.0f / 128.0f) + EPS * dn * dn);
            const unsigned ogw[8] = {og0.x, og0.y, og0.z, og0.w, og1.x, og1.y, og1.z, og1.w};
            unsigned outw[8];
#pragma unroll
            for (int i = 0; i < 4; ++i) { const f32x4 gv = *(const f32x4*)(gml + 16 * nseg + 4 * i);
                const float o0 = bf_lo(ogw[2 * i]), o1 = bf_hi(ogw[2 * i]), o2 = bf_lo(ogw[2 * i + 1]), o3 = bf_hi(ogw[2 * i + 1]);
                const float y0 = hv[i].x * rstd * gv.x * fast_rcp(1.0f + __expf(-o0)), y1 = hv[i].y * rstd * gv.y * fast_rcp(1.0f + __expf(-o1));
                const float y2 = hv[i].z * rstd * gv.z * fast_rcp(1.0f + __expf(-o2)), y3 = hv[i].w * rstd * gv.w * fast_rcp(1.0f + __expf(-o3));
                outw[2 * i] = cvt_pk_bf16(y0, y1); outw[2 * i + 1] = cvt_pk_bf16(y2, y3); }
            bf16_t* op = CAT + (rowbase + 64 * c + nrow) * DM + 128 * h + 16 * nseg;
            *(u32x4*)op = (u32x4){outw[0], outw[1], outw[2], outw[3]}; *(u32x4*)(op + 8) = (u32x4){outw[4], outw[5], outw[6], outw[7]};
        }
        if (c + 1 < 32) ML_SCALARS(par ^ 1);
        VM_WAIT(); LDS_WAIT();
#if ML_TOUCH
        asm volatile("" :: "v"(touch));
        if (c + 4 < 32 && tid < 384) { const int tl_ = tid >> 7, r_ = (tid & 127) >> 1, hf_ = tid & 1;
            const bf16_t* p_ = (tl_ == 2) ? (Z + (rowbase + 64 * (c + 4) + r_) * NZ + ZC_MLV + 128 * h + 64 * hf_) : (QKC + (rowbase + 64 * (c + 4) + r_) * DM + 512 * tl_ + 128 * h + 64 * hf_);
            touch = *(const volatile unsigned*)p_; }
#endif
        __syncthreads();
    }
#undef ML_DMA
#undef ML_GATES
#undef ML_SCALARS
}
#ifndef PROBE_HALF
#define PROBE_HALF 0
#endif
#ifndef Q_LPT
#define Q_LPT 0
#endif
#ifndef Q_PAIRED
#define Q_PAIRED 0
#endif
#if Q_PAIRED
#define QN_ATT 64
#else
#define QN_ATT 128
#endif
#ifndef ATT_MODE
#define ATT_MODE 0
#endif
#ifndef REPSUB
#define REPSUB 3
#endif
#ifndef PE_TOUCH
#define PE_TOUCH 0
#endif
#ifndef P7REP
#define P7REP 0
#endif
constexpr size_t WS_US = WS_END;
constexpr int PE_REP = 132;
constexpr int PE_RE = 0, PE_RG = 128 * PE_REP * 2;

__device__ __forceinline__ unsigned enc_f(float f) { const unsigned b = __float_as_uint(f); return b ^ ((unsigned)((int)b >> 31) | 0x80000000u); }
__device__ __forceinline__ float dec_f(unsigned e) { return __uint_as_float(e ^ ((~(unsigned)((int)e >> 31)) | 0x80000000u)); }
__device__ __forceinline__ unsigned umax3(unsigned a, unsigned b, unsigned c) { return max(max(a, b), c); }

#define CE_DESC(x, y) do { const unsigned hi_ = max((x), (y)), lo_ = min((x), (y)); (x) = hi_; (y) = lo_; } while (0)
__device__ __forceinline__ void sort16_desc(unsigned (&a)[16]) {
#pragma unroll
    for (int k = 2; k <= 16; k <<= 1)
#pragma unroll
        for (int j = k >> 1; j > 0; j >>= 1)
#pragma unroll
            for (int i = 0; i < 16; ++i) { const int l = i ^ j; if (l > i) { if ((i & k) == 0) CE_DESC(a[i], a[l]); else CE_DESC(a[l], a[i]); } }
}
__device__ __forceinline__ void bitonic_merge16_desc(unsigned (&a)[16]) {
#pragma unroll
    for (int j = 8; j > 0; j >>= 1)
#pragma unroll
        for (int i = 0; i < 16; ++i) { const int l = i ^ j; if (l > i) CE_DESC(a[i], a[l]); }
}
__device__ __forceinline__ void merge_top16(unsigned (&a)[16], const unsigned (&b)[16]) {
#pragma unroll
    for (int i = 0; i < 16; ++i) a[i] = max(a[i], b[15 - i]);
    bitonic_merge16_desc(a);
}
template <bool PAIR>
__device__ __forceinline__ void top16_of64(const unsigned (&key)[64], unsigned (&top)[16]) {
    unsigned q1[16], q2[16], q3[16];
#pragma unroll
    for (int i = 0; i < 16; ++i) { top[i] = key[i]; q1[i] = key[16 + i]; q2[i] = key[32 + i]; q3[i] = key[48 + i]; }
    sort16_desc(top); sort16_desc(q1); merge_top16(top, q1);
    sort16_desc(q2); sort16_desc(q3); merge_top16(q2, q3);
    merge_top16(top, q2);
    if (PAIR) {
        unsigned o[16];
#pragma unroll
        for (int i = 0; i < 16; ++i) o[i] = (unsigned)__shfl_xor((int)top[i], 32);
        merge_top16(top, o);
    }
}

__device__ __forceinline__ float gelu_exact(float v) { return 0.5f * v * (1.0f + erff(v * 0.70710678118654752f)); }
typedef __bf16 bf16x2_t __attribute__((ext_vector_type(2)));
__device__ __forceinline__ float dot2bf(unsigned a, unsigned b, float c) { return __builtin_amdgcn_fdot2_f32_bf16(__builtin_bit_cast(bf16x2_t, a), __builtin_bit_cast(bf16x2_t, b), c, false); }
__device__ __forceinline__ float dot8(const u32x4 a, const u32x4 b) { return dot2bf(a.x, b.x, dot2bf(a.y, b.y, dot2bf(a.z, b.z, dot2bf(a.w, b.w, 0.f)))); }
__device__ __forceinline__ float dpp_xor1(float v) { return __int_as_float(__builtin_amdgcn_update_dpp(0, __float_as_int(v), 0xB1, 0xF, 0xF, true)); }
__device__ __forceinline__ float dpp_xor2(float v) { return __int_as_float(__builtin_amdgcn_update_dpp(0, __float_as_int(v), 0x4E, 0xF, 0xF, true)); }
__device__ __forceinline__ float dpp_xor4(float v) { const int m = __builtin_amdgcn_update_dpp(0, __float_as_int(v), 0x141, 0xF, 0xF, true); return __int_as_float(__builtin_amdgcn_update_dpp(0, m, 0x1B, 0xF, 0xF, true)); }
__device__ __forceinline__ float reduce8x8(const float (&p)[8], const int j) {
    float r[4], q[2];
#pragma unroll
    for (int i = 0; i < 4; ++i) { const float keep = (j & 4) ? p[i + 4] : p[i], send = (j & 4) ? p[i] : p[i + 4]; r[i] = keep + __shfl_xor(send, 4); }
#pragma unroll
    for (int i = 0; i < 2; ++i) { const float keep = (j & 2) ? r[i + 2] : r[i], send = (j & 2) ? r[i] : r[i + 2]; q[i] = keep + __shfl_xor(send, 2); }
    const float keep = (j & 1) ? q[1] : q[0], send = (j & 1) ? q[0] : q[1];
    return keep + __shfl_xor(send, 1);
}

constexpr size_t WS_VS8 = WS_US + 16 * MiB, WS_SINV = WS_US + 32 * MiB;
__device__ __forceinline__ void peer_convert_rows(Frame& F, const int item) {
    const Args& A = *F.a;
    int lane_l = threadIdx.x & 63; asm volatile("" : "+v"(lane_l));
    const int lane = lane_l;
    float* SINV = (float*)(F.ws + WS_SINV);
    f32x4 gq[4];
    { const float* gp = A.in[I_GFFN] + 16 * lane; gq[0] = *(const f32x4*)gp; gq[1] = *(const f32x4*)(gp + 4); gq[2] = *(const f32x4*)(gp + 8); gq[3] = *(const f32x4*)(gp + 12); }
    for (int it0 = 64 * item + 4 * F.wave; it0 < 64 * item + 64; it0 += 32) {
        f32x4 v[4][4];
#pragma unroll
        for (int r = 0; r < 4; ++r) { const int it = it0 + r, tb = it >> 14, e = it & 16383;
            const float* src = (tb ? A.in[I_PV] : A.in[I_PU]) + (size_t)e * DM + 16 * lane;
#pragma unroll
            for (int q = 0; q < 4; ++q) v[r][q] = *(const f32x4*)(src + 4 * q); }
#pragma unroll
        for (int r = 0; r < 4; ++r) { const int it = it0 + r, tb = it >> 14, e = it & 16383;
            if (tb == 0) {
#pragma unroll
                for (int q = 0; q < 4; ++q) v[r][q] = v[r][q] * gq[q]; }
            float mx = 0.f;
#pragma unroll
            for (int q = 0; q < 4; ++q) mx = fmaxf(mx, fmaxf(fmaxf(fabsf(v[r][q].x), fabsf(v[r][q].y)), fmaxf(fabsf(v[r][q].z), fabsf(v[r][q].w))));
#pragma unroll
            for (int o = 1; o < 64; o <<= 1) mx = fmaxf(mx, __shfl_xor(mx, o));
            u32x4 o; unsigned ow[4]; float sinv;
            if (tb == 0) {
                const float sc = (mx > 0.f) ? 127.0f / mx : 0.f; sinv = mx * (1.0f / 127.0f);
#pragma unroll
                for (int q = 0; q < 4; ++q) { const int q0 = __float2int_rn(v[r][q].x * sc), q1 = __float2int_rn(v[r][q].y * sc), q2 = __float2int_rn(v[r][q].z * sc), q3 = __float2int_rn(v[r][q].w * sc);
                    ow[q] = (unsigned)(q0 & 255) | ((unsigned)(q1 & 255) << 8) | ((unsigned)(q2 & 255) << 16) | ((unsigned)(q3 & 255) << 24); }
            } else {
                int k = (mx > 0.f) ? (int)floorf(log2f(416.0f / mx)) : 0; k = k > 60 ? 60 : (k < -60 ? -60 : k);
                const float sc = exp2f((float)k); sinv = exp2f((float)-k);
#pragma unroll
                for (int q = 0; q < 4; ++q) { int wd = __builtin_amdgcn_cvt_pk_fp8_f32(v[r][q].x * sc, v[r][q].y * sc, 0, false); wd = __builtin_amdgcn_cvt_pk_fp8_f32(v[r][q].z * sc, v[r][q].w * sc, wd, true); ow[q] = (unsigned)wd; }
            }
            o.x = ow[0]; o.y = ow[1]; o.z = ow[2]; o.w = ow[3];
            unsigned char* dst = (unsigned char*)(F.ws + (tb ? WS_VS8 : WS_US)) + ((size_t)(lane >> 3) * 16384 + e) * 128 + 16 * (lane & 7);
            *(u32x4*)dst = o;
            if (lane == 0) SINV[tb * 16384 + e] = sinv;
        }
    }
}

template <bool DRY>
__device__ __forceinline__ void peer_tile(Frame& F, const int tile) {
    const Args& A = *F.a;
    const bf16_t* QP = (const bf16_t*)(F.ws + WS_BUFA); const bf16_t* XG = (const bf16_t*)(F.ws + WS_BUFB); bf16_t* XGW = (bf16_t*)(F.ws + WS_BUFB); const bf16_t* SK = (const bf16_t*)(F.ws + WS_SK);
    const float* rss2 = (const float*)(F.ctl + CW_RSS2);
    LAS unsigned short* RE = (LAS unsigned short*)(F.lds + PE_RE); LAS float* RG = (LAS float*)(F.lds + PE_RG);
    const int w = F.wave;
    {
        int lane = F.lane; asm volatile("" : "+v"(lane));
        const int tg = w & 3, hh = w >> 2, n = lane & 31, h2 = lane >> 5;
        const int tok = 32 * tg + n; const size_t trow = (size_t)tile * 128 + tok;
        for (int rrep = 0; rrep < ((P7REP & 1) ? 2 : 1); ++rrep)
        for (int hd = 4 * hh; hd < 4 * hh + 4; ++hd) {
            unsigned T2[2][16];
#pragma unroll
            for (int cc = 0; cc < 2; ++cc) {
                const int grp = 2 * hd + cc;
                bf16x8 Qf[4];
#pragma unroll
                for (int kk = 0; kk < 4; ++kk) Qf[kk] = *(const bf16x8*)(QP + trow * DM + 64 * grp + 16 * kk + 8 * h2);
                unsigned key[64];
                unsigned lowbase = 127u - 4u * (unsigned)h2; asm volatile("" : "+v"(lowbase));
#pragma unroll
                for (int kb = 0; kb < 4; ++kb) {
                    f32x16 S;
#pragma unroll
                    for (int e = 0; e < 16; ++e) S[e] = 0.f;
#pragma unroll
                    for (int kk = 0; kk < 4; ++kk) { const bf16x8 a = *(const bf16x8*)(SK + ((size_t)(grp * 128 + 32 * kb + n)) * 64 + 16 * kk + 8 * h2); S = __builtin_amdgcn_mfma_f32_32x32x16_bf16(a, Qf[kk], S, 0, 0, 0); }
#pragma unroll
                    for (int e = 0; e < 16; ++e) { const int idx0 = 32 * kb + (e & 3) + 8 * (e >> 2); key[16 * kb + e] = ((enc_f(S[e]) & ~127u) | lowbase) - (unsigned)idx0; }
                }
                top16_of64<true>(key, T2[cc]);
            }
            float va[16], vb[16];
#pragma unroll
            for (int i = 0; i < 16; ++i) { va[i] = dec_f(T2[0][i] & ~127u); vb[i] = dec_f(T2[1][i] & ~127u); }
            unsigned ck[64];
#pragma unroll
            for (int i = 50; i < 64; ++i) ck[i] = 0u;
            {
                int q = 0;
#pragma unroll
                for (int i = 0; i < 16; ++i)
#pragma unroll
                    for (int j = 0; j < 16; ++j) if ((i + 1) * (j + 1) <= 16) { ck[q] = (enc_f(va[i] + vb[j]) & ~255u) | (unsigned)(255 - (16 * i + j)); ++q; }
            }
            unsigned best[16];
            top16_of64<false>(ck, best);
            const float v0 = dec_f(best[0] & ~255u);
            float gw[16], zs = 0.f;
#pragma unroll
            for (int k = 0; k < 16; ++k) { gw[k] = __expf(dec_f(best[k] & ~255u) - v0); zs += gw[k]; }
            const float zinv = 1.0f / zs;
#pragma unroll
            for (int k = 0; k < 16; ++k) {
                const unsigned code = 255u - (best[k] & 255u); const unsigned ci = code >> 4, cj = code & 15u;
                unsigned ia = 0, ib = 0;
#pragma unroll
                for (int i = 0; i < 16; ++i) { ia = (ci == (unsigned)i) ? (127u - (T2[0][i] & 127u)) : ia; ib = (cj == (unsigned)i) ? (127u - (T2[1][i] & 127u)) : ib; }
                if (h2 == (k >> 3)) { RE[tok * PE_REP + hd * 16 + k] = (unsigned short)(ia * 128u + ib); RG[tok * PE_REP + hd * 16 + k] = gw[k] * zinv; }
            }
        }
    }
    __syncthreads();
    {
        int lane = F.lane; asm volatile("" : "+v"(lane));
        const unsigned char* US = (const unsigned char*)(F.ws + WS_US); const unsigned char* VS = (const unsigned char*)(F.ws + WS_VS8); const float* SINV = (const float*)(F.ws + WS_SINV);
        const int j = lane & 7, gid = 8 * w + (lane >> 3);
        const int tA = gid, tB = 64 + gid; const size_t rowA = (size_t)tile * 128 + tA, rowB = (size_t)tile * 128 + tB;
        const LAS unsigned short* reA = RE + tA * PE_REP; const LAS unsigned short* reB = RE + tB * PE_REP;
        LAS float* cfA = RG + tA * PE_REP; LAS float* cfB = RG + tB * PE_REP;
        float accA[16], accB[16];
#pragma unroll
        for (int i = 0; i < 16; ++i) { accA[i] = 0.f; accB[i] = 0.f; }
#define PE_DEC16P(w4, f2) do { (f2)[0] = __builtin_amdgcn_cvt_pk_f32_fp8((int)(w4).x, false); (f2)[1] = __builtin_amdgcn_cvt_pk_f32_fp8((int)(w4).x, true); (f2)[2] = __builtin_amdgcn_cvt_pk_f32_fp8((int)(w4).y, false); (f2)[3] = __builtin_amdgcn_cvt_pk_f32_fp8((int)(w4).y, true); \
            (f2)[4] = __builtin_amdgcn_cvt_pk_f32_fp8((int)(w4).z, false); (f2)[5] = __builtin_amdgcn_cvt_pk_f32_fp8((int)(w4).z, true); (f2)[6] = __builtin_amdgcn_cvt_pk_f32_fp8((int)(w4).w, false); (f2)[7] = __builtin_amdgcn_cvt_pk_f32_fp8((int)(w4).w, true); } while (0)
#define PE_ISSUE(buf_, re_, kb_, base_) do { const u32x4 e4 = *(const LAS u32x4*)((re_) + 8 * (kb_)); const unsigned ew[4] = {e4.x, e4.y, e4.z, e4.w}; \
                _Pragma("unroll") for (int i = 0; i < 8; ++i) { const unsigned e0 = (i & 1) ? (ew[i >> 1] >> 16) : (ew[i >> 1] & 0xffffu); (buf_)[i] = *(const u32x4*)((base_) + (size_t)e0 * 128); } } while (0)
        float sxA, sxB, isxA, isxB;
        { float mA = 0.f, mB = 0.f;
#pragma unroll
          for (int s = 0; s < 8; ++s) { const u32x4 a0 = *(const u32x4*)(XG + rowA * DM + 128 * s + 16 * j), a1 = *(const u32x4*)(XG + rowA * DM + 128 * s + 16 * j + 8), b0 = *(const u32x4*)(XG + rowB * DM + 128 * s + 16 * j), b1 = *(const u32x4*)(XG + rowB * DM + 128 * s + 16 * j + 8);
              const unsigned aw[8] = {a0.x, a0.y, a0.z, a0.w, a1.x, a1.y, a1.z, a1.w}, bw[8] = {b0.x, b0.y, b0.z, b0.w, b1.x, b1.y, b1.z, b1.w};
#pragma unroll
              for (int i = 0; i < 8; ++i) { mA = fmaxf(mA, fmaxf(fabsf(bf_lo(aw[i])), fabsf(bf_hi(aw[i])))); mB = fmaxf(mB, fmaxf(fabsf(bf_lo(bw[i])), fabsf(bf_hi(bw[i])))); } }
          mA = fmaxf(mA, __shfl_xor(mA, 1)); mA = fmaxf(mA, __shfl_xor(mA, 2)); mA = fmaxf(mA, __shfl_xor(mA, 4));
          mB = fmaxf(mB, __shfl_xor(mB, 1)); mB = fmaxf(mB, __shfl_xor(mB, 2)); mB = fmaxf(mB, __shfl_xor(mB, 4));
          sxA = (mA > 0.f) ? 127.0f / mA : 0.f; sxB = (mB > 0.f) ? 127.0f / mB : 0.f; isxA = mA * (1.0f / 127.0f); isxB = mB * (1.0f / 127.0f); }
        u32x4 xra0 = *(const u32x4*)(XG + rowA * DM + 16 * j), xra1 = *(const u32x4*)(XG + rowA * DM + 16 * j + 8), xrb0 = *(const u32x4*)(XG + rowB * DM + 16 * j), xrb1 = *(const u32x4*)(XG + rowB * DM + 16 * j + 8);
        u32x4 bufA[8], bufB[8];
        PE_ISSUE(bufA, reA, 0, US + 16 * j);
#pragma unroll 1
        for (int s2 = 0; s2 < ((P7REP & 2) ? 16 : 8); ++s2) {
            const int s = s2 & 7;
            if (s2 == 8) {
#pragma unroll
                for (int i = 0; i < 16; ++i) { accA[i] = 0.f; accB[i] = 0.f; } }
            unsigned xa[4], xb[4];
            { const unsigned aw[8] = {xra0.x, xra0.y, xra0.z, xra0.w, xra1.x, xra1.y, xra1.z, xra1.w}, bw[8] = {xrb0.x, xrb0.y, xrb0.z, xrb0.w, xrb1.x, xrb1.y, xrb1.z, xrb1.w};
#pragma unroll
              for (int i = 0; i < 4; ++i) { const int a0_ = __float2int_rn(bf_lo(aw[2 * i]) * sxA), a1_ = __float2int_rn(bf_hi(aw[2 * i]) * sxA), a2_ = __float2int_rn(bf_lo(aw[2 * i + 1]) * sxA), a3_ = __float2int_rn(bf_hi(aw[2 * i + 1]) * sxA);
                  const int b0_ = __float2int_rn(bf_lo(bw[2 * i]) * sxB), b1_ = __float2int_rn(bf_hi(bw[2 * i]) * sxB), b2_ = __float2int_rn(bf_lo(bw[2 * i + 1]) * sxB), b3_ = __float2int_rn(bf_hi(bw[2 * i + 1]) * sxB);
                  xa[i] = (unsigned)(a0_ & 255) | ((unsigned)(a1_ & 255) << 8) | ((unsigned)(a2_ & 255) << 16) | ((unsigned)(a3_ & 255) << 24);
                  xb[i] = (unsigned)(b0_ & 255) | ((unsigned)(b1_ & 255) << 8) | ((unsigned)(b2_ & 255) << 16) | ((unsigned)(b3_ & 255) << 24); } }
            { const int sn = (s + 1) & 7;
              xra0 = *(const u32x4*)(XG + rowA * DM + 128 * sn + 16 * j); xra1 = *(const u32x4*)(XG + rowA * DM + 128 * sn + 16 * j + 8); xrb0 = *(const u32x4*)(XG + rowB * DM + 128 * sn + 16 * j); xrb1 = *(const u32x4*)(XG + rowB * DM + 128 * sn + 16 * j + 8); }
            const unsigned char* Us = US + (size_t)s * (16384 * 128) + 16 * j; const unsigned char* Usn = US + (size_t)((s + 1) & 7) * (16384 * 128) + 16 * j;
#if PE_TOUCH
            const unsigned tchu = *(const volatile unsigned*)(US + (size_t)((s + 1) & 7) * (16384 * 128) + ((size_t)(((blockIdx.x >> 3) & 31) * 512 + F.tid)) * 128);
#endif
#define PE_UCOMP(buf_, x_, acc_, kb_) do { float pp[8]; _Pragma("unroll") for (int i = 0; i < 8; ++i) { int d_ = __builtin_amdgcn_sdot4((int)(buf_)[i].x, (int)(x_)[0], 0, false); d_ = __builtin_amdgcn_sdot4((int)(buf_)[i].y, (int)(x_)[1], d_, false); d_ = __builtin_amdgcn_sdot4((int)(buf_)[i].z, (int)(x_)[2], d_, false); d_ = __builtin_amdgcn_sdot4((int)(buf_)[i].w, (int)(x_)[3], d_, false); pp[i] = (float)d_; } \
                (acc_)[kb_] += reduce8x8(pp, j); asm volatile("" : "+v"((acc_)[kb_]) :: "memory"); } while (0)
#pragma unroll
            for (int kb = 0; kb < 16; ++kb) {
                PE_ISSUE(bufB, reB, kb, Us);
                PE_UCOMP(bufA, xa, accA, kb);
                if (kb + 1 < 16) PE_ISSUE(bufA, reA, kb + 1, Us); else PE_ISSUE(bufA, reA, 0, Usn);
                PE_UCOMP(bufB, xb, accB, kb);
            }
#if PE_TOUCH
            asm volatile("" :: "v"(tchu));
#endif
        }
#undef PE_UCOMP
        {
            const float rsA = rsqrtf(rss2[rowA] * (1.0f / DM) + EPS), rsB = rsqrtf(rss2[rowB] * (1.0f / DM) + EPS);
#pragma unroll
            for (int kb = 0; kb < 16; ++kb) { const int eA = reA[8 * kb + j], eB = reB[8 * kb + j];
                cfA[8 * kb + j] = cfA[8 * kb + j] * gelu_exact(accA[kb] * (rsA * isxA) * SINV[eA]) * SINV[16384 + eA]; cfB[8 * kb + j] = cfB[8 * kb + j] * gelu_exact(accB[kb] * (rsB * isxB) * SINV[eB]) * SINV[16384 + eB]; }
        }
        LDS_WAIT();
        float ssA = 0.f, ssB = 0.f;
        float* xoA = A.out + rowA * DM + 16 * j; float* xoB = A.out + rowB * DM + 16 * j;
        PE_ISSUE(bufA, reA, 0, VS + 16 * j);
#pragma unroll 1
        for (int s2 = 0; s2 < ((P7REP & 4) ? 16 : 8); ++s2) {
            const int s = s2 & 7; const bool dry = (P7REP & 4) && s2 < 8;
            const unsigned char* Vs = VS + (size_t)s * (16384 * 128) + 16 * j; const unsigned char* Vsn = VS + (size_t)((s + 1) & 7) * (16384 * 128) + 16 * j;
#if PE_TOUCH
            const unsigned tchv = *(const volatile unsigned*)(VS + (size_t)((s + 1) & 7) * (16384 * 128) + ((size_t)(((blockIdx.x >> 3) & 31) * 512 + F.tid)) * 128);
#endif
            u32x2 x2a[4], x2b[4];
#pragma unroll
            for (int q = 0; q < 4; ++q) { x2a[q] = *(const u32x2*)(XG + rowA * DM + 128 * s + 16 * j + 4 * q); x2b[q] = *(const u32x2*)(XG + rowB * DM + 128 * s + 16 * j + 4 * q); }
            f32x2 oa[8], ob[8];
#pragma unroll
            for (int i = 0; i < 8; ++i) { oa[i] = (f32x2){0.f, 0.f}; ob[i] = (f32x2){0.f, 0.f}; }
#define PE_VCOMP(buf_, cf_, o_, kb_) do { const f32x4 c0_ = *(const LAS f32x4*)((cf_) + 8 * (kb_)), c1_ = *(const LAS f32x4*)((cf_) + 8 * (kb_) + 4); const float cw_[8] = {c0_.x, c0_.y, c0_.z, c0_.w, c1_.x, c1_.y, c1_.z, c1_.w}; \
                _Pragma("unroll") for (int i = 0; i < 8; ++i) { const f32x2 c2 = (f32x2){cw_[i], cw_[i]}; f32x2 f2[8]; PE_DEC16P((buf_)[i], f2); _Pragma("unroll") for (int q = 0; q < 8; ++q) (o_)[q] = __builtin_elementwise_fma(c2, f2[q], (o_)[q]); } \
                asm volatile("" : "+v"((o_)[0]), "+v"((o_)[1]), "+v"((o_)[2]), "+v"((o_)[3]), "+v"((o_)[4]), "+v"((o_)[5]), "+v"((o_)[6]), "+v"((o_)[7]) :: "memory"); } while (0)
#pragma unroll
            for (int kb = 0; kb < 16; ++kb) {
                PE_ISSUE(bufB, reB, kb, Vs);
                PE_VCOMP(bufA, cfA, oa, kb);
                if (kb + 1 < 16) PE_ISSUE(bufA, reA, kb + 1, Vs); else PE_ISSUE(bufA, reA, 0, Vsn);
                PE_VCOMP(bufB, cfB, ob, kb);
            }
#if PE_TOUCH
            asm volatile("" :: "v"(tchv));
#endif
#undef PE_VCOMP
#pragma unroll
            for (int q = 0; q < 4; ++q) {
                const u32x2 xa2 = x2a[q], xb2 = x2b[q];
                f32x4 a0 = (f32x4){bf_lo(xa2.x), bf_hi(xa2.x), bf_lo(xa2.y), bf_hi(xa2.y)}, b0 = (f32x4){bf_lo(xb2.x), bf_hi(xb2.x), bf_lo(xb2.y), bf_hi(xb2.y)};
                a0 = a0 + (f32x4){oa[2 * q].x, oa[2 * q].y, oa[2 * q + 1].x, oa[2 * q + 1].y}; b0 = b0 + (f32x4){ob[2 * q].x, ob[2 * q].y, ob[2 * q + 1].x, ob[2 * q + 1].y};
                if (!dry && !DRY) { ssA += (a0.x * a0.x + a0.y * a0.y) + (a0.z * a0.z + a0.w * a0.w); ssB += (b0.x * b0.x + b0.y * b0.y) + (b0.z * b0.z + b0.w * b0.w);
                u32x2 pa, pb; pa.x = cvt_pk_bf16(a0.x, a0.y); pa.y = cvt_pk_bf16(a0.z, a0.w); pb.x = cvt_pk_bf16(b0.x, b0.y); pb.y = cvt_pk_bf16(b0.z, b0.w);
                *(u32x2*)(XGW + rowA * DM + 128 * s + 16 * j + 4 * q) = pa; *(u32x2*)(XGW + rowB * DM + 128 * s + 16 * j + 4 * q) = pb; } }
        }
#undef PE_DEC16P
#undef PE_ISSUE
        ssA += __shfl_xor(ssA, 1); ssA += __shfl_xor(ssA, 2); ssA += __shfl_xor(ssA, 4);
        ssB += __shfl_xor(ssB, 1); ssB += __shfl_xor(ssB, 2); ssB += __shfl_xor(ssB, 4);
        const float rfA = rsqrtf(ssA * (1.0f / DM) + EPS), rfB = rsqrtf(ssB * (1.0f / DM) + EPS);
        VM_WAIT();
        __builtin_amdgcn_fence(__ATOMIC_ACQUIRE, "agent");
        VM_WAIT();
        const float* gfin = A.in[I_GFIN] + 16 * j;
#pragma unroll 2
        for (int s = 0; s < 8; ++s)
#pragma unroll
            for (int q = 0; q < 4; ++q) {
                const f32x4 g0 = *(const f32x4*)(gfin + 128 * s + 4 * q);
                const u32x2 xa2 = *(const u32x2*)(XGW + rowA * DM + 128 * s + 16 * j + 4 * q), xb2 = *(const u32x2*)(XGW + rowB * DM + 128 * s + 16 * j + 4 * q);
                const f32x4 a0 = (f32x4){bf_lo(xa2.x), bf_hi(xa2.x), bf_lo(xa2.y), bf_hi(xa2.y)}, b0 = (f32x4){bf_lo(xb2.x), bf_hi(xb2.x), bf_lo(xb2.y), bf_hi(xb2.y)};
                if (!DRY) { *(f32x4*)(xoA + 128 * s + 4 * q) = a0 * rfA * g0; *(f32x4*)(xoB + 128 * s + 4 * q) = b0 * rfB * g0; } else { asm volatile("" :: "v"(a0 * rfA * g0), "v"(b0 * rfB * g0)); } }
    }
    __syncthreads();
}

#ifndef USE_COOP_LAUNCH
#define USE_COOP_LAUNCH 1
#endif
#ifndef USE_CG_SYNC
#define USE_CG_SYNC 0
#endif
#ifndef DBG_SRC
#define DBG_SRC 0
#endif
#ifndef DBG_ZC
#define DBG_ZC 0
#endif
#ifndef DBG_C0
#define DBG_C0 0
#endif
#ifndef DBG_C1
#define DBG_C1 1024
#endif
__global__ void __launch_bounds__(512, 2) mk_fwd(Args args) {
    extern __shared__ __attribute__((aligned(16))) unsigned char lds_raw[];
    Frame F;
    F.lds = (LAS unsigned char*)lds_raw;
    F.tid = threadIdx.x; F.lane = F.tid & 63; F.wave = __builtin_amdgcn_readfirstlane(F.tid >> 6);
    F.G = gridDim.x; { const int bx = blockIdx.x; F.vcu = (F.G % 8 == 0) ? (bx % 8) * (F.G / 8) + bx / 8 : bx; }
    F.a = &args; F.ws = args.ws; F.ctl = (unsigned*)(args.ws + WS_CTL);
    const int lo = args.ph_lo, hi = args.ph_hi;
#if USE_CG_SYNC
    cg::grid_group grid = cg::this_grid();
#define GRID_BAR() grid.sync()
#else
    { volatile LAS unsigned* st0 = (volatile LAS unsigned*)(F.lds + MISC_OFF); if (F.tid < 8) st0[F.tid] = 0u; }
    __syncthreads();
    XcdBarrier xbar; xbar.bar = F.ctl + CW_BAR; xbar.x = 0; xbar.st = nullptr;
    if (hi - lo > 1) xbar = xcd_barrier_post(F.ctl + CW_BAR, (volatile LAS unsigned*)(F.lds + MISC_OFF));
#define GRID_BAR() xcd_barrier(xbar)
#endif
#define IN(k) (lo <= (k) && (k) < hi)
#ifndef PHMASK
#define PHMASK 0x1FF
#endif
#ifndef P2SUB
#define P2SUB 7
#endif
#define PHON(k) (((PHMASK) >> (k)) & 1)
#ifndef REPMASK
#define REPMASK 0
#endif
#define NREP(k) ((((REPMASK) >> (k)) & 1) ? 2 : 1)
#define PHASE_BEGIN() do { int t_ = threadIdx.x; asm volatile("" : "+v"(t_)); F.tid = t_; F.lane = t_ & 63; } while (0)
#define SEAM(k) do { if (IN(k) && IN((k) + 1)) GRID_BAR(); } while (0)
    unsigned char* ws = args.ws;
    const int bx = blockIdx.x;

    if (PHON(0) && IN(0)) { for (int rep = 0; rep < NREP(0); ++rep) { PHASE_BEGIN(); p0_prologue(F); } }
    SEAM(0);
    if (PHON(1) && IN(1)) for (int rep = 0; rep < NREP(1); ++rep) {
        PHASE_BEGIN();
        { pg8::Sched S{0, T_TOK / 256, NZ / 256, (T_TOK / 256) * (NZ / 256), F.G, bx, 1, (const char*)(ws + WS_BUFA), (const char*)(ws + WS_WIN), (char*)(ws + WS_Z), (size_t)256 * DM * 2, (size_t)256 * DM * 2, 0, 2};
          pg8::EpiBf16 E{NZ, 1.0f, nullptr, nullptr};
          pg8::gemm_phase(F.lds, DM, DM, DM, S, E); }
        { pg8::Sched S{0, TMEM / 256, 2048 / 256, (TMEM / 256) * (2048 / 256), F.G, bx, 1, (const char*)(ws + WS_MEMN), (const char*)(ws + WS_WKV), (char*)(ws + WS_KV), (size_t)256 * DM * 2, (size_t)256 * DM * 2, 0, 2};
          pg8::EpiBf16 E{2048, 1.0f, nullptr, nullptr};
          pg8::gemm_phase(F.lds, DM, DM, DM, S, E); }
    }
    SEAM(1);
    if (PHON(2) && IN(2)) for (int rep = 0; rep < NREP(2); ++rep) {
        PHASE_BEGIN();
        conv_prepass(F);
    }
    SEAM(2);
    if (PHON(3) && IN(3)) for (int rep = 0; rep < NREP(3); ++rep) {
        PHASE_BEGIN();
        float lam;
        { float s1 = 0.f, s2 = 0.f;
          for (int i = 0; i < 64; ++i) { s1 += args.in[I_LQ1][i] * args.in[I_LK1][i]; s2 += args.in[I_LQ2][i] * args.in[I_LK2][i]; }
          lam = __expf(s1) - __expf(s2) + 0.2f; }
        LAS int* qslot = (LAS int*)(F.lds + MISC_OFF + 16);
        int qx = bx & 7, tried = 0;
        for (;;) {
            if (F.tid == 0) *qslot = (int)atomicAdd(F.ctl + CW_Q2 + 64 * (qx + 8 * rep), 1u);
            __syncthreads();
            const int u = *qslot;
            __syncthreads();
            if (u >= 8 + QN_ATT + 64 + 64) { if (++tried == 8) break; qx = (qx + 1) & 7; continue; }
            const int submask = (rep + 1 < NREP(3)) ? (REPSUB) : (P2SUB);
            if (u < 8) { const int p = qx + 8 * u; if ((submask & 1) && !((rep + 1 < NREP(3)) && (PROBE_HALF & 1) && u >= 4)) mlstm_unit(F, p >> 2, p & 3); }
            else if (u >= 8 + QN_ATT + 64) { if (rep + 1 == NREP(3)) peer_convert_rows(F, qx + 8 * (u - (8 + QN_ATT + 64))); }
            else if (u >= 8 + QN_ATT) { if (rep + 1 == NREP(3)) {
                const int gi = qx + 8 * (u - (8 + QN_ATT));
                if (gi < 256) { pg8::Sched S{1, 0, 0, 256, 1 << 30, gi, 1, (const char*)(ws + WS_KV), (const char*)(ws + WS_WCQ), (char*)(ws + WS_MB), 0, 0, 0, 2};
                    pg8::EpiBf16 E{DM, 0.0625f, nullptr, args.in[I_GCA]};
                    pg8::gemm_phase(F.lds, 256, 2048, DM, S, E); }
                else { pg8::Sched S{2, 0, 0, 256, 1 << 30, gi - 256, 1, (const char*)(ws + WS_WCO), (const char*)(ws + WS_KV), (char*)(ws + WS_VWB), 0, 0, 0, 2};
                    pg8::EpiBf16 E{DM, 1.0f, nullptr, nullptr};
                    pg8::gemm_phase(F.lds, 256, DM, 2048, S, E); } } }
            else if ((submask & 2) && !((rep + 1 < NREP(3)) && (PROBE_HALF & 2) && ((u - 8) >> 4) >= 4)) { const int j = u - 8;
#if Q_PAIRED
                { const int p = qx + 8 * (j >> 3), g_ = j & 7;
#pragma unroll 1
                  for (int hf = 0; hf < 2; ++hf) { const int qt_ = hf ? g_ : 15 - g_;
                      if (rep + 1 < NREP(3)) attn_unit<ATT_MODE>(F, p >> 2, p & 3, qt_, lam); else attn_unit<0>(F, p >> 2, p & 3, qt_, lam); } }
#elif Q_LPT
                const int p = qx + 8 * (j & 7), qt_ = 15 - (j >> 3);
#else
                const int p = qx + 8 * (j >> 4), qt_ = 15 - (j & 15);
#endif
#if !Q_PAIRED
                if (rep + 1 < NREP(3)) attn_unit<ATT_MODE>(F, p >> 2, p & 3, qt_, lam); else attn_unit<0>(F, p >> 2, p & 3, qt_, lam);
#endif
            }
        }
    }
    SEAM(3);
    if (PHON(4) && IN(4)) for (int rep = 0; rep < NREP(4); ++rep) {
        PHASE_BEGIN();
        pg8::Sched S{0, T_TOK / 256, 4, (T_TOK / 256) * 4, F.G, bx, 1, (const char*)(ws + WS_BUFA), (const char*)(ws + WS_WOUT), nullptr, (size_t)256 * DM * 2, (size_t)256 * DM * 2, 0, 2};
        pg8::EpiResidB<false> E{args.in[I_X], (bf16_t*)(ws + WS_BUFB), (float*)(F.ctl + ((rep + 1 < NREP(4)) ? CW_DUMMY : CW_RSS1))};
        pg8::gemm_phase(F.lds, DM, DM, DM, S, E);
    }
    SEAM(4);
    if (PHON(5) && IN(5)) for (int rep = 0; rep < NREP(5); ++rep) {
        PHASE_BEGIN();
        pg8::Sched S{0, T_TOK / 256, 4, (T_TOK / 256) * 4, F.G, bx, 8, (const char*)(ws + WS_BUFB), (const char*)(ws + WS_MB), nullptr, (size_t)256 * DM * 2, (size_t)256 * DM * 2, (size_t)DM * DM * 2, 2};
        pg8::EpiSoftmax E{(const float*)(F.ctl + CW_RSS1), (bf16_t*)(ws + WS_BUFA)};
        pg8::gemm_phase(F.lds, DM, DM, DM, S, E);
    }
    SEAM(5);
    if (PHON(6) && IN(6)) {
        PHASE_BEGIN();
        pg8::Sched S{0, T_TOK / 256, 4, (T_TOK / 256) * 4, F.G, bx, 8, (const char*)(ws + WS_BUFA), (const char*)(ws + WS_VWB), nullptr, (size_t)256 * DM * 2, (size_t)256 * DM * 2, (size_t)DM * DM * 2, 2};
        pg8::EpiResidB<true> E{(const void*)(ws + WS_BUFB), (bf16_t*)(ws + WS_BUFB), (float*)(F.ctl + CW_RSS2)};
        pg8::gemm_phase(F.lds, DM, DM, DM, S, E);
    }
    SEAM(6);
    if (PHON(7) && IN(7)) for (int rep = 0; rep < NREP(7); ++rep) {
        PHASE_BEGIN();
        pg8::Sched S{0, T_TOK / 256, 4, (T_TOK / 256) * 4, F.G, bx, 1, (const char*)(ws + WS_BUFB), (const char*)(ws + WS_WPQ), (char*)(ws + WS_BUFA), (size_t)256 * DM * 2, (size_t)256 * DM * 2, 0, 2};
        pg8::EpiBf16 E{DM, 1.0f, (const float*)(F.ctl + CW_RSS2), nullptr};
        pg8::gemm_phase(F.lds, DM, DM, DM, S, E);
    }
    SEAM(7);
    if (PHON(8) && IN(8)) {
        PHASE_BEGIN();
        if (NREP(8) > 1) { for (int tile = bx; tile < T_TOK / 128; tile += F.G) peer_tile<true>(F, tile); }
        for (int tile = bx; tile < T_TOK / 128; tile += F.G) peer_tile<false>(F, tile);
    }
    if (lo <= 9 && 9 < hi) {
        const bf16_t* src = (const bf16_t*)(ws + (DBG_SRC ? WS_Z : WS_BUFA));
        for (size_t i = (size_t)bx * 512 + F.tid; i < (size_t)T_TOK * DM / 2; i += (size_t)F.G * 512) { const size_t row_ = (2 * i) >> 10, col_ = (2 * i) & 1023; const unsigned u = DBG_SRC ? *(const unsigned*)(src + row_ * NZ + DBG_ZC + col_) : ((const unsigned*)src)[i]; const int col = (int)((2 * i) & 1023); const bool on = (col >= DBG_C0 && col < DBG_C1); args.out[2 * i] = on ? bf_lo(u) : 0.f; args.out[2 * i + 1] = on ? bf_hi(u) : 0.f; }
    }
#undef IN
#undef SEAM
}

#ifndef MK_N_LAUNCHES
#define MK_N_LAUNCHES 1
#endif
extern "C" void kernel_launch(void* const* d_in, const int* in_sizes, int n_in, void* d_out, int out_size, void* d_ws, size_t ws_size, hipStream_t stream) {
    static int grid = 0;
    if (grid == 0) {
        if (n_in != 26 || out_size != T_TOK * DM || ws_size < WS_END + 34 * MiB) { fprintf(stderr, "kernel_launch: unexpected shapes (n_in %d out %d ws %zu)\n", n_in, out_size, ws_size); grid = -1; return; }
        int dev = 0, cus = 0, per_cu = 0;
        hipGetDevice(&dev); hipDeviceGetAttribute(&cus, hipDeviceAttributeMultiprocessorCount, dev);
        if (hipFuncSetAttribute((const void*)mk_fwd, hipFuncAttributeMaxDynamicSharedMemorySize, LDS_BYTES) != hipSuccess) { fprintf(stderr, "kernel_launch: hipFuncSetAttribute failed\n"); grid = -1; return; }
        if (hipOccupancyMaxActiveBlocksPerMultiprocessor(&per_cu, (const void*)mk_fwd, 512, LDS_BYTES) != hipSuccess || per_cu < 1) { fprintf(stderr, "kernel_launch: occupancy query says %d\n", per_cu); per_cu = 1; }
        (void)hipGetLastError();
        grid = cus;
    }
    if (grid < 0) return;
    hipMemsetAsync((char*)d_ws + WS_CTL, 0, CTL_BYTES, stream);
    Args a{};
    for (int i = 0; i < 26; ++i) a.in[i] = (const float*)d_in[i];
    a.out = (float*)d_out; a.ws = (unsigned char*)d_ws;
    if (MK_N_LAUNCHES == 1) {
        a.ph_lo = 0; a.ph_hi = 9;
        void* kargs[] = {&a};
#if USE_COOP_LAUNCH
        hipError_t e = hipLaunchCooperativeKernel((const void*)mk_fwd, dim3(grid), dim3(512), kargs, LDS_BYTES, stream);
        if (e != hipSuccess) fprintf(stderr, "cooperative launch failed: %s (grid %d)\n", hipGetErrorString(e), grid);
#else
        (void)kargs; hipLaunchKernelGGL(mk_fwd, dim3(grid), dim3(512), LDS_BYTES, stream, a);
#endif
    } else {
#ifndef DBG_STOP
#define DBG_STOP 9
#endif
#ifndef DBG_DUMP
#define DBG_DUMP 0
#endif
        for (int p = 0; p < DBG_STOP; ++p) { a.ph_lo = p; a.ph_hi = p + 1; hipLaunchKernelGGL(mk_fwd, dim3(grid), dim3(512), LDS_BYTES, stream, a); }
        if (DBG_DUMP) { a.ph_lo = 9; a.ph_hi = 10; hipLaunchKernelGGL(mk_fwd, dim3(grid), dim3(512), LDS_BYTES, stream, a); }
    }
}
```

```cpp
#include <hip/hip_runtime.h>
#include <hip/hip_cooperative_groups.h>
#include <cstdio>
#include <cstdint>
namespace cg = cooperative_groups;

#define GAS __attribute__((address_space(1)))
#define LAS __attribute__((address_space(3)))
typedef unsigned short bf16_t;
typedef short bf16x8 __attribute__((ext_vector_type(8)));
typedef short s16x4 __attribute__((ext_vector_type(4)));
typedef float f32x4 __attribute__((ext_vector_type(4)));
typedef float f32x2 __attribute__((ext_vector_type(2)));
typedef float f32x16 __attribute__((ext_vector_type(16)));
typedef unsigned u32x4 __attribute__((ext_vector_type(4)));
typedef unsigned u32x2 __attribute__((ext_vector_type(2)));

constexpr int T_TOK = 32768, DM = 1024, NB = 16, SEQ = 2048, NZ = 3584, INW = 3592, MEML = 256, TMEM = NB * MEML;
constexpr float EPS = 1e-6f;
constexpr float LOG2E = 1.4426950408889634f;
constexpr int ZC_MLQ = 0, ZC_MLK = 512, ZC_MLV = 1024, ZC_MLO = 1536, ZC_DAQ = 2048, ZC_DAK = 2560, ZC_DAV = 3072;

constexpr size_t MiB = 1u << 20;
constexpr size_t WS_CTL = 0, CTL_BYTES = 1 * MiB;
constexpr size_t WS_WIN = 1 * MiB, WS_WOUT = 8 * MiB, WS_WCQ = 10 * MiB, WS_WKV = 12 * MiB, WS_WCO = 16 * MiB, WS_WPQ = 18 * MiB, WS_SK = 20 * MiB;
constexpr size_t WS_GATES = 21 * MiB, WS_MEMN = 22 * MiB, WS_KV = 30 * MiB, WS_MB = 46 * MiB, WS_VWB = 78 * MiB;
constexpr size_t WS_BUFA = 110 * MiB, WS_BUFB = 174 * MiB, WS_Z = 238 * MiB, WS_END = 462 * MiB;
constexpr int CW_Q2 = 64;
constexpr int CW_RSS1 = 16384;
constexpr int CW_RSS2 = 65536;
constexpr int CW_BAR = 131072;
constexpr int CW_DUMMY = 180224;

constexpr int LDS_BYTES = 147456;
constexpr int XCH_OFF = 131072;
constexpr int MISC_OFF = LDS_BYTES - 256;

__device__ __forceinline__ unsigned cvt_pk_bf16(float lo, float hi) { unsigned r; asm("v_cvt_pk_bf16_f32 %0, %1, %2" : "=v"(r) : "v"(lo), "v"(hi)); return r; }
__device__ __forceinline__ float bf_lo(unsigned u) { return __uint_as_float(u << 16); }
__device__ __forceinline__ float bf_hi(unsigned u) { return __uint_as_float(u & 0xffff0000u); }
__device__ __forceinline__ float wave_sum(float v) {
#pragma unroll
    for (int o = 1; o < 64; o <<= 1) v += __shfl_xor(v, o);
    return v;
}
__device__ __forceinline__ float fast_exp2(float x) { return __builtin_amdgcn_exp2f(x); }
__device__ __forceinline__ float fast_rcp(float x) { return __builtin_amdgcn_rcpf(x); }
#define LDS_WAIT() asm volatile("s_waitcnt lgkmcnt(0)" ::: "memory")
#define VM_WAIT() asm volatile("s_waitcnt vmcnt(0)" ::: "memory")

namespace pg8 {
constexpr int BM = 256, BK = 64, HALF = 128, HTB = HALF * BK * 2, STAGE_BYTES = 8 * HTB;
__device__ __forceinline__ int lds_byte(int r, int c) { const int st = (r >> 4) * 2 + (c >> 5), rr = r & 15, cc = c & 31, ob = rr * 64 + cc * 2; return st * 1024 + (ob ^ (((ob >> 9) & 1) << 5)); }
__device__ __forceinline__ void stage_rc(int b, int& R, int& C) { const int st = b / 1024, sb = b % 1024, swz = sb ^ (((sb >> 9) & 1) << 5); R = (st >> 1) * 16 + swz / 64; C = (st & 1) * 32 + (swz % 64) / 2; }
__device__ __forceinline__ int perm32(int rho) { const int n = rho >> 4, i = rho & 15; return 8 * (i >> 2) + 4 * n + (i & 3); }

struct Unit { const char* A; const char* B; char* O; int row0, col0, scol; };

template <class Epi, class Sched>
__device__ __forceinline__ void gemm_phase(LAS unsigned char* lds, const int K, const int lda, const int ldb, const Sched& S, const Epi& E) {
    int tid_l = threadIdx.x; asm volatile("" : "+v"(tid_l));
    const int tid = tid_l, wid = __builtin_amdgcn_readfirstlane(tid >> 6), lane = tid & 63, wr = wid >> 2, wc = wid & 3, fr = lane & 15, fq = lane >> 4;
    const int nt = K / BK;
    unsigned voffA[2], voffB[2];
#pragma unroll
    for (int i = 0; i < 2; ++i) { int R, C; stage_rc(tid * 16 + i * 8192, R, C); const int Rb = Epi::PERM ? ((R & ~31) + perm32(R & 31)) : R;
        voffA[i] = (unsigned)(R * lda + C) * 2u; voffB[i] = (unsigned)(Rb * ldb + C) * 2u; }
    const size_t kstep = (size_t)(BK * 2);
    const size_t hstepA = (size_t)HALF * lda * 2, hstepB = (size_t)HALF * ldb * 2;
    const unsigned ldsw = (unsigned)wid * 1024u;
    const int aoff = lds_byte(wr * 64 + fr, fq * 8), boff = lds_byte(wc * 32 + fr, fq * 8);
#define PG8_SA(b, h) (((b) * 2 + (h)) * HTB)
#define PG8_SB(b, h) ((4 + (b) * 2 + (h)) * HTB)
#define PG8_STAGE(bufoff, gbase, voff) do { _Pragma("unroll") for (int _i = 0; _i < 2; ++_i) \
        __builtin_amdgcn_global_load_lds((const unsigned*)((const char*)(gbase) + (voff)[_i]), (LAS unsigned*)(lds + (bufoff) + ldsw + _i * 8192), 16, 0, 0); } while (0)
#define PG8_LDA(dst, b, h) do { _Pragma("unroll") for (int m = 0; m < 4; ++m) _Pragma("unroll") for (int k = 0; k < 2; ++k) dst[m][k] = *(const LAS bf16x8*)(lds + PG8_SA(b, h) + aoff + m * 2048 + k * 1024); } while (0)
#define PG8_LDB(dst, b, h) do { _Pragma("unroll") for (int n = 0; n < 2; ++n) _Pragma("unroll") for (int k = 0; k < 2; ++k) dst[n][k] = *(const LAS bf16x8*)(lds + PG8_SB(b, h) + boff + n * 2048 + k * 1024); } while (0)
#define PG8_MMA(ai, bj, At, Bt) do { __builtin_amdgcn_s_setprio(1); _Pragma("unroll") for (int m = 0; m < 4; ++m) _Pragma("unroll") for (int n = 0; n < 2; ++n) _Pragma("unroll") for (int k = 0; k < 2; ++k) \
        acc[ai][bj][m][n] = __builtin_amdgcn_mfma_f32_16x16x32_bf16(Bt[n][k], At[m][k], acc[ai][bj][m][n], 0, 0, 0); __builtin_amdgcn_s_setprio(0); } while (0)
#define PG8_WAIT_V(n) asm volatile("s_waitcnt vmcnt(" #n ")" ::: "memory")
#define PG8_WAIT_L(n) asm volatile("s_waitcnt lgkmcnt(" #n ")" ::: "memory")
#define PG8_BAR __builtin_amdgcn_s_barrier()
#define PG8_SCHED __builtin_amdgcn_sched_barrier(0)
    Unit cur, nxt; int ui = 0;
    if (!S.next(0, cur)) return;
    f32x4 acc[2][2][4][2];
#pragma unroll
    for (int a = 0; a < 2; ++a)
#pragma unroll
        for (int b = 0; b < 2; ++b)
#pragma unroll
            for (int m = 0; m < 4; ++m)
#pragma unroll
                for (int n = 0; n < 2; ++n) acc[a][b][m][n] = (f32x4){0.f, 0.f, 0.f, 0.f};
    bf16x8 At[4][2], B0[2][2], B1[2][2];
    const char* cA = cur.A; const char* cB = cur.B;
    PG8_STAGE(PG8_SB(0, 0), cB, voffB); PG8_STAGE(PG8_SA(0, 0), cA, voffA); PG8_STAGE(PG8_SB(0, 1), cB + hstepB, voffB); PG8_STAGE(PG8_SA(0, 1), cA + hstepA, voffA);
    if (wr == 1) PG8_BAR;
    PG8_WAIT_V(4); PG8_BAR;
    PG8_STAGE(PG8_SB(1, 0), cB + kstep, voffB); PG8_STAGE(PG8_SA(1, 0), cA + kstep, voffA); PG8_STAGE(PG8_SB(1, 1), cB + hstepB + kstep, voffB);
    PG8_WAIT_V(6); PG8_BAR;
    for (;;) {
        const bool has_next = S.next(ui + 1, nxt);
        const char* nA = has_next ? nxt.A : cA; const char* nB = has_next ? nxt.B : cB;
        for (int t = 0; t < nt; t += 2) {
            const bool last = (t == nt - 2);
            const char* a1 = cA + (size_t)(t + 1) * kstep;
            const char* a2 = last ? nA : cA + (size_t)(t + 2) * kstep; const char* b2 = last ? nB : cB + (size_t)(t + 2) * kstep;
            const char* a3 = a2 + kstep; const char* b3 = b2 + kstep;
            PG8_LDB(B0, 0, 0); PG8_SCHED; PG8_LDA(At, 0, 0); PG8_STAGE(PG8_SA(1, 1), a1 + hstepA, voffA);
            PG8_WAIT_L(8); PG8_BAR; PG8_WAIT_L(0); PG8_MMA(0, 0, At, B0); PG8_BAR; PG8_SCHED;
            PG8_LDB(B1, 0, 1); PG8_STAGE(PG8_SB(0, 0), b2, voffB);
            PG8_BAR; PG8_WAIT_L(0); PG8_MMA(0, 1, At, B1); PG8_BAR;
            PG8_LDA(At, 0, 1); PG8_STAGE(PG8_SA(0, 0), a2, voffA);
            PG8_BAR; PG8_WAIT_L(0); PG8_MMA(1, 0, At, B0); PG8_BAR; PG8_SCHED;
            PG8_STAGE(PG8_SB(0, 1), b2 + hstepB, voffB);
            PG8_WAIT_V(6); PG8_BAR; PG8_MMA(1, 1, At, B1); PG8_BAR;
            PG8_LDB(B0, 1, 0); PG8_SCHED; PG8_LDA(At, 1, 0); PG8_STAGE(PG8_SA(0, 1), a2 + hstepA, voffA);
            PG8_WAIT_L(8); PG8_BAR; PG8_WAIT_L(0); PG8_MMA(0, 0, At, B0); PG8_BAR; PG8_SCHED;
            PG8_LDB(B1, 1, 1); PG8_STAGE(PG8_SB(1, 0), b3, voffB);
            PG8_BAR; PG8_WAIT_L(0); PG8_MMA(0, 1, At, B1); PG8_BAR;
            PG8_LDA(At, 1, 1); PG8_STAGE(PG8_SA(1, 0), a3, voffA);
            PG8_BAR; PG8_WAIT_L(0); PG8_MMA(1, 0, At, B0); PG8_BAR; PG8_SCHED;
            PG8_STAGE(PG8_SB(1, 1), b3 + hstepB, voffB);
            PG8_WAIT_V(6); PG8_BAR; PG8_MMA(1, 1, At, B1); PG8_BAR;
        }
        E(acc, cur, wr, wc, fr, fq, lds);
        if (!has_next) break;
#pragma unroll
        for (int a = 0; a < 2; ++a)
#pragma unroll
            for (int b = 0; b < 2; ++b)
#pragma unroll
                for (int m = 0; m < 4; ++m)
#pragma unroll
                    for (int n = 0; n < 2; ++n) acc[a][b][m][n] = (f32x4){0.f, 0.f, 0.f, 0.f};
        cur = nxt; cA = nA; cB = nB; ++ui;
    }
    PG8_WAIT_V(0);
    if (wr == 0) PG8_BAR;
    PG8_BAR;
#undef PG8_SA
#undef PG8_SB
#undef PG8_STAGE
#undef PG8_LDA
#undef PG8_LDB
#undef PG8_MMA
#undef PG8_WAIT_V
#undef PG8_WAIT_L
#undef PG8_BAR
#undef PG8_SCHED
}

struct Sched {
    int mode, nM, nN, nwg, G, c, tpb; const char* baseA; const char* baseB; char* baseO; size_t strideA, strideB, bstrideB; int ldo_bytes_per_el;
    __device__ __forceinline__ bool next(int i, Unit& u) const {
        const long L = (long)i * G + c; if (L >= nwg) return false;
        if (mode == 0) {
            int wgid = (int)L; { const int q = nwg / 8, r = nwg % 8, xcd = wgid % 8, off = wgid / 8; wgid = (xcd < r ? xcd * (q + 1) : r * (q + 1) + (xcd - r) * q) + off; }
            const int nig = 8 * nN, gid = wgid / nig, fm = gid * 8, gsz = (nM - fm) < 8 ? (nM - fm) : 8;
            const int pm = fm + ((wgid % nig) % gsz), pn = (wgid % nig) / gsz;
            u.A = baseA + (size_t)pm * strideA; u.B = baseB + (size_t)pn * strideB + (size_t)(pm / tpb) * bstrideB; u.O = baseO; u.row0 = pm * 256; u.col0 = pn * 256; u.scol = pn * 256;
        } else if (mode == 1) {
            const int l = (int)L, b = l >> 4, h = (l >> 2) & 3, kt = l & 3;
            u.A = baseA + ((size_t)(b * 256) * 2048 + h * 256) * 2; u.B = baseB + ((size_t)(kt * 256) * 1024 + h * 256) * 2;
            u.O = baseO + ((size_t)b * 1048576 + (size_t)(h * 256) * 1024 + kt * 256) * 2; u.row0 = 0; u.col0 = 0; u.scol = kt * 256;
        } else {
            const int l = (int)L, b = l >> 4, h = (l >> 2) & 3, ntile = l & 3;
            u.A = baseA + ((size_t)(ntile * 256) * 1024 + h * 256) * 2; u.B = baseB + ((size_t)(b * 256) * 2048 + 1024 + h * 256) * 2;
            u.O = baseO + ((size_t)b * 1048576 + (size_t)(ntile * 256) * 1024 + h * 256) * 2; u.row0 = 0; u.col0 = 0; u.scol = 0;
        }
        return true;
    }
};

struct EpiBf16 {
    static constexpr bool PERM = true;
    int ldc; float scale; const float* rss; const float* colscale;
    __device__ __forceinline__ void operator()(const f32x4 (&acc)[2][2][4][2], const Unit& u, int wr, int wc, int fr, int fq, LAS unsigned char*) const {
        bf16_t* base = (bf16_t*)u.O;
        f32x4 cs[2][2];
#pragma unroll
        for (int bj = 0; bj < 2; ++bj)
#pragma unroll
            for (int n = 0; n < 2; ++n) cs[bj][n] = colscale ? *(const f32x4*)(colscale + u.scol + wc * 32 + 8 * fq + bj * HALF + 4 * n) : (f32x4){1.f, 1.f, 1.f, 1.f};
#pragma unroll
        for (int ai = 0; ai < 2; ++ai)
#pragma unroll
            for (int m = 0; m < 4; ++m) {
                const int row = u.row0 + ai * HALF + wr * 64 + m * 16 + fr;
                float sc = scale; if (rss) sc *= rsqrtf(rss[row] * (1.0f / 1024.0f) + EPS);
                bf16_t* rowp = base + (size_t)row * ldc + u.col0 + wc * 32 + 8 * fq;
#pragma unroll
                for (int bj = 0; bj < 2; ++bj) { const f32x4 v0 = acc[ai][bj][m][0] * sc * cs[bj][0], v1 = acc[ai][bj][m][1] * sc * cs[bj][1];
                    u32x4 w; w.x = cvt_pk_bf16(v0[0], v0[1]); w.y = cvt_pk_bf16(v0[2], v0[3]); w.z = cvt_pk_bf16(v1[0], v1[1]); w.w = cvt_pk_bf16(v1[2], v1[3]);
                    *(u32x4*)(rowp + bj * HALF) = w; } }
    }
};
struct EpiResid {
    static constexpr bool PERM = false;
    const float* base; float* out; bf16_t* xg; const float* g; float* rss;
    __device__ __forceinline__ void operator()(const f32x4 (&acc)[2][2][4][2], const Unit& u, int wr, int wc, int fr, int fq, LAS unsigned char*) const {
        const int colb = u.col0 + wc * 32 + 4 * fq;
#pragma unroll
        for (int ai = 0; ai < 2; ++ai)
#pragma unroll
            for (int m = 0; m < 4; ++m) {
                const int row = u.row0 + ai * HALF + wr * 64 + m * 16 + fr; const size_t off = (size_t)row * DM + colb; float ss = 0.f;
#pragma unroll
                for (int bj = 0; bj < 2; ++bj)
#pragma unroll
                    for (int n = 0; n < 2; ++n) { const int co = bj * HALF + n * 16;
                        const f32x4 bs = *(const f32x4*)(base + off + co); const f32x4 v = bs + acc[ai][bj][m][n];
                        *(f32x4*)(out + off + co) = v; const f32x4 gv = *(const f32x4*)(g + colb + co); const f32x4 w = v * gv;
                        u32x2 pk; pk.x = cvt_pk_bf16(w[0], w[1]); pk.y = cvt_pk_bf16(w[2], w[3]); *(u32x2*)(xg + off + co) = pk;
                        ss += (v[0] * v[0] + v[1] * v[1]) + (v[2] * v[2] + v[3] * v[3]); }
                ss += __shfl_xor(ss, 16); ss += __shfl_xor(ss, 32);
                if (fq == 0) atomicAdd(rss + row, ss);
                asm volatile("" ::: "memory"); }
    }
};
template <bool BASE_BF16>
struct EpiResidB {
    static constexpr bool PERM = false;
    const void* base; bf16_t* out; float* rss;
    __device__ __forceinline__ void operator()(const f32x4 (&acc)[2][2][4][2], const Unit& u, int wr, int wc, int fr, int fq, LAS unsigned char*) const {
        const int colb = u.col0 + wc * 32 + 4 * fq;
#pragma unroll
        for (int ai = 0; ai < 2; ++ai)
#pragma unroll
            for (int m = 0; m < 4; ++m) {
                const int row = u.row0 + ai * HALF + wr * 64 + m * 16 + fr; const size_t off = (size_t)row * DM + colb; float ss = 0.f;
                f32x4 bs[2][2];
#pragma unroll
                for (int bj = 0; bj < 2; ++bj)
#pragma unroll
                    for (int n = 0; n < 2; ++n) { const int co = bj * HALF + n * 16;
                        if (BASE_BF16) { const u32x2 b2 = *(const u32x2*)((const bf16_t*)base + off + co); bs[bj][n] = (f32x4){bf_lo(b2.x), bf_hi(b2.x), bf_lo(b2.y), bf_hi(b2.y)}; }
                        else bs[bj][n] = *(const f32x4*)((const float*)base + off + co); }
#pragma unroll
                for (int bj = 0; bj < 2; ++bj)
#pragma unroll
                    for (int n = 0; n < 2; ++n) { const int co = bj * HALF + n * 16; const f32x4 v = bs[bj][n] + acc[ai][bj][m][n];
                        u32x2 pk; pk.x = cvt_pk_bf16(v[0], v[1]); pk.y = cvt_pk_bf16(v[2], v[3]); *(u32x2*)(out + off + co) = pk;
                        ss += (v[0] * v[0] + v[1] * v[1]) + (v[2] * v[2] + v[3] * v[3]); }
                ss += __shfl_xor(ss, 16); ss += __shfl_xor(ss, 32);
                if (fq == 0) atomicAdd(rss + row, ss);
                if (m & 1) asm volatile("" ::: "memory"); }
    }
};
struct EpiSoftmax {
    static constexpr bool PERM = true;
    const float* rss; bf16_t* P;
    __device__ __forceinline__ void operator()(f32x4 (&acc)[2][2][4][2], const Unit& u, int wr, int wc, int fr, int fq, LAS unsigned char* lds) const {
        LAS f32x2* X = (LAS f32x2*)(lds + XCH_OFF);
        float ml[2][4];
#pragma unroll
        for (int ai = 0; ai < 2; ++ai)
#pragma unroll
            for (int m = 0; m < 4; ++m) {
                const int r = ai * HALF + wr * 64 + m * 16 + fr;
                const float sc = rsqrtf(rss[u.row0 + r] * (1.0f / 1024.0f) + EPS) * LOG2E;
                float mx = -3.0e38f;
#pragma unroll
                for (int bj = 0; bj < 2; ++bj)
#pragma unroll
                    for (int n = 0; n < 2; ++n) { f32x4 v = acc[ai][bj][m][n] * sc; acc[ai][bj][m][n] = v; mx = fmaxf(mx, fmaxf(fmaxf(v[0], v[1]), fmaxf(v[2], v[3]))); }
                mx = fmaxf(mx, __shfl_xor(mx, 16)); mx = fmaxf(mx, __shfl_xor(mx, 32));
                float sm = 0.f;
#pragma unroll
                for (int bj = 0; bj < 2; ++bj)
#pragma unroll
                    for (int n = 0; n < 2; ++n) { f32x4 v = acc[ai][bj][m][n]; v[0] = fast_exp2(v[0] - mx); v[1] = fast_exp2(v[1] - mx); v[2] = fast_exp2(v[2] - mx); v[3] = fast_exp2(v[3] - mx);
                        acc[ai][bj][m][n] = v; sm += (v[0] + v[1]) + (v[2] + v[3]); }
                sm += __shfl_xor(sm, 16); sm += __shfl_xor(sm, 32);
                ml[ai][m] = mx;
                if (fq == 0) X[r * 4 + wc] = (f32x2){mx, sm};
            }
        LDS_WAIT(); __builtin_amdgcn_s_barrier(); asm volatile("" ::: "memory");
#pragma unroll
        for (int ai = 0; ai < 2; ++ai)
#pragma unroll
            for (int m = 0; m < 4; ++m) {
                const int r = ai * HALF + wr * 64 + m * 16 + fr;
                const f32x2 a = X[r * 4 + 0], b = X[r * 4 + 1], c = X[r * 4 + 2], d = X[r * 4 + 3];
                const float mg = fmaxf(fmaxf(a.x, b.x), fmaxf(c.x, d.x));
                const float lg = a.y * fast_exp2(a.x - mg) + b.y * fast_exp2(b.x - mg) + c.y * fast_exp2(c.x - mg) + d.y * fast_exp2(d.x - mg);
                const float f = fast_exp2(ml[ai][m] - mg) / lg;
                bf16_t* rowp = P + (size_t)(u.row0 + r) * DM + u.col0 + wc * 32 + 8 * fq;
#pragma unroll
                for (int bj = 0; bj < 2; ++bj) { const f32x4 v0 = acc[ai][bj][m][0] * f, v1 = acc[ai][bj][m][1] * f;
                    u32x4 w; w.x = cvt_pk_bf16(v0[0], v0[1]); w.y = cvt_pk_bf16(v0[2], v0[3]); w.z = cvt_pk_bf16(v1[0], v1[1]); w.w = cvt_pk_bf16(v1[2], v1[3]);
                    *(u32x4*)(rowp + bj * HALF) = w; } }
        LDS_WAIT();
    }
};
}
struct Args { const float* in[26]; float* out; unsigned char* ws; int ph_lo, ph_hi; };
enum { I_X = 0, I_MEM, I_GMIX, I_WIN, I_CONVW, I_BI, I_BF, I_GML, I_LQ1, I_LK1, I_LQ2, I_LK2, I_GDA, I_WOUT, I_GCA, I_GMEM, I_WCQ, I_WCK, I_WCV, I_WCO, I_GFFN, I_WPQ, I_SUBK, I_PU, I_PV, I_GFIN };

struct Frame {
    LAS unsigned char* lds;
    int tid, lane, wave, G, vcu;
    const Args* a;
    unsigned char* ws;
    unsigned* ctl;
};


#define XB_TMO      128
#define XB_XCNT(j)  (256  + 64 * (j))
#define XB_XSUB(j)  (1280 + 64 * (j))
#define XB_XGEN(j)  (2304 + 64 * (j))
#define XB_TOP      3328
#define XB_TOPGEN   3392
#define XCD_BAR_WORDS 3456
#define XB_SPIN_CAP (1u << 18)
__device__ __forceinline__ unsigned xb_ld(unsigned* p)              { return __hip_atomic_load(p, __ATOMIC_RELAXED, __HIP_MEMORY_SCOPE_AGENT); }
__device__ __forceinline__ unsigned xb_add(unsigned* p, unsigned v) { return __hip_atomic_fetch_add(p, v, __ATOMIC_RELAXED, __HIP_MEMORY_SCOPE_AGENT); }
__device__ __forceinline__ unsigned xb_xcc_id() { return (unsigned)__builtin_amdgcn_s_getreg((3 << 11) | 20) & 0xFu; }
#define XB_SPIN(cond, bar) do { unsigned _sp = 0; while (cond) { __builtin_amdgcn_s_sleep(1); \
    if ((++_sp & 255u) == 0u) { if (xb_ld(&(bar)[XB_TMO])) break; if (_sp > XB_SPIN_CAP) { atomicAdd(&(bar)[XB_TMO], 1u); break; } } } } while (0)
struct XcdBarrier { unsigned* bar; unsigned x; volatile LAS unsigned* st; };
__device__ __forceinline__ XcdBarrier xcd_barrier_post(unsigned* bar, volatile LAS unsigned* st) {
    XcdBarrier b; b.bar = bar; b.x = xb_xcc_id(); b.st = st;
    if (threadIdx.x == 0) (void)xb_add(&bar[XB_XCNT(b.x)], 1u);
    return b;
}
__device__ __forceinline__ void xcd_barrier_complete(unsigned* bar, unsigned x, unsigned& nloc, unsigned& nx) {
    const unsigned G = gridDim.x * gridDim.y * gridDim.z;
    unsigned sum, cnt, mine, sp = 0u;
    for (;;) {
        sum = 0u; cnt = 0u; mine = 0u;
#pragma unroll
        for (unsigned j = 0; j < 16; ++j) { const unsigned c = xb_ld(&bar[XB_XCNT(j)]); sum += c; cnt += (c > 0u) ? 1u : 0u; mine = (j == x) ? c : mine; }
        if (sum == G) break;
        __builtin_amdgcn_s_sleep(1);
        if ((++sp & 255u) == 0u) { if (xb_ld(&bar[XB_TMO])) break; if (sp > XB_SPIN_CAP) { atomicAdd(&bar[XB_TMO], 1u); break; } }
    }
    nloc = mine > 0u ? mine : 1u; nx = cnt > 0u ? cnt : 1u;
}
__device__ __forceinline__ void xcd_barrier(const XcdBarrier& b) {
    asm volatile("s_waitcnt vmcnt(0)" ::: "memory");
    __syncthreads();
    if (threadIdx.x == 0) {
        unsigned* bar = b.bar;
        __builtin_amdgcn_s_waitcnt(0);
        unsigned nloc = b.st[0], nx = b.st[1];
        if (nloc == 0u) { xcd_barrier_complete(bar, b.x, nloc, nx); b.st[0] = nloc; b.st[1] = nx; }
        const unsigned old = xb_add(&bar[XB_XSUB(b.x)], 1u);
        const unsigned gen = old / nloc;
        if (old + 1u == (gen + 1u) * nloc) {
            __builtin_amdgcn_fence(__ATOMIC_RELEASE, "agent");
            asm volatile("s_waitcnt vmcnt(0)" ::: "memory");
            const unsigned og = xb_add(&bar[XB_TOP], 1u);
            const unsigned tg = og / nx;
            if (og + 1u == (tg + 1u) * nx) xb_add(&bar[XB_TOPGEN], 1u);
            else XB_SPIN(xb_ld(&bar[XB_TOPGEN]) == tg, bar);
            __builtin_amdgcn_fence(__ATOMIC_ACQUIRE, "agent");
            xb_add(&bar[XB_XGEN(b.x)], 1u);
            asm volatile("s_waitcnt vmcnt(0)" ::: "memory");
        } else {
            XB_SPIN(xb_ld(&bar[XB_XGEN(b.x)]) == gen, bar);
            __builtin_amdgcn_fence(__ATOMIC_ACQUIRE, "agent");
            asm volatile("s_waitcnt vmcnt(0)" ::: "memory");
        }
    }
    __syncthreads();
}

__device__ __forceinline__ void p0_transpose_item(const float* W, int Nsrc, int K, int kb, int src_col0, bf16_t* WT, int dst_row0, LAS float* scr, int lane, const float* kscale = nullptr) {
    const int k0 = 64 * kb;
#pragma unroll 8
    for (int i = 0; i < 32; ++i) { const int kk = 2 * i + (lane >> 5); float wv = W[(size_t)(k0 + kk) * Nsrc + src_col0 + (lane & 31)]; if (kscale) wv *= kscale[k0 + kk]; scr[kk * 33 + (lane & 31)] = wv; }
    LDS_WAIT(); asm volatile("" ::: "memory");
    const int c = lane & 7;
#pragma unroll
    for (int j = 0; j < 4; ++j) { const int n = (lane >> 3) + 8 * j; const LAS float* s = scr + (8 * c) * 33 + n;
        u32x4 o; o.x = cvt_pk_bf16(s[0 * 33], s[1 * 33]); o.y = cvt_pk_bf16(s[2 * 33], s[3 * 33]); o.z = cvt_pk_bf16(s[4 * 33], s[5 * 33]); o.w = cvt_pk_bf16(s[6 * 33], s[7 * 33]);
        *(u32x4*)(WT + (size_t)(dst_row0 + n) * K + k0 + 8 * c) = o; }
    LDS_WAIT(); asm volatile("" ::: "memory");
}
__device__ __forceinline__ void rms_row_to_bf16(const float* xrow, const float* g, bf16_t* orow, int lane, f32x4 (&v)[4]) {
    const f32x4* xr = (const f32x4*)xrow + lane; float s = 0.f;
#pragma unroll
    for (int j = 0; j < 4; ++j) { v[j] = xr[64 * j]; s += (v[j].x * v[j].x + v[j].y * v[j].y) + (v[j].z * v[j].z + v[j].w * v[j].w); }
    const float rstd = rsqrtf(wave_sum(s) * (1.f / DM) + EPS);
    u32x2* o8 = (u32x2*)orow + lane;
#pragma unroll
    for (int j = 0; j < 4; ++j) { const f32x4 gv = *((const f32x4*)g + lane + 64 * j); v[j] = v[j] * rstd * gv; u32x2 pk; pk.x = cvt_pk_bf16(v[j].x, v[j].y); pk.y = cvt_pk_bf16(v[j].z, v[j].w); o8[64 * j] = pk; }
}

__device__ __forceinline__ void p0_prologue(Frame& F) {
    const Args& A = *F.a;
    LAS float* scr = (LAS float*)(F.lds + F.wave * 8448);
    LAS float* sG = (LAS float*)(F.lds + 67584);
    for (int k = F.tid; k < DM; k += 512) { const f32x4 w0 = *(const f32x4*)(A.in[I_WIN] + (size_t)k * INW + 2048), w1 = *(const f32x4*)(A.in[I_WIN] + (size_t)k * INW + 2052);
        sG[0 * DM + k] = w0.x; sG[1 * DM + k] = w0.y; sG[2 * DM + k] = w0.z; sG[3 * DM + k] = w0.w; sG[4 * DM + k] = w1.x; sG[5 * DM + k] = w1.y; sG[6 * DM + k] = w1.z; sG[7 * DM + k] = w1.w; }
    __syncthreads();
    const int gw = F.vcu * 8 + F.wave, NGW = F.G * 8;
    constexpr int KB = DM / 64;
    constexpr int I_IN = KB * (NZ / 32), I_SQ = KB * (DM / 32);
    constexpr int NITEMS = I_IN + 5 * I_SQ;
    bf16_t* WinT = (bf16_t*)(F.ws + WS_WIN); bf16_t* WoutT = (bf16_t*)(F.ws + WS_WOUT); bf16_t* WkvT = (bf16_t*)(F.ws + WS_WKV); bf16_t* WcoT = (bf16_t*)(F.ws + WS_WCO); bf16_t* WpqT = (bf16_t*)(F.ws + WS_WPQ);
    for (int it = gw; it < NITEMS; it += NGW) {
        int r = it;
        if (r < I_IN) { const int kb = r / (NZ / 32), nb = r % (NZ / 32), n0 = nb * 32; p0_transpose_item(A.in[I_WIN], INW, DM, kb, n0 + (n0 >= 2048 ? 8 : 0), WinT, n0, scr, F.lane); continue; } r -= I_IN;
        const int which = r / I_SQ; r -= which * I_SQ; const int kb = r / (DM / 32), n0 = (r % (DM / 32)) * 32;
        if (which == 0) p0_transpose_item(A.in[I_WOUT], DM, DM, kb, n0, WoutT, n0, scr, F.lane);
        else if (which == 1) p0_transpose_item(A.in[I_WCK], DM, DM, kb, n0, WkvT, n0, scr, F.lane);
        else if (which == 2) p0_transpose_item(A.in[I_WCV], DM, DM, kb, n0, WkvT, DM + n0, scr, F.lane);
        else if (which == 3) p0_transpose_item(A.in[I_WCO], DM, DM, kb, n0, WcoT, n0, scr, F.lane);
        else p0_transpose_item(A.in[I_WPQ], DM, DM, kb, n0, WpqT, n0, scr, F.lane, A.in[I_GFFN]);
    }
    {
        const int gt = F.vcu * 512 + F.tid, NT = F.G * 512;
        const f32x4* s0 = (const f32x4*)A.in[I_WCQ]; u32x2* d0 = (u32x2*)(F.ws + WS_WCQ);
        for (int i = gt; i < DM * DM / 4; i += NT) { const f32x4 v = s0[i]; u32x2 pk; pk.x = cvt_pk_bf16(v.x, v.y); pk.y = cvt_pk_bf16(v.z, v.w); d0[i] = pk; }
        const f32x4* s1 = (const f32x4*)A.in[I_SUBK]; u32x2* d1 = (u32x2*)(F.ws + WS_SK);
        for (int i = gt; i < 16 * 128 * 64 / 4; i += NT) { const f32x4 v = s1[i]; u32x2 pk; pk.x = cvt_pk_bf16(v.x, v.y); pk.y = cvt_pk_bf16(v.z, v.w); d1[i] = pk; }
    }
    {
        bf16_t* HN = (bf16_t*)(F.ws + WS_BUFA); float* GT = (float*)(F.ws + WS_GATES);
        for (int m = gw; m < T_TOK; m += NGW) {
            f32x4 v[4]; rms_row_to_bf16(A.in[I_X] + (size_t)m * DM, A.in[I_GMIX], HN + (size_t)m * DM, F.lane, v);
            float gacc[8];
#pragma unroll
            for (int j = 0; j < 8; ++j) gacc[j] = 0.f;
#pragma unroll
            for (int jj = 0; jj < 4; ++jj)
#pragma unroll
                for (int j = 0; j < 8; ++j) { const f32x4 wv = *(const LAS f32x4*)(sG + j * DM + 4 * F.lane + 256 * jj); gacc[j] += (v[jj].x * wv.x + v[jj].y * wv.y) + (v[jj].z * wv.z + v[jj].w * wv.w); }
            float r4[4], r2[2], r1;
            { const bool hi = (F.lane & 32) != 0;
#pragma unroll
              for (int i = 0; i < 4; ++i) { const float keep = hi ? gacc[i + 4] : gacc[i], send = hi ? gacc[i] : gacc[i + 4]; r4[i] = keep + __shfl_xor(send, 32); } }
            { const bool hi = (F.lane & 16) != 0;
#pragma unroll
              for (int i = 0; i < 2; ++i) { const float keep = hi ? r4[i + 2] : r4[i], send = hi ? r4[i] : r4[i + 2]; r2[i] = keep + __shfl_xor(send, 16); } }
            { const bool hi = (F.lane & 8) != 0; const float keep = hi ? r2[1] : r2[0], send = hi ? r2[0] : r2[1]; r1 = keep + __shfl_xor(send, 8); }
            r1 += __shfl_xor(r1, 4); r1 += __shfl_xor(r1, 2); r1 += __shfl_xor(r1, 1);
            if ((F.lane & 7) == 0) GT[(size_t)m * 8 + 4 * (F.lane >> 5) + 2 * ((F.lane >> 4) & 1) + ((F.lane >> 3) & 1)] = r1;
        }
        bf16_t* MN = (bf16_t*)(F.ws + WS_MEMN);
        for (int m = gw; m < TMEM; m += NGW) { f32x4 v[4]; rms_row_to_bf16(A.in[I_MEM] + (size_t)m * DM, A.in[I_GMEM], MN + (size_t)m * DM, F.lane, v); }
    }
}
#ifndef AT_DEPTH
#define AT_DEPTH 3
#endif
constexpr int AT_STAGE = 32768, AT_NST = 4;
__device__ __forceinline__ int swzf(int r) { return ((r & 3) << 2) | ((r >> 2) & 3); }

__device__ __forceinline__ void glds16_asm(const void* gsrc, unsigned lds_dst) {
    unsigned keep;
    asm volatile("s_mov_b32 %0, m0\n\ts_mov_b32 m0, %2\n\ts_nop 0\n\tglobal_load_lds_dwordx4 %1, off\n\ts_mov_b32 m0, %0" : "=&s"(keep) : "v"(gsrc), "s"(lds_dst) : "memory");
}

__device__ __forceinline__ s16x4 tr16(const LAS unsigned char* p) { return __builtin_amdgcn_ds_read_tr16_b64_v4i16((LAS s16x4*)p); }
__device__ __forceinline__ bf16x8 cat8(s16x4 lo, s16x4 hi) { return __builtin_shufflevector(lo, hi, 0, 1, 2, 3, 4, 5, 6, 7); }

template <int MODE>
__device__ __forceinline__ void attn_unit(Frame& F, const int b, const int h, const int qt, const float lam) {
    const Args& A = *F.a;
    const bf16_t* Z = (const bf16_t*)(F.ws + WS_Z);
    bf16_t* CAT = (bf16_t*)(F.ws + WS_BUFA);
    LAS unsigned char* lds = F.lds;
    int tid_l = F.tid; asm volatile("" : "+v"(tid_l));
    const int tid = tid_l, lane = tid & 63, w = F.wave, c = w & 1, qb = w >> 1, n = lane & 31, h2 = lane >> 5;
    const int q0 = qt * 128, r0 = q0 + 32 * qb, ntiles = 2 * qt + 2;
    const size_t rowbase = (size_t)b * SEQ;
    const float slope2 = __uint_as_float((unsigned)(127 - 2 * (h + 1)) << 23) * LOG2E, c1 = 0.125f * LOG2E;
    const float slope_hi = __uint_as_float(__float_as_uint(slope2) & 0xffff0000u), slope_lo = slope2 - slope_hi;
    bf16x8 Qf[4];
    { const bf16_t* qp = Z + (rowbase + r0 + n) * NZ + ZC_DAQ + h * 128 + c * 64 + 8 * h2;
#pragma unroll
      for (int kk = 0; kk < 4; ++kk) { const u32x4 q4_ = *(const u32x4*)(qp + 16 * kk); u32x4 o_;
          o_.x = cvt_pk_bf16(bf_lo(q4_.x) * c1, bf_hi(q4_.x) * c1); o_.y = cvt_pk_bf16(bf_lo(q4_.y) * c1, bf_hi(q4_.y) * c1); o_.z = cvt_pk_bf16(bf_lo(q4_.z) * c1, bf_hi(q4_.z) * c1); o_.w = cvt_pk_bf16(bf_lo(q4_.w) * c1, bf_hi(q4_.w) * c1);
          Qf[kk] = __builtin_bit_cast(bf16x8, o_); } }
    bf16x8 Qx, Kx[2];
    { u32x4 o_ = (u32x4){0u, 0u, 0u, 0u}; if (h2 == 0) o_.x = cvt_pk_bf16(slope_hi, slope_lo); Qx = __builtin_bit_cast(bf16x8, o_);
#pragma unroll
      for (int kb = 0; kb < 2; ++kb) { u32x4 k_ = (u32x4){0u, 0u, 0u, 0u}; if (h2 == 0) k_.x = cvt_pk_bf16((float)(32 * kb + n), (float)(32 * kb + n)); Kx[kb] = __builtin_bit_cast(bf16x8, k_); } }
    f32x16 O[4];
#pragma unroll
    for (int i = 0; i < 4; ++i)
#pragma unroll
        for (int j = 0; j < 16; ++j) O[i][j] = 0.f;
    float mrun = -3.0e38f, lsum = 0.f;
    const unsigned ldsbase = (unsigned)(size_t)lds;
#define AT_DMA(j_) do { if (MODE & 2) break; const int jj_ = (j_) < ntiles ? (j_) : ntiles - 1; \
        _Pragma("unroll") for (int m_ = 0; m_ < 4; ++m_) { const int i_ = w + 8 * m_, r_ = 4 * (i_ & 15) + (lane >> 4), gch_ = (lane & 15) ^ swzf(r_); \
            const bf16_t* src_ = Z + (rowbase + 64 * jj_ + r_) * NZ + ((i_ >= 16) ? ZC_DAV : ZC_DAK) + h * 128 + 8 * gch_; \
            glds16_asm(src_, ldsbase + (unsigned)(((j_) & 3) * AT_STAGE + i_ * 1024)); } } while (0)
#if AT_DEPTH == 3
    AT_DMA(0); AT_DMA(1); AT_DMA(2);
    asm volatile("s_waitcnt vmcnt(4)" ::: "memory");
#else
    AT_DMA(0); AT_DMA(1);
    VM_WAIT();
#endif
    __syncthreads();
    const int i16 = lane & 15, q4 = i16 >> 2, p4 = i16 & 3, blk = (lane >> 4) & 1;
#define AT_QK(S_, j_) do { const LAS unsigned char* Ks_ = lds + ((j_) & 3) * AT_STAGE; bf16x8 kf_[8]; \
        _Pragma("unroll") for (int kb = 0; kb < 2; ++kb) _Pragma("unroll") for (int kk = 0; kk < 4; ++kk) kf_[4 * kb + kk] = *(const LAS bf16x8*)(Ks_ + (32 * kb + n) * 256 + (((8 * c + 2 * kk + h2) ^ swzf(n)) << 4)); \
        _Pragma("unroll") for (int e = 0; e < 16; ++e) { (S_)[0][e] = 0.f; (S_)[1][e] = 0.f; } \
        _Pragma("unroll") for (int kb = 0; kb < 2; ++kb) { _Pragma("unroll") for (int kk = 0; kk < 4; ++kk) (S_)[kb] = __builtin_amdgcn_mfma_f32_32x32x16_bf16(kf_[4 * kb + kk], Qf[kk], (S_)[kb], 0, 0, 0); \
            (S_)[kb] = __builtin_amdgcn_mfma_f32_32x32x16_bf16(Kx[kb], Qx, (S_)[kb], 0, 0, 0); } } while (0)
#define AT_LOADV(buf_, dvb_) do { _Pragma("unroll") for (int kb = 0; kb < 2; ++kb) _Pragma("unroll") for (int s = 0; s < 2; ++s) { const int ch_ = 4 * (dvb_) + 2 * blk + (p4 >> 1); \
        const LAS unsigned char* vp = Vs + (32 * kb + 16 * s + 4 * h2 + q4) * 256 + 8 * (p4 & 1); \
        (buf_)[2 * kb + s] = cat8(tr16(vp + ((ch_ ^ swzf(4 * h2 + q4)) << 4)), tr16(vp + 8 * 256 + ((ch_ ^ swzf(8 + 4 * h2 + q4)) << 4))); } } while (0)
#define AT_PV(buf_, dvb_) do { _Pragma("unroll") for (int e = 0; e < 16; ++e) O[dvb_][e] *= alpha; \
        _Pragma("unroll") for (int kb = 0; kb < 2; ++kb) _Pragma("unroll") for (int s = 0; s < 2; ++s) O[dvb_] = __builtin_amdgcn_mfma_f32_32x32x16_bf16((buf_)[2 * kb + s], Pf[kb][s], O[dvb_], 0, 0, 0); } while (0)
#define AT_TILE(Sc_, Sn_, j_) do { \
        AT_DMA((j_) + AT_DEPTH); \
        const int k0 = 64 * (j_); \
        if (!(MODE & 1) && k0 <= r0 + 31) { \
            const LAS unsigned char* Vs = lds + ((j_) & 3) * AT_STAGE + 16384; \
            bf16x8 va[4], vb[4]; \
            if ((j_) + 1 < ntiles && k0 + 64 <= r0 + 31) AT_QK(Sn_, (j_) + 1); \
            AT_LOADV(va, 0); \
            const float D0 = (float)(r0 + n - k0 - 4 * h2); \
            const float tcon = slope2 * (float)(k0 - r0 - n);            \
            float mloc = -3.0e38f; \
            if (k0 + 63 > r0) { \
                _Pragma("unroll") for (int kb = 0; kb < 2; ++kb) _Pragma("unroll") for (int e = 0; e < 16; ++e) { const float off = (float)(32 * kb + (e & 3) + 8 * (e >> 2)); \
                    const float v = (off > D0) ? -INFINITY : (Sc_)[kb][e]; (Sc_)[kb][e] = v; mloc = fmaxf(mloc, v); } \
            } else { \
                _Pragma("unroll") for (int kb = 0; kb < 2; ++kb) _Pragma("unroll") for (int e = 0; e < 16; ++e) mloc = fmaxf(mloc, (Sc_)[kb][e]); \
            } \
            mloc = fmaxf(mloc, __shfl_xor(mloc, 32)) + tcon; \
            const float mnew = fmaxf(mrun, mloc), alpha = fast_exp2(mrun - mnew); \
            mrun = mnew; \
            const float mm = mnew - tcon; \
            float ps = 0.f; \
            _Pragma("unroll") for (int kb = 0; kb < 2; ++kb) _Pragma("unroll") for (int e = 0; e < 16; ++e) { const float pv = fast_exp2((Sc_)[kb][e] - mm); (Sc_)[kb][e] = pv; ps += pv; } \
            lsum = lsum * alpha + ps; \
            bf16x8 Pf[2][2]; \
            _Pragma("unroll") for (int kb = 0; kb < 2; ++kb) _Pragma("unroll") for (int s = 0; s < 2; ++s) { u32x4 pk; pk.x = cvt_pk_bf16((Sc_)[kb][8 * s + 0], (Sc_)[kb][8 * s + 1]); pk.y = cvt_pk_bf16((Sc_)[kb][8 * s + 2], (Sc_)[kb][8 * s + 3]); \
                pk.z = cvt_pk_bf16((Sc_)[kb][8 * s + 4], (Sc_)[kb][8 * s + 5]); pk.w = cvt_pk_bf16((Sc_)[kb][8 * s + 6], (Sc_)[kb][8 * s + 7]); Pf[kb][s] = __builtin_bit_cast(bf16x8, pk); } \
            AT_LOADV(vb, 1); AT_PV(va, 0); \
            AT_LOADV(va, 2); AT_PV(vb, 1); \
            AT_LOADV(vb, 3); AT_PV(va, 2); \
            AT_PV(vb, 3); \
        } \
        if (AT_DEPTH == 3) asm volatile("s_waitcnt vmcnt(4)" ::: "memory"); else asm volatile("s_waitcnt vmcnt(0)" ::: "memory"); \
        __syncthreads(); } while (0)
    f32x16 SA[2], SB[2];
    AT_QK(SA, 0);
    for (int j = 0; j < ntiles; j += 2) { AT_TILE(SA, SB, j); AT_TILE(SB, SA, j + 1); }
#undef AT_TILE
#undef AT_PV
#undef AT_LOADV
#undef AT_QK
    VM_WAIT();
    __syncthreads();
    { const float lt = lsum + __shfl_xor(lsum, 32); const float inv = (c == 0 ? 1.0f : lam) / lt;
#pragma unroll
      for (int dvb = 0; dvb < 4; ++dvb)
#pragma unroll
          for (int e = 0; e < 16; ++e) O[dvb][e] *= inv; }
    LAS float* cb = (LAS float*)lds + qb * 4096;
    if (c == 1) {
#pragma unroll
        for (int dvb = 0; dvb < 4; ++dvb)
#pragma unroll
            for (int e = 0; e < 16; ++e) cb[(dvb * 16 + e) * 64 + lane] = O[dvb][e];
    }
    __syncthreads();
    if (c == 0 && MODE == 0) {
        float ss = 0.f;
#pragma unroll
        for (int dvb = 0; dvb < 4; ++dvb)
#pragma unroll
            for (int e = 0; e < 16; ++e) { const float o = O[dvb][e] - cb[(dvb * 16 + e) * 64 + lane]; O[dvb][e] = o; ss += o * o; }
        ss += __shfl_xor(ss, 32);
        const float rstd = rsqrtf(ss * (1.0f / 128.0f) + EPS) * 0.8f;
        const float* g = A.in[I_GDA] + h * 128;
        bf16_t* op = CAT + (rowbase + r0 + n) * DM + 512 + h * 128;
#pragma unroll
        for (int dvb = 0; dvb < 4; ++dvb)
#pragma unroll
            for (int e4 = 0; e4 < 4; ++e4) { const int dv = 32 * dvb + 8 * e4 + 4 * h2; const f32x4 gv = *(const f32x4*)(g + dv);
                u32x2 pk; pk.x = cvt_pk_bf16(O[dvb][4 * e4 + 0] * rstd * gv.x, O[dvb][4 * e4 + 1] * rstd * gv.y); pk.y = cvt_pk_bf16(O[dvb][4 * e4 + 2] * rstd * gv.z, O[dvb][4 * e4 + 3] * rstd * gv.w);
                *(u32x2*)(op + dv) = pk; }
    }
    __syncthreads();
#undef AT_DMA
}
__device__ __forceinline__ void conv_prepass(Frame& F) {
    const Args& A = *F.a;
    const bf16_t* Z = (const bf16_t*)(F.ws + WS_Z);
    bf16_t* QKC = (bf16_t*)(F.ws + WS_BUFB);
    const int gt = F.vcu * 512 + F.tid, NT = F.G * 512;
    for (int it = gt; it < (T_TOK / 4) * 128; it += NT) {
        const int cg = it & 127, rb = it >> 7, row0 = 4 * rb, tl = row0 & (SEQ - 1), c0 = 8 * cg;
        float cw[4][8];
#pragma unroll
        for (int tp = 0; tp < 4; ++tp) { const f32x4 w0 = *(const f32x4*)(A.in[I_CONVW] + tp * 1024 + c0), w1 = *(const f32x4*)(A.in[I_CONVW] + tp * 1024 + c0 + 4);
            cw[tp][0] = w0.x; cw[tp][1] = w0.y; cw[tp][2] = w0.z; cw[tp][3] = w0.w; cw[tp][4] = w1.x; cw[tp][5] = w1.y; cw[tp][6] = w1.z; cw[tp][7] = w1.w; }
        u32x4 raw[7];
#pragma unroll
        for (int i = 0; i < 7; ++i) raw[i] = (tl - 3 + i >= 0) ? *(const u32x4*)(Z + (size_t)(row0 - 3 + i) * NZ + c0) : (u32x4){0u, 0u, 0u, 0u};
        const float ksc = (c0 >= 512) ? 0.08838834764831845f : 1.0f;
#pragma unroll
        for (int r = 0; r < 4; ++r) {
            float y[8];
#pragma unroll
            for (int ch = 0; ch < 8; ++ch) y[ch] = 0.f;
#pragma unroll
            for (int tp = 0; tp < 4; ++tp) { const u32x4 rv = raw[r + tp];
                y[0] += cw[tp][0] * bf_lo(rv.x); y[1] += cw[tp][1] * bf_hi(rv.x); y[2] += cw[tp][2] * bf_lo(rv.y); y[3] += cw[tp][3] * bf_hi(rv.y);
                y[4] += cw[tp][4] * bf_lo(rv.z); y[5] += cw[tp][5] * bf_hi(rv.z); y[6] += cw[tp][6] * bf_lo(rv.w); y[7] += cw[tp][7] * bf_hi(rv.w); }
#pragma unroll
            for (int ch = 0; ch < 8; ++ch) y[ch] = y[ch] * fast_rcp(1.0f + __expf(-y[ch])) * ksc;
            u32x4 pk; pk.x = cvt_pk_bf16(y[0], y[1]); pk.y = cvt_pk_bf16(y[2], y[3]); pk.z = cvt_pk_bf16(y[4], y[5]); pk.w = cvt_pk_bf16(y[6], y[7]);
            *(u32x4*)(QKC + (size_t)(row0 + r) * DM + c0) = pk;
        }
    }
}

#ifndef ML_TOUCH
#define ML_TOUCH 0
#endif
constexpr int ML_TB = 49152;
constexpr int ML_HB = 2 * ML_TB;
constexpr int ML_HP = 132;
constexpr int ML_SC = ML_HB + 64 * ML_HP * 4;

#define MFMA16(a, b, c) __builtin_amdgcn_mfma_f32_16x16x32_bf16((a), (b), (c), 0, 0, 0)

__device__ __forceinline__ void mlstm_unit(Frame& F, const int b, const int h) {
    const Args& A = *F.a;
    const bf16_t* Z = (const bf16_t*)(F.ws + WS_Z);
    const bf16_t* QKC = (const bf16_t*)(F.ws + WS_BUFB);
    const float* GT = (const float*)(F.ws + WS_GATES);
    bf16_t* CAT = (bf16_t*)(F.ws + WS_BUFA);
    LAS unsigned char* lds = F.lds;
    int tid_l = F.tid; asm volatile("" : "+v"(tid_l));
    const int tid = tid_l, lane = tid & 63, w = F.wave, n = lane & 15, g = lane >> 4, q4 = n >> 2, p4 = n & 3;
    const size_t rowbase = (size_t)b * SEQ;
    LAS float* sc = (LAS float*)(lds + ML_SC);
    LAS float* sA = sc; LAS float* sM = sc + 128; LAS float* sInter = sc + 256; LAS float* sMt = sc + 384; LAS float* sW = sc + 512; LAS float* sDi = sc + 640; LAS float* sQn = sc + 704; LAS float* sN = sc + 768;
    if (tid < 128) sN[tid] = 0.f;
    const unsigned ldsbase = (unsigned)(size_t)lds;
    const float bi = A.in[I_BI][h], bfg = A.in[I_BF][h];
    float gi_r, gf_r;
#define ML_DMA(cc, par_) do { const int t0_ = 64 * (cc); \
        _Pragma("unroll") for (int m_ = 0; m_ < 6; ++m_) { const int i_ = w + 8 * m_, tile_ = i_ >> 4, r_ = 4 * (i_ & 15) + (lane >> 4), gch_ = (lane & 15) ^ swzf(r_); \
            const bf16_t* src_ = (tile_ == 2) ? (Z + (rowbase + t0_ + r_) * NZ + ZC_MLV + 128 * h + 8 * gch_) : (QKC + (rowbase + t0_ + r_) * DM + 512 * tile_ + 128 * h + 8 * gch_); \
            glds16_asm(src_, ldsbase + (unsigned)((par_) * ML_TB + i_ * 1024)); } } while (0)
#define ML_GATES(cc) do { gi_r = GT[(rowbase + 64 * (cc) + lane) * 8 + h]; gf_r = GT[(rowbase + 64 * (cc) + lane) * 8 + 4 + h]; } while (0)
    float m_st = 0.f, decay_c = 1.f;
#define ML_SCALARS(par_) do { \
        const float gi = gi_r + bi, gfv = gf_r + bfg; \
        const float lf = fminf(gfv, 0.f) - __logf(1.0f + __expf(-fabsf(gfv))); \
        float bc = lf; \
        _Pragma("unroll") for (int o = 1; o < 64; o <<= 1) { const float t_ = __shfl_up(bc, o); if (lane >= o) bc += t_; } \
        const float av = gi - bc; float pm = av; \
        _Pragma("unroll") for (int o = 1; o < 64; o <<= 1) { const float t_ = __shfl_up(pm, o); if (lane >= o) pm = fmaxf(pm, t_); } \
        const float Mv = fmaxf(m_st, pm), inter = __expf(m_st - Mv), mt = bc + Mv; \
        const float M63 = __shfl(Mv, 63), bc63 = __shfl(bc, 63); \
        const float wg = __expf(av - M63); \
        decay_c = __shfl(inter, 63); m_st = bc63 + M63; \
        if (w == 0) { sA[(par_) * 64 + lane] = av; sM[(par_) * 64 + lane] = Mv; sInter[(par_) * 64 + lane] = inter; sMt[(par_) * 64 + lane] = mt; sW[(par_) * 64 + lane] = wg; } \
    } while (0)

    f32x4 Cacc[8];
#pragma unroll
    for (int dt = 0; dt < 8; ++dt) Cacc[dt] = (f32x4){0.f, 0.f, 0.f, 0.f};
    ML_GATES(0);
    ML_DMA(0, 0);
    ML_SCALARS(0);
    VM_WAIT(); LDS_WAIT();
    __syncthreads();
    const float* gml = A.in[I_GML] + 128 * h;
    const int e0 = 16 * w;
    unsigned touch = 0u;
#pragma unroll 1
    for (int c = 0; c < 32; ++c) {
        const float decay = decay_c; const int par = c & 1;
        const LAS unsigned char* TQ = lds + par * ML_TB; const LAS unsigned char* TK = TQ + 16384; const LAS unsigned char* TV = TQ + 32768;
        if (c + 1 < 32) { ML_DMA(c + 1, par ^ 1); ML_GATES(c + 1); }
        const int nrow = tid >> 3, nseg = tid & 7;
        { const int rr = 8 * w + (lane >> 3), seg = lane & 7, x = swzf(rr);
          const u32x4 qa = *(const LAS u32x4*)(TQ + rr * 256 + (((2 * seg) ^ x) << 4)), qb = *(const LAS u32x4*)(TQ + rr * 256 + (((2 * seg + 1) ^ x) << 4));
          const f32x4 n0 = *(const LAS f32x4*)(sN + 16 * seg), n1 = *(const LAS f32x4*)(sN + 16 * seg + 4), n2 = *(const LAS f32x4*)(sN + 16 * seg + 8), n3 = *(const LAS f32x4*)(sN + 16 * seg + 12);
          float d = bf_lo(qa.x) * n0.x + bf_hi(qa.x) * n0.y + bf_lo(qa.y) * n0.z + bf_hi(qa.y) * n0.w + bf_lo(qa.z) * n1.x + bf_hi(qa.z) * n1.y + bf_lo(qa.w) * n1.z + bf_hi(qa.w) * n1.w
                  + bf_lo(qb.x) * n2.x + bf_hi(qb.x) * n2.y + bf_lo(qb.y) * n2.z + bf_hi(qb.y) * n2.w + bf_lo(qb.z) * n3.x + bf_hi(qb.z) * n3.y + bf_lo(qb.w) * n3.z + bf_hi(qb.w) * n3.w;
          d += __shfl_xor(d, 1); d += __shfl_xor(d, 2); d += __shfl_xor(d, 4);
          if (seg == 0) sQn[rr] = d; }
        bf16x8 Vf[2], Cf[4];
#pragma unroll
        for (int ks = 0; ks < 2; ++ks) {
            const LAS unsigned char* vp = TV + (32 * ks + 4 * g + q4) * 256 + (((2 * w + (p4 >> 1)) ^ swzf(4 * g + q4)) << 4) + 8 * (p4 & 1);
            Vf[ks] = cat8(tr16(vp), tr16(vp + 16 * 256));
        }
#pragma unroll
        for (int kd = 0; kd < 4; ++kd) { const f32x4 c0 = Cacc[2 * kd], c1 = Cacc[2 * kd + 1]; u32x4 pk; pk.x = cvt_pk_bf16(c0[0], c0[1]); pk.y = cvt_pk_bf16(c0[2], c0[3]); pk.z = cvt_pk_bf16(c1[0], c1[1]); pk.w = cvt_pk_bf16(c1[2], c1[3]); Cf[kd] = __builtin_bit_cast(bf16x8, pk); }
#pragma unroll 1
        for (int lb = 0; lb < 4; ++lb) {
            u32x4 pk[2]; pk[0] = (u32x4){0u, 0u, 0u, 0u}; pk[1] = (u32x4){0u, 0u, 0u, 0u};
            float di = 0.f;
            const LAS unsigned char* qrow = TQ + (16 * lb + n) * 256;
            {
                bf16x8 Qf[4];
#pragma unroll
                for (int kk = 0; kk < 4; ++kk) Qf[kk] = *(const LAS bf16x8*)(qrow + (((4 * kk + g) ^ swzf(n)) << 4));
                const float Ml = sM[par * 64 + 16 * lb + n];
#pragma unroll
                for (int sb = 0; sb < 4; ++sb) if (sb <= lb) {
                    f32x4 acc = (f32x4){0.f, 0.f, 0.f, 0.f};
#pragma unroll
                    for (int kk = 0; kk < 4; ++kk) { const bf16x8 kf = *(const LAS bf16x8*)(TK + (16 * sb + n) * 256 + (((4 * kk + g) ^ swzf(n)) << 4)); acc = MFMA16(kf, Qf[kk], acc); }
                    const f32x4 av4 = *(const LAS f32x4*)(sA + par * 64 + 16 * sb + 4 * g);
                    float pv[4];
#pragma unroll
                    for (int r = 0; r < 4; ++r) { float e = acc[r] * fast_exp2((av4[r] - Ml) * LOG2E); if (sb == lb && (4 * g + r > n)) e = 0.f; pv[r] = e; di += e; }
                    const unsigned u0 = cvt_pk_bf16(pv[0], pv[1]), u1 = cvt_pk_bf16(pv[2], pv[3]);
                    if ((sb & 1) == 0) { pk[sb >> 1].x = u0; pk[sb >> 1].y = u1; } else { pk[sb >> 1].z = u0; pk[sb >> 1].w = u1; }
                }
            }
            di += __shfl_xor(di, 16); di += __shfl_xor(di, 32);
            if (w == 0 && g == 0) sDi[16 * lb + n] = di;
            f32x4 numI = (f32x4){0.f, 0.f, 0.f, 0.f}, accI = (f32x4){0.f, 0.f, 0.f, 0.f};
            numI = MFMA16(__builtin_bit_cast(bf16x8, pk[0]), Vf[0], numI);
            if (lb >= 2) numI = MFMA16(__builtin_bit_cast(bf16x8, pk[1]), Vf[1], numI);
#pragma unroll
            for (int kd = 0; kd < 4; ++kd) { const s16x4 lo = *(const LAS s16x4*)(qrow + (((4 * kd + (g >> 1)) ^ swzf(n)) << 4) + 8 * (g & 1)), hi = *(const LAS s16x4*)(qrow + (((4 * kd + 2 + (g >> 1)) ^ swzf(n)) << 4) + 8 * (g & 1));
                accI = MFMA16(cat8(lo, hi), Cf[kd], accI); }
            const f32x4 in4 = *(const LAS f32x4*)(sInter + par * 64 + 16 * lb + 4 * g);
#pragma unroll
            for (int r = 0; r < 4; ++r) *(LAS float*)(lds + ML_HB + ((16 * lb + 4 * g + r) * ML_HP + e0 + n) * 4) = numI[r] + in4[r] * accI[r];
            asm volatile("" ::: "memory");
        }
        const u32x4 og0 = *(const u32x4*)(Z + (rowbase + 64 * c + nrow) * NZ + ZC_MLO + 128 * h + 16 * nseg), og1 = *(const u32x4*)(Z + (rowbase + 64 * c + nrow) * NZ + ZC_MLO + 128 * h + 16 * nseg + 8);
        bf16x8 Vw[2], Wf[2];
#pragma unroll
        for (int ks = 0; ks < 2; ++ks) {
            const f32x4 wl = *(const LAS f32x4*)(sW + par * 64 + 32 * ks + 4 * g), wh = *(const LAS f32x4*)(sW + par * 64 + 32 * ks + 16 + 4 * g);
            const u32x4 v4 = __builtin_bit_cast(u32x4, Vf[ks]);
            u32x4 pw; pw.x = cvt_pk_bf16(bf_lo(v4.x) * wl.x, bf_hi(v4.x) * wl.y); pw.y = cvt_pk_bf16(bf_lo(v4.y) * wl.z, bf_hi(v4.y) * wl.w); pw.z = cvt_pk_bf16(bf_lo(v4.z) * wh.x, bf_hi(v4.z) * wh.y); pw.w = cvt_pk_bf16(bf_lo(v4.w) * wh.z, bf_hi(v4.w) * wh.w);
            Vw[ks] = __builtin_bit_cast(bf16x8, pw);
            u32x4 pf; pf.x = cvt_pk_bf16(wl.x, wl.y); pf.y = cvt_pk_bf16(wl.z, wl.w); pf.z = cvt_pk_bf16(wh.x, wh.y); pf.w = cvt_pk_bf16(wh.z, wh.w);
            if (n != 0) pf = (u32x4){0u, 0u, 0u, 0u};
            Wf[ks] = __builtin_bit_cast(bf16x8, pf);
        }
        f32x4 cn = (f32x4){0.f, 0.f, 0.f, 0.f};
#pragma unroll
        for (int dt = 0; dt < 8; ++dt) {
            f32x4 cacc = Cacc[dt] * decay;
#pragma unroll
            for (int ks = 0; ks < 2; ++ks) { const LAS unsigned char* kp = TK + (32 * ks + 4 * g + q4) * 256 + (((2 * dt + (p4 >> 1)) ^ swzf(4 * g + q4)) << 4) + 8 * (p4 & 1);
                const bf16x8 kt = cat8(tr16(kp), tr16(kp + 16 * 256)); cacc = MFMA16(kt, Vw[ks], cacc); if (dt == w) cn = MFMA16(kt, Wf[ks], cn); }
            Cacc[dt] = cacc;
        }
        LDS_WAIT();
        __syncthreads();
        if (n == 0) {
#pragma unroll
            for (int r = 0; r < 4; ++r) sN[16 * w + 4 * g + r] = decay * sN[16 * w + 4 * g + r] + cn[r]; }
        {
            const LAS float* hp = (const LAS float*)(lds + ML_HB) + nrow * ML_HP + 16 * nseg;
            f32x4 hv[4]; float ss = 0.f;
#pragma unroll
            for (int i = 0; i < 4; ++i) { hv[i] = *(const LAS f32x4*)(hp + 4 * i); ss += (hv[i].x * hv[i].x + hv[i].y * hv[i].y) + (hv[i].z * hv[i].z + hv[i].w * hv[i].w); }
            ss += __shfl_xor(ss, 1); ss += __shfl_xor(ss, 2); ss += __shfl_xor(ss, 4);
            const float den = sDi[nrow] + sInter[par * 64 + nrow] * sQn[nrow];
            const float dn = fmaxf(fabsf(den), __expf(-sMt[par * 64 + nrow]));
            const float rstd = rsqrtf(ss * (1.0f / 128.0f) + EPS * dn * dn);
            const unsigned ogw[8] = {og0.x, og0.y, og0.z, og0.w, og1.x, og1.y, og1.z, og1.w};
            unsigned outw[8];
#pragma unroll
            for (int i = 0; i < 4; ++i) { const f32x4 gv = *(const f32x4*)(gml + 16 * nseg + 4 * i);
                const float o0 = bf_lo(ogw[2 * i]), o1 = bf_hi(ogw[2 * i]), o2 = bf_lo(ogw[2 * i + 1]), o3 = bf_hi(ogw[2 * i + 1]);
                const float y0 = hv[i].x * rstd * gv.x * fast_rcp(1.0f + __expf(-o0)), y1 = hv[i].y * rstd * gv.y * fast_rcp(1.0f + __expf(-o1));
                const float y2 = hv[i].z * rstd * gv.z * fast_rcp(1.0f + __expf(-o2)), y3 = hv[i].w * rstd * gv.w * fast_rcp(1.0f + __expf(-o3));
                outw[2 * i] = cvt_pk_bf16(y0, y1); outw[2 * i + 1] = cvt_pk_bf16(y2, y3); }
            bf16_t* op = CAT + (rowbase + 64 * c + nrow) * DM + 128 * h + 16 * nseg;
            *(u32x4*)op = (u32x4){outw[0], outw[1], outw[2], outw[3]}; *(u32x4*)(op + 8) = (u32x4){outw[4], outw[5], outw[6], outw[7]};
        }
        if (c + 1 < 32) ML_SCALARS(par ^ 1);
        VM_WAIT(); LDS_WAIT();
#if ML_TOUCH
        asm volatile("" :: "v"(touch));
        if (c + 4 < 32 && tid < 384) { const int tl_ = tid >> 7, r_ = (tid & 127) >> 1, hf_ = tid & 1;
            const bf16_t* p_ = (tl_ == 2) ? (Z + (rowbase + 64 * (c + 4) + r_) * NZ + ZC_MLV + 128 * h + 64 * hf_) : (QKC + (rowbase + 64 * (c + 4) + r_) * DM + 512 * tl_ + 128 * h + 64 * hf_);
            touch = *(const volatile unsigned*)p_; }
#endif
        __syncthreads();
    }
#undef ML_DMA
#undef ML_GATES
#undef ML_SCALARS
}
#ifndef PROBE_HALF
#define PROBE_HALF 0
#endif
#ifndef Q_LPT
#define Q_LPT 0
#endif
#ifndef Q_PAIRED
#define Q_PAIRED 0
#endif
#if Q_PAIRED
#define QN_ATT 64
#else
#define QN_ATT 128
#endif
#ifndef ATT_MODE
#define ATT_MODE 0
#endif
#ifndef REPSUB
#define REPSUB 3
#endif
#ifndef PE_TOUCH
#define PE_TOUCH 0
#endif
#ifndef P7REP
#define P7REP 0
#endif
constexpr size_t WS_US = WS_END;
constexpr int PE_REP = 132;
constexpr int PE_RE = 0, PE_RG = 128 * PE_REP * 4;

__device__ __forceinline__ unsigned enc_f(float f) { const unsigned b = __float_as_uint(f); return b ^ ((unsigned)((int)b >> 31) | 0x80000000u); }
__device__ __forceinline__ float dec_f(unsigned e) { return __uint_as_float(e ^ ((~(unsigned)((int)e >> 31)) | 0x80000000u)); }
__device__ __forceinline__ unsigned umax3(unsigned a, unsigned b, unsigned c) { return max(max(a, b), c); }

#define CE_DESC(x, y) do { const unsigned hi_ = max((x), (y)), lo_ = min((x), (y)); (x) = hi_; (y) = lo_; } while (0)
__device__ __forceinline__ void sort16_desc(unsigned (&a)[16]) {
#pragma unroll
    for (int k = 2; k <= 16; k <<= 1)
#pragma unroll
        for (int j = k >> 1; j > 0; j >>= 1)
#pragma unroll
            for (int i = 0; i < 16; ++i) { const int l = i ^ j; if (l > i) { if ((i & k) == 0) CE_DESC(a[i], a[l]); else CE_DESC(a[l], a[i]); } }
}
__device__ __forceinline__ void bitonic_merge16_desc(unsigned (&a)[16]) {
#pragma unroll
    for (int j = 8; j > 0; j >>= 1)
#pragma unroll
        for (int i = 0; i < 16; ++i) { const int l = i ^ j; if (l > i) CE_DESC(a[i], a[l]); }
}
__device__ __forceinline__ void merge_top16(unsigned (&a)[16], const unsigned (&b)[16]) {
#pragma unroll
    for (int i = 0; i < 16; ++i) a[i] = max(a[i], b[15 - i]);
    bitonic_merge16_desc(a);
}
template <bool PAIR>
__device__ __forceinline__ void top16_of64(const unsigned (&key)[64], unsigned (&top)[16]) {
    unsigned q1[16], q2[16], q3[16];
#pragma unroll
    for (int i = 0; i < 16; ++i) { top[i] = key[i]; q1[i] = key[16 + i]; q2[i] = key[32 + i]; q3[i] = key[48 + i]; }
    sort16_desc(top); sort16_desc(q1); merge_top16(top, q1);
    sort16_desc(q2); sort16_desc(q3); merge_top16(q2, q3);
    merge_top16(top, q2);
    if (PAIR) {
        unsigned o[16];
#pragma unroll
        for (int i = 0; i < 16; ++i) o[i] = (unsigned)__shfl_xor((int)top[i], 32);
        merge_top16(top, o);
    }
}

__device__ __forceinline__ float gelu_exact(float v) { return 0.5f * v * (1.0f + erff(v * 0.70710678118654752f)); }
typedef __bf16 bf16x2_t __attribute__((ext_vector_type(2)));
__device__ __forceinline__ float dot2bf(unsigned a, unsigned b, float c) { return __builtin_amdgcn_fdot2_f32_bf16(__builtin_bit_cast(bf16x2_t, a), __builtin_bit_cast(bf16x2_t, b), c, false); }
__device__ __forceinline__ float dot8(const u32x4 a, const u32x4 b) { return dot2bf(a.x, b.x, dot2bf(a.y, b.y, dot2bf(a.z, b.z, dot2bf(a.w, b.w, 0.f)))); }
__device__ __forceinline__ float dpp_xor1(float v) { return __int_as_float(__builtin_amdgcn_update_dpp(0, __float_as_int(v), 0xB1, 0xF, 0xF, true)); }
__device__ __forceinline__ float dpp_xor2(float v) { return __int_as_float(__builtin_amdgcn_update_dpp(0, __float_as_int(v), 0x4E, 0xF, 0xF, true)); }
__device__ __forceinline__ float dpp_xor4(float v) { const int m = __builtin_amdgcn_update_dpp(0, __float_as_int(v), 0x141, 0xF, 0xF, true); return __int_as_float(__builtin_amdgcn_update_dpp(0, m, 0x1B, 0xF, 0xF, true)); }
__device__ __forceinline__ float reduce8x8(const float (&p)[8], const int j) {
    float r[4], q[2];
#pragma unroll
    for (int i = 0; i < 4; ++i) { const float keep = (j & 4) ? p[i + 4] : p[i], send = (j & 4) ? p[i] : p[i + 4]; r[i] = keep + __shfl_xor(send, 4); }
#pragma unroll
    for (int i = 0; i < 2; ++i) { const float keep = (j & 2) ? r[i + 2] : r[i], send = (j & 2) ? r[i] : r[i + 2]; q[i] = keep + __shfl_xor(send, 2); }
    const float keep = (j & 1) ? q[1] : q[0], send = (j & 1) ? q[0] : q[1];
    return keep + __shfl_xor(send, 1);
}

__device__ __forceinline__ int reduce8x8i(const float (&p)[8], const int j) {
    int r[4], q[2];
#pragma unroll
    for (int i = 0; i < 4; ++i) { const int keep = __float_as_int((j & 4) ? p[i + 4] : p[i]), send = __float_as_int((j & 4) ? p[i] : p[i + 4]); r[i] = keep + __shfl_xor(send, 4); }
#pragma unroll
    for (int i = 0; i < 2; ++i) { const int keep = (j & 2) ? r[i + 2] : r[i], send = (j & 2) ? r[i] : r[i + 2]; q[i] = keep + __shfl_xor(send, 2); }
    const int keep = (j & 1) ? q[1] : q[0], send = (j & 1) ? q[0] : q[1];
    return keep + __shfl_xor(send, 1);
}
constexpr size_t WS_VS8 = WS_US + 16 * MiB, WS_SINV = WS_US + 32 * MiB;
__device__ __forceinline__ void peer_convert_rows(Frame& F, const int item) {
    const Args& A = *F.a;
    int lane_l = threadIdx.x & 63; asm volatile("" : "+v"(lane_l));
    const int lane = lane_l;
    float* SINV = (float*)(F.ws + WS_SINV);
    f32x4 gq[4];
    { const float* gp = A.in[I_GFFN] + 16 * lane; gq[0] = *(const f32x4*)gp; gq[1] = *(const f32x4*)(gp + 4); gq[2] = *(const f32x4*)(gp + 8); gq[3] = *(const f32x4*)(gp + 12); }
    for (int it0 = 64 * item + 4 * F.wave; it0 < 64 * item + 64; it0 += 32) {
        f32x4 v[4][4];
#pragma unroll
        for (int r = 0; r < 4; ++r) { const int it = it0 + r, tb = it >> 14, e = it & 16383;
            const float* src = (tb ? A.in[I_PV] : A.in[I_PU]) + (size_t)e * DM + 16 * lane;
#pragma unroll
            for (int q = 0; q < 4; ++q) v[r][q] = *(const f32x4*)(src + 4 * q); }
#pragma unroll
        for (int r = 0; r < 4; ++r) { const int it = it0 + r, tb = it >> 14, e = it & 16383;
            if (tb == 0) {
#pragma unroll
                for (int q = 0; q < 4; ++q) v[r][q] = v[r][q] * gq[q]; }
            float mx = 0.f;
#pragma unroll
            for (int q = 0; q < 4; ++q) mx = fmaxf(mx, fmaxf(fmaxf(fabsf(v[r][q].x), fabsf(v[r][q].y)), fmaxf(fabsf(v[r][q].z), fabsf(v[r][q].w))));
#pragma unroll
            for (int o = 1; o < 64; o <<= 1) mx = fmaxf(mx, __shfl_xor(mx, o));
            u32x4 o; unsigned ow[4]; float sinv;
            if (tb == 0) {
                const float sc = (mx > 0.f) ? 127.0f / mx : 0.f; sinv = mx * (1.0f / 127.0f);
#pragma unroll
                for (int q = 0; q < 4; ++q) { const int q0 = __float2int_rn(v[r][q].x * sc), q1 = __float2int_rn(v[r][q].y * sc), q2 = __float2int_rn(v[r][q].z * sc), q3 = __float2int_rn(v[r][q].w * sc);
                    ow[q] = (unsigned)(q0 & 255) | ((unsigned)(q1 & 255) << 8) | ((unsigned)(q2 & 255) << 16) | ((unsigned)(q3 & 255) << 24); }
            } else {
                int k = (mx > 0.f) ? (int)floorf(log2f(416.0f / mx)) : 0; k = k > 60 ? 60 : (k < -60 ? -60 : k);
                const float sc = exp2f((float)k); sinv = exp2f((float)-k);
#pragma unroll
                for (int q = 0; q < 4; ++q) { int wd = __builtin_amdgcn_cvt_pk_fp8_f32(v[r][q].x * sc, v[r][q].y * sc, 0, false); wd = __builtin_amdgcn_cvt_pk_fp8_f32(v[r][q].z * sc, v[r][q].w * sc, wd, true); ow[q] = (unsigned)wd; }
            }
            o.x = ow[0]; o.y = ow[1]; o.z = ow[2]; o.w = ow[3];
            unsigned char* dst = (unsigned char*)(F.ws + (tb ? WS_VS8 : WS_US)) + ((size_t)(lane >> 3) * 16384 + e) * 128 + 16 * (lane & 7);
            *(u32x4*)dst = o;
            if (lane == 0) SINV[tb * 16384 + e] = sinv;
        }
    }
}

template <bool DRY>
__device__ __forceinline__ void peer_tile(Frame& F, const int tile) {
    const Args& A = *F.a;
    const bf16_t* QP = (const bf16_t*)(F.ws + WS_BUFA); const bf16_t* XG = (const bf16_t*)(F.ws + WS_BUFB); bf16_t* XGW = (bf16_t*)(F.ws + WS_BUFB); const bf16_t* SK = (const bf16_t*)(F.ws + WS_SK);
    const float* rss2 = (const float*)(F.ctl + CW_RSS2);
    LAS unsigned* RE = (LAS unsigned*)(F.lds + PE_RE); LAS float* RG = (LAS float*)(F.lds + PE_RG);
    const int w = F.wave;
    {
        int lane = F.lane; asm volatile("" : "+v"(lane));
        const int tg = w & 3, hh = w >> 2, n = lane & 31, h2 = lane >> 5;
        const int tok = 32 * tg + n; const size_t trow = (size_t)tile * 128 + tok;
        for (int rrep = 0; rrep < ((P7REP & 1) ? 2 : 1); ++rrep)
        for (int hd = 4 * hh; hd < 4 * hh + 4; ++hd) {
            unsigned T2[2][16];
#pragma unroll
            for (int cc = 0; cc < 2; ++cc) {
                const int grp = 2 * hd + cc;
                bf16x8 Qf[4];
#pragma unroll
                for (int kk = 0; kk < 4; ++kk) Qf[kk] = *(const bf16x8*)(QP + trow * DM + 64 * grp + 16 * kk + 8 * h2);
                unsigned key[64];
                unsigned lowbase = 127u - 4u * (unsigned)h2; asm volatile("" : "+v"(lowbase));
#pragma unroll
                for (int kb = 0; kb < 4; ++kb) {
                    f32x16 S;
#pragma unroll
                    for (int e = 0; e < 16; ++e) S[e] = 0.f;
#pragma unroll
                    for (int kk = 0; kk < 4; ++kk) { const bf16x8 a = *(const bf16x8*)(SK + ((size_t)(grp * 128 + 32 * kb + n)) * 64 + 16 * kk + 8 * h2); S = __builtin_amdgcn_mfma_f32_32x32x16_bf16(a, Qf[kk], S, 0, 0, 0); }
#pragma unroll
                    for (int e = 0; e < 16; ++e) { const int idx0 = 32 * kb + (e & 3) + 8 * (e >> 2); key[16 * kb + e] = ((enc_f(S[e]) & ~127u) | lowbase) - (unsigned)idx0; }
                }
                top16_of64<true>(key, T2[cc]);
            }
            float va[16], vb[16];
#pragma unroll
            for (int i = 0; i < 16; ++i) { va[i] = dec_f(T2[0][i] & ~127u); vb[i] = dec_f(T2[1][i] & ~127u); }
            unsigned ck[64];
#pragma unroll
            for (int i = 50; i < 64; ++i) ck[i] = 0u;
            {
                int q = 0;
#pragma unroll
                for (int i = 0; i < 16; ++i)
#pragma unroll
                    for (int j = 0; j < 16; ++j) if ((i + 1) * (j + 1) <= 16) { ck[q] = (enc_f(va[i] + vb[j]) & ~255u) | (unsigned)(255 - (16 * i + j)); ++q; }
            }
            unsigned best[16];
            top16_of64<false>(ck, best);
            const float v0 = dec_f(best[0] & ~255u);
            float gw[16], zs = 0.f;
#pragma unroll
            for (int k = 0; k < 16; ++k) { gw[k] = __expf(dec_f(best[k] & ~255u) - v0); zs += gw[k]; }
            const float zinv = 1.0f / zs;
#pragma unroll
            for (int k = 0; k < 16; ++k) {
                const unsigned code = 255u - (best[k] & 255u); const unsigned ci = code >> 4, cj = code & 15u;
                unsigned ia = 0, ib = 0;
#pragma unroll
                for (int i = 0; i < 16; ++i) { ia = (ci == (unsigned)i) ? (127u - (T2[0][i] & 127u)) : ia; ib = (cj == (unsigned)i) ? (127u - (T2[1][i] & 127u)) : ib; }
                if (h2 == (k >> 3)) { RE[tok * PE_REP + hd * 16 + k] = (ia * 128u + ib) << 7; RG[tok * PE_REP + hd * 16 + k] = gw[k] * zinv; }
            }
        }
    }
    __syncthreads();
    {
        int lane = F.lane; asm volatile("" : "+v"(lane));
        const unsigned char* US = (const unsigned char*)(F.ws + WS_US); const unsigned char* VS = (const unsigned char*)(F.ws + WS_VS8); const float* SINV = (const float*)(F.ws + WS_SINV);
        const int j = lane & 7, gid = 8 * w + (lane >> 3);
        const int tA = gid, tB = 64 + gid; const size_t rowA = (size_t)tile * 128 + tA, rowB = (size_t)tile * 128 + tB;
        const LAS unsigned* reA = RE + tA * PE_REP; const LAS unsigned* reB = RE + tB * PE_REP;
        LAS float* cfA = RG + tA * PE_REP; LAS float* cfB = RG + tB * PE_REP;
        float accA[16], accB[16];
#pragma unroll
        for (int i = 0; i < 16; ++i) { accA[i] = 0.f; accB[i] = 0.f; }
#define PE_DEC16P(w4, f2) do { (f2)[0] = __builtin_amdgcn_cvt_pk_f32_fp8((int)(w4).x, false); (f2)[1] = __builtin_amdgcn_cvt_pk_f32_fp8((int)(w4).x, true); (f2)[2] = __builtin_amdgcn_cvt_pk_f32_fp8((int)(w4).y, false); (f2)[3] = __builtin_amdgcn_cvt_pk_f32_fp8((int)(w4).y, true); \
            (f2)[4] = __builtin_amdgcn_cvt_pk_f32_fp8((int)(w4).z, false); (f2)[5] = __builtin_amdgcn_cvt_pk_f32_fp8((int)(w4).z, true); (f2)[6] = __builtin_amdgcn_cvt_pk_f32_fp8((int)(w4).w, false); (f2)[7] = __builtin_amdgcn_cvt_pk_f32_fp8((int)(w4).w, true); } while (0)
#define PE_ISSUE(buf_, re_, kb_, base_) do { const u32x4 e4a = *(const LAS u32x4*)((re_) + 8 * (kb_)), e4b = *(const LAS u32x4*)((re_) + 8 * (kb_) + 4); const unsigned ew[8] = {e4a.x, e4a.y, e4a.z, e4a.w, e4b.x, e4b.y, e4b.z, e4b.w}; \
                _Pragma("unroll") for (int i = 0; i < 8; ++i) (buf_)[i] = *(const u32x4*)((base_) + (size_t)ew[i]); } while (0)
        float sxA, sxB, isxA, isxB;
        { float mA = 0.f, mB = 0.f;
#pragma unroll
          for (int s = 0; s < 8; ++s) { const u32x4 a0 = *(const u32x4*)(XG + rowA * DM + 128 * s + 16 * j), a1 = *(const u32x4*)(XG + rowA * DM + 128 * s + 16 * j + 8), b0 = *(const u32x4*)(XG + rowB * DM + 128 * s + 16 * j), b1 = *(const u32x4*)(XG + rowB * DM + 128 * s + 16 * j + 8);
              const unsigned aw[8] = {a0.x, a0.y, a0.z, a0.w, a1.x, a1.y, a1.z, a1.w}, bw[8] = {b0.x, b0.y, b0.z, b0.w, b1.x, b1.y, b1.z, b1.w};
#pragma unroll
              for (int i = 0; i < 8; ++i) { mA = fmaxf(mA, fmaxf(fabsf(bf_lo(aw[i])), fabsf(bf_hi(aw[i])))); mB = fmaxf(mB, fmaxf(fabsf(bf_lo(bw[i])), fabsf(bf_hi(bw[i])))); } }
          mA = fmaxf(mA, __shfl_xor(mA, 1)); mA = fmaxf(mA, __shfl_xor(mA, 2)); mA = fmaxf(mA, __shfl_xor(mA, 4));
          mB = fmaxf(mB, __shfl_xor(mB, 1)); mB = fmaxf(mB, __shfl_xor(mB, 2)); mB = fmaxf(mB, __shfl_xor(mB, 4));
          sxA = (mA > 0.f) ? 127.0f / mA : 0.f; sxB = (mB > 0.f) ? 127.0f / mB : 0.f; isxA = mA * (1.0f / 127.0f); isxB = mB * (1.0f / 127.0f); }
        u32x4 xra0 = *(const u32x4*)(XG + rowA * DM + 16 * j), xra1 = *(const u32x4*)(XG + rowA * DM + 16 * j + 8), xrb0 = *(const u32x4*)(XG + rowB * DM + 16 * j), xrb1 = *(const u32x4*)(XG + rowB * DM + 16 * j + 8);
        u32x4 bufA[8], bufB[8];
        PE_ISSUE(bufA, reA, 0, US + 16 * j);
#pragma unroll 1
        for (int s2 = 0; s2 < ((P7REP & 2) ? 16 : 8); ++s2) {
            const int s = s2 & 7;
            if (s2 == 8) {
#pragma unroll
                for (int i = 0; i < 16; ++i) { accA[i] = 0.f; accB[i] = 0.f; } }
            unsigned xa[4], xb[4];
            { const unsigned aw[8] = {xra0.x, xra0.y, xra0.z, xra0.w, xra1.x, xra1.y, xra1.z, xra1.w}, bw[8] = {xrb0.x, xrb0.y, xrb0.z, xrb0.w, xrb1.x, xrb1.y, xrb1.z, xrb1.w};
#pragma unroll
              for (int i = 0; i < 4; ++i) { const int a0_ = __float2int_rn(bf_lo(aw[2 * i]) * sxA), a1_ = __float2int_rn(bf_hi(aw[2 * i]) * sxA), a2_ = __float2int_rn(bf_lo(aw[2 * i + 1]) * sxA), a3_ = __float2int_rn(bf_hi(aw[2 * i + 1]) * sxA);
                  const int b0_ = __float2int_rn(bf_lo(bw[2 * i]) * sxB), b1_ = __float2int_rn(bf_hi(bw[2 * i]) * sxB), b2_ = __float2int_rn(bf_lo(bw[2 * i + 1]) * sxB), b3_ = __float2int_rn(bf_hi(bw[2 * i + 1]) * sxB);
                  xa[i] = (unsigned)(a0_ & 255) | ((unsigned)(a1_ & 255) << 8) | ((unsigned)(a2_ & 255) << 16) | ((unsigned)(a3_ & 255) << 24);
                  xb[i] = (unsigned)(b0_ & 255) | ((unsigned)(b1_ & 255) << 8) | ((unsigned)(b2_ & 255) << 16) | ((unsigned)(b3_ & 255) << 24); } }
            { const int sn = (s + 1) & 7;
              xra0 = *(const u32x4*)(XG + rowA * DM + 128 * sn + 16 * j); xra1 = *(const u32x4*)(XG + rowA * DM + 128 * sn + 16 * j + 8); xrb0 = *(const u32x4*)(XG + rowB * DM + 128 * sn + 16 * j); xrb1 = *(const u32x4*)(XG + rowB * DM + 128 * sn + 16 * j + 8); }
            const unsigned char* Us = US + (size_t)s * (16384 * 128) + 16 * j; const unsigned char* Usn = US + (size_t)((s + 1) & 7) * (16384 * 128) + 16 * j;
#if PE_TOUCH
            const unsigned tchu = *(const volatile unsigned*)(US + (size_t)((s + 1) & 7) * (16384 * 128) + ((size_t)(((blockIdx.x >> 3) & 31) * 512 + F.tid)) * 128);
#endif
#define PE_UCOMP(buf_, x_, acc_, kb_) do { float pp[8]; _Pragma("unroll") for (int i = 0; i < 8; ++i) { int d_ = __builtin_amdgcn_sdot4((int)(buf_)[i].x, (int)(x_)[0], 0, false); d_ = __builtin_amdgcn_sdot4((int)(buf_)[i].y, (int)(x_)[1], d_, false); d_ = __builtin_amdgcn_sdot4((int)(buf_)[i].z, (int)(x_)[2], d_, false); d_ = __builtin_amdgcn_sdot4((int)(buf_)[i].w, (int)(x_)[3], d_, false); pp[i] = __int_as_float(d_); } \
                (acc_)[kb_] += (float)reduce8x8i(pp, j); asm volatile("" : "+v"((acc_)[kb_]) :: "memory"); } while (0)
#pragma unroll
            for (int kb = 0; kb < 16; ++kb) {
                PE_ISSUE(bufB, reB, kb, Us);
                PE_UCOMP(bufA, xa, accA, kb);
                if (kb + 1 < 16) PE_ISSUE(bufA, reA, kb + 1, Us); else PE_ISSUE(bufA, reA, 0, Usn);
                PE_UCOMP(bufB, xb, accB, kb);
            }
#if PE_TOUCH
            asm volatile("" :: "v"(tchu));
#endif
        }
#undef PE_UCOMP
        {
            const float rsA = rsqrtf(rss2[rowA] * (1.0f / DM) + EPS), rsB = rsqrtf(rss2[rowB] * (1.0f / DM) + EPS);
#pragma unroll
            for (int kb = 0; kb < 16; ++kb) { const int eA = (int)(reA[8 * kb + j] >> 7), eB = (int)(reB[8 * kb + j] >> 7);
                cfA[8 * kb + j] = cfA[8 * kb + j] * gelu_exact(accA[kb] * (rsA * isxA) * SINV[eA]) * SINV[16384 + eA]; cfB[8 * kb + j] = cfB[8 * kb + j] * gelu_exact(accB[kb] * (rsB * isxB) * SINV[eB]) * SINV[16384 + eB]; }
        }
        LDS_WAIT();
        float ssA = 0.f, ssB = 0.f;
        float* xoA = A.out + rowA * DM + 16 * j; float* xoB = A.out + rowB * DM + 16 * j;
        PE_ISSUE(bufA, reA, 0, VS + 16 * j);
#pragma unroll 1
        for (int s2 = 0; s2 < ((P7REP & 4) ? 16 : 8); ++s2) {
            const int s = s2 & 7; const bool dry = (P7REP & 4) && s2 < 8;
            const unsigned char* Vs = VS + (size_t)s * (16384 * 128) + 16 * j; const unsigned char* Vsn = VS + (size_t)((s + 1) & 7) * (16384 * 128) + 16 * j;
#if PE_TOUCH
            const unsigned tchv = *(const volatile unsigned*)(VS + (size_t)((s + 1) & 7) * (16384 * 128) + ((size_t)(((blockIdx.x >> 3) & 31) * 512 + F.tid)) * 128);
#endif
            u32x2 x2a[4], x2b[4];
#pragma unroll
            for (int q = 0; q < 4; ++q) { x2a[q] = *(const u32x2*)(XG + rowA * DM + 128 * s + 16 * j + 4 * q); x2b[q] = *(const u32x2*)(XG + rowB * DM + 128 * s + 16 * j + 4 * q); }
            f32x2 oa[8], ob[8];
#pragma unroll
            for (int i = 0; i < 8; ++i) { oa[i] = (f32x2){0.f, 0.f}; ob[i] = (f32x2){0.f, 0.f}; }
#define PE_VCOMP(buf_, cf_, o_, kb_) do { const f32x4 c0_ = *(const LAS f32x4*)((cf_) + 8 * (kb_)), c1_ = *(const LAS f32x4*)((cf_) + 8 * (kb_) + 4); const float cw_[8] = {c0_.x, c0_.y, c0_.z, c0_.w, c1_.x, c1_.y, c1_.z, c1_.w}; \
                _Pragma("unroll") for (int i = 0; i < 8; ++i) { const f32x2 c2 = (f32x2){cw_[i], cw_[i]}; f32x2 f2[8]; PE_DEC16P((buf_)[i], f2); _Pragma("unroll") for (int q = 0; q < 8; ++q) (o_)[q] = __builtin_elementwise_fma(c2, f2[q], (o_)[q]); } \
                asm volatile("" : "+v"((o_)[0]), "+v"((o_)[1]), "+v"((o_)[2]), "+v"((o_)[3]), "+v"((o_)[4]), "+v"((o_)[5]), "+v"((o_)[6]), "+v"((o_)[7]) :: "memory"); } while (0)
#pragma unroll
            for (int kb = 0; kb < 16; ++kb) {
                PE_ISSUE(bufB, reB, kb, Vs);
                PE_VCOMP(bufA, cfA, oa, kb);
                if (kb + 1 < 16) PE_ISSUE(bufA, reA, kb + 1, Vs); else PE_ISSUE(bufA, reA, 0, Vsn);
                PE_VCOMP(bufB, cfB, ob, kb);
            }
#if PE_TOUCH
            asm volatile("" :: "v"(tchv));
#endif
#undef PE_VCOMP
#pragma unroll
            for (int q = 0; q < 4; ++q) {
                const u32x2 xa2 = x2a[q], xb2 = x2b[q];
                f32x4 a0 = (f32x4){bf_lo(xa2.x), bf_hi(xa2.x), bf_lo(xa2.y), bf_hi(xa2.y)}, b0 = (f32x4){bf_lo(xb2.x), bf_hi(xb2.x), bf_lo(xb2.y), bf_hi(xb2.y)};
                a0 = a0 + (f32x4){oa[2 * q].x, oa[2 * q].y, oa[2 * q + 1].x, oa[2 * q + 1].y}; b0 = b0 + (f32x4){ob[2 * q].x, ob[2 * q].y, ob[2 * q + 1].x, ob[2 * q + 1].y};
                if (!dry && !DRY) { ssA += (a0.x * a0.x + a0.y * a0.y) + (a0.z * a0.z + a0.w * a0.w); ssB += (b0.x * b0.x + b0.y * b0.y) + (b0.z * b0.z + b0.w * b0.w);
                u32x2 pa, pb; pa.x = cvt_pk_bf16(a0.x, a0.y); pa.y = cvt_pk_bf16(a0.z, a0.w); pb.x = cvt_pk_bf16(b0.x, b0.y); pb.y = cvt_pk_bf16(b0.z, b0.w);
                *(u32x2*)(XGW + rowA * DM + 128 * s + 16 * j + 4 * q) = pa; *(u32x2*)(XGW + rowB * DM + 128 * s + 16 * j + 4 * q) = pb; } }
        }
#undef PE_DEC16P
#undef PE_ISSUE
        ssA += __shfl_xor(ssA, 1); ssA += __shfl_xor(ssA, 2); ssA += __shfl_xor(ssA, 4);
        ssB += __shfl_xor(ssB, 1); ssB += __shfl_xor(ssB, 2); ssB += __shfl_xor(ssB, 4);
        const float rfA = rsqrtf(ssA * (1.0f / DM) + EPS), rfB = rsqrtf(ssB * (1.0f / DM) + EPS);
        VM_WAIT();
        __builtin_amdgcn_fence(__ATOMIC_ACQUIRE, "agent");
        VM_WAIT();
        const float* gfin = A.in[I_GFIN] + 16 * j;
#pragma unroll 2
        for (int s = 0; s < 8; ++s)
#pragma unroll
            for (int q = 0; q < 4; ++q) {
                const f32x4 g0 = *(const f32x4*)(gfin + 128 * s + 4 * q);
                const u32x2 xa2 = *(const u32x2*)(XGW + rowA * DM + 128 * s + 16 * j + 4 * q), xb2 = *(const u32x2*)(XGW + rowB * DM + 128 * s + 16 * j + 4 * q);
                const f32x4 a0 = (f32x4){bf_lo(xa2.x), bf_hi(xa2.x), bf_lo(xa2.y), bf_hi(xa2.y)}, b0 = (f32x4){bf_lo(xb2.x), bf_hi(xb2.x), bf_lo(xb2.y), bf_hi(xb2.y)};
                if (!DRY) { *(f32x4*)(xoA + 128 * s + 4 * q) = a0 * rfA * g0; *(f32x4*)(xoB + 128 * s + 4 * q) = b0 * rfB * g0; } else { asm volatile("" :: "v"(a0 * rfA * g0), "v"(b0 * rfB * g0)); } }
    }
    __syncthreads();
}

#ifndef USE_COOP_LAUNCH
#define USE_COOP_LAUNCH 1
#endif
#ifndef USE_CG_SYNC
#define USE_CG_SYNC 0
#endif
#ifndef DBG_SRC
#define DBG_SRC 0
#endif
#ifndef DBG_ZC
#define DBG_ZC 0
#endif
#ifndef DBG_C0
#define DBG_C0 0
#endif
#ifndef DBG_C1
#define DBG_C1 1024
#endif
__global__ void __launch_bounds__(512, 2) mk_fwd(Args args) {
    extern __shared__ __attribute__((aligned(16))) unsigned char lds_raw[];
    Frame F;
    F.lds = (LAS unsigned char*)lds_raw;
    F.tid = threadIdx.x; F.lane = F.tid & 63; F.wave = __builtin_amdgcn_readfirstlane(F.tid >> 6);
    F.G = gridDim.x; { const int bx = blockIdx.x; F.vcu = (F.G % 8 == 0) ? (bx % 8) * (F.G / 8) + bx / 8 : bx; }
    F.a = &args; F.ws = args.ws; F.ctl = (unsigned*)(args.ws + WS_CTL);
    const int lo = args.ph_lo, hi = args.ph_hi;
#if USE_CG_SYNC
    cg::grid_group grid = cg::this_grid();
#define GRID_BAR() grid.sync()
#else
    { volatile LAS unsigned* st0 = (volatile LAS unsigned*)(F.lds + MISC_OFF); if (F.tid < 8) st0[F.tid] = 0u; }
    __syncthreads();
    XcdBarrier xbar; xbar.bar = F.ctl + CW_BAR; xbar.x = 0; xbar.st = nullptr;
    if (hi - lo > 1) xbar = xcd_barrier_post(F.ctl + CW_BAR, (volatile LAS unsigned*)(F.lds + MISC_OFF));
#define GRID_BAR() xcd_barrier(xbar)
#endif
#define IN(k) (lo <= (k) && (k) < hi)
#ifndef PHMASK
#define PHMASK 0x1FF
#endif
#ifndef P2SUB
#define P2SUB 7
#endif
#define PHON(k) (((PHMASK) >> (k)) & 1)
#ifndef REPMASK
#define REPMASK 0
#endif
#define NREP(k) ((((REPMASK) >> (k)) & 1) ? 2 : 1)
#define PHASE_BEGIN() do { int t_ = threadIdx.x; asm volatile("" : "+v"(t_)); F.tid = t_; F.lane = t_ & 63; } while (0)
#define SEAM(k) do { if (IN(k) && IN((k) + 1)) GRID_BAR(); } while (0)
    unsigned char* ws = args.ws;
    const int bx = blockIdx.x;

    if (PHON(0) && IN(0)) { for (int rep = 0; rep < NREP(0); ++rep) { PHASE_BEGIN(); p0_prologue(F); } }
    SEAM(0);
    if (PHON(1) && IN(1)) for (int rep = 0; rep < NREP(1); ++rep) {
        PHASE_BEGIN();
        { pg8::Sched S{0, T_TOK / 256, NZ / 256, (T_TOK / 256) * (NZ / 256), F.G, bx, 1, (const char*)(ws + WS_BUFA), (const char*)(ws + WS_WIN), (char*)(ws + WS_Z), (size_t)256 * DM * 2, (size_t)256 * DM * 2, 0, 2};
          pg8::EpiBf16 E{NZ, 1.0f, nullptr, nullptr};
          pg8::gemm_phase(F.lds, DM, DM, DM, S, E); }
        { pg8::Sched S{0, TMEM / 256, 2048 / 256, (TMEM / 256) * (2048 / 256), F.G, bx, 1, (const char*)(ws + WS_MEMN), (const char*)(ws + WS_WKV), (char*)(ws + WS_KV), (size_t)256 * DM * 2, (size_t)256 * DM * 2, 0, 2};
          pg8::EpiBf16 E{2048, 1.0f, nullptr, nullptr};
          pg8::gemm_phase(F.lds, DM, DM, DM, S, E); }
    }
    SEAM(1);
    if (PHON(2) && IN(2)) for (int rep = 0; rep < NREP(2); ++rep) {
        PHASE_BEGIN();
        conv_prepass(F);
    }
    SEAM(2);
    if (PHON(3) && IN(3)) for (int rep = 0; rep < NREP(3); ++rep) {
        PHASE_BEGIN();
        float lam;
        { float s1 = 0.f, s2 = 0.f;
          for (int i = 0; i < 64; ++i) { s1 += args.in[I_LQ1][i] * args.in[I_LK1][i]; s2 += args.in[I_LQ2][i] * args.in[I_LK2][i]; }
          lam = __expf(s1) - __expf(s2) + 0.2f; }
        LAS int* qslot = (LAS int*)(F.lds + MISC_OFF + 16);
        int qx = bx & 7, tried = 0;
        for (;;) {
            if (F.tid == 0) *qslot = (int)atomicAdd(F.ctl + CW_Q2 + 64 * (qx + 8 * rep), 1u);
            __syncthreads();
            const int u = *qslot;
            __syncthreads();
            if (u >= 8 + QN_ATT + 64 + 64) { if (++tried == 8) break; qx = (qx + 1) & 7; continue; }
            const int submask = (rep + 1 < NREP(3)) ? (REPSUB) : (P2SUB);
            if (u < 8) { const int p = qx + 8 * u; if ((submask & 1) && !((rep + 1 < NREP(3)) && (PROBE_HALF & 1) && u >= 4)) mlstm_unit(F, p >> 2, p & 3); }
            else if (u >= 8 + QN_ATT + 64) { if (rep + 1 == NREP(3)) peer_convert_rows(F, qx + 8 * (u - (8 + QN_ATT + 64))); }
            else if (u >= 8 + QN_ATT) { if (rep + 1 == NREP(3)) {
                const int gi = qx + 8 * (u - (8 + QN_ATT));
                if (gi < 256) { pg8::Sched S{1, 0, 0, 256, 1 << 30, gi, 1, (const char*)(ws + WS_KV), (const char*)(ws + WS_WCQ), (char*)(ws + WS_MB), 0, 0, 0, 2};
                    pg8::EpiBf16 E{DM, 0.0625f, nullptr, args.in[I_GCA]};
                    pg8::gemm_phase(F.lds, 256, 2048, DM, S, E); }
                else { pg8::Sched S{2, 0, 0, 256, 1 << 30, gi - 256, 1, (const char*)(ws + WS_WCO), (const char*)(ws + WS_KV), (char*)(ws + WS_VWB), 0, 0, 0, 2};
                    pg8::EpiBf16 E{DM, 1.0f, nullptr, nullptr};
                    pg8::gemm_phase(F.lds, 256, DM, 2048, S, E); } } }
            else if ((submask & 2) && !((rep + 1 < NREP(3)) && (PROBE_HALF & 2) && ((u - 8) >> 4) >= 4)) { const int j = u - 8;
#if Q_PAIRED
                { const int p = qx + 8 * (j >> 3), g_ = j & 7;
#pragma unroll 1
                  for (int hf = 0; hf < 2; ++hf) { const int qt_ = hf ? g_ : 15 - g_;
                      if (rep + 1 < NREP(3)) attn_unit<ATT_MODE>(F, p >> 2, p & 3, qt_, lam); else attn_unit<0>(F, p >> 2, p & 3, qt_, lam); } }
#elif Q_LPT
                const int p = qx + 8 * (j & 7), qt_ = 15 - (j >> 3);
#else
                const int p = qx + 8 * (j >> 4), qt_ = 15 - (j & 15);
#endif
#if !Q_PAIRED
                if (rep + 1 < NREP(3)) attn_unit<ATT_MODE>(F, p >> 2, p & 3, qt_, lam); else attn_unit<0>(F, p >> 2, p & 3, qt_, lam);
#endif
            }
        }
    }
    SEAM(3);
    if (PHON(4) && IN(4)) for (int rep = 0; rep < NREP(4); ++rep) {
        PHASE_BEGIN();
        pg8::Sched S{0, T_TOK / 256, 4, (T_TOK / 256) * 4, F.G, bx, 1, (const char*)(ws + WS_BUFA), (const char*)(ws + WS_WOUT), nullptr, (size_t)256 * DM * 2, (size_t)256 * DM * 2, 0, 2};
        pg8::EpiResidB<false> E{args.in[I_X], (bf16_t*)(ws + WS_BUFB), (float*)(F.ctl + ((rep + 1 < NREP(4)) ? CW_DUMMY : CW_RSS1))};
        pg8::gemm_phase(F.lds, DM, DM, DM, S, E);
    }
    SEAM(4);
    if (PHON(5) && IN(5)) for (int rep = 0; rep < NREP(5); ++rep) {
        PHASE_BEGIN();
        pg8::Sched S{0, T_TOK / 256, 4, (T_TOK / 256) * 4, F.G, bx, 8, (const char*)(ws + WS_BUFB), (const char*)(ws + WS_MB), nullptr, (size_t)256 * DM * 2, (size_t)256 * DM * 2, (size_t)DM * DM * 2, 2};
        pg8::EpiSoftmax E{(const float*)(F.ctl + CW_RSS1), (bf16_t*)(ws + WS_BUFA)};
        pg8::gemm_phase(F.lds, DM, DM, DM, S, E);
    }
    SEAM(5);
    if (PHON(6) && IN(6)) {
        PHASE_BEGIN();
        pg8::Sched S{0, T_TOK / 256, 4, (T_TOK / 256) * 4, F.G, bx, 8, (const char*)(ws + WS_BUFA), (const char*)(ws + WS_VWB), nullptr, (size_t)256 * DM * 2, (size_t)256 * DM * 2, (size_t)DM * DM * 2, 2};
        pg8::EpiResidB<true> E{(const void*)(ws + WS_BUFB), (bf16_t*)(ws + WS_BUFB), (float*)(F.ctl + CW_RSS2)};
        pg8::gemm_phase(F.lds, DM, DM, DM, S, E);
    }
    SEAM(6);
    if (PHON(7) && IN(7)) for (int rep = 0; rep < NREP(7); ++rep) {
        PHASE_BEGIN();
        pg8::Sched S{0, T_TOK / 256, 4, (T_TOK / 256) * 4, F.G, bx, 1, (const char*)(ws + WS_BUFB), (const char*)(ws + WS_WPQ), (char*)(ws + WS_BUFA), (size_t)256 * DM * 2, (size_t)256 * DM * 2, 0, 2};
        pg8::EpiBf16 E{DM, 1.0f, (const float*)(F.ctl + CW_RSS2), nullptr};
        pg8::gemm_phase(F.lds, DM, DM, DM, S, E);
    }
    SEAM(7);
    if (PHON(8) && IN(8)) {
        PHASE_BEGIN();
        if (NREP(8) > 1) { for (int tile = bx; tile < T_TOK / 128; tile += F.G) peer_tile<true>(F, tile); }
        for (int tile = bx; tile < T_TOK / 128; tile += F.G) peer_tile<false>(F, tile);
    }
    if (lo <= 9 && 9 < hi) {
        const bf16_t* src = (const bf16_t*)(ws + (DBG_SRC ? WS_Z : WS_BUFA));
        for (size_t i = (size_t)bx * 512 + F.tid; i < (size_t)T_TOK * DM / 2; i += (size_t)F.G * 512) { const size_t row_ = (2 * i) >> 10, col_ = (2 * i) & 1023; const unsigned u = DBG_SRC ? *(const unsigned*)(src + row_ * NZ + DBG_ZC + col_) : ((const unsigned*)src)[i]; const int col = (int)((2 * i) & 1023); const bool on = (col >= DBG_C0 && col < DBG_C1); args.out[2 * i] = on ? bf_lo(u) : 0.f; args.out[2 * i + 1] = on ? bf_hi(u) : 0.f; }
    }
#undef IN
#undef SEAM
}

#ifndef MK_N_LAUNCHES
#define MK_N_LAUNCHES 1
#endif
extern "C" void kernel_launch(void* const* d_in, const int* in_sizes, int n_in, void* d_out, int out_size, void* d_ws, size_t ws_size, hipStream_t stream) {
    static int grid = 0;
    if (grid == 0) {
        if (n_in != 26 || out_size != T_TOK * DM || ws_size < WS_END + 34 * MiB) { fprintf(stderr, "kernel_launch: unexpected shapes (n_in %d out %d ws %zu)\n", n_in, out_size, ws_size); grid = -1; return; }
        int dev = 0, cus = 0, per_cu = 0;
        hipGetDevice(&dev); hipDeviceGetAttribute(&cus, hipDeviceAttributeMultiprocessorCount, dev);
        if (hipFuncSetAttribute((const void*)mk_fwd, hipFuncAttributeMaxDynamicSharedMemorySize, LDS_BYTES) != hipSuccess) { fprintf(stderr, "kernel_launch: hipFuncSetAttribute failed\n"); grid = -1; return; }
        if (hipOccupancyMaxActiveBlocksPerMultiprocessor(&per_cu, (const void*)mk_fwd, 512, LDS_BYTES) != hipSuccess || per_cu < 1) { fprintf(stderr, "kernel_launch: occupancy query says %d\n", per_cu); per_cu = 1; }
        (void)hipGetLastError();
        grid = cus;
    }
    if (grid < 0) return;
    hipMemsetAsync((char*)d_ws + WS_CTL, 0, CTL_BYTES, stream);
    Args a{};
    for (int i = 0; i < 26; ++i) a.in[i] = (const float*)d_in[i];
    a.out = (float*)d_out; a.ws = (unsigned char*)d_ws;
    if (MK_N_LAUNCHES == 1) {
        a.ph_lo = 0; a.ph_hi = 9;
        void* kargs[] = {&a};
#if USE_COOP_LAUNCH
        hipError_t e = hipLaunchCooperativeKernel((const void*)mk_fwd, dim3(grid), dim3(512), kargs, LDS_BYTES, stream);
        if (e != hipSuccess) fprintf(stderr, "cooperative launch failed: %s (grid %d)\n", hipGetErrorString(e), grid);
#else
        (void)kargs; hipLaunchKernelGGL(mk_fwd, dim3(grid), dim3(512), LDS_BYTES, stream, a);
#endif
    } else {
#ifndef DBG_STOP
#define DBG_STOP 9
#endif
#ifndef DBG_DUMP
#define DBG_DUMP 0
#endif
        for (int p = 0; p < DBG_STOP; ++p) { a.ph_lo = p; a.ph_hi = p + 1; hipLaunchKernelGGL(mk_fwd, dim3(grid), dim3(512), LDS_BYTES, stream, a); }
        if (DBG_DUMP) { a.ph_lo = 9; a.ph_hi = 10; hipLaunchKernelGGL(mk_fwd, dim3(grid), dim3(512), LDS_BYTES, stream, a); }
    }
}
```

```cpp
#include <hip/hip_runtime.h>
#include <hip/hip_cooperative_groups.h>
#include <cstdio>
#include <cstdint>
namespace cg = cooperative_groups;

#define GAS __attribute__((address_space(1)))
#define LAS __attribute__((address_space(3)))
typedef unsigned short bf16_t;
typedef short bf16x8 __attribute__((ext_vector_type(8)));
typedef short s16x4 __attribute__((ext_vector_type(4)));
typedef float f32x4 __attribute__((ext_vector_type(4)));
typedef float f32x2 __attribute__((ext_vector_type(2)));
typedef float f32x16 __attribute__((ext_vector_type(16)));
typedef unsigned u32x4 __attribute__((ext_vector_type(4)));
typedef unsigned u32x2 __attribute__((ext_vector_type(2)));
typedef int i32x4 __attribute__((ext_vector_type(4)));

constexpr int T_TOK = 32768, DM = 1024, NB = 16, SEQ = 2048, NZ = 3584, INW = 3592, MEML = 256, TMEM = NB * MEML;
constexpr float EPS = 1e-6f;
constexpr float LOG2E = 1.4426950408889634f;
constexpr int ZC_MLQ = 0, ZC_MLK = 512, ZC_MLV = 1024, ZC_MLO = 1536, ZC_DAQ = 2048, ZC_DAK = 2560, ZC_DAV = 3072;

constexpr size_t MiB = 1u << 20;
constexpr size_t WS_CTL = 0, CTL_BYTES = 1 * MiB;
constexpr size_t WS_WIN = 1 * MiB, WS_WOUT = 8 * MiB, WS_WCQ = 10 * MiB, WS_WKV = 12 * MiB, WS_WCO = 16 * MiB, WS_WPQ = 18 * MiB, WS_SK = 20 * MiB;
constexpr size_t WS_GATES = 21 * MiB, WS_MEMN = 22 * MiB, WS_KV = 30 * MiB, WS_MB = 46 * MiB, WS_VWB = 78 * MiB;
constexpr size_t WS_BUFA = 110 * MiB, WS_BUFB = 174 * MiB, WS_Z = 238 * MiB, WS_END = 462 * MiB;
constexpr int CW_Q2 = 64;
constexpr int CW_RSS1 = 16384;
constexpr int CW_WSC = 49152;
constexpr int CW_RSS2 = 65536;
constexpr int CW_HSC = 98304;
constexpr int CW_BAR = 131072;
constexpr int CW_DUMMY = 180224;

constexpr int LDS_BYTES = 147456;
constexpr int XCH_OFF = 131072;
constexpr int MISC_OFF = LDS_BYTES - 256;

__device__ __forceinline__ unsigned cvt_pk_bf16(float lo, float hi) { unsigned r; asm("v_cvt_pk_bf16_f32 %0, %1, %2" : "=v"(r) : "v"(lo), "v"(hi)); return r; }
__device__ __forceinline__ float bf_lo(unsigned u) { return __uint_as_float(u << 16); }
__device__ __forceinline__ float bf_hi(unsigned u) { return __uint_as_float(u & 0xffff0000u); }
__device__ __forceinline__ float wave_sum(float v) {
#pragma unroll
    for (int o = 1; o < 64; o <<= 1) v += __shfl_xor(v, o);
    return v;
}
__device__ __forceinline__ float fast_exp2(float x) { return __builtin_amdgcn_exp2f(x); }
__device__ __forceinline__ float fast_rcp(float x) { return __builtin_amdgcn_rcpf(x); }
#define LDS_WAIT() asm volatile("s_waitcnt lgkmcnt(0)" ::: "memory")
#define VM_WAIT() asm volatile("s_waitcnt vmcnt(0)" ::: "memory")

namespace pg8 {
constexpr int BM = 256, BK = 64, HALF = 128, HTB = HALF * BK * 2, STAGE_BYTES = 8 * HTB;
__device__ __forceinline__ int lds_byte(int r, int c) { const int st = (r >> 4) * 2 + (c >> 5), rr = r & 15, cc = c & 31, ob = rr * 64 + cc * 2; return st * 1024 + (ob ^ (((ob >> 9) & 1) << 5)); }
__device__ __forceinline__ void stage_rc(int b, int& R, int& C) { const int st = b / 1024, sb = b % 1024, swz = sb ^ (((sb >> 9) & 1) << 5); R = (st >> 1) * 16 + swz / 64; C = (st & 1) * 32 + (swz % 64) / 2; }
__device__ __forceinline__ int perm32(int rho) { const int n = rho >> 4, i = rho & 15; return 8 * (i >> 2) + 4 * n + (i & 3); }

struct Unit { const char* A; const char* B; char* O; int row0, col0, scol; };

template <class Epi, class Sched, bool I8 = false>
__device__ __forceinline__ void gemm_phase(LAS unsigned char* lds, const int K, const int lda, const int ldb, const Sched& S, const Epi& E) {
    int tid_l = threadIdx.x; asm volatile("" : "+v"(tid_l));
    const int tid = tid_l, wid = __builtin_amdgcn_readfirstlane(tid >> 6), lane = tid & 63, wr = wid >> 2, wc = wid & 3, fr = lane & 15, fq = lane >> 4;
    const int nt = K / BK;
    unsigned voffA[2], voffB[2];
#pragma unroll
    for (int i = 0; i < 2; ++i) { int R, C; stage_rc(tid * 16 + i * 8192, R, C); const int Rb = Epi::PERM ? ((R & ~31) + perm32(R & 31)) : R;
        voffA[i] = (unsigned)(R * lda + C) * 2u; voffB[i] = (unsigned)(Rb * ldb + C) * 2u; }
    const size_t kstep = (size_t)(BK * 2);
    const size_t hstepA = (size_t)HALF * lda * 2, hstepB = (size_t)HALF * ldb * 2;
    const unsigned ldsw = (unsigned)wid * 1024u;
    const int aoff = lds_byte(wr * 64 + fr, fq * 8), boff = lds_byte(wc * 32 + fr, fq * 8);
#define PG8_SA(b, h) (((b) * 2 + (h)) * HTB)
#define PG8_SB(b, h) ((4 + (b) * 2 + (h)) * HTB)
#define PG8_STAGE(bufoff, gbase, voff) do { _Pragma("unroll") for (int _i = 0; _i < 2; ++_i) \
        __builtin_amdgcn_global_load_lds((const unsigned*)((const char*)(gbase) + (voff)[_i]), (LAS unsigned*)(lds + (bufoff) + ldsw + _i * 8192), 16, 0, 0); } while (0)
#define PG8_LDA(dst, b, h) do { _Pragma("unroll") for (int m = 0; m < 4; ++m) _Pragma("unroll") for (int k = 0; k < 2; ++k) dst[m][k] = *(const LAS bf16x8*)(lds + PG8_SA(b, h) + aoff + m * 2048 + k * 1024); } while (0)
#define PG8_LDB(dst, b, h) do { _Pragma("unroll") for (int n = 0; n < 2; ++n) _Pragma("unroll") for (int k = 0; k < 2; ++k) dst[n][k] = *(const LAS bf16x8*)(lds + PG8_SB(b, h) + boff + n * 2048 + k * 1024); } while (0)
#define PG8_MMA(ai, bj, At, Bt) do { __builtin_amdgcn_s_setprio(1); _Pragma("unroll") for (int m = 0; m < 4; ++m) _Pragma("unroll") for (int n = 0; n < 2; ++n) _Pragma("unroll") for (int k = 0; k < 2; ++k) \
        { if (I8) acc[ai][bj][m][n] = __builtin_bit_cast(f32x4, __builtin_amdgcn_mfma_i32_16x16x64_i8(__builtin_bit_cast(i32x4, Bt[n][k]), __builtin_bit_cast(i32x4, At[m][k]), __builtin_bit_cast(i32x4, acc[ai][bj][m][n]), 0, 0, 0)); \
          else acc[ai][bj][m][n] = __builtin_amdgcn_mfma_f32_16x16x32_bf16(Bt[n][k], At[m][k], acc[ai][bj][m][n], 0, 0, 0); } __builtin_amdgcn_s_setprio(0); } while (0)
#define PG8_WAIT_V(n) asm volatile("s_waitcnt vmcnt(" #n ")" ::: "memory")
#define PG8_WAIT_L(n) asm volatile("s_waitcnt lgkmcnt(" #n ")" ::: "memory")
#define PG8_BAR __builtin_amdgcn_s_barrier()
#define PG8_SCHED __builtin_amdgcn_sched_barrier(0)
    Unit cur, nxt; int ui = 0;
    if (!S.next(0, cur)) return;
    f32x4 acc[2][2][4][2];
#pragma unroll
    for (int a = 0; a < 2; ++a)
#pragma unroll
        for (int b = 0; b < 2; ++b)
#pragma unroll
            for (int m = 0; m < 4; ++m)
#pragma unroll
                for (int n = 0; n < 2; ++n) acc[a][b][m][n] = (f32x4){0.f, 0.f, 0.f, 0.f};
    bf16x8 At[4][2], B0[2][2], B1[2][2];
    const char* cA = cur.A; const char* cB = cur.B;
    PG8_STAGE(PG8_SB(0, 0), cB, voffB); PG8_STAGE(PG8_SA(0, 0), cA, voffA); PG8_STAGE(PG8_SB(0, 1), cB + hstepB, voffB); PG8_STAGE(PG8_SA(0, 1), cA + hstepA, voffA);
    if (wr == 1) PG8_BAR;
    PG8_WAIT_V(4); PG8_BAR;
    PG8_STAGE(PG8_SB(1, 0), cB + kstep, voffB); PG8_STAGE(PG8_SA(1, 0), cA + kstep, voffA); PG8_STAGE(PG8_SB(1, 1), cB + hstepB + kstep, voffB);
    PG8_WAIT_V(6); PG8_BAR;
    for (;;) {
        const bool has_next = S.next(ui + 1, nxt);
        const char* nA = has_next ? nxt.A : cA; const char* nB = has_next ? nxt.B : cB;
        for (int t = 0; t < nt; t += 2) {
            const bool last = (t == nt - 2);
            const char* a1 = cA + (size_t)(t + 1) * kstep;
            const char* a2 = last ? nA : cA + (size_t)(t + 2) * kstep; const char* b2 = last ? nB : cB + (size_t)(t + 2) * kstep;
            const char* a3 = a2 + kstep; const char* b3 = b2 + kstep;
            PG8_LDB(B0, 0, 0); PG8_SCHED; PG8_LDA(At, 0, 0); PG8_STAGE(PG8_SA(1, 1), a1 + hstepA, voffA);
            PG8_WAIT_L(8); PG8_BAR; PG8_WAIT_L(0); PG8_MMA(0, 0, At, B0); PG8_BAR; PG8_SCHED;
            PG8_LDB(B1, 0, 1); PG8_STAGE(PG8_SB(0, 0), b2, voffB);
            PG8_BAR; PG8_WAIT_L(0); PG8_MMA(0, 1, At, B1); PG8_BAR;
            PG8_LDA(At, 0, 1); PG8_STAGE(PG8_SA(0, 0), a2, voffA);
            PG8_BAR; PG8_WAIT_L(0); PG8_MMA(1, 0, At, B0); PG8_BAR; PG8_SCHED;
            PG8_STAGE(PG8_SB(0, 1), b2 + hstepB, voffB);
            PG8_WAIT_V(6); PG8_BAR; PG8_MMA(1, 1, At, B1); PG8_BAR;
            PG8_LDB(B0, 1, 0); PG8_SCHED; PG8_LDA(At, 1, 0); PG8_STAGE(PG8_SA(0, 1), a2 + hstepA, voffA);
            PG8_WAIT_L(8); PG8_BAR; PG8_WAIT_L(0); PG8_MMA(0, 0, At, B0); PG8_BAR; PG8_SCHED;
            PG8_LDB(B1, 1, 1); PG8_STAGE(PG8_SB(1, 0), b3, voffB);
            PG8_BAR; PG8_WAIT_L(0); PG8_MMA(0, 1, At, B1); PG8_BAR;
            PG8_LDA(At, 1, 1); PG8_STAGE(PG8_SA(1, 0), a3, voffA);
            PG8_BAR; PG8_WAIT_L(0); PG8_MMA(1, 0, At, B0); PG8_BAR; PG8_SCHED;
            PG8_STAGE(PG8_SB(1, 1), b3 + hstepB, voffB);
            PG8_WAIT_V(6); PG8_BAR; PG8_MMA(1, 1, At, B1); PG8_BAR;
        }
        if (I8) {
#pragma unroll
            for (int a = 0; a < 2; ++a)
#pragma unroll
                for (int b = 0; b < 2; ++b)
#pragma unroll
                    for (int m = 0; m < 4; ++m)
#pragma unroll
                        for (int n = 0; n < 2; ++n)
#pragma unroll
                            for (int e = 0; e < 4; ++e) acc[a][b][m][n][e] = (float)__float_as_int(acc[a][b][m][n][e]);
        }
        if (!E.skip()) E(acc, cur, wr, wc, fr, fq, lds);
        else {
#pragma unroll
            for (int a = 0; a < 2; ++a)
#pragma unroll
                for (int b = 0; b < 2; ++b)
#pragma unroll
                    for (int m = 0; m < 4; ++m)
#pragma unroll
                        for (int n = 0; n < 2; ++n) asm volatile("" :: "v"(acc[a][b][m][n]));
        }
        if (!has_next) break;
#pragma unroll
        for (int a = 0; a < 2; ++a)
#pragma unroll
            for (int b = 0; b < 2; ++b)
#pragma unroll
                for (int m = 0; m < 4; ++m)
#pragma unroll
                    for (int n = 0; n < 2; ++n) acc[a][b][m][n] = (f32x4){0.f, 0.f, 0.f, 0.f};
        cur = nxt; cA = nA; cB = nB; ++ui;
    }
    PG8_WAIT_V(0);
    if (wr == 0) PG8_BAR;
    PG8_BAR;
#undef PG8_SA
#undef PG8_SB
#undef PG8_STAGE
#undef PG8_LDA
#undef PG8_LDB
#undef PG8_MMA
#undef PG8_WAIT_V
#undef PG8_WAIT_L
#undef PG8_BAR
#undef PG8_SCHED
}

struct Sched {
    int mode, nM, nN, nwg, G, c, tpb; const char* baseA; const char* baseB; char* baseO; size_t strideA, strideB, bstrideB; int ldo_bytes_per_el;
    __device__ __forceinline__ bool next(int i, Unit& u) const {
        const long L = (long)i * G + c; if (L >= nwg) return false;
        if (mode == 0) {
            int wgid = (int)L; { const int q = nwg / 8, r = nwg % 8, xcd = wgid % 8, off = wgid / 8; wgid = (xcd < r ? xcd * (q + 1) : r * (q + 1) + (xcd - r) * q) + off; }
            const int nig = 8 * nN, gid = wgid / nig, fm = gid * 8, gsz = (nM - fm) < 8 ? (nM - fm) : 8;
            const int pm = fm + ((wgid % nig) % gsz), pn = (wgid % nig) / gsz;
            u.A = baseA + (size_t)pm * strideA; u.B = baseB + (size_t)pn * strideB + (size_t)(pm / tpb) * bstrideB; u.O = baseO; u.row0 = pm * 256; u.col0 = pn * 256; u.scol = pn * 256;
        } else if (mode == 1) {
            const int l = (int)L, b = l >> 4, h = (l >> 2) & 3, kt = l & 3;
            u.A = baseA + ((size_t)(b * 256) * 2048 + h * 256) * 2; u.B = baseB + ((size_t)(kt * 256) * 1024 + h * 256) * 2;
            u.O = baseO + ((size_t)b * 1048576 + (size_t)(h * 256) * 1024 + kt * 256) * 2; u.row0 = 0; u.col0 = 0; u.scol = kt * 256;
        } else {
            const int l = (int)L, b = l >> 4, h = (l >> 2) & 3, ntile = l & 3;
            u.A = baseA + ((size_t)(ntile * 256) * 1024 + h * 256) * 2; u.B = baseB + ((size_t)(b * 256) * 2048 + 1024 + h * 256) * 2;
            u.O = baseO + ((size_t)b * 1048576 + (size_t)(ntile * 256) * 1024 + h * 256) * 2; u.row0 = 0; u.col0 = 0; u.scol = 0;
        }
        return true;
    }
};

struct EpiBf16 {
    static constexpr bool PERM = true;
    int ldc; float scale; const float* rss; const float* colscale; const float* rowscale; int probe;
    __device__ __forceinline__ bool skip() const { return probe == 2; }
    __device__ __forceinline__ void operator()(const f32x4 (&acc)[2][2][4][2], const Unit& u, int wr, int wc, int fr, int fq, LAS unsigned char*) const {
        bf16_t* base = (bf16_t*)u.O;
        f32x4 cs[2][2];
#pragma unroll
        for (int bj = 0; bj < 2; ++bj)
#pragma unroll
            for (int n = 0; n < 2; ++n) cs[bj][n] = colscale ? *(const f32x4*)(colscale + u.scol + wc * 32 + 8 * fq + bj * HALF + 4 * n) : (f32x4){1.f, 1.f, 1.f, 1.f};
        float scv[2][4];
#pragma unroll
        for (int ai = 0; ai < 2; ++ai)
#pragma unroll
            for (int m = 0; m < 4; ++m) { const int row = u.row0 + ai * HALF + wr * 64 + m * 16 + fr;
                float sc = scale; if (rss) sc *= rsqrtf(rss[row] * (1.0f / 1024.0f) + EPS); if (rowscale) sc *= rowscale[row]; scv[ai][m] = sc; }
        asm volatile("" ::: "memory");
#pragma unroll
        for (int ai = 0; ai < 2; ++ai)
#pragma unroll
            for (int m = 0; m < 4; ++m) {
                const int row = u.row0 + ai * HALF + wr * 64 + m * 16 + fr;
                const float sc = scv[ai][m];
                bf16_t* rowp = probe ? base + (size_t)blockIdx.x * 32768 + (row & 127) * 256 + wc * 32 + 8 * fq : base + (size_t)row * ldc + u.col0 + wc * 32 + 8 * fq;
#pragma unroll
                for (int bj = 0; bj < 2; ++bj) { const f32x4 v0 = acc[ai][bj][m][0] * sc * cs[bj][0], v1 = acc[ai][bj][m][1] * sc * cs[bj][1];
                    u32x4 w; w.x = cvt_pk_bf16(v0[0], v0[1]); w.y = cvt_pk_bf16(v0[2], v0[3]); w.z = cvt_pk_bf16(v1[0], v1[1]); w.w = cvt_pk_bf16(v1[2], v1[3]);
                    *(u32x4*)(rowp + bj * HALF) = w; } }
    }
};
struct EpiResid {
    static constexpr bool PERM = false;
    const float* base; float* out; bf16_t* xg; const float* g; float* rss;
    __device__ __forceinline__ void operator()(const f32x4 (&acc)[2][2][4][2], const Unit& u, int wr, int wc, int fr, int fq, LAS unsigned char*) const {
        const int colb = u.col0 + wc * 32 + 4 * fq;
#pragma unroll
        for (int ai = 0; ai < 2; ++ai)
#pragma unroll
            for (int m = 0; m < 4; ++m) {
                const int row = u.row0 + ai * HALF + wr * 64 + m * 16 + fr; const size_t off = (size_t)row * DM + colb; float ss = 0.f;
#pragma unroll
                for (int bj = 0; bj < 2; ++bj)
#pragma unroll
                    for (int n = 0; n < 2; ++n) { const int co = bj * HALF + n * 16;
                        const f32x4 bs = *(const f32x4*)(base + off + co); const f32x4 v = bs + acc[ai][bj][m][n];
                        *(f32x4*)(out + off + co) = v; const f32x4 gv = *(const f32x4*)(g + colb + co); const f32x4 w = v * gv;
                        u32x2 pk; pk.x = cvt_pk_bf16(w[0], w[1]); pk.y = cvt_pk_bf16(w[2], w[3]); *(u32x2*)(xg + off + co) = pk;
                        ss += (v[0] * v[0] + v[1] * v[1]) + (v[2] * v[2] + v[3] * v[3]); }
                ss += __shfl_xor(ss, 16); ss += __shfl_xor(ss, 32);
                if (fq == 0) atomicAdd(rss + row, ss);
                asm volatile("" ::: "memory"); }
    }
};
template <bool BASE_BF16>
struct EpiResidB {
    static constexpr bool PERM = false;
    const void* base; bf16_t* out; float* rss;
    __device__ __forceinline__ bool skip() const { return false; }
    __device__ __forceinline__ void load_raw(f32x4 (&raw)[2][2], const size_t off) const {
#pragma unroll
        for (int bj = 0; bj < 2; ++bj)
#pragma unroll
            for (int n = 0; n < 2; ++n) { const int co = bj * HALF + n * 16;
                if (BASE_BF16) { const u32x2 b2 = *(const u32x2*)((const bf16_t*)base + off + co); raw[bj][n] = (f32x4){__uint_as_float(b2.x), __uint_as_float(b2.y), 0.f, 0.f}; }
                else raw[bj][n] = *(const f32x4*)((const float*)base + off + co); }
    }
    __device__ __forceinline__ void operator()(const f32x4 (&acc)[2][2][4][2], const Unit& u, int wr, int wc, int fr, int fq, LAS unsigned char*) const {
        const int colb = u.col0 + wc * 32 + 4 * fq;
        const int rowb = u.row0 + wr * 64 + fr;
        f32x4 cur[2][2], nxt[2][2];
        load_raw(cur, (size_t)rowb * DM + colb);
#pragma unroll
        for (int it = 0; it < 8; ++it) {
            const int ai = it >> 2, m = it & 3;
            const int row = rowb + ai * HALF + m * 16; const size_t off = (size_t)row * DM + colb; float ss = 0.f;
            if (it + 1 < 8) load_raw(nxt, (size_t)(rowb + ((it + 1) >> 2) * HALF + ((it + 1) & 3) * 16) * DM + colb);
            asm volatile("" ::: "memory");
#pragma unroll
            for (int bj = 0; bj < 2; ++bj)
#pragma unroll
                for (int n = 0; n < 2; ++n) { const int co = bj * HALF + n * 16;
                    f32x4 bs;
                    if (BASE_BF16) { const unsigned bx_ = __float_as_uint(cur[bj][n].x), by_ = __float_as_uint(cur[bj][n].y); bs = (f32x4){bf_lo(bx_), bf_hi(bx_), bf_lo(by_), bf_hi(by_)}; } else bs = cur[bj][n];
                    const f32x4 v = bs + acc[ai][bj][m][n];
                    u32x2 pk; pk.x = cvt_pk_bf16(v[0], v[1]); pk.y = cvt_pk_bf16(v[2], v[3]); *(u32x2*)(out + off + co) = pk;
                    ss += (v[0] * v[0] + v[1] * v[1]) + (v[2] * v[2] + v[3] * v[3]); }
            ss += __shfl_xor(ss, 16); ss += __shfl_xor(ss, 32);
            if (fq == 0) atomicAdd(rss + row, ss);
            asm volatile("" ::: "memory");
#pragma unroll
            for (int bj = 0; bj < 2; ++bj)
#pragma unroll
                for (int n = 0; n < 2; ++n) cur[bj][n] = nxt[bj][n];
        }
    }
};
struct EpiSoftmax {
    static constexpr bool PERM = true;
    const float* rss; bf16_t* P;
    __device__ __forceinline__ bool skip() const { return false; }
    __device__ __forceinline__ void operator()(f32x4 (&acc)[2][2][4][2], const Unit& u, int wr, int wc, int fr, int fq, LAS unsigned char* lds) const {
        LAS f32x2* X = (LAS f32x2*)(lds + XCH_OFF);
        float ml[2][4];
#pragma unroll
        for (int ai = 0; ai < 2; ++ai)
#pragma unroll
            for (int m = 0; m < 4; ++m) {
                const int r = ai * HALF + wr * 64 + m * 16 + fr;
                const float sc = rsqrtf(rss[u.row0 + r] * (1.0f / 1024.0f) + EPS) * LOG2E;
                float mx = -3.0e38f;
#pragma unroll
                for (int bj = 0; bj < 2; ++bj)
#pragma unroll
                    for (int n = 0; n < 2; ++n) { f32x4 v = acc[ai][bj][m][n] * sc; acc[ai][bj][m][n] = v; mx = fmaxf(mx, fmaxf(fmaxf(v[0], v[1]), fmaxf(v[2], v[3]))); }
                mx = fmaxf(mx, __shfl_xor(mx, 16)); mx = fmaxf(mx, __shfl_xor(mx, 32));
                float sm = 0.f;
#pragma unroll
                for (int bj = 0; bj < 2; ++bj)
#pragma unroll
                    for (int n = 0; n < 2; ++n) { f32x4 v = acc[ai][bj][m][n]; v[0] = fast_exp2(v[0] - mx); v[1] = fast_exp2(v[1] - mx); v[2] = fast_exp2(v[2] - mx); v[3] = fast_exp2(v[3] - mx);
                        acc[ai][bj][m][n] = v; sm += (v[0] + v[1]) + (v[2] + v[3]); }
                sm += __shfl_xor(sm, 16); sm += __shfl_xor(sm, 32);
                ml[ai][m] = mx;
                if (fq == 0) X[r * 4 + wc] = (f32x2){mx, sm};
            }
        LDS_WAIT(); __builtin_amdgcn_s_barrier(); asm volatile("" ::: "memory");
#pragma unroll
        for (int ai = 0; ai < 2; ++ai)
#pragma unroll
            for (int m = 0; m < 4; ++m) {
                const int r = ai * HALF + wr * 64 + m * 16 + fr;
                const f32x2 a = X[r * 4 + 0], b = X[r * 4 + 1], c = X[r * 4 + 2], d = X[r * 4 + 3];
                const float mg = fmaxf(fmaxf(a.x, b.x), fmaxf(c.x, d.x));
                const float lg = a.y * fast_exp2(a.x - mg) + b.y * fast_exp2(b.x - mg) + c.y * fast_exp2(c.x - mg) + d.y * fast_exp2(d.x - mg);
                const float f = fast_exp2(ml[ai][m] - mg) / lg;
                bf16_t* rowp = P + (size_t)(u.row0 + r) * DM + u.col0 + wc * 32 + 8 * fq;
#pragma unroll
                for (int bj = 0; bj < 2; ++bj) { const f32x4 v0 = acc[ai][bj][m][0] * f, v1 = acc[ai][bj][m][1] * f;
                    u32x4 w; w.x = cvt_pk_bf16(v0[0], v0[1]); w.y = cvt_pk_bf16(v0[2], v0[3]); w.z = cvt_pk_bf16(v1[0], v1[1]); w.w = cvt_pk_bf16(v1[2], v1[3]);
                    *(u32x4*)(rowp + bj * HALF) = w; } }
        LDS_WAIT();
    }
};
}
struct Args { const float* in[26]; float* out; unsigned char* ws; int ph_lo, ph_hi; };
enum { I_X = 0, I_MEM, I_GMIX, I_WIN, I_CONVW, I_BI, I_BF, I_GML, I_LQ1, I_LK1, I_LQ2, I_LK2, I_GDA, I_WOUT, I_GCA, I_GMEM, I_WCQ, I_WCK, I_WCV, I_WCO, I_GFFN, I_WPQ, I_SUBK, I_PU, I_PV, I_GFIN };

struct Frame {
    LAS unsigned char* lds;
    int tid, lane, wave, G, vcu;
    const Args* a;
    unsigned char* ws;
    unsigned* ctl;
};


#define XB_TMO      128
#define XB_XCNT(j)  (256  + 64 * (j))
#define XB_XSUB(j)  (1280 + 64 * (j))
#define XB_XGEN(j)  (2304 + 64 * (j))
#define XB_TOP      3328
#define XB_TOPGEN   3392
#define XCD_BAR_WORDS 3456
#define XB_SPIN_CAP (1u << 18)
__device__ __forceinline__ unsigned xb_ld(unsigned* p)              { return __hip_atomic_load(p, __ATOMIC_RELAXED, __HIP_MEMORY_SCOPE_AGENT); }
__device__ __forceinline__ unsigned xb_add(unsigned* p, unsigned v) { return __hip_atomic_fetch_add(p, v, __ATOMIC_RELAXED, __HIP_MEMORY_SCOPE_AGENT); }
__device__ __forceinline__ unsigned xb_xcc_id() { return (unsigned)__builtin_amdgcn_s_getreg((3 << 11) | 20) & 0xFu; }
#define XB_SPIN(cond, bar) do { unsigned _sp = 0; while (cond) { __builtin_amdgcn_s_sleep(1); \
    if ((++_sp & 255u) == 0u) { if (xb_ld(&(bar)[XB_TMO])) break; if (_sp > XB_SPIN_CAP) { atomicAdd(&(bar)[XB_TMO], 1u); break; } } } } while (0)
struct XcdBarrier { unsigned* bar; unsigned x; volatile LAS unsigned* st; };
__device__ __forceinline__ XcdBarrier xcd_barrier_post(unsigned* bar, volatile LAS unsigned* st) {
    XcdBarrier b; b.bar = bar; b.x = xb_xcc_id(); b.st = st;
    if (threadIdx.x == 0) (void)xb_add(&bar[XB_XCNT(b.x)], 1u);
    return b;
}
__device__ __forceinline__ void xcd_barrier_complete(unsigned* bar, unsigned x, unsigned& nloc, unsigned& nx) {
    const unsigned G = gridDim.x * gridDim.y * gridDim.z;
    unsigned sum, cnt, mine, sp = 0u;
    for (;;) {
        sum = 0u; cnt = 0u; mine = 0u;
#pragma unroll
        for (unsigned j = 0; j < 16; ++j) { const unsigned c = xb_ld(&bar[XB_XCNT(j)]); sum += c; cnt += (c > 0u) ? 1u : 0u; mine = (j == x) ? c : mine; }
        if (sum == G) break;
        __builtin_amdgcn_s_sleep(1);
        if ((++sp & 255u) == 0u) { if (xb_ld(&bar[XB_TMO])) break; if (sp > XB_SPIN_CAP) { atomicAdd(&bar[XB_TMO], 1u); break; } }
    }
    nloc = mine > 0u ? mine : 1u; nx = cnt > 0u ? cnt : 1u;
}
__device__ __forceinline__ void xcd_barrier(const XcdBarrier& b) {
    asm volatile("s_waitcnt vmcnt(0)" ::: "memory");
    __syncthreads();
    if (threadIdx.x == 0) {
        unsigned* bar = b.bar;
        __builtin_amdgcn_s_waitcnt(0);
        unsigned nloc = b.st[0], nx = b.st[1];
        if (nloc == 0u) { xcd_barrier_complete(bar, b.x, nloc, nx); b.st[0] = nloc; b.st[1] = nx; }
        const unsigned old = xb_add(&bar[XB_XSUB(b.x)], 1u);
        const unsigned gen = old / nloc;
        if (old + 1u == (gen + 1u) * nloc) {
            __builtin_amdgcn_fence(__ATOMIC_RELEASE, "agent");
            asm volatile("s_waitcnt vmcnt(0)" ::: "memory");
            const unsigned og = xb_add(&bar[XB_TOP], 1u);
            const unsigned tg = og / nx;
            if (og + 1u == (tg + 1u) * nx) xb_add(&bar[XB_TOPGEN], 1u);
            else XB_SPIN(xb_ld(&bar[XB_TOPGEN]) == tg, bar);
            __builtin_amdgcn_fence(__ATOMIC_ACQUIRE, "agent");
            xb_add(&bar[XB_XGEN(b.x)], 1u);
            asm volatile("s_waitcnt vmcnt(0)" ::: "memory");
        } else {
            XB_SPIN(xb_ld(&bar[XB_XGEN(b.x)]) == gen, bar);
            __builtin_amdgcn_fence(__ATOMIC_ACQUIRE, "agent");
            asm volatile("s_waitcnt vmcnt(0)" ::: "memory");
        }
    }
    __syncthreads();
}

__device__ __forceinline__ void p0_transpose_item(const float* W, int Nsrc, int K, int kb, int src_col0, bf16_t* WT, int dst_row0, LAS float* scr, int lane, const float* kscale = nullptr) {
    const int k0 = 64 * kb;
#pragma unroll 8
    for (int i = 0; i < 32; ++i) { const int kk = 2 * i + (lane >> 5); float wv = W[(size_t)(k0 + kk) * Nsrc + src_col0 + (lane & 31)]; if (kscale) wv *= kscale[k0 + kk]; scr[kk * 33 + (lane & 31)] = wv; }
    LDS_WAIT(); asm volatile("" ::: "memory");
    const int c = lane & 7;
#pragma unroll
    for (int j = 0; j < 4; ++j) { const int n = (lane >> 3) + 8 * j; const LAS float* s = scr + (8 * c) * 33 + n;
        u32x4 o; o.x = cvt_pk_bf16(s[0 * 33], s[1 * 33]); o.y = cvt_pk_bf16(s[2 * 33], s[3 * 33]); o.z = cvt_pk_bf16(s[4 * 33], s[5 * 33]); o.w = cvt_pk_bf16(s[6 * 33], s[7 * 33]);
        *(u32x4*)(WT + (size_t)(dst_row0 + n) * K + k0 + 8 * c) = o; }
    LDS_WAIT(); asm volatile("" ::: "memory");
}
__device__ __forceinline__ void rms_row_to_bf16(const float* xrow, const float* g, bf16_t* orow, int lane, f32x4 (&v)[4]) {
    const f32x4* xr = (const f32x4*)xrow + lane; float s = 0.f;
#pragma unroll
    for (int j = 0; j < 4; ++j) { v[j] = xr[64 * j]; s += (v[j].x * v[j].x + v[j].y * v[j].y) + (v[j].z * v[j].z + v[j].w * v[j].w); }
    const float rstd = rsqrtf(wave_sum(s) * (1.f / DM) + EPS);
    u32x2* o8 = (u32x2*)orow + lane;
#pragma unroll
    for (int j = 0; j < 4; ++j) { const f32x4 gv = *((const f32x4*)g + lane + 64 * j); v[j] = v[j] * rstd * gv; u32x2 pk; pk.x = cvt_pk_bf16(v[j].x, v[j].y); pk.y = cvt_pk_bf16(v[j].z, v[j].w); o8[64 * j] = pk; }
}

__device__ __forceinline__ float rms_row_to_i8(const float* xrow, const float* g, unsigned char* orow, int lane, f32x4 (&v)[4]) {
    const f32x4* xr = (const f32x4*)xrow + lane; float s = 0.f;
#pragma unroll
    for (int j = 0; j < 4; ++j) { v[j] = xr[64 * j]; s += (v[j].x * v[j].x + v[j].y * v[j].y) + (v[j].z * v[j].z + v[j].w * v[j].w); }
    const float rstd = rsqrtf(wave_sum(s) * (1.f / DM) + EPS);
    float mx = 0.f;
#pragma unroll
    for (int j = 0; j < 4; ++j) { const f32x4 gv = *((const f32x4*)g + lane + 64 * j); v[j] = v[j] * rstd * gv; mx = fmaxf(mx, fmaxf(fmaxf(fabsf(v[j].x), fabsf(v[j].y)), fmaxf(fabsf(v[j].z), fabsf(v[j].w)))); }
#pragma unroll
    for (int o = 32; o >= 1; o >>= 1) mx = fmaxf(mx, __shfl_xor(mx, o));
    const float qs = (mx > 0.f) ? 127.0f / mx : 0.f;
    unsigned* o4 = (unsigned*)orow + lane;
#pragma unroll
    for (int j = 0; j < 4; ++j) { const int a = __float2int_rn(v[j].x * qs), b = __float2int_rn(v[j].y * qs), c = __float2int_rn(v[j].z * qs), d = __float2int_rn(v[j].w * qs);
        o4[64 * j] = (unsigned)(a & 255) | ((unsigned)(b & 255) << 8) | ((unsigned)(c & 255) << 16) | ((unsigned)(d & 255) << 24); }
    return mx * (1.0f / 127.0f);
}

__device__ __forceinline__ void p0_prologue(Frame& F) {
    const Args& A = *F.a;
    LAS float* scr = (LAS float*)(F.lds + F.wave * 8448);
    LAS float* sG = (LAS float*)(F.lds + 67584);
    for (int k = F.tid; k < DM; k += 512) { const f32x4 w0 = *(const f32x4*)(A.in[I_WIN] + (size_t)k * INW + 2048), w1 = *(const f32x4*)(A.in[I_WIN] + (size_t)k * INW + 2052);
        sG[0 * DM + k] = w0.x; sG[1 * DM + k] = w0.y; sG[2 * DM + k] = w0.z; sG[3 * DM + k] = w0.w; sG[4 * DM + k] = w1.x; sG[5 * DM + k] = w1.y; sG[6 * DM + k] = w1.z; sG[7 * DM + k] = w1.w; }
    __syncthreads();
    {
        LAS float* cmax = (LAS float*)(F.lds + 67584 + 32768);
        unsigned char* Win8 = (unsigned char*)(F.ws + WS_WIN); float* wsc = (float*)(F.ctl + CW_WSC);
        const int lane = F.lane, w = F.wave, nl = lane & 31, kh = lane >> 5;
        for (int strip = F.vcu; strip < NZ / 32; strip += F.G) {
            const int n0 = strip * 32, src0 = n0 + (n0 >= 2048 ? 8 : 0);
            const float* Wc = A.in[I_WIN] + src0 + nl;
            float mx = 0.f;
#pragma unroll 8
            for (int i = 0; i < 64; ++i) mx = fmaxf(mx, fabsf(Wc[(size_t)(128 * w + 2 * i + kh) * INW]));
            mx = fmaxf(mx, __shfl_xor(mx, 32));
            if (lane < 32) cmax[w * 32 + lane] = mx;
            __syncthreads();
            float cm = 0.f;
#pragma unroll
            for (int ww = 0; ww < 8; ++ww) cm = fmaxf(cm, cmax[ww * 32 + nl]);
            const float qs = (cm > 0.f) ? 127.0f / cm : 0.f;
            if (w == 0 && lane < 32) wsc[n0 + lane] = cm * (1.0f / 127.0f);
#pragma unroll 1
            for (int kb2 = 0; kb2 < 2; ++kb2) {
                const int k0 = 128 * w + 64 * kb2;
#pragma unroll 8
                for (int i = 0; i < 32; ++i) { const int kk = 2 * i + kh; scr[kk * 33 + nl] = Wc[(size_t)(k0 + kk) * INW] * qs; }
                LDS_WAIT(); asm volatile("" ::: "memory");
                const int c = lane & 3;
#pragma unroll
                for (int j = 0; j < 2; ++j) { const int n = (lane >> 2) + 16 * j; const LAS float* sp = scr + (16 * c) * 33 + n;
                    unsigned o[4];
#pragma unroll
                    for (int q = 0; q < 4; ++q) { const int a = __float2int_rn(sp[(4 * q + 0) * 33]), b = __float2int_rn(sp[(4 * q + 1) * 33]), cc = __float2int_rn(sp[(4 * q + 2) * 33]), d = __float2int_rn(sp[(4 * q + 3) * 33]);
                        o[q] = (unsigned)(a & 255) | ((unsigned)(b & 255) << 8) | ((unsigned)(cc & 255) << 16) | ((unsigned)(d & 255) << 24); }
                    *(u32x4*)(Win8 + (size_t)(n0 + n) * DM + k0 + 16 * c) = (u32x4){o[0], o[1], o[2], o[3]}; }
                LDS_WAIT(); asm volatile("" ::: "memory");
            }
            __syncthreads();
        }
    }
    const int gw = F.vcu * 8 + F.wave, NGW = F.G * 8;
    constexpr int KB = DM / 64;
    constexpr int I_SQ = KB * (DM / 32);
    constexpr int NITEMS = 5 * I_SQ;
    bf16_t* WoutT = (bf16_t*)(F.ws + WS_WOUT); bf16_t* WkvT = (bf16_t*)(F.ws + WS_WKV); bf16_t* WcoT = (bf16_t*)(F.ws + WS_WCO); bf16_t* WpqT = (bf16_t*)(F.ws + WS_WPQ);
    for (int it = gw; it < NITEMS; it += NGW) {
        int r = it;
        const int which = r / I_SQ; r -= which * I_SQ; const int kb = r / (DM / 32), n0 = (r % (DM / 32)) * 32;
        if (which == 0) p0_transpose_item(A.in[I_WOUT], DM, DM, kb, n0, WoutT, n0, scr, F.lane);
        else if (which == 1) p0_transpose_item(A.in[I_WCK], DM, DM, kb, n0, WkvT, n0, scr, F.lane);
        else if (which == 2) p0_transpose_item(A.in[I_WCV], DM, DM, kb, n0, WkvT, DM + n0, scr, F.lane);
        else if (which == 3) p0_transpose_item(A.in[I_WCO], DM, DM, kb, n0, WcoT, n0, scr, F.lane);
        else p0_transpose_item(A.in[I_WPQ], DM, DM, kb, n0, WpqT, n0, scr, F.lane, A.in[I_GFFN]);
    }
    {
        const int gt = F.vcu * 512 + F.tid, NT = F.G * 512;
        const f32x4* s0 = (const f32x4*)A.in[I_WCQ]; u32x2* d0 = (u32x2*)(F.ws + WS_WCQ);
        for (int i = gt; i < DM * DM / 4; i += NT) { const f32x4 v = s0[i]; u32x2 pk; pk.x = cvt_pk_bf16(v.x, v.y); pk.y = cvt_pk_bf16(v.z, v.w); d0[i] = pk; }
        const f32x4* s1 = (const f32x4*)A.in[I_SUBK]; u32x2* d1 = (u32x2*)(F.ws + WS_SK);
        for (int i = gt; i < 16 * 128 * 64 / 4; i += NT) { const f32x4 v = s1[i]; u32x2 pk; pk.x = cvt_pk_bf16(v.x, v.y); pk.y = cvt_pk_bf16(v.z, v.w); d1[i] = pk; }
    }
    {
        unsigned char* HN = (unsigned char*)(F.ws + WS_BUFA); float* GT = (float*)(F.ws + WS_GATES); float* hsc = (float*)(F.ctl + CW_HSC);
        for (int m = gw; m < T_TOK; m += NGW) {
            f32x4 v[4]; const float hs = rms_row_to_i8(A.in[I_X] + (size_t)m * DM, A.in[I_GMIX], HN + (size_t)m * DM, F.lane, v);
            if (F.lane == 0) hsc[m] = hs;
            float gacc[8];
#pragma unroll
            for (int j = 0; j < 8; ++j) gacc[j] = 0.f;
#pragma unroll
            for (int jj = 0; jj < 4; ++jj)
#pragma unroll
                for (int j = 0; j < 8; ++j) { const f32x4 wv = *(const LAS f32x4*)(sG + j * DM + 4 * F.lane + 256 * jj); gacc[j] += (v[jj].x * wv.x + v[jj].y * wv.y) + (v[jj].z * wv.z + v[jj].w * wv.w); }
            float r4[4], r2[2], r1;
            { const bool hi = (F.lane & 32) != 0;
#pragma unroll
              for (int i = 0; i < 4; ++i) { const float keep = hi ? gacc[i + 4] : gacc[i], send = hi ? gacc[i] : gacc[i + 4]; r4[i] = keep + __shfl_xor(send, 32); } }
            { const bool hi = (F.lane & 16) != 0;
#pragma unroll
              for (int i = 0; i < 2; ++i) { const float keep = hi ? r4[i + 2] : r4[i], send = hi ? r4[i] : r4[i + 2]; r2[i] = keep + __shfl_xor(send, 16); } }
            { const bool hi = (F.lane & 8) != 0; const float keep = hi ? r2[1] : r2[0], send = hi ? r2[0] : r2[1]; r1 = keep + __shfl_xor(send, 8); }
            r1 += __shfl_xor(r1, 4); r1 += __shfl_xor(r1, 2); r1 += __shfl_xor(r1, 1);
            if ((F.lane & 7) == 0) GT[(size_t)m * 8 + 4 * (F.lane >> 5) + 2 * ((F.lane >> 4) & 1) + ((F.lane >> 3) & 1)] = r1;
        }
        bf16_t* MN = (bf16_t*)(F.ws + WS_MEMN);
        for (int m = gw; m < TMEM; m += NGW) { f32x4 v[4]; rms_row_to_bf16(A.in[I_MEM] + (size_t)m * DM, A.in[I_GMEM], MN + (size_t)m * DM, F.lane, v); }
    }
}
#ifndef AT_DEPTH
#define AT_DEPTH 3
#endif
constexpr int AT_STAGE = 32768, AT_NST = 4;
__device__ __forceinline__ int swzf(int r) { return ((r & 3) << 2) | ((r >> 2) & 3); }

__device__ __forceinline__ void glds16_asm(const void* gsrc, unsigned lds_dst) {
    unsigned keep;
    asm volatile("s_mov_b32 %0, m0\n\ts_mov_b32 m0, %2\n\ts_nop 0\n\tglobal_load_lds_dwordx4 %1, off\n\ts_mov_b32 m0, %0" : "=&s"(keep) : "v"(gsrc), "s"(lds_dst) : "memory");
}

__device__ __forceinline__ s16x4 tr16(const LAS unsigned char* p) { return __builtin_amdgcn_ds_read_tr16_b64_v4i16((LAS s16x4*)p); }
__device__ __forceinline__ bf16x8 cat8(s16x4 lo, s16x4 hi) { return __builtin_shufflevector(lo, hi, 0, 1, 2, 3, 4, 5, 6, 7); }

template <int MODE>
__device__ __forceinline__ void attn_unit(Frame& F, const int b, const int h, const int qt, const float lam) {
    const Args& A = *F.a;
    const bf16_t* Z = (const bf16_t*)(F.ws + WS_Z);
    bf16_t* CAT = (bf16_t*)(F.ws + WS_BUFA);
    LAS unsigned char* lds = F.lds;
    int tid_l = F.tid; asm volatile("" : "+v"(tid_l));
    const int tid = tid_l, lane = tid & 63, w = F.wave, c = w & 1, qb = w >> 1, n = lane & 31, h2 = lane >> 5;
    const int q0 = qt * 128, r0 = q0 + 32 * qb, ntiles = 2 * qt + 2;
    const size_t rowbase = (size_t)b * SEQ;
    const float slope2 = __uint_as_float((unsigned)(127 - 2 * (h + 1)) << 23) * LOG2E, c1 = 0.125f * LOG2E;
    const float slope_hi = __uint_as_float(__float_as_uint(slope2) & 0xffff0000u), slope_lo = slope2 - slope_hi;
    bf16x8 Qf[4];
    { const bf16_t* qp = Z + (rowbase + r0 + n) * NZ + ZC_DAQ + h * 128 + c * 64 + 8 * h2;
#pragma unroll
      for (int kk = 0; kk < 4; ++kk) { const u32x4 q4_ = *(const u32x4*)(qp + 16 * kk); u32x4 o_;
          o_.x = cvt_pk_bf16(bf_lo(q4_.x) * c1, bf_hi(q4_.x) * c1); o_.y = cvt_pk_bf16(bf_lo(q4_.y) * c1, bf_hi(q4_.y) * c1); o_.z = cvt_pk_bf16(bf_lo(q4_.z) * c1, bf_hi(q4_.z) * c1); o_.w = cvt_pk_bf16(bf_lo(q4_.w) * c1, bf_hi(q4_.w) * c1);
          Qf[kk] = __builtin_bit_cast(bf16x8, o_); } }
    bf16x8 Qx, Kx[2];
    { u32x4 o_ = (u32x4){0u, 0u, 0u, 0u}; if (h2 == 0) o_.x = cvt_pk_bf16(slope_hi, slope_lo); Qx = __builtin_bit_cast(bf16x8, o_);
#pragma unroll
      for (int kb = 0; kb < 2; ++kb) { u32x4 k_ = (u32x4){0u, 0u, 0u, 0u}; if (h2 == 0) k_.x = cvt_pk_bf16((float)(32 * kb + n), (float)(32 * kb + n)); Kx[kb] = __builtin_bit_cast(bf16x8, k_); } }
    f32x16 O[4];
#pragma unroll
    for (int i = 0; i < 4; ++i)
#pragma unroll
        for (int j = 0; j < 16; ++j) O[i][j] = 0.f;
    float mrun = -3.0e38f, lsum = 0.f;
    const unsigned ldsbase = (unsigned)(size_t)lds;
#define AT_DMA(j_) do { if (MODE & 2) break; const int jj_ = (j_) < ntiles ? (j_) : ntiles - 1; \
        _Pragma("unroll") for (int m_ = 0; m_ < 4; ++m_) { const int i_ = w + 8 * m_, r_ = 4 * (i_ & 15) + (lane >> 4), gch_ = (lane & 15) ^ swzf(r_); \
            const bf16_t* src_ = Z + (rowbase + 64 * jj_ + r_) * NZ + ((i_ >= 16) ? ZC_DAV : ZC_DAK) + h * 128 + 8 * gch_; \
            glds16_asm(src_, ldsbase + (unsigned)(((j_) & 3) * AT_STAGE + i_ * 1024)); } } while (0)
#if AT_DEPTH == 3
    AT_DMA(0); AT_DMA(1); AT_DMA(2);
    asm volatile("s_waitcnt vmcnt(4)" ::: "memory");
#else
    AT_DMA(0); AT_DMA(1);
    VM_WAIT();
#endif
    __syncthreads();
    const int i16 = lane & 15, q4 = i16 >> 2, p4 = i16 & 3, blk = (lane >> 4) & 1;
#define AT_QK(S_, j_) do { const LAS unsigned char* Ks_ = lds + ((j_) & 3) * AT_STAGE; bf16x8 kf_[8]; \
        _Pragma("unroll") for (int kb = 0; kb < 2; ++kb) _Pragma("unroll") for (int kk = 0; kk < 4; ++kk) kf_[4 * kb + kk] = *(const LAS bf16x8*)(Ks_ + (32 * kb + n) * 256 + (((8 * c + 2 * kk + h2) ^ swzf(n)) << 4)); \
        _Pragma("unroll") for (int e = 0; e < 16; ++e) { (S_)[0][e] = 0.f; (S_)[1][e] = 0.f; } \
        _Pragma("unroll") for (int kb = 0; kb < 2; ++kb) { _Pragma("unroll") for (int kk = 0; kk < 4; ++kk) (S_)[kb] = __builtin_amdgcn_mfma_f32_32x32x16_bf16(kf_[4 * kb + kk], Qf[kk], (S_)[kb], 0, 0, 0); \
            (S_)[kb] = __builtin_amdgcn_mfma_f32_32x32x16_bf16(Kx[kb], Qx, (S_)[kb], 0, 0, 0); } } while (0)
#define AT_LOADV(buf_, dvb_) do { _Pragma("unroll") for (int kb = 0; kb < 2; ++kb) _Pragma("unroll") for (int s = 0; s < 2; ++s) { const int ch_ = 4 * (dvb_) + 2 * blk + (p4 >> 1); \
        const LAS unsigned char* vp = Vs + (32 * kb + 16 * s + 4 * h2 + q4) * 256 + 8 * (p4 & 1); \
        (buf_)[2 * kb + s] = cat8(tr16(vp + ((ch_ ^ swzf(4 * h2 + q4)) << 4)), tr16(vp + 8 * 256 + ((ch_ ^ swzf(8 + 4 * h2 + q4)) << 4))); } } while (0)
#define AT_PV(buf_, dvb_) do { _Pragma("unroll") for (int e = 0; e < 16; ++e) O[dvb_][e] *= alpha; \
        _Pragma("unroll") for (int kb = 0; kb < 2; ++kb) _Pragma("unroll") for (int s = 0; s < 2; ++s) O[dvb_] = __builtin_amdgcn_mfma_f32_32x32x16_bf16((buf_)[2 * kb + s], Pf[kb][s], O[dvb_], 0, 0, 0); } while (0)
#define AT_TILE(Sc_, Sn_, j_) do { \
        AT_DMA((j_) + AT_DEPTH); \
        const int k0 = 64 * (j_); \
        if (!(MODE & 1) && k0 <= r0 + 31) { \
            const LAS unsigned char* Vs = lds + ((j_) & 3) * AT_STAGE + 16384; \
            bf16x8 va[4], vb[4]; \
            if ((j_) + 1 < ntiles && k0 + 64 <= r0 + 31) AT_QK(Sn_, (j_) + 1); \
            AT_LOADV(va, 0); \
            const float D0 = (float)(r0 + n - k0 - 4 * h2); \
            const float tcon = slope2 * (float)(k0 - r0 - n);            \
            float mloc = -3.0e38f; \
            if (k0 + 63 > r0) { \
                _Pragma("unroll") for (int kb = 0; kb < 2; ++kb) _Pragma("unroll") for (int e = 0; e < 16; ++e) { const float off = (float)(32 * kb + (e & 3) + 8 * (e >> 2)); \
                    const float v = (off > D0) ? -INFINITY : (Sc_)[kb][e]; (Sc_)[kb][e] = v; mloc = fmaxf(mloc, v); } \
            } else { \
                _Pragma("unroll") for (int kb = 0; kb < 2; ++kb) _Pragma("unroll") for (int e = 0; e < 16; ++e) mloc = fmaxf(mloc, (Sc_)[kb][e]); \
            } \
            mloc = fmaxf(mloc, __shfl_xor(mloc, 32)) + tcon; \
            const float mnew = fmaxf(mrun, mloc), alpha = fast_exp2(mrun - mnew); \
            mrun = mnew; \
            const float mm = mnew - tcon; \
            float ps = 0.f; \
            _Pragma("unroll") for (int kb = 0; kb < 2; ++kb) _Pragma("unroll") for (int e = 0; e < 16; ++e) { const float pv = fast_exp2((Sc_)[kb][e] - mm); (Sc_)[kb][e] = pv; ps += pv; } \
            lsum = lsum * alpha + ps; \
            bf16x8 Pf[2][2]; \
            _Pragma("unroll") for (int kb = 0; kb < 2; ++kb) _Pragma("unroll") for (int s = 0; s < 2; ++s) { u32x4 pk; pk.x = cvt_pk_bf16((Sc_)[kb][8 * s + 0], (Sc_)[kb][8 * s + 1]); pk.y = cvt_pk_bf16((Sc_)[kb][8 * s + 2], (Sc_)[kb][8 * s + 3]); \
                pk.z = cvt_pk_bf16((Sc_)[kb][8 * s + 4], (Sc_)[kb][8 * s + 5]); pk.w = cvt_pk_bf16((Sc_)[kb][8 * s + 6], (Sc_)[kb][8 * s + 7]); Pf[kb][s] = __builtin_bit_cast(bf16x8, pk); } \
            AT_LOADV(vb, 1); AT_PV(va, 0); \
            AT_LOADV(va, 2); AT_PV(vb, 1); \
            AT_LOADV(vb, 3); AT_PV(va, 2); \
            AT_PV(vb, 3); \
        } \
        if (AT_DEPTH == 3) asm volatile("s_waitcnt vmcnt(4)" ::: "memory"); else asm volatile("s_waitcnt vmcnt(0)" ::: "memory"); \
        __syncthreads(); } while (0)
    f32x16 SA[2], SB[2];
    AT_QK(SA, 0);
    for (int j = 0; j < ntiles; j += 2) { AT_TILE(SA, SB, j); AT_TILE(SB, SA, j + 1); }
#undef AT_TILE
#undef AT_PV
#undef AT_LOADV
#undef AT_QK
    VM_WAIT();
    __syncthreads();
    { const float lt = lsum + __shfl_xor(lsum, 32); const float inv = (c == 0 ? 1.0f : lam) / lt;
#pragma unroll
      for (int dvb = 0; dvb < 4; ++dvb)
#pragma unroll
          for (int e = 0; e < 16; ++e) O[dvb][e] *= inv; }
    LAS float* cb = (LAS float*)lds + qb * 4096;
    if (c == 1) {
#pragma unroll
        for (int dvb = 0; dvb < 4; ++dvb)
#pragma unroll
            for (int e = 0; e < 16; ++e) cb[(dvb * 16 + e) * 64 + lane] = O[dvb][e];
    }
    __syncthreads();
    if (c == 0 && MODE == 0) {
        float ss = 0.f;
#pragma unroll
        for (int dvb = 0; dvb < 4; ++dvb)
#pragma unroll
            for (int e = 0; e < 16; ++e) { const float o = O[dvb][e] - cb[(dvb * 16 + e) * 64 + lane]; O[dvb][e] = o; ss += o * o; }
        ss += __shfl_xor(ss, 32);
        const float rstd = rsqrtf(ss * (1.0f / 128.0f) + EPS) * 0.8f;
        const float* g = A.in[I_GDA] + h * 128;
        bf16_t* op = CAT + (rowbase + r0 + n) * DM + 512 + h * 128;
#pragma unroll
        for (int dvb = 0; dvb < 4; ++dvb)
#pragma unroll
            for (int e4 = 0; e4 < 4; ++e4) { const int dv = 32 * dvb + 8 * e4 + 4 * h2; const f32x4 gv = *(const f32x4*)(g + dv);
                u32x2 pk; pk.x = cvt_pk_bf16(O[dvb][4 * e4 + 0] * rstd * gv.x, O[dvb][4 * e4 + 1] * rstd * gv.y); pk.y = cvt_pk_bf16(O[dvb][4 * e4 + 2] * rstd * gv.z, O[dvb][4 * e4 + 3] * rstd * gv.w);
                *(u32x2*)(op + dv) = pk; }
    }
    __syncthreads();
#undef AT_DMA
}
__device__ __forceinline__ void conv_prepass(Frame& F) {
    const Args& A = *F.a;
    const bf16_t* Z = (const bf16_t*)(F.ws + WS_Z);
    bf16_t* QKC = (bf16_t*)(F.ws + WS_BUFB);
    const int gt = F.vcu * 512 + F.tid, NT = F.G * 512;
    for (int it = gt; it < (T_TOK / 4) * 128; it += NT) {
        const int cg = it & 127, rb = it >> 7, row0 = 4 * rb, tl = row0 & (SEQ - 1), c0 = 8 * cg;
        float cw[4][8];
#pragma unroll
        for (int tp = 0; tp < 4; ++tp) { const f32x4 w0 = *(const f32x4*)(A.in[I_CONVW] + tp * 1024 + c0), w1 = *(const f32x4*)(A.in[I_CONVW] + tp * 1024 + c0 + 4);
            cw[tp][0] = w0.x; cw[tp][1] = w0.y; cw[tp][2] = w0.z; cw[tp][3] = w0.w; cw[tp][4] = w1.x; cw[tp][5] = w1.y; cw[tp][6] = w1.z; cw[tp][7] = w1.w; }
        u32x4 raw[7];
#pragma unroll
        for (int i = 0; i < 7; ++i) raw[i] = (tl - 3 + i >= 0) ? *(const u32x4*)(Z + (size_t)(row0 - 3 + i) * NZ + c0) : (u32x4){0u, 0u, 0u, 0u};
        const float ksc = (c0 >= 512) ? 0.08838834764831845f : 1.0f;
#pragma unroll
        for (int r = 0; r < 4; ++r) {
            float y[8];
#pragma unroll
            for (int ch = 0; ch < 8; ++ch) y[ch] = 0.f;
#pragma unroll
            for (int tp = 0; tp < 4; ++tp) { const u32x4 rv = raw[r + tp];
                y[0] += cw[tp][0] * bf_lo(rv.x); y[1] += cw[tp][1] * bf_hi(rv.x); y[2] += cw[tp][2] * bf_lo(rv.y); y[3] += cw[tp][3] * bf_hi(rv.y);
                y[4] += cw[tp][4] * bf_lo(rv.z); y[5] += cw[tp][5] * bf_hi(rv.z); y[6] += cw[tp][6] * bf_lo(rv.w); y[7] += cw[tp][7] * bf_hi(rv.w); }
#pragma unroll
            for (int ch = 0; ch < 8; ++ch) y[ch] = y[ch] * fast_rcp(1.0f + __expf(-y[ch])) * ksc;
            u32x4 pk; pk.x = cvt_pk_bf16(y[0], y[1]); pk.y = cvt_pk_bf16(y[2], y[3]); pk.z = cvt_pk_bf16(y[4], y[5]); pk.w = cvt_pk_bf16(y[6], y[7]);
            *(u32x4*)(QKC + (size_t)(row0 + r) * DM + c0) = pk;
        }
    }
}

#ifndef ML_TOUCH
#define ML_TOUCH 0
#endif
constexpr int ML_TB = 49152;
constexpr int ML_HB = 2 * ML_TB;
constexpr int ML_HP = 132;
constexpr int ML_SC = ML_HB + 64 * ML_HP * 4;

#define MFMA16(a, b, c) __builtin_amdgcn_mfma_f32_16x16x32_bf16((a), (b), (c), 0, 0, 0)

__device__ __forceinline__ void mlstm_unit(Frame& F, const int b, const int h) {
    const Args& A = *F.a;
    const bf16_t* Z = (const bf16_t*)(F.ws + WS_Z);
    const bf16_t* QKC = (const bf16_t*)(F.ws + WS_BUFB);
    const float* GT = (const float*)(F.ws + WS_GATES);
    bf16_t* CAT = (bf16_t*)(F.ws + WS_BUFA);
    LAS unsigned char* lds = F.lds;
    int tid_l = F.tid; asm volatile("" : "+v"(tid_l));
    const int tid = tid_l, lane = tid & 63, w = F.wave, n = lane & 15, g = lane >> 4, q4 = n >> 2, p4 = n & 3;
    const size_t rowbase = (size_t)b * SEQ;
    LAS float* sc = (LAS float*)(lds + ML_SC);
    LAS float* sA = sc; LAS float* sM = sc + 128; LAS float* sInter = sc + 256; LAS float* sMt = sc + 384; LAS float* sW = sc + 512; LAS float* sDi = sc + 640; LAS float* sQn = sc + 704; LAS float* sN = sc + 768;
    if (tid < 128) sN[tid] = 0.f;
    const unsigned ldsbase = (unsigned)(size_t)lds;
    const float bi = A.in[I_BI][h], bfg = A.in[I_BF][h];
    float gi_r, gf_r;
#define ML_DMA(cc, par_) do { const int t0_ = 64 * (cc); \
        _Pragma("unroll") for (int m_ = 0; m_ < 6; ++m_) { const int i_ = w + 8 * m_, tile_ = i_ >> 4, r_ = 4 * (i_ & 15) + (lane >> 4), gch_ = (lane & 15) ^ swzf(r_); \
            const bf16_t* src_ = (tile_ == 2) ? (Z + (rowbase + t0_ + r_) * NZ + ZC_MLV + 128 * h + 8 * gch_) : (QKC + (rowbase + t0_ + r_) * DM + 512 * tile_ + 128 * h + 8 * gch_); \
            glds16_asm(src_, ldsbase + (unsigned)((par_) * ML_TB + i_ * 1024)); } } while (0)
#define ML_GATES(cc) do { gi_r = GT[(rowbase + 64 * (cc) + lane) * 8 + h]; gf_r = GT[(rowbase + 64 * (cc) + lane) * 8 + 4 + h]; } while (0)
    float m_st = 0.f, decay_c = 1.f;
#define ML_SCALARS(par_) do { \
        const float gi = gi_r + bi, gfv = gf_r + bfg; \
        const float lf = fminf(gfv, 0.f) - __logf(1.0f + __expf(-fabsf(gfv))); \
        float bc = lf; \
        _Pragma("unroll") for (int o = 1; o < 64; o <<= 1) { const float t_ = __shfl_up(bc, o); if (lane >= o) bc += t_; } \
        const float av = gi - bc; float pm = av; \
        _Pragma("unroll") for (int o = 1; o < 64; o <<= 1) { const float t_ = __shfl_up(pm, o); if (lane >= o) pm = fmaxf(pm, t_); } \
        const float Mv = fmaxf(m_st, pm), inter = __expf(m_st - Mv), mt = bc + Mv; \
        const float M63 = __shfl(Mv, 63), bc63 = __shfl(bc, 63); \
        const float wg = __expf(av - M63); \
        decay_c = __shfl(inter, 63); m_st = bc63 + M63; \
        if (w == 0) { sA[(par_) * 64 + lane] = av; sM[(par_) * 64 + lane] = Mv; sInter[(par_) * 64 + lane] = inter; sMt[(par_) * 64 + lane] = mt; sW[(par_) * 64 + lane] = wg; } \
    } while (0)

    f32x4 Cacc[8];
#pragma unroll
    for (int dt = 0; dt < 8; ++dt) Cacc[dt] = (f32x4){0.f, 0.f, 0.f, 0.f};
    ML_GATES(0);
    ML_DMA(0, 0);
    ML_SCALARS(0);
    VM_WAIT(); LDS_WAIT();
    __syncthreads();
    const float* gml = A.in[I_GML] + 128 * h;
    const int e0 = 16 * w;
    unsigned touch = 0u;
#pragma unroll 1
    for (int c = 0; c < 32; ++c) {
        const float decay = decay_c; const int par = c & 1;
        const LAS unsigned char* TQ = lds + par * ML_TB; const LAS unsigned char* TK = TQ + 16384; const LAS unsigned char* TV = TQ + 32768;
        if (c + 1 < 32) { ML_DMA(c + 1, par ^ 1); ML_GATES(c + 1); }
        const int nrow = tid >> 3, nseg = tid & 7;
        { const int rr = 8 * w + (lane >> 3), seg = lane & 7, x = swzf(rr);
          const u32x4 qa = *(const LAS u32x4*)(TQ + rr * 256 + (((2 * seg) ^ x) << 4)), qb = *(const LAS u32x4*)(TQ + rr * 256 + (((2 * seg + 1) ^ x) << 4));
          const f32x4 n0 = *(const LAS f32x4*)(sN + 16 * seg), n1 = *(const LAS f32x4*)(sN + 16 * seg + 4), n2 = *(const LAS f32x4*)(sN + 16 * seg + 8), n3 = *(const LAS f32x4*)(sN + 16 * seg + 12);
          float d = bf_lo(qa.x) * n0.x + bf_hi(qa.x) * n0.y + bf_lo(qa.y) * n0.z + bf_hi(qa.y) * n0.w + bf_lo(qa.z) * n1.x + bf_hi(qa.z) * n1.y + bf_lo(qa.w) * n1.z + bf_hi(qa.w) * n1.w
                  + bf_lo(qb.x) * n2.x + bf_hi(qb.x) * n2.y + bf_lo(qb.y) * n2.z + bf_hi(qb.y) * n2.w + bf_lo(qb.z) * n3.x + bf_hi(qb.z) * n3.y + bf_lo(qb.w) * n3.z + bf_hi(qb.w) * n3.w;
          d += __shfl_xor(d, 1); d += __shfl_xor(d, 2); d += __shfl_xor(d, 4);
          if (seg == 0) sQn[rr] = d; }
        bf16x8 Vf[2], Cf[4];
#pragma unroll
        for (int ks = 0; ks < 2; ++ks) {
            const LAS unsigned char* vp = TV + (32 * ks + 4 * g + q4) * 256 + (((2 * w + (p4 >> 1)) ^ swzf(4 * g + q4)) << 4) + 8 * (p4 & 1);
            Vf[ks] = cat8(tr16(vp), tr16(vp + 16 * 256));
        }
#pragma unroll
        for (int kd = 0; kd < 4; ++kd) { const f32x4 c0 = Cacc[2 * kd], c1 = Cacc[2 * kd + 1]; u32x4 pk; pk.x = cvt_pk_bf16(c0[0], c0[1]); pk.y = cvt_pk_bf16(c0[2], c0[3]); pk.z = cvt_pk_bf16(c1[0], c1[1]); pk.w = cvt_pk_bf16(c1[2], c1[3]); Cf[kd] = __builtin_bit_cast(bf16x8, pk); }
#pragma unroll 1
        for (int lb = 0; lb < 4; ++lb) {
            u32x4 pk[2]; pk[0] = (u32x4){0u, 0u, 0u, 0u}; pk[1] = (u32x4){0u, 0u, 0u, 0u};
            float di = 0.f;
            const LAS unsigned char* qrow = TQ + (16 * lb + n) * 256;
            {
                bf16x8 Qf[4];
#pragma unroll
                for (int kk = 0; kk < 4; ++kk) Qf[kk] = *(const LAS bf16x8*)(qrow + (((4 * kk + g) ^ swzf(n)) << 4));
                const float Ml = sM[par * 64 + 16 * lb + n];
#pragma unroll
                for (int sb = 0; sb < 4; ++sb) if (sb <= lb) {
                    f32x4 acc = (f32x4){0.f, 0.f, 0.f, 0.f};
#pragma unroll
                    for (int kk = 0; kk < 4; ++kk) { const bf16x8 kf = *(const LAS bf16x8*)(TK + (16 * sb + n) * 256 + (((4 * kk + g) ^ swzf(n)) << 4)); acc = MFMA16(kf, Qf[kk], acc); }
                    const f32x4 av4 = *(const LAS f32x4*)(sA + par * 64 + 16 * sb + 4 * g);
                    float pv[4];
#pragma unroll
                    for (int r = 0; r < 4; ++r) { float e = acc[r] * fast_exp2((av4[r] - Ml) * LOG2E); if (sb == lb && (4 * g + r > n)) e = 0.f; pv[r] = e; di += e; }
                    const unsigned u0 = cvt_pk_bf16(pv[0], pv[1]), u1 = cvt_pk_bf16(pv[2], pv[3]);
                    if ((sb & 1) == 0) { pk[sb >> 1].x = u0; pk[sb >> 1].y = u1; } else { pk[sb >> 1].z = u0; pk[sb >> 1].w = u1; }
                }
            }
            di += __shfl_xor(di, 16); di += __shfl_xor(di, 32);
            if (w == 0 && g == 0) sDi[16 * lb + n] = di;
            f32x4 numI = (f32x4){0.f, 0.f, 0.f, 0.f}, accI = (f32x4){0.f, 0.f, 0.f, 0.f};
            numI = MFMA16(__builtin_bit_cast(bf16x8, pk[0]), Vf[0], numI);
            if (lb >= 2) numI = MFMA16(__builtin_bit_cast(bf16x8, pk[1]), Vf[1], numI);
#pragma unroll
            for (int kd = 0; kd < 4; ++kd) { const s16x4 lo = *(const LAS s16x4*)(qrow + (((4 * kd + (g >> 1)) ^ swzf(n)) << 4) + 8 * (g & 1)), hi = *(const LAS s16x4*)(qrow + (((4 * kd + 2 + (g >> 1)) ^ swzf(n)) << 4) + 8 * (g & 1));
                accI = MFMA16(cat8(lo, hi), Cf[kd], accI); }
            const f32x4 in4 = *(const LAS f32x4*)(sInter + par * 64 + 16 * lb + 4 * g);
#pragma unroll
            for (int r = 0; r < 4; ++r) *(LAS float*)(lds + ML_HB + ((16 * lb + 4 * g + r) * ML_HP + e0 + n) * 4) = numI[r] + in4[r] * accI[r];
            asm volatile("" ::: "memory");
        }
        const u32x4 og0 = *(const u32x4*)(Z + (rowbase + 64 * c + nrow) * NZ + ZC_MLO + 128 * h + 16 * nseg), og1 = *(const u32x4*)(Z + (rowbase + 64 * c + nrow) * NZ + ZC_MLO + 128 * h + 16 * nseg + 8);
        bf16x8 Vw[2], Wf[2];
#pragma unroll
        for (int ks = 0; ks < 2; ++ks) {
            const f32x4 wl = *(const LAS f32x4*)(sW + par * 64 + 32 * ks + 4 * g), wh = *(const LAS f32x4*)(sW + par * 64 + 32 * ks + 16 + 4 * g);
            const u32x4 v4 = __builtin_bit_cast(u32x4, Vf[ks]);
            u32x4 pw; pw.x = cvt_pk_bf16(bf_lo(v4.x) * wl.x, bf_hi(v4.x) * wl.y); pw.y = cvt_pk_bf16(bf_lo(v4.y) * wl.z, bf_hi(v4.y) * wl.w); pw.z = cvt_pk_bf16(bf_lo(v4.z) * wh.x, bf_hi(v4.z) * wh.y); pw.w = cvt_pk_bf16(bf_lo(v4.w) * wh.z, bf_hi(v4.w) * wh.w);
            Vw[ks] = __builtin_bit_cast(bf16x8, pw);
            u32x4 pf; pf.x = cvt_pk_bf16(wl.x, wl.y); pf.y = cvt_pk_bf16(wl.z, wl.w); pf.z = cvt_pk_bf16(wh.x, wh.y); pf.w = cvt_pk_bf16(wh.z, wh.w);
            if (n != 0) pf = (u32x4){0u, 0u, 0u, 0u};
            Wf[ks] = __builtin_bit_cast(bf16x8, pf);
        }
        f32x4 cn = (f32x4){0.f, 0.f, 0.f, 0.f};
#pragma unroll
        for (int dt = 0; dt < 8; ++dt) {
            f32x4 cacc = Cacc[dt] * decay;
#pragma unroll
            for (int ks = 0; ks < 2; ++ks) { const LAS unsigned char* kp = TK + (32 * ks + 4 * g + q4) * 256 + (((2 * dt + (p4 >> 1)) ^ swzf(4 * g + q4)) << 4) + 8 * (p4 & 1);
                const bf16x8 kt = cat8(tr16(kp), tr16(kp + 16 * 256)); cacc = MFMA16(kt, Vw[ks], cacc); if (dt == w) cn = MFMA16(kt, Wf[ks], cn); }
            Cacc[dt] = cacc;
        }
        LDS_WAIT();
        __syncthreads();
        if (n == 0) {
#pragma unroll
            for (int r = 0; r < 4; ++r) sN[16 * w + 4 * g + r] = decay * sN[16 * w + 4 * g + r] + cn[r]; }
        {
            const LAS float* hp = (const LAS float*)(lds + ML_HB) + nrow * ML_HP + 16 * nseg;
            f32x4 hv[4]; float ss = 0.f;
#pragma unroll
            for (int i = 0; i < 4; ++i) { hv[i] = *(const LAS f32x4*)(hp + 4 * i); ss += (hv[i].x * hv[i].x + hv[i].y * hv[i].y) + (hv[i].z * hv[i].z + hv[i].w * hv[i].w); }
            ss += __shfl_xor(ss, 1); ss += __shfl_xor(ss, 2); ss += __shfl_xor(ss, 4);
            const float den = sDi[nrow] + sInter[par * 64 + nrow] * sQn[nrow];
            const float dn = fmaxf(fabsf(den), __expf(-sMt[par * 64 + nrow]));
            const float rstd = rsqrtf(ss * (1.0f / 128.0f) + EPS * dn * dn);
            const unsigned ogw[8] = {og0.x, og0.y, og0.z, og0.w, og1.x, og1.y, og1.z, og1.w};
            unsigned outw[8];
#pragma unroll
            for (int i = 0; i < 4; ++i) { const f32x4 gv = *(const f32x4*)(gml + 16 * nseg + 4 * i);
                const float o0 = bf_lo(ogw[2 * i]), o1 = bf_hi(ogw[2 * i]), o2 = bf_lo(ogw[2 * i + 1]), o3 = bf_hi(ogw[2 * i + 1]);
                const float y0 = hv[i].x * rstd * gv.x * fast_rcp(1.0f + __expf(-o0)), y1 = hv[i].y * rstd * gv.y * fast_rcp(1.0f + __expf(-o1));
                const float y2 = hv[i].z * rstd * gv.z * fast_rcp(1.0f + __expf(-o2)), y3 = hv[i].w * rstd * gv.w * fast_rcp(1.0f + __expf(-o3));
                outw[2 * i] = cvt_pk_bf16(y0, y1); outw[2 * i + 1] = cvt_pk_bf16(y2, y3); }
            bf16_t* op = CAT + (rowbase + 64 * c + nrow) * DM + 128 * h + 16 * nseg;
            *(u32x4*)op = (u32x4){outw[0], outw[1], outw[2], outw[3]}; *(u32x4*)(op + 8) = (u32x4){outw[4], outw[5], outw[6], outw[7]};
        }
        if (c + 1 < 32) ML_SCALARS(par ^ 1);
        VM_WAIT(); LDS_WAIT();
#if ML_TOUCH
        asm volatile("" :: "v"(touch));
        if (c + 4 < 32 && tid < 384) { const int tl_ = tid >> 7, r_ = (tid & 127) >> 1, hf_ = tid & 1;
            const bf16_t* p_ = (tl_ == 2) ? (Z + (rowbase + 64 * (c + 4) + r_) * NZ + ZC_MLV + 128 * h + 64 * hf_) : (QKC + (rowbase + 64 * (c + 4) + r_) * DM + 512 * tl_ + 128 * h + 64 * hf_);
            touch = *(const volatile unsigned*)p_; }
#endif
        __syncthreads();
    }
#undef ML_DMA
#undef ML_GATES
#undef ML_SCALARS
}
#ifndef PROBE_HALF
#define PROBE_HALF 0
#endif
#ifndef Q_LPT
#define Q_LPT 0
#endif
#ifndef Q_PAIRED
#define Q_PAIRED 0
#endif
#if Q_PAIRED
#define QN_ATT 64
#else
#define QN_ATT 128
#endif
#ifndef ATT_MODE
#define ATT_MODE 0
#endif
#ifndef REPSUB
#define REPSUB 3
#endif
#ifndef PE_TOUCH
#define PE_TOUCH 0
#endif
#ifndef PE_VMFMA
#define PE_VMFMA 0
#endif
#ifndef PE_XV
#define PE_XV 0
#endif
#ifndef PE_XP
#define PE_XP 0
#endif
#ifndef PE_XU
#define PE_XU 0
#endif
#ifndef P7REP
#define P7REP 0
#endif
constexpr size_t WS_US = WS_END;
constexpr int PE_REP = 132;
constexpr int PE_CS = 2 * 128 * PE_REP * 4, PE_SS = PE_CS + 512;
constexpr int PE_RE = 0, PE_RG = 128 * PE_REP * 4;

__device__ __forceinline__ unsigned enc_f(float f) { const unsigned b = __float_as_uint(f); return b ^ ((unsigned)((int)b >> 31) | 0x80000000u); }
__device__ __forceinline__ float dec_f(unsigned e) { return __uint_as_float(e ^ ((~(unsigned)((int)e >> 31)) | 0x80000000u)); }
__device__ __forceinline__ unsigned umax3(unsigned a, unsigned b, unsigned c) { return max(max(a, b), c); }

#define CE_DESC(x, y) do { const unsigned hi_ = max((x), (y)), lo_ = min((x), (y)); (x) = hi_; (y) = lo_; } while (0)
__device__ __forceinline__ void sort16_desc(unsigned (&a)[16]) {
#define C2(x, y) CE_DESC(a[x], a[y])
    C2(0, 13); C2(1, 12); C2(2, 15); C2(3, 14); C2(4, 8); C2(5, 6); C2(7, 11); C2(9, 10);
    C2(0, 5); C2(1, 7); C2(2, 9); C2(3, 4); C2(6, 13); C2(8, 14); C2(10, 15); C2(11, 12);
    C2(0, 1); C2(2, 3); C2(4, 5); C2(6, 8); C2(7, 9); C2(10, 11); C2(12, 13); C2(14, 15);
    C2(0, 2); C2(1, 3); C2(4, 10); C2(5, 11); C2(6, 7); C2(8, 9); C2(12, 14); C2(13, 15);
    C2(1, 2); C2(3, 12); C2(4, 6); C2(5, 7); C2(8, 10); C2(9, 11); C2(13, 14);
    C2(1, 4); C2(2, 6); C2(5, 8); C2(7, 10); C2(9, 13); C2(11, 14);
    C2(2, 4); C2(3, 6); C2(9, 12); C2(11, 13);
    C2(3, 5); C2(6, 8); C2(7, 9); C2(10, 12);
    C2(3, 4); C2(5, 6); C2(7, 8); C2(9, 10); C2(11, 12);
    C2(6, 7); C2(8, 9);
#undef C2
}
__device__ __forceinline__ void bitonic_merge16_desc(unsigned (&a)[16]) {
#pragma unroll
    for (int j = 8; j > 0; j >>= 1)
#pragma unroll
        for (int i = 0; i < 16; ++i) { const int l = i ^ j; if (l > i) CE_DESC(a[i], a[l]); }
}
__device__ __forceinline__ void bitonic_merge8_desc(unsigned (&a)[8]) {
#pragma unroll
    for (int j = 4; j > 0; j >>= 1)
#pragma unroll
        for (int i = 0; i < 8; ++i) { const int l = i ^ j; if (l > i) CE_DESC(a[i], a[l]); }
}
__device__ __forceinline__ void merge_top16(unsigned (&a)[16], const unsigned (&b)[16]) {
#pragma unroll
    for (int i = 0; i < 16; ++i) a[i] = max(a[i], b[15 - i]);
    bitonic_merge16_desc(a);
}
template <bool PAIR>
__device__ __forceinline__ void top16_of64(const unsigned (&key)[64], unsigned (&top)[16]) {
    unsigned q1[16], q2[16], q3[16];
#pragma unroll
    for (int i = 0; i < 16; ++i) { top[i] = key[i]; q1[i] = key[16 + i]; q2[i] = key[32 + i]; q3[i] = key[48 + i]; }
    sort16_desc(top); sort16_desc(q1); merge_top16(top, q1);
    sort16_desc(q2); sort16_desc(q3); merge_top16(q2, q3);
    merge_top16(top, q2);
    if (PAIR) {
        unsigned o[16];
#pragma unroll
        for (int i = 0; i < 16; ++i) o[i] = (unsigned)__shfl_xor((int)top[i], 32);
        merge_top16(top, o);
    }
}

__device__ __forceinline__ float gelu_exact(float v) { return 0.5f * v * (1.0f + erff(v * 0.70710678118654752f)); }
typedef __bf16 bf16x2_t __attribute__((ext_vector_type(2)));
__device__ __forceinline__ float dot2bf(unsigned a, unsigned b, float c) { return __builtin_amdgcn_fdot2_f32_bf16(__builtin_bit_cast(bf16x2_t, a), __builtin_bit_cast(bf16x2_t, b), c, false); }
__device__ __forceinline__ float dot8(const u32x4 a, const u32x4 b) { return dot2bf(a.x, b.x, dot2bf(a.y, b.y, dot2bf(a.z, b.z, dot2bf(a.w, b.w, 0.f)))); }
__device__ __forceinline__ float dpp_xor1(float v) { return __int_as_float(__builtin_amdgcn_update_dpp(0, __float_as_int(v), 0xB1, 0xF, 0xF, true)); }
__device__ __forceinline__ float dpp_xor2(float v) { return __int_as_float(__builtin_amdgcn_update_dpp(0, __float_as_int(v), 0x4E, 0xF, 0xF, true)); }
__device__ __forceinline__ float dpp_xor4(float v) { const int m = __builtin_amdgcn_update_dpp(0, __float_as_int(v), 0x141, 0xF, 0xF, true); return __int_as_float(__builtin_amdgcn_update_dpp(0, m, 0x1B, 0xF, 0xF, true)); }
__device__ __forceinline__ float reduce8x8(const float (&p)[8], const int j) {
    float r[4], q[2];
#pragma unroll
    for (int i = 0; i < 4; ++i) { const float keep = (j & 4) ? p[i + 4] : p[i], send = (j & 4) ? p[i] : p[i + 4]; r[i] = keep + __shfl_xor(send, 4); }
#pragma unroll
    for (int i = 0; i < 2; ++i) { const float keep = (j & 2) ? r[i + 2] : r[i], send = (j & 2) ? r[i] : r[i + 2]; q[i] = keep + __shfl_xor(send, 2); }
    const float keep = (j & 1) ? q[1] : q[0], send = (j & 1) ? q[0] : q[1];
    return keep + __shfl_xor(send, 1);
}

__device__ __forceinline__ int reduce8x8i(const float (&p)[8], const int j) {
    int r[4], q[2];
#pragma unroll
    for (int i = 0; i < 4; ++i) { const int keep = __float_as_int((j & 4) ? p[i + 4] : p[i]), send = __float_as_int((j & 4) ? p[i] : p[i + 4]); r[i] = keep + __shfl_xor(send, 4); }
#pragma unroll
    for (int i = 0; i < 2; ++i) { const int keep = (j & 2) ? r[i + 2] : r[i], send = (j & 2) ? r[i] : r[i + 2]; q[i] = keep + __shfl_xor(send, 2); }
    const int keep = (j & 1) ? q[1] : q[0], send = (j & 1) ? q[0] : q[1];
    return keep + __shfl_xor(send, 1);
}
constexpr size_t WS_VS8 = WS_US + 16 * MiB, WS_SINV = WS_US + 32 * MiB;
__device__ __forceinline__ void peer_convert_rows(Frame& F, const int item) {
    const Args& A = *F.a;
    int lane_l = threadIdx.x & 63; asm volatile("" : "+v"(lane_l));
    const int lane = lane_l;
    float* SINV = (float*)(F.ws + WS_SINV);
    f32x4 gq[4];
    { const float* gp = A.in[I_GFFN] + 16 * lane; gq[0] = *(const f32x4*)gp; gq[1] = *(const f32x4*)(gp + 4); gq[2] = *(const f32x4*)(gp + 8); gq[3] = *(const f32x4*)(gp + 12); }
    for (int it0 = 64 * item + 4 * F.wave; it0 < 64 * item + 64; it0 += 32) {
        f32x4 v[4][4];
#pragma unroll
        for (int r = 0; r < 4; ++r) { const int it = it0 + r, tb = it >> 14, e = it & 16383;
            const float* src = (tb ? A.in[I_PV] : A.in[I_PU]) + (size_t)e * DM + 16 * lane;
#pragma unroll
            for (int q = 0; q < 4; ++q) v[r][q] = *(const f32x4*)(src + 4 * q); }
#pragma unroll
        for (int r = 0; r < 4; ++r) { const int it = it0 + r, tb = it >> 14, e = it & 16383;
            if (tb == 0) {
#pragma unroll
                for (int q = 0; q < 4; ++q) v[r][q] = v[r][q] * gq[q]; }
            float mx = 0.f;
#pragma unroll
            for (int q = 0; q < 4; ++q) mx = fmaxf(mx, fmaxf(fmaxf(fabsf(v[r][q].x), fabsf(v[r][q].y)), fmaxf(fabsf(v[r][q].z), fabsf(v[r][q].w))));
#pragma unroll
            for (int o = 1; o < 64; o <<= 1) mx = fmaxf(mx, __shfl_xor(mx, o));
            u32x4 o; unsigned ow[4]; float sinv;
            if (tb == 0 || PE_VMFMA) {
                const float sc = (mx > 0.f) ? 127.0f / mx : 0.f; sinv = mx * (1.0f / 127.0f);
#pragma unroll
                for (int q = 0; q < 4; ++q) { const int q0 = __float2int_rn(v[r][q].x * sc), q1 = __float2int_rn(v[r][q].y * sc), q2 = __float2int_rn(v[r][q].z * sc), q3 = __float2int_rn(v[r][q].w * sc);
                    ow[q] = (unsigned)(q0 & 255) | ((unsigned)(q1 & 255) << 8) | ((unsigned)(q2 & 255) << 16) | ((unsigned)(q3 & 255) << 24); }
            } else {
                int k = (mx > 0.f) ? (int)floorf(log2f(416.0f / mx)) : 0; k = k > 60 ? 60 : (k < -60 ? -60 : k);
                const float sc = exp2f((float)k); sinv = exp2f((float)-k);
#pragma unroll
                for (int q = 0; q < 4; ++q) { int wd = __builtin_amdgcn_cvt_pk_fp8_f32(v[r][q].x * sc, v[r][q].y * sc, 0, false); wd = __builtin_amdgcn_cvt_pk_fp8_f32(v[r][q].z * sc, v[r][q].w * sc, wd, true); ow[q] = (unsigned)wd; }
            }
            o.x = ow[0]; o.y = ow[1]; o.z = ow[2]; o.w = ow[3];
            unsigned char* dst = (unsigned char*)(F.ws + (tb ? WS_VS8 : WS_US)) + ((size_t)(lane >> 3) * 16384 + e) * 128 + 16 * (lane & 7);
            *(u32x4*)dst = o;
            if (lane == 0) SINV[tb * 16384 + e] = sinv;
        }
    }
}

template <bool DRY>
__device__ __forceinline__ void peer_tile(Frame& F, const int tile) {
    const Args& A = *F.a;
    const bf16_t* QP = (const bf16_t*)(F.ws + WS_BUFA); const bf16_t* XG = (const bf16_t*)(F.ws + WS_BUFB); bf16_t* XGW = (bf16_t*)(F.ws + WS_BUFB); const bf16_t* SK = (const bf16_t*)(F.ws + WS_SK);
    const float* rss2 = (const float*)(F.ctl + CW_RSS2);
    LAS unsigned* RE = (LAS unsigned*)(F.lds + PE_RE); LAS float* RG = (LAS float*)(F.lds + PE_RG);
    const int w = F.wave;
    {
        int lane = F.lane; asm volatile("" : "+v"(lane));
        const int tg = w & 3, hh = w >> 2, n = lane & 31, h2 = lane >> 5;
        const int tok = 32 * tg + n; const size_t trow = (size_t)tile * 128 + tok;
        for (int rrep = 0; rrep < ((P7REP & 1) ? 2 : 1); ++rrep)
        for (int hd = 4 * hh; hd < 4 * hh + 4; ++hd) {
            unsigned T2[2][16];
#pragma unroll
            for (int cc = 0; cc < 2; ++cc) {
                const int grp = 2 * hd + cc;
                bf16x8 Qf[4];
#pragma unroll
                for (int kk = 0; kk < 4; ++kk) Qf[kk] = *(const bf16x8*)(QP + trow * DM + 64 * grp + 16 * kk + 8 * h2);
                unsigned key[64];
                unsigned lowbase = 127u - 4u * (unsigned)h2; asm volatile("" : "+v"(lowbase));
#pragma unroll
                for (int kb = 0; kb < 4; ++kb) {
                    f32x16 S;
#pragma unroll
                    for (int e = 0; e < 16; ++e) S[e] = 0.f;
#pragma unroll
                    for (int kk = 0; kk < 4; ++kk) { const bf16x8 a = *(const bf16x8*)(SK + ((size_t)(grp * 128 + 32 * kb + n)) * 64 + 16 * kk + 8 * h2); S = __builtin_amdgcn_mfma_f32_32x32x16_bf16(a, Qf[kk], S, 0, 0, 0); }
#pragma unroll
                    for (int e = 0; e < 16; ++e) { const int idx0 = 32 * kb + (e & 3) + 8 * (e >> 2); key[16 * kb + e] = ((enc_f(S[e]) & ~127u) | lowbase) - (unsigned)idx0; }
                }
                top16_of64<true>(key, T2[cc]);
            }
            float va[16], vb[16];
#pragma unroll
            for (int i = 0; i < 16; ++i) { va[i] = dec_f(T2[0][i] & ~127u); vb[i] = dec_f(T2[1][i] & ~127u); }
#define CKEY(i_, j_) ((enc_f(va[i_] + vb[j_]) & ~255u) | (unsigned)(255 - (16 * (i_) + (j_))))
            unsigned best[16];
            {
                unsigned c0[16];
#pragma unroll
                for (int q = 0; q < 16; ++q) best[q] = CKEY(0, q);
#pragma unroll
                for (int q = 1; q < 16; ++q) c0[q - 1] = CKEY(q, 0);
                c0[15] = 0u;
                merge_top16(best, c0);
                unsigned y1[16];
#pragma unroll
                for (int q = 1; q < 8; ++q) y1[q - 1] = CKEY(1, q);
                y1[7] = 0u; y1[8] = 0u; y1[9] = 0u;
#pragma unroll
                for (int q = 2; q < 8; ++q) y1[17 - q] = CKEY(q, 1);
                bitonic_merge16_desc(y1);
                unsigned y2[8];
                unsigned b1 = CKEY(3, 3), b2 = CKEY(4, 2); CE_DESC(b1, b2);
                y2[0] = CKEY(2, 2); y2[1] = CKEY(2, 3); y2[2] = CKEY(2, 4); y2[3] = 0u; y2[4] = 0u; y2[5] = b2; y2[6] = b1; y2[7] = CKEY(3, 2);
                bitonic_merge8_desc(y2);
#pragma unroll
                for (int q = 8; q < 16; ++q) y1[q] = max(y1[q], y2[15 - q]);
                bitonic_merge16_desc(y1);
                merge_top16(best, y1);
            }
#undef CKEY
            const float v0 = dec_f(best[0] & ~255u);
            float gw[16], zs = 0.f;
#pragma unroll
            for (int k = 0; k < 16; ++k) { gw[k] = __expf(dec_f(best[k] & ~255u) - v0); zs += gw[k]; }
            const float zinv = 1.0f / zs;
            unsigned TA[4], TB[4];
#pragma unroll
            for (int d = 0; d < 4; ++d) {
                TA[d] = 0x7F7F7F7Fu - ((T2[0][4 * d] & 127u) | ((T2[0][4 * d + 1] & 127u) << 8) | ((T2[0][4 * d + 2] & 127u) << 16) | ((T2[0][4 * d + 3] & 127u) << 24));
                TB[d] = 0x7F7F7F7Fu - ((T2[1][4 * d] & 127u) | ((T2[1][4 * d + 1] & 127u) << 8) | ((T2[1][4 * d + 2] & 127u) << 16) | ((T2[1][4 * d + 3] & 127u) << 24)); }
#pragma unroll
            for (int kk = 0; kk < 8; ++kk) {
                const unsigned bk = h2 ? best[8 + kk] : best[kk]; const float gk = h2 ? gw[8 + kk] : gw[kk];
                const unsigned code = 255u - (bk & 255u); const unsigned ci = code >> 4, cj = code & 15u;
                const unsigned sa = (ci & 7u) | 0x0C0C0C00u, sb = (cj & 7u) | 0x0C0C0C00u;
                const unsigned ia = (ci & 8u) ? __builtin_amdgcn_perm(TA[3], TA[2], sa) : __builtin_amdgcn_perm(TA[1], TA[0], sa);
                const unsigned ib = (cj & 8u) ? __builtin_amdgcn_perm(TB[3], TB[2], sb) : __builtin_amdgcn_perm(TB[1], TB[0], sb);
                RE[tok * PE_REP + hd * 16 + 8 * h2 + kk] = (ia * 128u + ib) << 7; RG[tok * PE_REP + hd * 16 + 8 * h2 + kk] = gk * zinv;
            }
        }
    }
    __syncthreads();
    {
        int lane = F.lane; asm volatile("" : "+v"(lane));
        const unsigned char* US = (const unsigned char*)(F.ws + WS_US); const unsigned char* VS = (const unsigned char*)(F.ws + WS_VS8); const float* SINV = (const float*)(F.ws + WS_SINV);
        const int j = lane & 7, gid = 8 * w + (lane >> 3);
        const int tA = gid, tB = 64 + gid; const size_t rowA = (size_t)tile * 128 + tA, rowB = (size_t)tile * 128 + tB;
        const LAS unsigned* reA = RE + tA * PE_REP; const LAS unsigned* reB = RE + tB * PE_REP;
        LAS float* cfA = RG + tA * PE_REP; LAS float* cfB = RG + tB * PE_REP;
        float accA[16], accB[16];
#pragma unroll
        for (int i = 0; i < 16; ++i) { accA[i] = 0.f; accB[i] = 0.f; }
#define PE_DEC16P(w4, f2) do { (f2)[0] = __builtin_amdgcn_cvt_pk_f32_fp8((int)(w4).x, false); (f2)[1] = __builtin_amdgcn_cvt_pk_f32_fp8((int)(w4).x, true); (f2)[2] = __builtin_amdgcn_cvt_pk_f32_fp8((int)(w4).y, false); (f2)[3] = __builtin_amdgcn_cvt_pk_f32_fp8((int)(w4).y, true); \
            (f2)[4] = __builtin_amdgcn_cvt_pk_f32_fp8((int)(w4).z, false); (f2)[5] = __builtin_amdgcn_cvt_pk_f32_fp8((int)(w4).z, true); (f2)[6] = __builtin_amdgcn_cvt_pk_f32_fp8((int)(w4).w, false); (f2)[7] = __builtin_amdgcn_cvt_pk_f32_fp8((int)(w4).w, true); } while (0)
#define PE_ISSUE(buf_, re_, kb_, base_) do { const u32x4 e4a = *(const LAS u32x4*)((re_) + 8 * (kb_)), e4b = *(const LAS u32x4*)((re_) + 8 * (kb_) + 4); const unsigned ew[8] = {e4a.x, e4a.y, e4a.z, e4a.w, e4b.x, e4b.y, e4b.z, e4b.w}; \
                _Pragma("unroll") for (int i = 0; i < 8; ++i) (buf_)[i] = *(const u32x4*)((base_) + (size_t)ew[i]); } while (0)
        float sxA, sxB, isxA, isxB;
        { float mA = 0.f, mB = 0.f;
#pragma unroll
          for (int s = 0; s < 8; ++s) { const u32x4 a0 = *(const u32x4*)(XG + rowA * DM + 128 * s + 16 * j), a1 = *(const u32x4*)(XG + rowA * DM + 128 * s + 16 * j + 8), b0 = *(const u32x4*)(XG + rowB * DM + 128 * s + 16 * j), b1 = *(const u32x4*)(XG + rowB * DM + 128 * s + 16 * j + 8);
              const unsigned aw[8] = {a0.x, a0.y, a0.z, a0.w, a1.x, a1.y, a1.z, a1.w}, bw[8] = {b0.x, b0.y, b0.z, b0.w, b1.x, b1.y, b1.z, b1.w};
#pragma unroll
              for (int i = 0; i < 8; ++i) { mA = fmaxf(mA, fmaxf(fabsf(bf_lo(aw[i])), fabsf(bf_hi(aw[i])))); mB = fmaxf(mB, fmaxf(fabsf(bf_lo(bw[i])), fabsf(bf_hi(bw[i])))); } }
          mA = fmaxf(mA, __shfl_xor(mA, 1)); mA = fmaxf(mA, __shfl_xor(mA, 2)); mA = fmaxf(mA, __shfl_xor(mA, 4));
          mB = fmaxf(mB, __shfl_xor(mB, 1)); mB = fmaxf(mB, __shfl_xor(mB, 2)); mB = fmaxf(mB, __shfl_xor(mB, 4));
          sxA = (mA > 0.f) ? 127.0f / mA : 0.f; sxB = (mB > 0.f) ? 127.0f / mB : 0.f; isxA = mA * (1.0f / 127.0f); isxB = mB * (1.0f / 127.0f); }
        u32x4 xra0 = *(const u32x4*)(XG + rowA * DM + 16 * j), xra1 = *(const u32x4*)(XG + rowA * DM + 16 * j + 8), xrb0 = *(const u32x4*)(XG + rowB * DM + 16 * j), xrb1 = *(const u32x4*)(XG + rowB * DM + 16 * j + 8);
        u32x4 bufA[8], bufB[8];
        PE_ISSUE(bufA, reA, 0, US + 16 * j);
#pragma unroll 1
        for (int s2 = 0; s2 < ((P7REP & 2) ? 16 : 8); ++s2) {
            const int s = s2 & 7;
            if (s2 == 8) {
#pragma unroll
                for (int i = 0; i < 16; ++i) { accA[i] = 0.f; accB[i] = 0.f; } }
            int dmu = 0;
            unsigned xa[4], xb[4];
            { const unsigned aw[8] = {xra0.x, xra0.y, xra0.z, xra0.w, xra1.x, xra1.y, xra1.z, xra1.w}, bw[8] = {xrb0.x, xrb0.y, xrb0.z, xrb0.w, xrb1.x, xrb1.y, xrb1.z, xrb1.w};
#pragma unroll
              for (int i = 0; i < 4; ++i) { const int a0_ = __float2int_rn(bf_lo(aw[2 * i]) * sxA), a1_ = __float2int_rn(bf_hi(aw[2 * i]) * sxA), a2_ = __float2int_rn(bf_lo(aw[2 * i + 1]) * sxA), a3_ = __float2int_rn(bf_hi(aw[2 * i + 1]) * sxA);
                  const int b0_ = __float2int_rn(bf_lo(bw[2 * i]) * sxB), b1_ = __float2int_rn(bf_hi(bw[2 * i]) * sxB), b2_ = __float2int_rn(bf_lo(bw[2 * i + 1]) * sxB), b3_ = __float2int_rn(bf_hi(bw[2 * i + 1]) * sxB);
                  xa[i] = (unsigned)(a0_ & 255) | ((unsigned)(a1_ & 255) << 8) | ((unsigned)(a2_ & 255) << 16) | ((unsigned)(a3_ & 255) << 24);
                  xb[i] = (unsigned)(b0_ & 255) | ((unsigned)(b1_ & 255) << 8) | ((unsigned)(b2_ & 255) << 16) | ((unsigned)(b3_ & 255) << 24); } }
            { const int sn = (s + 1) & 7;
              xra0 = *(const u32x4*)(XG + rowA * DM + 128 * sn + 16 * j); xra1 = *(const u32x4*)(XG + rowA * DM + 128 * sn + 16 * j + 8); xrb0 = *(const u32x4*)(XG + rowB * DM + 128 * sn + 16 * j); xrb1 = *(const u32x4*)(XG + rowB * DM + 128 * sn + 16 * j + 8); }
            const unsigned char* Us = US + (size_t)s * (16384 * 128) + 16 * j; const unsigned char* Usn = US + (size_t)((s + 1) & 7) * (16384 * 128) + 16 * j;
#if PE_TOUCH
            const unsigned tchu = *(const volatile unsigned*)(US + (size_t)((s + 1) & 7) * (16384 * 128) + ((size_t)(((blockIdx.x >> 3) & 31) * 512 + F.tid)) * 128);
#endif
#define PE_UCOMP(buf_, x_, acc_, kb_) do { float pp[8]; _Pragma("unroll") for (int i = 0; i < 8; ++i) { int d_ = __builtin_amdgcn_sdot4((int)(buf_)[i].x, (int)(x_)[0], 0, false); d_ = __builtin_amdgcn_sdot4((int)(buf_)[i].y, (int)(x_)[1], d_, false); d_ = __builtin_amdgcn_sdot4((int)(buf_)[i].z, (int)(x_)[2], d_, false); d_ = __builtin_amdgcn_sdot4((int)(buf_)[i].w, (int)(x_)[3], d_, false); pp[i] = __int_as_float(d_); \
                    if (PE_XU) { _Pragma("unroll") for (int q = 0; q < PE_XU; ++q) dmu = __builtin_amdgcn_sdot4((int)(buf_)[i].x, (int)(x_)[q & 3], dmu, false); } } \
                (acc_)[kb_] += (float)reduce8x8i(pp, j); asm volatile("" : "+v"((acc_)[kb_]) :: "memory"); } while (0)
#pragma unroll
            for (int kb = 0; kb < 16; ++kb) {
                PE_ISSUE(bufB, reB, kb, Us);
                PE_UCOMP(bufA, xa, accA, kb);
                if (kb + 1 < 16) PE_ISSUE(bufA, reA, kb + 1, Us); else PE_ISSUE(bufA, reA, 0, Usn);
                PE_UCOMP(bufB, xb, accB, kb);
            }
            if (PE_XU) asm volatile("" :: "v"(dmu));
#if PE_TOUCH
            asm volatile("" :: "v"(tchu));
#endif
        }
#undef PE_UCOMP
#if PE_VMFMA
        LAS float* csc = (LAS float*)(F.lds + PE_CS); LAS float* ssb = (LAS float*)(F.lds + PE_SS);
        {
            const float rsA = rsqrtf(rss2[rowA] * (1.0f / DM) + EPS), rsB = rsqrtf(rss2[rowB] * (1.0f / DM) + EPS);
            float mA = 0.f, mB = 0.f;
#pragma unroll
            for (int kb = 0; kb < 16; ++kb) { const int eA = (int)(reA[8 * kb + j] >> 7), eB = (int)(reB[8 * kb + j] >> 7);
                accA[kb] = cfA[8 * kb + j] * gelu_exact(accA[kb] * (rsA * isxA) * SINV[eA]) * SINV[16384 + eA]; accB[kb] = cfB[8 * kb + j] * gelu_exact(accB[kb] * (rsB * isxB) * SINV[eB]) * SINV[16384 + eB];
                mA = fmaxf(mA, fabsf(accA[kb])); mB = fmaxf(mB, fabsf(accB[kb])); }
            mA = fmaxf(mA, __shfl_xor(mA, 1)); mA = fmaxf(mA, __shfl_xor(mA, 2)); mA = fmaxf(mA, __shfl_xor(mA, 4));
            mB = fmaxf(mB, __shfl_xor(mB, 1)); mB = fmaxf(mB, __shfl_xor(mB, 2)); mB = fmaxf(mB, __shfl_xor(mB, 4));
            const float qA = (mA > 0.f) ? 127.0f / mA : 0.f, qB = (mB > 0.f) ? 127.0f / mB : 0.f;
#pragma unroll
            for (int kb = 0; kb < 16; ++kb) { ((LAS unsigned*)cfA)[8 * kb + j] = (unsigned)(__float2int_rn(accA[kb] * qA) & 255) * 0x01010101u; ((LAS unsigned*)cfB)[8 * kb + j] = (unsigned)(__float2int_rn(accB[kb] * qB) & 255) * 0x01010101u; }
            if (j == 0) { csc[tA] = mA * (1.0f / 127.0f); csc[tB] = mB * (1.0f / 127.0f); ssb[tA] = 0.f; ssb[tB] = 0.f; }
        }
        LDS_WAIT();
        {
            const int g16 = lane & 15, kg = lane >> 4, w8 = 8 * w;
            const unsigned m0 = (g16 < 4) ? (0xFFu << (8 * (g16 & 3))) : 0u, m1 = (g16 >= 4 && g16 < 8) ? (0xFFu << (8 * (g16 & 3))) : 0u;
            const int ecol = 8 * (lane & 15) + 4 * ((lane >> 4) & 1);
            const LAS unsigned* RQ = (const LAS unsigned*)RG;
#define PV_ISSUE(buf_, qb_, t_, n0_, base_) do { u32x2 of_[8]; \
                _Pragma("unroll") for (int n = 0; n < 8; ++n) { of_[n] = *(const LAS u32x2*)(RE + (t_) * PE_REP + 8 * ((n0_) + n) + 2 * kg); (qb_)[n] = *(const LAS u32x2*)(RQ + (t_) * PE_REP + 8 * ((n0_) + n) + 2 * kg); } \
                asm volatile("" ::: "memory"); \
                _Pragma("unroll") for (int n = 0; n < 8; ++n) { (buf_)[2 * n] = *(const u32x2*)((base_) + (of_[n].x + lofs)); (buf_)[2 * n + 1] = *(const u32x2*)((base_) + (of_[n].y + lofs)); } \
                asm volatile("" ::: "memory"); } while (0)
#define PV_COMP(buf_, qb_) do { _Pragma("unroll") for (int n = 0; n < 8; ++n) { \
                const i32x4 sel_ = (i32x4){(int)((qb_)[n].x & m0), (int)((qb_)[n].x & m1), (int)((qb_)[n].y & m0), (int)((qb_)[n].y & m1)}; \
                const i32x4 dat_ = (i32x4){(int)(buf_)[2 * n].x, (int)(buf_)[2 * n].y, (int)(buf_)[2 * n + 1].x, (int)(buf_)[2 * n + 1].y}; \
                if (n & 1) acc1 = __builtin_amdgcn_mfma_i32_16x16x64_i8(sel_, dat_, acc1, 0, 0, 0); else acc0 = __builtin_amdgcn_mfma_i32_16x16x64_i8(sel_, dat_, acc0, 0, 0, 0); } } while (0)
            const unsigned lofs = 8u * (unsigned)g16;
            u32x2 bufA[16], bufB[16], qA8[8], qB8[8];
            PV_ISSUE(bufA, qA8, w8, 0, VS);
#pragma unroll 1
            for (int un = 0; un < 128; ++un) {
                const int s = un >> 4, tk = un & 15, t = w8 + (tk & 7) + ((tk & 8) << 3);
                const int u2 = un + 1, sn = (u2 >> 4) & 7, tkn = u2 & 15, tn = w8 + (tkn & 7) + ((tkn & 8) << 3);
                const unsigned char* Vs = VS + (size_t)s * (16384 * 128); const unsigned char* Vsn = VS + (size_t)sn * (16384 * 128);
                const size_t xoff = ((size_t)tile * 128 + t) * DM + 128 * s + ecol;
                const u32x2 xr = *(const u32x2*)(XG + xoff);
                i32x4 acc0 = (i32x4){0, 0, 0, 0}, acc1 = (i32x4){0, 0, 0, 0};
                PV_ISSUE(bufB, qB8, t, 8, Vs);
                PV_COMP(bufA, qA8);
                PV_ISSUE(bufA, qA8, tn, 0, Vsn);
                PV_COMP(bufB, qB8);
                const float cs = csc[t];
                f32x4 a0 = (f32x4){bf_lo(xr.x), bf_hi(xr.x), bf_lo(xr.y), bf_hi(xr.y)};
                a0 = a0 + (f32x4){(float)(acc0.x + acc1.x), (float)(acc0.y + acc1.y), (float)(acc0.z + acc1.z), (float)(acc0.w + acc1.w)} * cs;
                const float ss = (a0.x * a0.x + a0.y * a0.y) + (a0.z * a0.z + a0.w * a0.w);
                if (!DRY) {
                    if (lane < 32) { __hip_atomic_fetch_add(ssb + t, ss, __ATOMIC_RELAXED, __HIP_MEMORY_SCOPE_WORKGROUP);   u32x2 pa; pa.x = cvt_pk_bf16(a0.x, a0.y); pa.y = cvt_pk_bf16(a0.z, a0.w); *(u32x2*)(XGW + xoff) = pa; } }
            }
#undef PV_ISSUE
#undef PV_COMP
        }
#undef PE_DEC16P
#undef PE_ISSUE
        LDS_WAIT();
        float ssA = ssb[tA], ssB = ssb[tB];
        float* xoA = A.out + rowA * DM + 16 * j; float* xoB = A.out + rowB * DM + 16 * j;
        const float rfA = rsqrtf(ssA * (1.0f / DM) + EPS), rfB = rsqrtf(ssB * (1.0f / DM) + EPS);
#else
        {
            const float rsA = rsqrtf(rss2[rowA] * (1.0f / DM) + EPS), rsB = rsqrtf(rss2[rowB] * (1.0f / DM) + EPS);
#pragma unroll
            for (int kb = 0; kb < 16; ++kb) { const int eA = (int)(reA[8 * kb + j] >> 7), eB = (int)(reB[8 * kb + j] >> 7);
                cfA[8 * kb + j] = cfA[8 * kb + j] * gelu_exact(accA[kb] * (rsA * isxA) * SINV[eA]) * SINV[16384 + eA]; cfB[8 * kb + j] = cfB[8 * kb + j] * gelu_exact(accB[kb] * (rsB * isxB) * SINV[eB]) * SINV[16384 + eB]; }
        }
        LDS_WAIT();
        float ssA = 0.f, ssB = 0.f;
        float* xoA = A.out + rowA * DM + 16 * j; float* xoB = A.out + rowB * DM + 16 * j;
        PE_ISSUE(bufA, reA, 0, VS + 16 * j);
#pragma unroll 1
        for (int s2 = 0; s2 < ((P7REP & 4) ? 16 : 8); ++s2) {
            const int s = s2 & 7; const bool dry = (P7REP & 4) && s2 < 8;
            const unsigned char* Vs = VS + (size_t)s * (16384 * 128) + 16 * j; const unsigned char* Vsn = VS + (size_t)((s + 1) & 7) * (16384 * 128) + 16 * j;
#if PE_TOUCH
            const unsigned tchv = *(const volatile unsigned*)(VS + (size_t)((s + 1) & 7) * (16384 * 128) + ((size_t)(((blockIdx.x >> 3) & 31) * 512 + F.tid)) * 128);
#endif
            u32x2 x2a[4], x2b[4];
#pragma unroll
            for (int q = 0; q < 4; ++q) { x2a[q] = *(const u32x2*)(XG + rowA * DM + 128 * s + 16 * j + 4 * q); x2b[q] = *(const u32x2*)(XG + rowB * DM + 128 * s + 16 * j + 4 * q); }
            f32x2 oa[8], ob[8];
            f32x2 dmy[2] = {(f32x2){0.f, 0.f}, (f32x2){0.f, 0.f}}; int dmi[4] = {0, 0, 0, 0};
#pragma unroll
            for (int i = 0; i < 8; ++i) { oa[i] = (f32x2){0.f, 0.f}; ob[i] = (f32x2){0.f, 0.f}; }
#define PE_VCOMP(buf_, cf_, o_, kb_) do { const f32x4 c0_ = *(const LAS f32x4*)((cf_) + 8 * (kb_)), c1_ = *(const LAS f32x4*)((cf_) + 8 * (kb_) + 4); const float cw_[8] = {c0_.x, c0_.y, c0_.z, c0_.w, c1_.x, c1_.y, c1_.z, c1_.w}; \
                _Pragma("unroll") for (int i = 0; i < 8; ++i) { const f32x2 c2 = (f32x2){cw_[i], cw_[i]}; f32x2 f2[8]; PE_DEC16P((buf_)[i], f2); _Pragma("unroll") for (int q = 0; q < 8; ++q) (o_)[q] = __builtin_elementwise_fma(c2, f2[q], (o_)[q]); \
                    if (PE_XV) { _Pragma("unroll") for (int q = 0; q < PE_XV; ++q) dmy[q & 1] = __builtin_elementwise_fma(c2, f2[q], dmy[q & 1]); } \
                    if (PE_XP) { _Pragma("unroll") for (int q = 0; q < PE_XP; ++q) { dmi[q & 1] = (int)__builtin_amdgcn_perm((buf_)[i].x, (unsigned)dmi[q & 1], 0x05010400u + (unsigned)q); dmi[2 + (q & 1)] = __builtin_amdgcn_sdot4((int)(buf_)[i].y, dmi[q & 1], dmi[2 + (q & 1)], false); } } } \
                asm volatile("" : "+v"((o_)[0]), "+v"((o_)[1]), "+v"((o_)[2]), "+v"((o_)[3]), "+v"((o_)[4]), "+v"((o_)[5]), "+v"((o_)[6]), "+v"((o_)[7]) :: "memory"); } while (0)
#pragma unroll
            for (int kb = 0; kb < 16; ++kb) {
                PE_ISSUE(bufB, reB, kb, Vs);
                PE_VCOMP(bufA, cfA, oa, kb);
                if (kb + 1 < 16) PE_ISSUE(bufA, reA, kb + 1, Vs); else PE_ISSUE(bufA, reA, 0, Vsn);
                PE_VCOMP(bufB, cfB, ob, kb);
            }
#if PE_TOUCH
            asm volatile("" :: "v"(tchv));
#endif
#undef PE_VCOMP
            if (PE_XV) asm volatile("" :: "v"(dmy[0]), "v"(dmy[1]));
            if (PE_XP) asm volatile("" :: "v"(dmi[2]), "v"(dmi[3]));
#pragma unroll
            for (int q = 0; q < 4; ++q) {
                const u32x2 xa2 = x2a[q], xb2 = x2b[q];
                f32x4 a0 = (f32x4){bf_lo(xa2.x), bf_hi(xa2.x), bf_lo(xa2.y), bf_hi(xa2.y)}, b0 = (f32x4){bf_lo(xb2.x), bf_hi(xb2.x), bf_lo(xb2.y), bf_hi(xb2.y)};
                a0 = a0 + (f32x4){oa[2 * q].x, oa[2 * q].y, oa[2 * q + 1].x, oa[2 * q + 1].y}; b0 = b0 + (f32x4){ob[2 * q].x, ob[2 * q].y, ob[2 * q + 1].x, ob[2 * q + 1].y};
                if (!dry && !DRY) { ssA += (a0.x * a0.x + a0.y * a0.y) + (a0.z * a0.z + a0.w * a0.w); ssB += (b0.x * b0.x + b0.y * b0.y) + (b0.z * b0.z + b0.w * b0.w);
                u32x2 pa, pb; pa.x = cvt_pk_bf16(a0.x, a0.y); pa.y = cvt_pk_bf16(a0.z, a0.w); pb.x = cvt_pk_bf16(b0.x, b0.y); pb.y = cvt_pk_bf16(b0.z, b0.w);
                *(u32x2*)(XGW + rowA * DM + 128 * s + 16 * j + 4 * q) = pa; *(u32x2*)(XGW + rowB * DM + 128 * s + 16 * j + 4 * q) = pb; } }
        }
#undef PE_DEC16P
#undef PE_ISSUE
        ssA += __shfl_xor(ssA, 1); ssA += __shfl_xor(ssA, 2); ssA += __shfl_xor(ssA, 4);
        ssB += __shfl_xor(ssB, 1); ssB += __shfl_xor(ssB, 2); ssB += __shfl_xor(ssB, 4);
        const float rfA = rsqrtf(ssA * (1.0f / DM) + EPS), rfB = rsqrtf(ssB * (1.0f / DM) + EPS);
#endif
        VM_WAIT();
        __builtin_amdgcn_fence(__ATOMIC_ACQUIRE, "agent");
        VM_WAIT();
        const float* gfin = A.in[I_GFIN] + 16 * j;
#pragma unroll 2
        for (int s = 0; s < 8; ++s)
#pragma unroll
            for (int q = 0; q < 4; ++q) {
                const f32x4 g0 = *(const f32x4*)(gfin + 128 * s + 4 * q);
                const u32x2 xa2 = *(const u32x2*)(XGW + rowA * DM + 128 * s + 16 * j + 4 * q), xb2 = *(const u32x2*)(XGW + rowB * DM + 128 * s + 16 * j + 4 * q);
                const f32x4 a0 = (f32x4){bf_lo(xa2.x), bf_hi(xa2.x), bf_lo(xa2.y), bf_hi(xa2.y)}, b0 = (f32x4){bf_lo(xb2.x), bf_hi(xb2.x), bf_lo(xb2.y), bf_hi(xb2.y)};
                if (!DRY) { *(f32x4*)(xoA + 128 * s + 4 * q) = a0 * rfA * g0; *(f32x4*)(xoB + 128 * s + 4 * q) = b0 * rfB * g0; } else { asm volatile("" :: "v"(a0 * rfA * g0), "v"(b0 * rfB * g0)); } }
    }
    __syncthreads();
}

#ifndef USE_COOP_LAUNCH
#define USE_COOP_LAUNCH 1
#endif
#ifndef USE_CG_SYNC
#define USE_CG_SYNC 0
#endif
#ifndef DBG_SRC
#define DBG_SRC 0
#endif
#ifndef DBG_ZC
#define DBG_ZC 0
#endif
#ifndef DBG_C0
#define DBG_C0 0
#endif
#ifndef DBG_C1
#define DBG_C1 1024
#endif
__global__ void __launch_bounds__(512, 2) mk_fwd(Args args) {
    extern __shared__ __attribute__((aligned(16))) unsigned char lds_raw[];
    Frame F;
    F.lds = (LAS unsigned char*)lds_raw;
    F.tid = threadIdx.x; F.lane = F.tid & 63; F.wave = __builtin_amdgcn_readfirstlane(F.tid >> 6);
    F.G = gridDim.x; { const int bx = blockIdx.x; F.vcu = (F.G % 8 == 0) ? (bx % 8) * (F.G / 8) + bx / 8 : bx; }
    F.a = &args; F.ws = args.ws; F.ctl = (unsigned*)(args.ws + WS_CTL);
    const int lo = args.ph_lo, hi = args.ph_hi;
#if USE_CG_SYNC
    cg::grid_group grid = cg::this_grid();
#define GRID_BAR() grid.sync()
#else
    { volatile LAS unsigned* st0 = (volatile LAS unsigned*)(F.lds + MISC_OFF); if (F.tid < 8) st0[F.tid] = 0u; }
    __syncthreads();
    XcdBarrier xbar; xbar.bar = F.ctl + CW_BAR; xbar.x = 0; xbar.st = nullptr;
    if (hi - lo > 1) xbar = xcd_barrier_post(F.ctl + CW_BAR, (volatile LAS unsigned*)(F.lds + MISC_OFF));
#define GRID_BAR() xcd_barrier(xbar)
#endif
#define IN(k) (lo <= (k) && (k) < hi)
#ifndef PHMASK
#define PHMASK 0x1FF
#endif
#ifndef P2SUB
#define P2SUB 7
#endif
#ifndef P1PROBE
#define P1PROBE 0
#endif
#define PHON(k) (((PHMASK) >> (k)) & 1)
#ifndef REPMASK
#define REPMASK 0
#endif
#define NREP(k) ((((REPMASK) >> (k)) & 1) ? 2 : 1)
#define PHASE_BEGIN() do { int t_ = threadIdx.x; asm volatile("" : "+v"(t_)); F.tid = t_; F.lane = t_ & 63; } while (0)
#define SEAM(k) do { if (IN(k) && IN((k) + 1)) GRID_BAR(); } while (0)
    unsigned char* ws = args.ws;
    const int bx = blockIdx.x;

    if (PHON(0) && IN(0)) { for (int rep = 0; rep < NREP(0); ++rep) { PHASE_BEGIN(); p0_prologue(F); } }
    SEAM(0);
    if (PHON(1) && IN(1)) for (int rep = 0; rep < NREP(1); ++rep) {
        PHASE_BEGIN();
        { pg8::Sched S{0, T_TOK / 256, NZ / 256, (T_TOK / 256) * (NZ / 256), F.G, bx, 1, (const char*)(ws + WS_BUFA), (const char*)(ws + WS_WIN), (char*)(ws + WS_Z), (size_t)256 * DM, (size_t)256 * DM, 0, 2};
          pg8::EpiBf16 E{NZ, 1.0f, nullptr, (const float*)(F.ctl + CW_WSC), (const float*)(F.ctl + CW_HSC), (P1PROBE && rep + 1 < NREP(1)) ? (P1PROBE & 3) : 0};
          pg8::gemm_phase<pg8::EpiBf16, pg8::Sched, true>(F.lds, DM / 2, DM / 2, DM / 2, S, E); }
        if (!((P1PROBE & 4) && rep + 1 < NREP(1)))
        { pg8::Sched S{0, TMEM / 256, 2048 / 256, (TMEM / 256) * (2048 / 256), F.G, bx, 1, (const char*)(ws + WS_MEMN), (const char*)(ws + WS_WKV), (char*)(ws + WS_KV), (size_t)256 * DM * 2, (size_t)256 * DM * 2, 0, 2};
          pg8::EpiBf16 E{2048, 1.0f, nullptr, nullptr};
          pg8::gemm_phase(F.lds, DM, DM, DM, S, E); }
    }
    SEAM(1);
    if (PHON(2) && IN(2)) for (int rep = 0; rep < NREP(2); ++rep) {
        PHASE_BEGIN();
        conv_prepass(F);
    }
    SEAM(2);
    if (PHON(3) && IN(3)) for (int rep = 0; rep < NREP(3); ++rep) {
        PHASE_BEGIN();
        float lam;
        { float s1 = 0.f, s2 = 0.f;
          for (int i = 0; i < 64; ++i) { s1 += args.in[I_LQ1][i] * args.in[I_LK1][i]; s2 += args.in[I_LQ2][i] * args.in[I_LK2][i]; }
          lam = __expf(s1) - __expf(s2) + 0.2f; }
        LAS int* qslot = (LAS int*)(F.lds + MISC_OFF + 16);
        int qx = bx & 7, tried = 0;
        for (;;) {
            if (F.tid == 0) *qslot = (int)atomicAdd(F.ctl + CW_Q2 + 64 * (qx + 8 * rep), 1u);
            __syncthreads();
            const int u = *qslot;
            __syncthreads();
            if (u >= 8 + QN_ATT + 64 + 64) { if (++tried == 8) break; qx = (qx + 1) & 7; continue; }
            const int submask = (rep + 1 < NREP(3)) ? (REPSUB) : (P2SUB);
            if (u < 8) { const int p = qx + 8 * u; if ((submask & 1) && !((rep + 1 < NREP(3)) && (PROBE_HALF & 1) && u >= 4)) mlstm_unit(F, p >> 2, p & 3); }
            else if (u >= 8 + QN_ATT + 64) { if (rep + 1 == NREP(3)) peer_convert_rows(F, qx + 8 * (u - (8 + QN_ATT + 64))); }
            else if (u >= 8 + QN_ATT) { if (rep + 1 == NREP(3)) {
                const int gi = qx + 8 * (u - (8 + QN_ATT));
                if (gi < 256) { pg8::Sched S{1, 0, 0, 256, 1 << 30, gi, 1, (const char*)(ws + WS_KV), (const char*)(ws + WS_WCQ), (char*)(ws + WS_MB), 0, 0, 0, 2};
                    pg8::EpiBf16 E{DM, 0.0625f, nullptr, args.in[I_GCA]};
                    pg8::gemm_phase(F.lds, 256, 2048, DM, S, E); }
                else { pg8::Sched S{2, 0, 0, 256, 1 << 30, gi - 256, 1, (const char*)(ws + WS_WCO), (const char*)(ws + WS_KV), (char*)(ws + WS_VWB), 0, 0, 0, 2};
                    pg8::EpiBf16 E{DM, 1.0f, nullptr, nullptr};
                    pg8::gemm_phase(F.lds, 256, DM, 2048, S, E); } } }
            else if ((submask & 2) && !((rep + 1 < NREP(3)) && (PROBE_HALF & 2) && ((u - 8) >> 4) >= 4)) { const int j = u - 8;
#if Q_PAIRED
                { const int p = qx + 8 * (j >> 3), g_ = j & 7;
#pragma unroll 1
                  for (int hf = 0; hf < 2; ++hf) { const int qt_ = hf ? g_ : 15 - g_;
                      if (rep + 1 < NREP(3)) attn_unit<ATT_MODE>(F, p >> 2, p & 3, qt_, lam); else attn_unit<0>(F, p >> 2, p & 3, qt_, lam); } }
#elif Q_LPT
                const int p = qx + 8 * (j & 7), qt_ = 15 - (j >> 3);
#else
                const int p = qx + 8 * (j >> 4), qt_ = 15 - (j & 15);
#endif
#if !Q_PAIRED
                if (rep + 1 < NREP(3)) attn_unit<ATT_MODE>(F, p >> 2, p & 3, qt_, lam); else attn_unit<0>(F, p >> 2, p & 3, qt_, lam);
#endif
            }
        }
    }
    SEAM(3);
    if (PHON(4) && IN(4)) for (int rep = 0; rep < NREP(4); ++rep) {
        PHASE_BEGIN();
        pg8::Sched S{0, T_TOK / 256, 4, (T_TOK / 256) * 4, F.G, bx, 1, (const char*)(ws + WS_BUFA), (const char*)(ws + WS_WOUT), nullptr, (size_t)256 * DM * 2, (size_t)256 * DM * 2, 0, 2};
        pg8::EpiResidB<false> E{args.in[I_X], (bf16_t*)(ws + WS_BUFB), (float*)(F.ctl + ((rep + 1 < NREP(4)) ? CW_DUMMY : CW_RSS1))};
        pg8::gemm_phase(F.lds, DM, DM, DM, S, E);
    }
    SEAM(4);
    if (PHON(5) && IN(5)) for (int rep = 0; rep < NREP(5); ++rep) {
        PHASE_BEGIN();
        pg8::Sched S{0, T_TOK / 256, 4, (T_TOK / 256) * 4, F.G, bx, 8, (const char*)(ws + WS_BUFB), (const char*)(ws + WS_MB), nullptr, (size_t)256 * DM * 2, (size_t)256 * DM * 2, (size_t)DM * DM * 2, 2};
        pg8::EpiSoftmax E{(const float*)(F.ctl + CW_RSS1), (bf16_t*)(ws + WS_BUFA)};
        pg8::gemm_phase(F.lds, DM, DM, DM, S, E);
    }
    SEAM(5);
    if (PHON(6) && IN(6)) {
        PHASE_BEGIN();
        pg8::Sched S{0, T_TOK / 256, 4, (T_TOK / 256) * 4, F.G, bx, 8, (const char*)(ws + WS_BUFA), (const char*)(ws + WS_VWB), nullptr, (size_t)256 * DM * 2, (size_t)256 * DM * 2, (size_t)DM * DM * 2, 2};
        pg8::EpiResidB<true> E{(const void*)(ws + WS_BUFB), (bf16_t*)(ws + WS_BUFB), (float*)(F.ctl + CW_RSS2)};
        pg8::gemm_phase(F.lds, DM, DM, DM, S, E);
    }
    SEAM(6);
    if (PHON(7) && IN(7)) for (int rep = 0; rep < NREP(7); ++rep) {
        PHASE_BEGIN();
        pg8::Sched S{0, T_TOK / 256, 4, (T_TOK / 256) * 4, F.G, bx, 1, (const char*)(ws + WS_BUFB), (const char*)(ws + WS_WPQ), (char*)(ws + WS_BUFA), (size_t)256 * DM * 2, (size_t)256 * DM * 2, 0, 2};
        pg8::EpiBf16 E{DM, 1.0f, (const float*)(F.ctl + CW_RSS2), nullptr};
        pg8::gemm_phase(F.lds, DM, DM, DM, S, E);
    }
    SEAM(7);
    if (PHON(8) && IN(8)) {
        PHASE_BEGIN();
        if (NREP(8) > 1) { for (int tile = bx; tile < T_TOK / 128; tile += F.G) peer_tile<true>(F, tile); }
        for (int tile = bx; tile < T_TOK / 128; tile += F.G) peer_tile<false>(F, tile);
    }
    if (lo <= 9 && 9 < hi) {
        const bf16_t* src = (const bf16_t*)(ws + (DBG_SRC ? WS_Z : WS_BUFA));
        for (size_t i = (size_t)bx * 512 + F.tid; i < (size_t)T_TOK * DM / 2; i += (size_t)F.G * 512) { const size_t row_ = (2 * i) >> 10, col_ = (2 * i) & 1023; const unsigned u = DBG_SRC ? *(const unsigned*)(src + row_ * NZ + DBG_ZC + col_) : ((const unsigned*)src)[i]; const int col = (int)((2 * i) & 1023); const bool on = (col >= DBG_C0 && col < DBG_C1); args.out[2 * i] = on ? bf_lo(u) : 0.f; args.out[2 * i + 1] = on ? bf_hi(u) : 0.f; }
    }
#undef IN
#undef SEAM
}

#ifndef MK_N_LAUNCHES
#define MK_N_LAUNCHES 1
#endif
extern "C" void kernel_launch(void* const* d_in, const int* in_sizes, int n_in, void* d_out, int out_size, void* d_ws, size_t ws_size, hipStream_t stream) {
    static int grid = 0;
    if (grid == 0) {
        if (n_in != 26 || out_size != T_TOK * DM || ws_size < WS_END + 34 * MiB) { fprintf(stderr, "kernel_launch: unexpected shapes (n_in %d out %d ws %zu)\n", n_in, out_size, ws_size); grid = -1; return; }
        int dev = 0, cus = 0, per_cu = 0;
        hipGetDevice(&dev); hipDeviceGetAttribute(&cus, hipDeviceAttributeMultiprocessorCount, dev);
        if (hipFuncSetAttribute((const void*)mk_fwd, hipFuncAttributeMaxDynamicSharedMemorySize, LDS_BYTES) != hipSuccess) { fprintf(stderr, "kernel_launch: hipFuncSetAttribute failed\n"); grid = -1; return; }
        if (hipOccupancyMaxActiveBlocksPerMultiprocessor(&per_cu, (const void*)mk_fwd, 512, LDS_BYTES) != hipSuccess || per_cu < 1) { fprintf(stderr, "kernel_launch: occupancy query says %d\n", per_cu); per_cu = 1; }
        (void)hipGetLastError();
        grid = cus;
    }
    if (grid < 0) return;
    hipMemsetAsync((char*)d_ws + WS_CTL, 0, CTL_BYTES, stream);
    Args a{};
    for (int i = 0; i < 26; ++i) a.in[i] = (const float*)d_in[i];
    a.out = (float*)d_out; a.ws = (unsigned char*)d_ws;
    if (MK_N_LAUNCHES == 1) {
        a.ph_lo = 0; a.ph_hi = 9;
        void* kargs[] = {&a};
#if USE_COOP_LAUNCH
        hipError_t e = hipLaunchCooperativeKernel((const void*)mk_fwd, dim3(grid), dim3(512), kargs, LDS_BYTES, stream);
        if (e != hipSuccess) fprintf(stderr, "cooperative launch failed: %s (grid %d)\n", hipGetErrorString(e), grid);
#else
        (void)kargs; hipLaunchKernelGGL(mk_fwd, dim3(grid), dim3(512), LDS_BYTES, stream, a);
#endif
    } else {
#ifndef DBG_STOP
#define DBG_STOP 9
#endif
#ifndef DBG_DUMP
#define DBG_DUMP 0
#endif
        for (int p = 0; p < DBG_STOP; ++p) { a.ph_lo = p; a.ph_hi = p + 1; hipLaunchKernelGGL(mk_fwd, dim3(grid), dim3(512), LDS_BYTES, stream, a); }
        if (DBG_DUMP) { a.ph_lo = 9; a.ph_hi = 10; hipLaunchKernelGGL(mk_fwd, dim3(grid), dim3(512), LDS_BYTES, stream, a); }
    }
}
```

```cpp
#include <hip/hip_runtime.h>
#include <hip/hip_cooperative_groups.h>
#include <cstdio>
#include <cstdint>
namespace cg = cooperative_groups;

#define GAS __attribute__((address_space(1)))
#define LAS __attribute__((address_space(3)))
typedef unsigned short bf16_t;
typedef short bf16x8 __attribute__((ext_vector_type(8)));
typedef short s16x4 __attribute__((ext_vector_type(4)));
typedef float f32x4 __attribute__((ext_vector_type(4)));
typedef float f32x2 __attribute__((ext_vector_type(2)));
typedef float f32x16 __attribute__((ext_vector_type(16)));
typedef unsigned u32x4 __attribute__((ext_vector_type(4)));
typedef unsigned u32x2 __attribute__((ext_vector_type(2)));
typedef int i32x4 __attribute__((ext_vector_type(4)));

constexpr int T_TOK = 32768, DM = 1024, NB = 16, SEQ = 2048, NZ = 3584, INW = 3592, MEML = 256, TMEM = NB * MEML;
constexpr float EPS = 1e-6f;
constexpr float LOG2E = 1.4426950408889634f;
constexpr int ZC_MLQ = 0, ZC_MLK = 512, ZC_MLV = 1024, ZC_MLO = 1536, ZC_DAQ = 2048, ZC_DAK = 2560, ZC_DAV = 3072;

constexpr size_t MiB = 1u << 20;
constexpr size_t WS_CTL = 0, CTL_BYTES = 1 * MiB;
constexpr size_t WS_WIN = 1 * MiB, WS_WOUT = 8 * MiB, WS_WCQ = 10 * MiB, WS_WKV = 12 * MiB, WS_WCO = 16 * MiB, WS_WPQ = 18 * MiB, WS_SK = 20 * MiB;
constexpr size_t WS_GATES = 21 * MiB, WS_MEMN = 22 * MiB, WS_KV = 30 * MiB, WS_MB = 46 * MiB, WS_VWB = 78 * MiB;
constexpr size_t WS_BUFA = 110 * MiB, WS_BUFB = 174 * MiB, WS_Z = 238 * MiB, WS_END = 462 * MiB;
constexpr int CW_Q2 = 64;
constexpr int CW_RSS1 = 16384;
constexpr int CW_WSC = 49152;
constexpr int CW_KMAX = 53248;
constexpr int CW_RSS2 = 65536;
constexpr int CW_HSC = 98304;
constexpr int CW_BAR = 131072;
constexpr int CW_DUMMY = 180224;

constexpr int LDS_BYTES = 147456;
constexpr int XCH_OFF = 131072;
constexpr int MISC_OFF = LDS_BYTES - 256;

__device__ __forceinline__ unsigned cvt_pk_bf16(float lo, float hi) { unsigned r; asm("v_cvt_pk_bf16_f32 %0, %1, %2" : "=v"(r) : "v"(lo), "v"(hi)); return r; }
__device__ __forceinline__ float bf_lo(unsigned u) { return __uint_as_float(u << 16); }
__device__ __forceinline__ float bf_hi(unsigned u) { return __uint_as_float(u & 0xffff0000u); }
__device__ __forceinline__ float wave_sum(float v) {
#pragma unroll
    for (int o = 1; o < 64; o <<= 1) v += __shfl_xor(v, o);
    return v;
}
__device__ __forceinline__ float fast_exp2(float x) { return __builtin_amdgcn_exp2f(x); }
__device__ __forceinline__ float fast_rcp(float x) { return __builtin_amdgcn_rcpf(x); }
#define LDS_WAIT() asm volatile("s_waitcnt lgkmcnt(0)" ::: "memory")
#define VM_WAIT() asm volatile("s_waitcnt vmcnt(0)" ::: "memory")

namespace pg8 {
constexpr int BM = 256, BK = 64, HALF = 128, HTB = HALF * BK * 2, STAGE_BYTES = 8 * HTB;
__device__ __forceinline__ int lds_byte(int r, int c) { const int st = (r >> 4) * 2 + (c >> 5), rr = r & 15, cc = c & 31, ob = rr * 64 + cc * 2; return st * 1024 + (ob ^ (((ob >> 9) & 1) << 5)); }
__device__ __forceinline__ void stage_rc(int b, int& R, int& C) { const int st = b / 1024, sb = b % 1024, swz = sb ^ (((sb >> 9) & 1) << 5); R = (st >> 1) * 16 + swz / 64; C = (st & 1) * 32 + (swz % 64) / 2; }
__device__ __forceinline__ int perm32(int rho) { const int n = rho >> 4, i = rho & 15; return 8 * (i >> 2) + 4 * n + (i & 3); }

struct Unit { const char* A; const char* B; char* O; int row0, col0, scol; };

template <class Epi, class Sched, bool I8 = false>
__device__ __forceinline__ void gemm_phase(LAS unsigned char* lds, const int K, const int lda, const int ldb, const Sched& S, const Epi& E) {
    int tid_l = threadIdx.x; asm volatile("" : "+v"(tid_l));
    const int tid = tid_l, wid = __builtin_amdgcn_readfirstlane(tid >> 6), lane = tid & 63, wr = wid >> 2, wc = wid & 3, fr = lane & 15, fq = lane >> 4;
    const int nt = K / BK;
    unsigned voffA[2], voffB[2];
#pragma unroll
    for (int i = 0; i < 2; ++i) { int R, C; stage_rc(tid * 16 + i * 8192, R, C); const int Rb = Epi::PERM ? ((R & ~31) + perm32(R & 31)) : R;
        voffA[i] = (unsigned)(R * lda + C) * 2u; voffB[i] = (unsigned)(Rb * ldb + C) * 2u; }
    const size_t kstep = (size_t)(BK * 2);
    const size_t hstepA = (size_t)HALF * lda * 2, hstepB = (size_t)HALF * ldb * 2;
    const unsigned ldsw = (unsigned)wid * 1024u;
    const int aoff = lds_byte(wr * 64 + fr, fq * 8), boff = lds_byte(wc * 32 + fr, fq * 8);
#define PG8_SA(b, h) (((b) * 2 + (h)) * HTB)
#define PG8_SB(b, h) ((4 + (b) * 2 + (h)) * HTB)
#define PG8_STAGE(bufoff, gbase, voff) do { _Pragma("unroll") for (int _i = 0; _i < 2; ++_i) \
        __builtin_amdgcn_global_load_lds((const unsigned*)((const char*)(gbase) + (voff)[_i]), (LAS unsigned*)(lds + (bufoff) + ldsw + _i * 8192), 16, 0, 0); } while (0)
#define PG8_LDA(dst, b, h) do { _Pragma("unroll") for (int m = 0; m < 4; ++m) _Pragma("unroll") for (int k = 0; k < 2; ++k) dst[m][k] = *(const LAS bf16x8*)(lds + PG8_SA(b, h) + aoff + m * 2048 + k * 1024); } while (0)
#define PG8_LDB(dst, b, h) do { _Pragma("unroll") for (int n = 0; n < 2; ++n) _Pragma("unroll") for (int k = 0; k < 2; ++k) dst[n][k] = *(const LAS bf16x8*)(lds + PG8_SB(b, h) + boff + n * 2048 + k * 1024); } while (0)
#define PG8_MMA(ai, bj, At, Bt) do { __builtin_amdgcn_s_setprio(1); _Pragma("unroll") for (int m = 0; m < 4; ++m) _Pragma("unroll") for (int n = 0; n < 2; ++n) _Pragma("unroll") for (int k = 0; k < 2; ++k) \
        { if (I8) acc[ai][bj][m][n] = __builtin_bit_cast(f32x4, __builtin_amdgcn_mfma_i32_16x16x64_i8(__builtin_bit_cast(i32x4, Bt[n][k]), __builtin_bit_cast(i32x4, At[m][k]), __builtin_bit_cast(i32x4, acc[ai][bj][m][n]), 0, 0, 0)); \
          else acc[ai][bj][m][n] = __builtin_amdgcn_mfma_f32_16x16x32_bf16(Bt[n][k], At[m][k], acc[ai][bj][m][n], 0, 0, 0); } __builtin_amdgcn_s_setprio(0); } while (0)
#define PG8_WAIT_V(n) asm volatile("s_waitcnt vmcnt(" #n ")" ::: "memory")
#define PG8_WAIT_L(n) asm volatile("s_waitcnt lgkmcnt(" #n ")" ::: "memory")
#define PG8_BAR __builtin_amdgcn_s_barrier()
#define PG8_SCHED __builtin_amdgcn_sched_barrier(0)
    Unit cur, nxt; int ui = 0;
    if (!S.next(0, cur)) return;
    f32x4 acc[2][2][4][2];
#pragma unroll
    for (int a = 0; a < 2; ++a)
#pragma unroll
        for (int b = 0; b < 2; ++b)
#pragma unroll
            for (int m = 0; m < 4; ++m)
#pragma unroll
                for (int n = 0; n < 2; ++n) acc[a][b][m][n] = (f32x4){0.f, 0.f, 0.f, 0.f};
    bf16x8 At[4][2], B0[2][2], B1[2][2];
    const char* cA = cur.A; const char* cB = cur.B;
    PG8_STAGE(PG8_SB(0, 0), cB, voffB); PG8_STAGE(PG8_SA(0, 0), cA, voffA); PG8_STAGE(PG8_SB(0, 1), cB + hstepB, voffB); PG8_STAGE(PG8_SA(0, 1), cA + hstepA, voffA);
    if (wr == 1) PG8_BAR;
    PG8_WAIT_V(4); PG8_BAR;
    PG8_STAGE(PG8_SB(1, 0), cB + kstep, voffB); PG8_STAGE(PG8_SA(1, 0), cA + kstep, voffA); PG8_STAGE(PG8_SB(1, 1), cB + hstepB + kstep, voffB);
    PG8_WAIT_V(6); PG8_BAR;
    for (;;) {
        const bool has_next = S.next(ui + 1, nxt);
        const char* nA = has_next ? nxt.A : cA; const char* nB = has_next ? nxt.B : cB;
        for (int t = 0; t < nt; t += 2) {
            const bool last = (t == nt - 2);
            const char* a1 = cA + (size_t)(t + 1) * kstep;
            const char* a2 = last ? nA : cA + (size_t)(t + 2) * kstep; const char* b2 = last ? nB : cB + (size_t)(t + 2) * kstep;
            const char* a3 = a2 + kstep; const char* b3 = b2 + kstep;
            PG8_LDB(B0, 0, 0); PG8_SCHED; PG8_LDA(At, 0, 0); PG8_STAGE(PG8_SA(1, 1), a1 + hstepA, voffA);
            PG8_WAIT_L(8); PG8_BAR; PG8_WAIT_L(0); PG8_MMA(0, 0, At, B0); PG8_BAR; PG8_SCHED;
            PG8_LDB(B1, 0, 1); PG8_STAGE(PG8_SB(0, 0), b2, voffB);
            PG8_BAR; PG8_WAIT_L(0); PG8_MMA(0, 1, At, B1); PG8_BAR;
            PG8_LDA(At, 0, 1); PG8_STAGE(PG8_SA(0, 0), a2, voffA);
            PG8_BAR; PG8_WAIT_L(0); PG8_MMA(1, 0, At, B0); PG8_BAR; PG8_SCHED;
            PG8_STAGE(PG8_SB(0, 1), b2 + hstepB, voffB);
            PG8_WAIT_V(6); PG8_BAR; PG8_MMA(1, 1, At, B1); PG8_BAR;
            PG8_LDB(B0, 1, 0); PG8_SCHED; PG8_LDA(At, 1, 0); PG8_STAGE(PG8_SA(0, 1), a2 + hstepA, voffA);
            PG8_WAIT_L(8); PG8_BAR; PG8_WAIT_L(0); PG8_MMA(0, 0, At, B0); PG8_BAR; PG8_SCHED;
            PG8_LDB(B1, 1, 1); PG8_STAGE(PG8_SB(1, 0), b3, voffB);
            PG8_BAR; PG8_WAIT_L(0); PG8_MMA(0, 1, At, B1); PG8_BAR;
            PG8_LDA(At, 1, 1); PG8_STAGE(PG8_SA(1, 0), a3, voffA);
            PG8_BAR; PG8_WAIT_L(0); PG8_MMA(1, 0, At, B0); PG8_BAR; PG8_SCHED;
            PG8_STAGE(PG8_SB(1, 1), b3 + hstepB, voffB);
            PG8_WAIT_V(6); PG8_BAR; PG8_MMA(1, 1, At, B1); PG8_BAR;
        }
        if (I8) {
#pragma unroll
            for (int a = 0; a < 2; ++a)
#pragma unroll
                for (int b = 0; b < 2; ++b)
#pragma unroll
                    for (int m = 0; m < 4; ++m)
#pragma unroll
                        for (int n = 0; n < 2; ++n)
#pragma unroll
                            for (int e = 0; e < 4; ++e) acc[a][b][m][n][e] = (float)__float_as_int(acc[a][b][m][n][e]);
        }
        if (!E.skip()) E(acc, cur, wr, wc, fr, fq, lds);
        else {
#pragma unroll
            for (int a = 0; a < 2; ++a)
#pragma unroll
                for (int b = 0; b < 2; ++b)
#pragma unroll
                    for (int m = 0; m < 4; ++m)
#pragma unroll
                        for (int n = 0; n < 2; ++n) asm volatile("" :: "v"(acc[a][b][m][n]));
        }
        if (!has_next) break;
#pragma unroll
        for (int a = 0; a < 2; ++a)
#pragma unroll
            for (int b = 0; b < 2; ++b)
#pragma unroll
                for (int m = 0; m < 4; ++m)
#pragma unroll
                    for (int n = 0; n < 2; ++n) acc[a][b][m][n] = (f32x4){0.f, 0.f, 0.f, 0.f};
        cur = nxt; cA = nA; cB = nB; ++ui;
    }
    PG8_WAIT_V(0);
    if (wr == 0) PG8_BAR;
    PG8_BAR;
#undef PG8_SA
#undef PG8_SB
#undef PG8_STAGE
#undef PG8_LDA
#undef PG8_LDB
#undef PG8_MMA
#undef PG8_WAIT_V
#undef PG8_WAIT_L
#undef PG8_BAR
#undef PG8_SCHED
}

struct Sched {
    int mode, nM, nN, nwg, G, c, tpb; const char* baseA; const char* baseB; char* baseO; size_t strideA, strideB, bstrideB; int ldo_bytes_per_el;
    __device__ __forceinline__ bool next(int i, Unit& u) const {
        const long L = (long)i * G + c; if (L >= nwg) return false;
        if (mode == 0) {
            int wgid = (int)L; { const int q = nwg / 8, r = nwg % 8, xcd = wgid % 8, off = wgid / 8; wgid = (xcd < r ? xcd * (q + 1) : r * (q + 1) + (xcd - r) * q) + off; }
            const int nig = 8 * nN, gid = wgid / nig, fm = gid * 8, gsz = (nM - fm) < 8 ? (nM - fm) : 8;
            const int pm = fm + ((wgid % nig) % gsz), pn = (wgid % nig) / gsz;
            u.A = baseA + (size_t)pm * strideA; u.B = baseB + (size_t)pn * strideB + (size_t)(pm / tpb) * bstrideB; u.O = baseO; u.row0 = pm * 256; u.col0 = pn * 256; u.scol = pn * 256;
        } else if (mode == 1) {
            const int l = (int)L, b = l >> 4, h = (l >> 2) & 3, kt = l & 3;
            u.A = baseA + ((size_t)(b * 256) * 2048 + h * 256) * 2; u.B = baseB + ((size_t)(kt * 256) * 1024 + h * 256) * 2;
            u.O = baseO + ((size_t)b * 1048576 + (size_t)(h * 256) * 1024 + kt * 256) * 2; u.row0 = 0; u.col0 = 0; u.scol = kt * 256;
        } else {
            const int l = (int)L, b = l >> 4, h = (l >> 2) & 3, ntile = l & 3;
            u.A = baseA + ((size_t)(ntile * 256) * 1024 + h * 256) * 2; u.B = baseB + ((size_t)(b * 256) * 2048 + 1024 + h * 256) * 2;
            u.O = baseO + ((size_t)b * 1048576 + (size_t)(ntile * 256) * 1024 + h * 256) * 2; u.row0 = 0; u.col0 = 0; u.scol = 0;
        }
        return true;
    }
};

struct EpiBf16 {
    static constexpr bool PERM = true;
    int ldc; float scale; const float* rss; const float* colscale; const float* rowscale; int probe;
    __device__ __forceinline__ bool skip() const { return probe == 2; }
    __device__ __forceinline__ void operator()(const f32x4 (&acc)[2][2][4][2], const Unit& u, int wr, int wc, int fr, int fq, LAS unsigned char*) const {
        bf16_t* base = (bf16_t*)u.O;
        f32x4 cs[2][2];
#pragma unroll
        for (int bj = 0; bj < 2; ++bj)
#pragma unroll
            for (int n = 0; n < 2; ++n) cs[bj][n] = colscale ? *(const f32x4*)(colscale + u.scol + wc * 32 + 8 * fq + bj * HALF + 4 * n) : (f32x4){1.f, 1.f, 1.f, 1.f};
        float scv[2][4];
#pragma unroll
        for (int ai = 0; ai < 2; ++ai)
#pragma unroll
            for (int m = 0; m < 4; ++m) { const int row = u.row0 + ai * HALF + wr * 64 + m * 16 + fr;
                float sc = scale; if (rss) sc *= rsqrtf(rss[row] * (1.0f / 1024.0f) + EPS); if (rowscale) sc *= rowscale[row]; scv[ai][m] = sc; }
        asm volatile("" ::: "memory");
#pragma unroll
        for (int ai = 0; ai < 2; ++ai)
#pragma unroll
            for (int m = 0; m < 4; ++m) {
                const int row = u.row0 + ai * HALF + wr * 64 + m * 16 + fr;
                const float sc = scv[ai][m];
                bf16_t* rowp = probe ? base + (size_t)blockIdx.x * 32768 + (row & 127) * 256 + wc * 32 + 8 * fq : base + (size_t)row * ldc + u.col0 + wc * 32 + 8 * fq;
#pragma unroll
                for (int bj = 0; bj < 2; ++bj) { const f32x4 v0 = acc[ai][bj][m][0] * sc * cs[bj][0], v1 = acc[ai][bj][m][1] * sc * cs[bj][1];
                    u32x4 w; w.x = cvt_pk_bf16(v0[0], v0[1]); w.y = cvt_pk_bf16(v0[2], v0[3]); w.z = cvt_pk_bf16(v1[0], v1[1]); w.w = cvt_pk_bf16(v1[2], v1[3]);
                    *(u32x4*)(rowp + bj * HALF) = w; } }
    }
};
struct EpiResid {
    static constexpr bool PERM = false;
    const float* base; float* out; bf16_t* xg; const float* g; float* rss;
    __device__ __forceinline__ void operator()(const f32x4 (&acc)[2][2][4][2], const Unit& u, int wr, int wc, int fr, int fq, LAS unsigned char*) const {
        const int colb = u.col0 + wc * 32 + 4 * fq;
#pragma unroll
        for (int ai = 0; ai < 2; ++ai)
#pragma unroll
            for (int m = 0; m < 4; ++m) {
                const int row = u.row0 + ai * HALF + wr * 64 + m * 16 + fr; const size_t off = (size_t)row * DM + colb; float ss = 0.f;
#pragma unroll
                for (int bj = 0; bj < 2; ++bj)
#pragma unroll
                    for (int n = 0; n < 2; ++n) { const int co = bj * HALF + n * 16;
                        const f32x4 bs = *(const f32x4*)(base + off + co); const f32x4 v = bs + acc[ai][bj][m][n];
                        *(f32x4*)(out + off + co) = v; const f32x4 gv = *(const f32x4*)(g + colb + co); const f32x4 w = v * gv;
                        u32x2 pk; pk.x = cvt_pk_bf16(w[0], w[1]); pk.y = cvt_pk_bf16(w[2], w[3]); *(u32x2*)(xg + off + co) = pk;
                        ss += (v[0] * v[0] + v[1] * v[1]) + (v[2] * v[2] + v[3] * v[3]); }
                ss += __shfl_xor(ss, 16); ss += __shfl_xor(ss, 32);
                if (fq == 0) atomicAdd(rss + row, ss);
                asm volatile("" ::: "memory"); }
    }
};
template <bool BASE_BF16>
struct EpiResidB {
    static constexpr bool PERM = false;
    const void* base; bf16_t* out; float* rss;
    __device__ __forceinline__ bool skip() const { return false; }
    __device__ __forceinline__ void load_raw(f32x4 (&raw)[2][2], const size_t off) const {
#pragma unroll
        for (int bj = 0; bj < 2; ++bj)
#pragma unroll
            for (int n = 0; n < 2; ++n) { const int co = bj * HALF + n * 16;
                if (BASE_BF16) { const u32x2 b2 = *(const u32x2*)((const bf16_t*)base + off + co); raw[bj][n] = (f32x4){__uint_as_float(b2.x), __uint_as_float(b2.y), 0.f, 0.f}; }
                else raw[bj][n] = *(const f32x4*)((const float*)base + off + co); }
    }
    __device__ __forceinline__ void operator()(const f32x4 (&acc)[2][2][4][2], const Unit& u, int wr, int wc, int fr, int fq, LAS unsigned char*) const {
        const int colb = u.col0 + wc * 32 + 4 * fq;
        const int rowb = u.row0 + wr * 64 + fr;
        f32x4 cur[2][2], nxt[2][2];
        load_raw(cur, (size_t)rowb * DM + colb);
#pragma unroll
        for (int it = 0; it < 8; ++it) {
            const int ai = it >> 2, m = it & 3;
            const int row = rowb + ai * HALF + m * 16; const size_t off = (size_t)row * DM + colb; float ss = 0.f;
            if (it + 1 < 8) load_raw(nxt, (size_t)(rowb + ((it + 1) >> 2) * HALF + ((it + 1) & 3) * 16) * DM + colb);
            asm volatile("" ::: "memory");
#pragma unroll
            for (int bj = 0; bj < 2; ++bj)
#pragma unroll
                for (int n = 0; n < 2; ++n) { const int co = bj * HALF + n * 16;
                    f32x4 bs;
                    if (BASE_BF16) { const unsigned bx_ = __float_as_uint(cur[bj][n].x), by_ = __float_as_uint(cur[bj][n].y); bs = (f32x4){bf_lo(bx_), bf_hi(bx_), bf_lo(by_), bf_hi(by_)}; } else bs = cur[bj][n];
                    const f32x4 v = bs + acc[ai][bj][m][n];
                    u32x2 pk; pk.x = cvt_pk_bf16(v[0], v[1]); pk.y = cvt_pk_bf16(v[2], v[3]); *(u32x2*)(out + off + co) = pk;
                    ss += (v[0] * v[0] + v[1] * v[1]) + (v[2] * v[2] + v[3] * v[3]); }
            ss += __shfl_xor(ss, 16); ss += __shfl_xor(ss, 32);
            if (fq == 0) atomicAdd(rss + row, ss);
            asm volatile("" ::: "memory");
#pragma unroll
            for (int bj = 0; bj < 2; ++bj)
#pragma unroll
                for (int n = 0; n < 2; ++n) cur[bj][n] = nxt[bj][n];
        }
    }
};
struct EpiSoftmax {
    static constexpr bool PERM = true;
    const float* rss; bf16_t* P;
    __device__ __forceinline__ bool skip() const { return false; }
    __device__ __forceinline__ void operator()(f32x4 (&acc)[2][2][4][2], const Unit& u, int wr, int wc, int fr, int fq, LAS unsigned char* lds) const {
        LAS f32x2* X = (LAS f32x2*)(lds + XCH_OFF);
        float ml[2][4];
#pragma unroll
        for (int ai = 0; ai < 2; ++ai)
#pragma unroll
            for (int m = 0; m < 4; ++m) {
                const int r = ai * HALF + wr * 64 + m * 16 + fr;
                const float sc = rsqrtf(rss[u.row0 + r] * (1.0f / 1024.0f) + EPS) * LOG2E;
                float mx = -3.0e38f;
#pragma unroll
                for (int bj = 0; bj < 2; ++bj)
#pragma unroll
                    for (int n = 0; n < 2; ++n) { f32x4 v = acc[ai][bj][m][n] * sc; acc[ai][bj][m][n] = v; mx = fmaxf(mx, fmaxf(fmaxf(v[0], v[1]), fmaxf(v[2], v[3]))); }
                mx = fmaxf(mx, __shfl_xor(mx, 16)); mx = fmaxf(mx, __shfl_xor(mx, 32));
                float sm = 0.f;
#pragma unroll
                for (int bj = 0; bj < 2; ++bj)
#pragma unroll
                    for (int n = 0; n < 2; ++n) { f32x4 v = acc[ai][bj][m][n]; v[0] = fast_exp2(v[0] - mx); v[1] = fast_exp2(v[1] - mx); v[2] = fast_exp2(v[2] - mx); v[3] = fast_exp2(v[3] - mx);
                        acc[ai][bj][m][n] = v; sm += (v[0] + v[1]) + (v[2] + v[3]); }
                sm += __shfl_xor(sm, 16); sm += __shfl_xor(sm, 32);
                ml[ai][m] = mx;
                if (fq == 0) X[r * 4 + wc] = (f32x2){mx, sm};
            }
        LDS_WAIT(); __builtin_amdgcn_s_barrier(); asm volatile("" ::: "memory");
#pragma unroll
        for (int ai = 0; ai < 2; ++ai)
#pragma unroll
            for (int m = 0; m < 4; ++m) {
                const int r = ai * HALF + wr * 64 + m * 16 + fr;
                const f32x2 a = X[r * 4 + 0], b = X[r * 4 + 1], c = X[r * 4 + 2], d = X[r * 4 + 3];
                const float mg = fmaxf(fmaxf(a.x, b.x), fmaxf(c.x, d.x));
                const float lg = a.y * fast_exp2(a.x - mg) + b.y * fast_exp2(b.x - mg) + c.y * fast_exp2(c.x - mg) + d.y * fast_exp2(d.x - mg);
                const float f = fast_exp2(ml[ai][m] - mg) / lg;
                bf16_t* rowp = P + (size_t)(u.row0 + r) * DM + u.col0 + wc * 32 + 8 * fq;
#pragma unroll
                for (int bj = 0; bj < 2; ++bj) { const f32x4 v0 = acc[ai][bj][m][0] * f, v1 = acc[ai][bj][m][1] * f;
                    u32x4 w; w.x = cvt_pk_bf16(v0[0], v0[1]); w.y = cvt_pk_bf16(v0[2], v0[3]); w.z = cvt_pk_bf16(v1[0], v1[1]); w.w = cvt_pk_bf16(v1[2], v1[3]);
                    *(u32x4*)(rowp + bj * HALF) = w; } }
        LDS_WAIT();
    }
};
}
struct Args { const float* in[26]; float* out; unsigned char* ws; int ph_lo, ph_hi; };
enum { I_X = 0, I_MEM, I_GMIX, I_WIN, I_CONVW, I_BI, I_BF, I_GML, I_LQ1, I_LK1, I_LQ2, I_LK2, I_GDA, I_WOUT, I_GCA, I_GMEM, I_WCQ, I_WCK, I_WCV, I_WCO, I_GFFN, I_WPQ, I_SUBK, I_PU, I_PV, I_GFIN };

struct Frame {
    LAS unsigned char* lds;
    int tid, lane, wave, G, vcu;
    const Args* a;
    unsigned char* ws;
    unsigned* ctl;
};


#define XB_TMO      128
#define XB_XCNT(j)  (256  + 64 * (j))
#define XB_XSUB(j)  (1280 + 64 * (j))
#define XB_XGEN(j)  (2304 + 64 * (j))
#define XB_TOP      3328
#define XB_TOPGEN   3392
#define XCD_BAR_WORDS 3456
#define XB_SPIN_CAP (1u << 18)
__device__ __forceinline__ unsigned xb_ld(unsigned* p)              { return __hip_atomic_load(p, __ATOMIC_RELAXED, __HIP_MEMORY_SCOPE_AGENT); }
__device__ __forceinline__ unsigned xb_add(unsigned* p, unsigned v) { return __hip_atomic_fetch_add(p, v, __ATOMIC_RELAXED, __HIP_MEMORY_SCOPE_AGENT); }
__device__ __forceinline__ unsigned xb_xcc_id() { return (unsigned)__builtin_amdgcn_s_getreg((3 << 11) | 20) & 0xFu; }
#define XB_SPIN(cond, bar) do { unsigned _sp = 0; while (cond) { __builtin_amdgcn_s_sleep(1); \
    if ((++_sp & 255u) == 0u) { if (xb_ld(&(bar)[XB_TMO])) break; if (_sp > XB_SPIN_CAP) { atomicAdd(&(bar)[XB_TMO], 1u); break; } } } } while (0)
struct XcdBarrier { unsigned* bar; unsigned x; volatile LAS unsigned* st; };
__device__ __forceinline__ XcdBarrier xcd_barrier_post(unsigned* bar, volatile LAS unsigned* st) {
    XcdBarrier b; b.bar = bar; b.x = xb_xcc_id(); b.st = st;
    if (threadIdx.x == 0) (void)xb_add(&bar[XB_XCNT(b.x)], 1u);
    return b;
}
__device__ __forceinline__ void xcd_barrier_complete(unsigned* bar, unsigned x, unsigned& nloc, unsigned& nx) {
    const unsigned G = gridDim.x * gridDim.y * gridDim.z;
    unsigned sum, cnt, mine, sp = 0u;
    for (;;) {
        sum = 0u; cnt = 0u; mine = 0u;
#pragma unroll
        for (unsigned j = 0; j < 16; ++j) { const unsigned c = xb_ld(&bar[XB_XCNT(j)]); sum += c; cnt += (c > 0u) ? 1u : 0u; mine = (j == x) ? c : mine; }
        if (sum == G) break;
        __builtin_amdgcn_s_sleep(1);
        if ((++sp & 255u) == 0u) { if (xb_ld(&bar[XB_TMO])) break; if (sp > XB_SPIN_CAP) { atomicAdd(&bar[XB_TMO], 1u); break; } }
    }
    nloc = mine > 0u ? mine : 1u; nx = cnt > 0u ? cnt : 1u;
}
__device__ __forceinline__ void xcd_barrier(const XcdBarrier& b) {
    asm volatile("s_waitcnt vmcnt(0)" ::: "memory");
    __syncthreads();
    if (threadIdx.x == 0) {
        unsigned* bar = b.bar;
        __builtin_amdgcn_s_waitcnt(0);
        unsigned nloc = b.st[0], nx = b.st[1];
        if (nloc == 0u) { xcd_barrier_complete(bar, b.x, nloc, nx); b.st[0] = nloc; b.st[1] = nx; }
        const unsigned old = xb_add(&bar[XB_XSUB(b.x)], 1u);
        const unsigned gen = old / nloc;
        if (old + 1u == (gen + 1u) * nloc) {
            __builtin_amdgcn_fence(__ATOMIC_RELEASE, "agent");
            asm volatile("s_waitcnt vmcnt(0)" ::: "memory");
            const unsigned og = xb_add(&bar[XB_TOP], 1u);
            const unsigned tg = og / nx;
            if (og + 1u == (tg + 1u) * nx) xb_add(&bar[XB_TOPGEN], 1u);
            else XB_SPIN(xb_ld(&bar[XB_TOPGEN]) == tg, bar);
            __builtin_amdgcn_fence(__ATOMIC_ACQUIRE, "agent");
            xb_add(&bar[XB_XGEN(b.x)], 1u);
            asm volatile("s_waitcnt vmcnt(0)" ::: "memory");
        } else {
            XB_SPIN(xb_ld(&bar[XB_XGEN(b.x)]) == gen, bar);
            __builtin_amdgcn_fence(__ATOMIC_ACQUIRE, "agent");
            asm volatile("s_waitcnt vmcnt(0)" ::: "memory");
        }
    }
    __syncthreads();
}

__device__ __forceinline__ void p0_transpose_item(const float* W, int Nsrc, int K, int kb, int src_col0, bf16_t* WT, int dst_row0, LAS float* scr, int lane, const float* kscale = nullptr) {
    const int k0 = 64 * kb;
#pragma unroll 8
    for (int i = 0; i < 32; ++i) { const int kk = 2 * i + (lane >> 5); float wv = W[(size_t)(k0 + kk) * Nsrc + src_col0 + (lane & 31)]; if (kscale) wv *= kscale[k0 + kk]; scr[kk * 33 + (lane & 31)] = wv; }
    LDS_WAIT(); asm volatile("" ::: "memory");
    const int c = lane & 7;
#pragma unroll
    for (int j = 0; j < 4; ++j) { const int n = (lane >> 3) + 8 * j; const LAS float* s = scr + (8 * c) * 33 + n;
        u32x4 o; o.x = cvt_pk_bf16(s[0 * 33], s[1 * 33]); o.y = cvt_pk_bf16(s[2 * 33], s[3 * 33]); o.z = cvt_pk_bf16(s[4 * 33], s[5 * 33]); o.w = cvt_pk_bf16(s[6 * 33], s[7 * 33]);
        *(u32x4*)(WT + (size_t)(dst_row0 + n) * K + k0 + 8 * c) = o; }
    LDS_WAIT(); asm volatile("" ::: "memory");
}
__device__ __forceinline__ void rms_row_to_bf16(const float* xrow, const float* g, bf16_t* orow, int lane, f32x4 (&v)[4]) {
    const f32x4* xr = (const f32x4*)xrow + lane; float s = 0.f;
#pragma unroll
    for (int j = 0; j < 4; ++j) { v[j] = xr[64 * j]; s += (v[j].x * v[j].x + v[j].y * v[j].y) + (v[j].z * v[j].z + v[j].w * v[j].w); }
    const float rstd = rsqrtf(wave_sum(s) * (1.f / DM) + EPS);
    u32x2* o8 = (u32x2*)orow + lane;
#pragma unroll
    for (int j = 0; j < 4; ++j) { const f32x4 gv = *((const f32x4*)g + lane + 64 * j); v[j] = v[j] * rstd * gv; u32x2 pk; pk.x = cvt_pk_bf16(v[j].x, v[j].y); pk.y = cvt_pk_bf16(v[j].z, v[j].w); o8[64 * j] = pk; }
}

__device__ __forceinline__ float rms_row_to_i8(const float* g, unsigned char* orow, int lane, f32x4 (&v)[4]) {
    float s = 0.f;
#pragma unroll
    for (int j = 0; j < 4; ++j) s += (v[j].x * v[j].x + v[j].y * v[j].y) + (v[j].z * v[j].z + v[j].w * v[j].w);
    const float rstd = rsqrtf(wave_sum(s) * (1.f / DM) + EPS);
    float mx = 0.f;
#pragma unroll
    for (int j = 0; j < 4; ++j) { const f32x4 gv = *((const f32x4*)g + lane + 64 * j); v[j] = v[j] * rstd * gv; mx = fmaxf(mx, fmaxf(fmaxf(fabsf(v[j].x), fabsf(v[j].y)), fmaxf(fabsf(v[j].z), fabsf(v[j].w)))); }
#pragma unroll
    for (int o = 32; o >= 1; o >>= 1) mx = fmaxf(mx, __shfl_xor(mx, o));
    const float qs = (mx > 0.f) ? 127.0f / mx : 0.f;
    unsigned* o4 = (unsigned*)orow + lane;
#pragma unroll
    for (int j = 0; j < 4; ++j) { const int a = __float2int_rn(v[j].x * qs), b = __float2int_rn(v[j].y * qs), c = __float2int_rn(v[j].z * qs), d = __float2int_rn(v[j].w * qs);
        o4[64 * j] = (unsigned)(a & 255) | ((unsigned)(b & 255) << 8) | ((unsigned)(c & 255) << 16) | ((unsigned)(d & 255) << 24); }
    return mx * (1.0f / 127.0f);
}

__device__ __forceinline__ void p0_prologue(Frame& F) {
    const Args& A = *F.a;
    LAS float* scr = (LAS float*)(F.lds + F.wave * 8448);
    LAS float* sG = (LAS float*)(F.lds + 67584);
    for (int k = F.tid; k < DM; k += 512) { const f32x4 w0 = *(const f32x4*)(A.in[I_WIN] + (size_t)k * INW + 2048), w1 = *(const f32x4*)(A.in[I_WIN] + (size_t)k * INW + 2052);
        sG[0 * DM + k] = w0.x; sG[1 * DM + k] = w0.y; sG[2 * DM + k] = w0.z; sG[3 * DM + k] = w0.w; sG[4 * DM + k] = w1.x; sG[5 * DM + k] = w1.y; sG[6 * DM + k] = w1.z; sG[7 * DM + k] = w1.w; }
    __syncthreads();
    {
        LAS float* cmax = (LAS float*)(F.lds + 67584 + 32768);
        unsigned char* Win8 = (unsigned char*)(F.ws + WS_WIN); float* wsc = (float*)(F.ctl + CW_WSC);
        const int lane = F.lane, w = F.wave, nl = lane & 31, kh = lane >> 5;
        for (int strip = F.vcu; strip < NZ / 32; strip += F.G) {
            const int n0 = strip * 32, src0 = n0 + (n0 >= 2048 ? 8 : 0);
            const float* Wc = A.in[I_WIN] + src0 + nl;
            float mx = 0.f;
#pragma unroll 8
            for (int i = 0; i < 64; ++i) mx = fmaxf(mx, fabsf(Wc[(size_t)(128 * w + 2 * i + kh) * INW]));
            mx = fmaxf(mx, __shfl_xor(mx, 32));
            if (lane < 32) cmax[w * 32 + lane] = mx;
            __syncthreads();
            float cm = 0.f;
#pragma unroll
            for (int ww = 0; ww < 8; ++ww) cm = fmaxf(cm, cmax[ww * 32 + nl]);
            const float qs = (cm > 0.f) ? 127.0f / cm : 0.f;
            if (w == 0 && lane < 32) wsc[n0 + lane] = cm * (1.0f / 127.0f);
#pragma unroll 1
            for (int kb2 = 0; kb2 < 2; ++kb2) {
                const int k0 = 128 * w + 64 * kb2;
#pragma unroll 8
                for (int i = 0; i < 32; ++i) { const int kk = 2 * i + kh; scr[kk * 33 + nl] = Wc[(size_t)(k0 + kk) * INW] * qs; }
                LDS_WAIT(); asm volatile("" ::: "memory");
                const int c = lane & 3;
#pragma unroll
                for (int j = 0; j < 2; ++j) { const int n = (lane >> 2) + 16 * j; const LAS float* sp = scr + (16 * c) * 33 + n;
                    unsigned o[4];
#pragma unroll
                    for (int q = 0; q < 4; ++q) { const int a = __float2int_rn(sp[(4 * q + 0) * 33]), b = __float2int_rn(sp[(4 * q + 1) * 33]), cc = __float2int_rn(sp[(4 * q + 2) * 33]), d = __float2int_rn(sp[(4 * q + 3) * 33]);
                        o[q] = (unsigned)(a & 255) | ((unsigned)(b & 255) << 8) | ((unsigned)(cc & 255) << 16) | ((unsigned)(d & 255) << 24); }
                    *(u32x4*)(Win8 + (size_t)(n0 + n) * DM + k0 + 16 * c) = (u32x4){o[0], o[1], o[2], o[3]}; }
                LDS_WAIT(); asm volatile("" ::: "memory");
            }
            __syncthreads();
        }
    }
    const int gw = F.vcu * 8 + F.wave, NGW = F.G * 8;
    constexpr int KB = DM / 64;
    constexpr int I_SQ = KB * (DM / 32);
    constexpr int NITEMS = 5 * I_SQ;
    bf16_t* WoutT = (bf16_t*)(F.ws + WS_WOUT); bf16_t* WkvT = (bf16_t*)(F.ws + WS_WKV); bf16_t* WcoT = (bf16_t*)(F.ws + WS_WCO); bf16_t* WpqT = (bf16_t*)(F.ws + WS_WPQ);
    for (int it = gw; it < NITEMS; it += NGW) {
        int r = it;
        const int which = r / I_SQ; r -= which * I_SQ; const int kb = r / (DM / 32), n0 = (r % (DM / 32)) * 32;
        if (which == 0) p0_transpose_item(A.in[I_WOUT], DM, DM, kb, n0, WoutT, n0, scr, F.lane);
        else if (which == 1) p0_transpose_item(A.in[I_WCK], DM, DM, kb, n0, WkvT, n0, scr, F.lane);
        else if (which == 2) p0_transpose_item(A.in[I_WCV], DM, DM, kb, n0, WkvT, DM + n0, scr, F.lane);
        else if (which == 3) p0_transpose_item(A.in[I_WCO], DM, DM, kb, n0, WcoT, n0, scr, F.lane);
        else p0_transpose_item(A.in[I_WPQ], DM, DM, kb, n0, WpqT, n0, scr, F.lane, A.in[I_GFFN]);
    }
    {
        const int gt = F.vcu * 512 + F.tid, NT = F.G * 512;
        const f32x4* s0 = (const f32x4*)A.in[I_WCQ]; u32x2* d0 = (u32x2*)(F.ws + WS_WCQ);
        for (int i = gt; i < DM * DM / 4; i += NT) { const f32x4 v = s0[i]; u32x2 pk; pk.x = cvt_pk_bf16(v.x, v.y); pk.y = cvt_pk_bf16(v.z, v.w); d0[i] = pk; }
        const f32x4* s1 = (const f32x4*)A.in[I_SUBK]; u32x2* d1 = (u32x2*)(F.ws + WS_SK);
        for (int i = gt; i < 16 * 128 * 64 / 4; i += NT) { const f32x4 v = s1[i]; u32x2 pk; pk.x = cvt_pk_bf16(v.x, v.y); pk.y = cvt_pk_bf16(v.z, v.w); d1[i] = pk; }
    }
    {
        unsigned char* HN = (unsigned char*)(F.ws + WS_BUFA); float* GT = (float*)(F.ws + WS_GATES); float* hsc = (float*)(F.ctl + CW_HSC);
        f32x4 nx[4];
        if (gw < T_TOK) {
#pragma unroll
            for (int j = 0; j < 4; ++j) nx[j] = *((const f32x4*)(A.in[I_X] + (size_t)gw * DM) + F.lane + 64 * j); }
        for (int m = gw; m < T_TOK; m += NGW) {
            f32x4 v[4];
#pragma unroll
            for (int j = 0; j < 4; ++j) v[j] = nx[j];
            { const int mn = (m + NGW < T_TOK) ? m + NGW : m;
#pragma unroll
              for (int j = 0; j < 4; ++j) nx[j] = *((const f32x4*)(A.in[I_X] + (size_t)mn * DM) + F.lane + 64 * j); }
            const float hs = rms_row_to_i8(A.in[I_GMIX], HN + (size_t)m * DM, F.lane, v);
            if (F.lane == 0) hsc[m] = hs;
            float gacc[8];
#pragma unroll
            for (int j = 0; j < 8; ++j) gacc[j] = 0.f;
#pragma unroll
            for (int jj = 0; jj < 4; ++jj)
#pragma unroll
                for (int j = 0; j < 8; ++j) { const f32x4 wv = *(const LAS f32x4*)(sG + j * DM + 4 * F.lane + 256 * jj); gacc[j] += (v[jj].x * wv.x + v[jj].y * wv.y) + (v[jj].z * wv.z + v[jj].w * wv.w); }
            float r4[4], r2[2], r1;
            { const bool hi = (F.lane & 32) != 0;
#pragma unroll
              for (int i = 0; i < 4; ++i) { const float keep = hi ? gacc[i + 4] : gacc[i], send = hi ? gacc[i] : gacc[i + 4]; r4[i] = keep + __shfl_xor(send, 32); } }
            { const bool hi = (F.lane & 16) != 0;
#pragma unroll
              for (int i = 0; i < 2; ++i) { const float keep = hi ? r4[i + 2] : r4[i], send = hi ? r4[i] : r4[i + 2]; r2[i] = keep + __shfl_xor(send, 16); } }
            { const bool hi = (F.lane & 8) != 0; const float keep = hi ? r2[1] : r2[0], send = hi ? r2[0] : r2[1]; r1 = keep + __shfl_xor(send, 8); }
            r1 += __shfl_xor(r1, 4); r1 += __shfl_xor(r1, 2); r1 += __shfl_xor(r1, 1);
            if ((F.lane & 7) == 0) GT[(size_t)m * 8 + 4 * (F.lane >> 5) + 2 * ((F.lane >> 4) & 1) + ((F.lane >> 3) & 1)] = r1;
        }
        bf16_t* MN = (bf16_t*)(F.ws + WS_MEMN);
        for (int m = gw; m < TMEM; m += NGW) { f32x4 v[4]; rms_row_to_bf16(A.in[I_MEM] + (size_t)m * DM, A.in[I_GMEM], MN + (size_t)m * DM, F.lane, v); }
    }
}
#ifndef AT_DEPTH
#define AT_DEPTH 3
#endif
constexpr int AT_STAGE = 32768, AT_NST = 4;
__device__ __forceinline__ int swzf(int r) { return ((r & 3) << 2) | ((r >> 2) & 3); }

__device__ __forceinline__ void glds16_asm(const void* gsrc, unsigned lds_dst) {
    unsigned keep;
    asm volatile("s_mov_b32 %0, m0\n\ts_mov_b32 m0, %2\n\ts_nop 0\n\tglobal_load_lds_dwordx4 %1, off\n\ts_mov_b32 m0, %0" : "=&s"(keep) : "v"(gsrc), "s"(lds_dst) : "memory");
}

__device__ __forceinline__ s16x4 tr16(const LAS unsigned char* p) { return __builtin_amdgcn_ds_read_tr16_b64_v4i16((LAS s16x4*)p); }
__device__ __forceinline__ bf16x8 cat8(s16x4 lo, s16x4 hi) { return __builtin_shufflevector(lo, hi, 0, 1, 2, 3, 4, 5, 6, 7); }

template <int MODE>
__device__ __forceinline__ void attn_unit(Frame& F, const int b, const int h, const int qt, const float lam) {
    const Args& A = *F.a;
    const bf16_t* Z = (const bf16_t*)(F.ws + WS_Z);
    bf16_t* CAT = (bf16_t*)(F.ws + WS_BUFA);
    LAS unsigned char* lds = F.lds;
    int tid_l = F.tid; asm volatile("" : "+v"(tid_l));
    const int tid = tid_l, lane = tid & 63, w = F.wave, c = w & 1, qb = w >> 1, n = lane & 31, h2 = lane >> 5;
    const int q0 = qt * 128, r0 = q0 + 32 * qb, ntiles = 2 * qt + 2;
    const size_t rowbase = (size_t)b * SEQ;
    const float slope2 = __uint_as_float((unsigned)(127 - 2 * (h + 1)) << 23) * LOG2E, c1 = 0.125f * LOG2E;
    const float slope_hi = __uint_as_float(__float_as_uint(slope2) & 0xffff0000u), slope_lo = slope2 - slope_hi;
    bf16x8 Qf[4];
    { const bf16_t* qp = Z + (rowbase + r0 + n) * NZ + ZC_DAQ + h * 128 + c * 64 + 8 * h2;
#pragma unroll
      for (int kk = 0; kk < 4; ++kk) { const u32x4 q4_ = *(const u32x4*)(qp + 16 * kk); u32x4 o_;
          o_.x = cvt_pk_bf16(bf_lo(q4_.x) * c1, bf_hi(q4_.x) * c1); o_.y = cvt_pk_bf16(bf_lo(q4_.y) * c1, bf_hi(q4_.y) * c1); o_.z = cvt_pk_bf16(bf_lo(q4_.z) * c1, bf_hi(q4_.z) * c1); o_.w = cvt_pk_bf16(bf_lo(q4_.w) * c1, bf_hi(q4_.w) * c1);
          Qf[kk] = __builtin_bit_cast(bf16x8, o_); } }
    bf16x8 Qx, Kx[2];
    { u32x4 o_ = (u32x4){0u, 0u, 0u, 0u}; if (h2 == 0) o_.x = cvt_pk_bf16(slope_hi, slope_lo); Qx = __builtin_bit_cast(bf16x8, o_);
#pragma unroll
      for (int kb = 0; kb < 2; ++kb) { u32x4 k_ = (u32x4){0u, 0u, 0u, 0u}; if (h2 == 0) k_.x = cvt_pk_bf16((float)(32 * kb + n), (float)(32 * kb + n)); Kx[kb] = __builtin_bit_cast(bf16x8, k_); } }
    f32x16 O[4];
#pragma unroll
    for (int i = 0; i < 4; ++i)
#pragma unroll
        for (int j = 0; j < 16; ++j) O[i][j] = 0.f;
    float mrun = -3.0e38f, lsum = 0.f;
    float Bn;
    { float qs = 0.f;
#pragma unroll
      for (int kk = 0; kk < 4; ++kk) { const u32x4 q4_ = __builtin_bit_cast(u32x4, Qf[kk]);
          qs += (bf_lo(q4_.x) * bf_lo(q4_.x) + bf_hi(q4_.x) * bf_hi(q4_.x)) + (bf_lo(q4_.y) * bf_lo(q4_.y) + bf_hi(q4_.y) * bf_hi(q4_.y)) + (bf_lo(q4_.z) * bf_lo(q4_.z) + bf_hi(q4_.z) * bf_hi(q4_.z)) + (bf_lo(q4_.w) * bf_lo(q4_.w) + bf_hi(q4_.w) * bf_hi(q4_.w)); }
      qs += __shfl_xor(qs, 32);
      const float k2 = __uint_as_float(*(const volatile unsigned*)(F.ctl + CW_KMAX + b * 8 + h * 2 + c));
      Bn = sqrtf(qs * k2) * 1.001f + 0.01f; }
    volatile LAS int* dflag = (volatile LAS int*)(lds + MISC_OFF + 64);
    const unsigned ldsbase = (unsigned)(size_t)lds;
#define AT_DMA(j_) do { if (MODE & 2) break; const int jj_ = ntiles - 1 - ((j_) < ntiles ? (j_) : ntiles - 1);     \
        _Pragma("unroll") for (int m_ = 0; m_ < 4; ++m_) { const int i_ = w + 8 * m_, r_ = 4 * (i_ & 15) + (lane >> 4), gch_ = (lane & 15) ^ swzf(r_); \
            const bf16_t* src_ = Z + (rowbase + 64 * jj_ + r_) * NZ + ((i_ >= 16) ? ZC_DAV : ZC_DAK) + h * 128 + 8 * gch_; \
            glds16_asm(src_, ldsbase + (unsigned)(((j_) & 3) * AT_STAGE + i_ * 1024)); } } while (0)
#if AT_DEPTH == 3
    AT_DMA(0); AT_DMA(1); AT_DMA(2);
    asm volatile("s_waitcnt vmcnt(4)" ::: "memory");
#else
    AT_DMA(0); AT_DMA(1);
    VM_WAIT();
#endif
    __syncthreads();
    const int i16 = lane & 15, q4 = i16 >> 2, p4 = i16 & 3, blk = (lane >> 4) & 1;
#define AT_QK(S_, j_) do { const LAS unsigned char* Ks_ = lds + ((j_) & 3) * AT_STAGE; bf16x8 kf_[8]; \
        _Pragma("unroll") for (int kb = 0; kb < 2; ++kb) _Pragma("unroll") for (int kk = 0; kk < 4; ++kk) kf_[4 * kb + kk] = *(const LAS bf16x8*)(Ks_ + (32 * kb + n) * 256 + (((8 * c + 2 * kk + h2) ^ swzf(n)) << 4)); \
        _Pragma("unroll") for (int e = 0; e < 16; ++e) { (S_)[0][e] = 0.f; (S_)[1][e] = 0.f; } \
        _Pragma("unroll") for (int kb = 0; kb < 2; ++kb) { _Pragma("unroll") for (int kk = 0; kk < 4; ++kk) (S_)[kb] = __builtin_amdgcn_mfma_f32_32x32x16_bf16(kf_[4 * kb + kk], Qf[kk], (S_)[kb], 0, 0, 0); \
            (S_)[kb] = __builtin_amdgcn_mfma_f32_32x32x16_bf16(Kx[kb], Qx, (S_)[kb], 0, 0, 0); } } while (0)
#define AT_LOADV(buf_, dvb_) do { _Pragma("unroll") for (int kb = 0; kb < 2; ++kb) _Pragma("unroll") for (int s = 0; s < 2; ++s) { const int ch_ = 4 * (dvb_) + 2 * blk + (p4 >> 1); \
        const LAS unsigned char* vp = Vs + (32 * kb + 16 * s + 4 * h2 + q4) * 256 + 8 * (p4 & 1); \
        (buf_)[2 * kb + s] = cat8(tr16(vp + ((ch_ ^ swzf(4 * h2 + q4)) << 4)), tr16(vp + 8 * 256 + ((ch_ ^ swzf(8 + 4 * h2 + q4)) << 4))); } } while (0)
#define AT_PV(buf_, dvb_) do { \
        _Pragma("unroll") for (int kb = 0; kb < 2; ++kb) _Pragma("unroll") for (int s = 0; s < 2; ++s) O[dvb_] = __builtin_amdgcn_mfma_f32_32x32x16_bf16((buf_)[2 * kb + s], Pf[kb][s], O[dvb_], 0, 0, 0); } while (0)
#define AT_TILE(Sc_, Sn_, j_) do { \
        AT_DMA((j_) + AT_DEPTH); \
        const int k0 = 64 * (ntiles - 1 - (j_)); \
        if (!(MODE & 1) && (j_) + 1 < ntiles && k0 - 64 <= r0 + 31) AT_QK(Sn_, (j_) + 1); \
        if (!(MODE & 1) && k0 <= r0 + 31) { \
            const LAS unsigned char* Vs = lds + ((j_) & 3) * AT_STAGE + 16384; \
            bf16x8 va[4], vb[4]; \
            const float D0 = (float)(r0 + n - k0 - 4 * h2); \
            const float tcon = slope2 * (float)(k0 - r0 - n);            \
            float mloc = -3.0e38f; \
            if (k0 + 63 > r0) { \
                _Pragma("unroll") for (int kb = 0; kb < 2; ++kb) _Pragma("unroll") for (int e = 0; e < 16; ++e) { const float off = (float)(32 * kb + (e & 3) + 8 * (e >> 2)); \
                    const float v = (off > D0) ? -INFINITY : (Sc_)[kb][e]; (Sc_)[kb][e] = v; mloc = fmaxf(mloc, v); } \
            } else { \
                _Pragma("unroll") for (int kb = 0; kb < 2; ++kb) _Pragma("unroll") for (int e = 0; e < 16; ++e) mloc = fmaxf(mloc, (Sc_)[kb][e]); \
            } \
            mloc = fmaxf(mloc, __shfl_xor(mloc, 32)) + tcon; \
              \
            if (__builtin_amdgcn_ballot_w64(mloc > mrun - 40.0f) != 0ull) { \
            AT_LOADV(va, 0); \
              \
            if (__builtin_amdgcn_ballot_w64(mloc > mrun + 8.0f) != 0ull) { \
                const float mnew = fmaxf(mrun, mloc), alpha = fast_exp2(mrun - mnew); \
                mrun = mnew; lsum *= alpha; \
                _Pragma("unroll") for (int dvb = 0; dvb < 4; ++dvb) _Pragma("unroll") for (int e = 0; e < 16; ++e) O[dvb][e] *= alpha; \
            } \
            const float mm = mrun - tcon; \
            float ps = 0.f; \
            _Pragma("unroll") for (int kb = 0; kb < 2; ++kb) _Pragma("unroll") for (int e = 0; e < 16; ++e) { const float pv = fast_exp2((Sc_)[kb][e] - mm); (Sc_)[kb][e] = pv; ps += pv; } \
            lsum += ps; \
            bf16x8 Pf[2][2]; \
            _Pragma("unroll") for (int kb = 0; kb < 2; ++kb) _Pragma("unroll") for (int s = 0; s < 2; ++s) { u32x4 pk; pk.x = cvt_pk_bf16((Sc_)[kb][8 * s + 0], (Sc_)[kb][8 * s + 1]); pk.y = cvt_pk_bf16((Sc_)[kb][8 * s + 2], (Sc_)[kb][8 * s + 3]); \
                pk.z = cvt_pk_bf16((Sc_)[kb][8 * s + 4], (Sc_)[kb][8 * s + 5]); pk.w = cvt_pk_bf16((Sc_)[kb][8 * s + 6], (Sc_)[kb][8 * s + 7]); Pf[kb][s] = __builtin_bit_cast(bf16x8, pk); } \
            AT_LOADV(vb, 1); AT_PV(va, 0); \
            AT_LOADV(va, 2); AT_PV(vb, 1); \
            AT_LOADV(vb, 3); AT_PV(va, 2); \
            AT_PV(vb, 3); \
            } \
        } \
        if (AT_DEPTH == 3) asm volatile("s_waitcnt vmcnt(4)" ::: "memory"); else asm volatile("s_waitcnt vmcnt(0)" ::: "memory"); \
        __syncthreads(); } while (0)
    f32x16 SA[2], SB[2];
    if (64 * (ntiles - 1) <= r0 + 31) AT_QK(SA, 0);
    for (int j = 0; j < ntiles; j += 2) {
        AT_TILE(SA, SB, j);
        { const float kr = (float)(64 * (ntiles - 2 - j));
          const bool live = !(Bn - slope2 * ((float)(r0 + n) - kr + 1.0f) < mrun - 40.0f);
          const bool wdone = __builtin_amdgcn_ballot_w64(live) == 0ull;
          if (lane == 0) dflag[w] = wdone ? 1 : 0; }
        AT_TILE(SB, SA, j + 1);
        { int alld = 1;
#pragma unroll
          for (int ww = 0; ww < 8; ++ww) alld &= dflag[ww];
          if (alld) break; }
    }
#undef AT_TILE
#undef AT_PV
#undef AT_LOADV
#undef AT_QK
    VM_WAIT();
    __syncthreads();
    { const float lt = lsum + __shfl_xor(lsum, 32); const float inv = (c == 0 ? 1.0f : lam) / lt;
#pragma unroll
      for (int dvb = 0; dvb < 4; ++dvb)
#pragma unroll
          for (int e = 0; e < 16; ++e) O[dvb][e] *= inv; }
    LAS float* cb = (LAS float*)lds + qb * 4096;
    if (c == 1) {
#pragma unroll
        for (int dvb = 0; dvb < 4; ++dvb)
#pragma unroll
            for (int e = 0; e < 16; ++e) cb[(dvb * 16 + e) * 64 + lane] = O[dvb][e];
    }
    __syncthreads();
    if (c == 0 && MODE == 0) {
        float ss = 0.f;
#pragma unroll
        for (int dvb = 0; dvb < 4; ++dvb)
#pragma unroll
            for (int e = 0; e < 16; ++e) { const float o = O[dvb][e] - cb[(dvb * 16 + e) * 64 + lane]; O[dvb][e] = o; ss += o * o; }
        ss += __shfl_xor(ss, 32);
        const float rstd = rsqrtf(ss * (1.0f / 128.0f) + EPS) * 0.8f;
        const float* g = A.in[I_GDA] + h * 128;
        bf16_t* op = CAT + (rowbase + r0 + n) * DM + 512 + h * 128;
#pragma unroll
        for (int dvb = 0; dvb < 4; ++dvb)
#pragma unroll
            for (int e4 = 0; e4 < 4; ++e4) { const int dv = 32 * dvb + 8 * e4 + 4 * h2; const f32x4 gv = *(const f32x4*)(g + dv);
                u32x2 pk; pk.x = cvt_pk_bf16(O[dvb][4 * e4 + 0] * rstd * gv.x, O[dvb][4 * e4 + 1] * rstd * gv.y); pk.y = cvt_pk_bf16(O[dvb][4 * e4 + 2] * rstd * gv.z, O[dvb][4 * e4 + 3] * rstd * gv.w);
                *(u32x2*)(op + dv) = pk; }
    }
    __syncthreads();
#undef AT_DMA
}
__device__ __forceinline__ void conv_prepass(Frame& F) {
    const Args& A = *F.a;
    const bf16_t* Z = (const bf16_t*)(F.ws + WS_Z);
    bf16_t* QKC = (bf16_t*)(F.ws + WS_BUFB);
    const int gt = F.vcu * 512 + F.tid, NT = F.G * 512;
    for (int it = gt; it < (T_TOK / 4) * 128; it += NT) {
        const int cg = it & 127, rb = it >> 7, row0 = 4 * rb, tl = row0 & (SEQ - 1), c0 = 8 * cg;
        float cw[4][8];
#pragma unroll
        for (int tp = 0; tp < 4; ++tp) { const f32x4 w0 = *(const f32x4*)(A.in[I_CONVW] + tp * 1024 + c0), w1 = *(const f32x4*)(A.in[I_CONVW] + tp * 1024 + c0 + 4);
            cw[tp][0] = w0.x; cw[tp][1] = w0.y; cw[tp][2] = w0.z; cw[tp][3] = w0.w; cw[tp][4] = w1.x; cw[tp][5] = w1.y; cw[tp][6] = w1.z; cw[tp][7] = w1.w; }
        u32x4 raw[7];
#pragma unroll
        for (int i = 0; i < 7; ++i) raw[i] = (tl - 3 + i >= 0) ? *(const u32x4*)(Z + (size_t)(row0 - 3 + i) * NZ + c0) : (u32x4){0u, 0u, 0u, 0u};
        const float ksc = (c0 >= 512) ? 0.08838834764831845f : 1.0f;
#pragma unroll
        for (int r = 0; r < 4; ++r) {
            float y[8];
#pragma unroll
            for (int ch = 0; ch < 8; ++ch) y[ch] = 0.f;
#pragma unroll
            for (int tp = 0; tp < 4; ++tp) { const u32x4 rv = raw[r + tp];
                y[0] += cw[tp][0] * bf_lo(rv.x); y[1] += cw[tp][1] * bf_hi(rv.x); y[2] += cw[tp][2] * bf_lo(rv.y); y[3] += cw[tp][3] * bf_hi(rv.y);
                y[4] += cw[tp][4] * bf_lo(rv.z); y[5] += cw[tp][5] * bf_hi(rv.z); y[6] += cw[tp][6] * bf_lo(rv.w); y[7] += cw[tp][7] * bf_hi(rv.w); }
#pragma unroll
            for (int ch = 0; ch < 8; ++ch) y[ch] = y[ch] * fast_rcp(1.0f + __expf(-y[ch])) * ksc;
            u32x4 pk; pk.x = cvt_pk_bf16(y[0], y[1]); pk.y = cvt_pk_bf16(y[2], y[3]); pk.z = cvt_pk_bf16(y[4], y[5]); pk.w = cvt_pk_bf16(y[6], y[7]);
            *(u32x4*)(QKC + (size_t)(row0 + r) * DM + c0) = pk;
        }
    }
    {
        unsigned* kmax = F.ctl + CW_KMAX;
        const int lane = F.tid & 63, gw = F.vcu * 8 + F.wave, NGW = F.G * 8;
        for (int rb = gw; rb < T_TOK / 16; rb += NGW) {
            float mx = 0.f;
#pragma unroll 4
            for (int r = 0; r < 16; ++r) { const u32x4 v = *(const u32x4*)(Z + (size_t)(rb * 16 + r) * NZ + ZC_DAK + 8 * lane);
                float ss = (bf_lo(v.x) * bf_lo(v.x) + bf_hi(v.x) * bf_hi(v.x)) + (bf_lo(v.y) * bf_lo(v.y) + bf_hi(v.y) * bf_hi(v.y)) + (bf_lo(v.z) * bf_lo(v.z) + bf_hi(v.z) * bf_hi(v.z)) + (bf_lo(v.w) * bf_lo(v.w) + bf_hi(v.w) * bf_hi(v.w));
                ss += __shfl_xor(ss, 1); ss += __shfl_xor(ss, 2); ss += __shfl_xor(ss, 4);
                mx = fmaxf(mx, ss); }
            if ((lane & 7) == 0) atomicMax(kmax + ((rb * 16) >> 11) * 8 + (lane >> 3), __float_as_uint(mx));
        }
    }
}

#ifndef ML_TOUCH
#define ML_TOUCH 0
#endif
constexpr int ML_TB = 49152;
constexpr int ML_HB = 2 * ML_TB;
constexpr int ML_HP = 132;
constexpr int ML_SC = ML_HB + 64 * ML_HP * 4;

#define MFMA16(a, b, c) __builtin_amdgcn_mfma_f32_16x16x32_bf16((a), (b), (c), 0, 0, 0)

__device__ __forceinline__ void mlstm_unit(Frame& F, const int b, const int h) {
    const Args& A = *F.a;
    const bf16_t* Z = (const bf16_t*)(F.ws + WS_Z);
    const bf16_t* QKC = (const bf16_t*)(F.ws + WS_BUFB);
    const float* GT = (const float*)(F.ws + WS_GATES);
    bf16_t* CAT = (bf16_t*)(F.ws + WS_BUFA);
    LAS unsigned char* lds = F.lds;
    int tid_l = F.tid; asm volatile("" : "+v"(tid_l));
    const int tid = tid_l, lane = tid & 63, w = F.wave, n = lane & 15, g = lane >> 4, q4 = n >> 2, p4 = n & 3;
    const size_t rowbase = (size_t)b * SEQ;
    LAS float* sc = (LAS float*)(lds + ML_SC);
    LAS float* sA = sc; LAS float* sM = sc + 128; LAS float* sInter = sc + 256; LAS float* sMt = sc + 384; LAS float* sW = sc + 512; LAS float* sDi = sc + 640; LAS float* sQn = sc + 704; LAS float* sN = sc + 768;
    if (tid < 128) sN[tid] = 0.f;
    const unsigned ldsbase = (unsigned)(size_t)lds;
    const float bi = A.in[I_BI][h], bfg = A.in[I_BF][h];
    float gi_r, gf_r;
#define ML_DMA(cc, par_) do { const int t0_ = 64 * (cc); \
        _Pragma("unroll") for (int m_ = 0; m_ < 6; ++m_) { const int i_ = w + 8 * m_, tile_ = i_ >> 4, r_ = 4 * (i_ & 15) + (lane >> 4), gch_ = (lane & 15) ^ swzf(r_); \
            const bf16_t* src_ = (tile_ == 2) ? (Z + (rowbase + t0_ + r_) * NZ + ZC_MLV + 128 * h + 8 * gch_) : (QKC + (rowbase + t0_ + r_) * DM + 512 * tile_ + 128 * h + 8 * gch_); \
            glds16_asm(src_, ldsbase + (unsigned)((par_) * ML_TB + i_ * 1024)); } } while (0)
#define ML_GATES(cc) do { gi_r = GT[(rowbase + 64 * (cc) + lane) * 8 + h]; gf_r = GT[(rowbase + 64 * (cc) + lane) * 8 + 4 + h]; } while (0)
    float m_st = 0.f, decay_c = 1.f;
#define ML_SCALARS(par_) do { \
        const float gi = gi_r + bi, gfv = gf_r + bfg; \
        const float lf = fminf(gfv, 0.f) - __logf(1.0f + __expf(-fabsf(gfv))); \
        float bc = lf; \
        _Pragma("unroll") for (int o = 1; o < 64; o <<= 1) { const float t_ = __shfl_up(bc, o); if (lane >= o) bc += t_; } \
        const float av = gi - bc; float pm = av; \
        _Pragma("unroll") for (int o = 1; o < 64; o <<= 1) { const float t_ = __shfl_up(pm, o); if (lane >= o) pm = fmaxf(pm, t_); } \
        const float Mv = fmaxf(m_st, pm), inter = __expf(m_st - Mv), mt = bc + Mv; \
        const float M63 = __shfl(Mv, 63), bc63 = __shfl(bc, 63); \
        const float wg = __expf(av - M63); \
        decay_c = __shfl(inter, 63); m_st = bc63 + M63; \
        if (w == 0) { sA[(par_) * 64 + lane] = av; sM[(par_) * 64 + lane] = Mv; sInter[(par_) * 64 + lane] = inter; sMt[(par_) * 64 + lane] = mt; sW[(par_) * 64 + lane] = wg; } \
    } while (0)

    f32x4 Cacc[8];
#pragma unroll
    for (int dt = 0; dt < 8; ++dt) Cacc[dt] = (f32x4){0.f, 0.f, 0.f, 0.f};
    ML_GATES(0);
    ML_DMA(0, 0);
    ML_SCALARS(0);
    VM_WAIT(); LDS_WAIT();
    __syncthreads();
    const float* gml = A.in[I_GML] + 128 * h;
    const int e0 = 16 * w;
    unsigned touch = 0u;
#pragma unroll 1
    for (int c = 0; c < 32; ++c) {
        const float decay = decay_c; const int par = c & 1;
        const LAS unsigned char* TQ = lds + par * ML_TB; const LAS unsigned char* TK = TQ + 16384; const LAS unsigned char* TV = TQ + 32768;
        if (c + 1 < 32) { ML_DMA(c + 1, par ^ 1); ML_GATES(c + 1); }
        const int nrow = tid >> 3, nseg = tid & 7;
        { const int rr = 8 * w + (lane >> 3), seg = lane & 7, x = swzf(rr);
          const u32x4 qa = *(const LAS u32x4*)(TQ + rr * 256 + (((2 * seg) ^ x) << 4)), qb = *(const LAS u32x4*)(TQ + rr * 256 + (((2 * seg + 1) ^ x) << 4));
          const f32x4 n0 = *(const LAS f32x4*)(sN + 16 * seg), n1 = *(const LAS f32x4*)(sN + 16 * seg + 4), n2 = *(const LAS f32x4*)(sN + 16 * seg + 8), n3 = *(const LAS f32x4*)(sN + 16 * seg + 12);
          float d = bf_lo(qa.x) * n0.x + bf_hi(qa.x) * n0.y + bf_lo(qa.y) * n0.z + bf_hi(qa.y) * n0.w + bf_lo(qa.z) * n1.x + bf_hi(qa.z) * n1.y + bf_lo(qa.w) * n1.z + bf_hi(qa.w) * n1.w
                  + bf_lo(qb.x) * n2.x + bf_hi(qb.x) * n2.y + bf_lo(qb.y) * n2.z + bf_hi(qb.y) * n2.w + bf_lo(qb.z) * n3.x + bf_hi(qb.z) * n3.y + bf_lo(qb.w) * n3.z + bf_hi(qb.w) * n3.w;
          d += __shfl_xor(d, 1); d += __shfl_xor(d, 2); d += __shfl_xor(d, 4);
          if (seg == 0) sQn[rr] = d; }
        bf16x8 Vf[2], Cf[4];
#pragma unroll
        for (int ks = 0; ks < 2; ++ks) {
            const LAS unsigned char* vp = TV + (32 * ks + 4 * g + q4) * 256 + (((2 * w + (p4 >> 1)) ^ swzf(4 * g + q4)) << 4) + 8 * (p4 & 1);
            Vf[ks] = cat8(tr16(vp), tr16(vp + 16 * 256));
        }
#pragma unroll
        for (int kd = 0; kd < 4; ++kd) { const f32x4 c0 = Cacc[2 * kd], c1 = Cacc[2 * kd + 1]; u32x4 pk; pk.x = cvt_pk_bf16(c0[0], c0[1]); pk.y = cvt_pk_bf16(c0[2], c0[3]); pk.z = cvt_pk_bf16(c1[0], c1[1]); pk.w = cvt_pk_bf16(c1[2], c1[3]); Cf[kd] = __builtin_bit_cast(bf16x8, pk); }
#pragma unroll 1
        for (int lb = 0; lb < 4; ++lb) {
            u32x4 pk[2]; pk[0] = (u32x4){0u, 0u, 0u, 0u}; pk[1] = (u32x4){0u, 0u, 0u, 0u};
            float di = 0.f;
            const LAS unsigned char* qrow = TQ + (16 * lb + n) * 256;
            {
                bf16x8 Qf[4];
#pragma unroll
                for (int kk = 0; kk < 4; ++kk) Qf[kk] = *(const LAS bf16x8*)(qrow + (((4 * kk + g) ^ swzf(n)) << 4));
                const float Ml = sM[par * 64 + 16 * lb + n];
#pragma unroll
                for (int sb = 0; sb < 4; ++sb) if (sb <= lb) {
                    f32x4 acc = (f32x4){0.f, 0.f, 0.f, 0.f};
#pragma unroll
                    for (int kk = 0; kk < 4; ++kk) { const bf16x8 kf = *(const LAS bf16x8*)(TK + (16 * sb + n) * 256 + (((4 * kk + g) ^ swzf(n)) << 4)); acc = MFMA16(kf, Qf[kk], acc); }
                    const f32x4 av4 = *(const LAS f32x4*)(sA + par * 64 + 16 * sb + 4 * g);
                    float pv[4];
#pragma unroll
                    for (int r = 0; r < 4; ++r) { float e = acc[r] * fast_exp2((av4[r] - Ml) * LOG2E); if (sb == lb && (4 * g + r > n)) e = 0.f; pv[r] = e; di += e; }
                    const unsigned u0 = cvt_pk_bf16(pv[0], pv[1]), u1 = cvt_pk_bf16(pv[2], pv[3]);
                    if ((sb & 1) == 0) { pk[sb >> 1].x = u0; pk[sb >> 1].y = u1; } else { pk[sb >> 1].z = u0; pk[sb >> 1].w = u1; }
                }
            }
            di += __shfl_xor(di, 16); di += __shfl_xor(di, 32);
            if (w == 0 && g == 0) sDi[16 * lb + n] = di;
            f32x4 numI = (f32x4){0.f, 0.f, 0.f, 0.f}, accI = (f32x4){0.f, 0.f, 0.f, 0.f};
            numI = MFMA16(__builtin_bit_cast(bf16x8, pk[0]), Vf[0], numI);
            if (lb >= 2) numI = MFMA16(__builtin_bit_cast(bf16x8, pk[1]), Vf[1], numI);
#pragma unroll
            for (int kd = 0; kd < 4; ++kd) { const s16x4 lo = *(const LAS s16x4*)(qrow + (((4 * kd + (g >> 1)) ^ swzf(n)) << 4) + 8 * (g & 1)), hi = *(const LAS s16x4*)(qrow + (((4 * kd + 2 + (g >> 1)) ^ swzf(n)) << 4) + 8 * (g & 1));
                accI = MFMA16(cat8(lo, hi), Cf[kd], accI); }
            const f32x4 in4 = *(const LAS f32x4*)(sInter + par * 64 + 16 * lb + 4 * g);
#pragma unroll
            for (int r = 0; r < 4; ++r) *(LAS float*)(lds + ML_HB + ((16 * lb + 4 * g + r) * ML_HP + e0 + n) * 4) = numI[r] + in4[r] * accI[r];
            asm volatile("" ::: "memory");
        }
        const u32x4 og0 = *(const u32x4*)(Z + (rowbase + 64 * c + nrow) * NZ + ZC_MLO + 128 * h + 16 * nseg), og1 = *(const u32x4*)(Z + (rowbase + 64 * c + nrow) * NZ + ZC_MLO + 128 * h + 16 * nseg + 8);
        bf16x8 Vw[2], Wf[2];
#pragma unroll
        for (int ks = 0; ks < 2; ++ks) {
            const f32x4 wl = *(const LAS f32x4*)(sW + par * 64 + 32 * ks + 4 * g), wh = *(const LAS f32x4*)(sW + par * 64 + 32 * ks + 16 + 4 * g);
            const u32x4 v4 = __builtin_bit_cast(u32x4, Vf[ks]);
            u32x4 pw; pw.x = cvt_pk_bf16(bf_lo(v4.x) * wl.x, bf_hi(v4.x) * wl.y); pw.y = cvt_pk_bf16(bf_lo(v4.y) * wl.z, bf_hi(v4.y) * wl.w); pw.z = cvt_pk_bf16(bf_lo(v4.z) * wh.x, bf_hi(v4.z) * wh.y); pw.w = cvt_pk_bf16(bf_lo(v4.w) * wh.z, bf_hi(v4.w) * wh.w);
            Vw[ks] = __builtin_bit_cast(bf16x8, pw);
            u32x4 pf; pf.x = cvt_pk_bf16(wl.x, wl.y); pf.y = cvt_pk_bf16(wl.z, wl.w); pf.z = cvt_pk_bf16(wh.x, wh.y); pf.w = cvt_pk_bf16(wh.z, wh.w);
            if (n != 0) pf = (u32x4){0u, 0u, 0u, 0u};
            Wf[ks] = __builtin_bit_cast(bf16x8, pf);
        }
        f32x4 cn = (f32x4){0.f, 0.f, 0.f, 0.f};
#pragma unroll
        for (int dt = 0; dt < 8; ++dt) {
            f32x4 cacc = Cacc[dt] * decay;
#pragma unroll
            for (int ks = 0; ks < 2; ++ks) { const LAS unsigned char* kp = TK + (32 * ks + 4 * g + q4) * 256 + (((2 * dt + (p4 >> 1)) ^ swzf(4 * g + q4)) << 4) + 8 * (p4 & 1);
                const bf16x8 kt = cat8(tr16(kp), tr16(kp + 16 * 256)); cacc = MFMA16(kt, Vw[ks], cacc); if (dt == w) cn = MFMA16(kt, Wf[ks], cn); }
            Cacc[dt] = cacc;
        }
        LDS_WAIT();
        __syncthreads();
        if (n == 0) {
#pragma unroll
            for (int r = 0; r < 4; ++r) sN[16 * w + 4 * g + r] = decay * sN[16 * w + 4 * g + r] + cn[r]; }
        {
            const LAS float* hp = (const LAS float*)(lds + ML_HB) + nrow * ML_HP + 16 * nseg;
            f32x4 hv[4]; float ss = 0.f;
#pragma unroll
            for (int i = 0; i < 4; ++i) { hv[i] = *(const LAS f32x4*)(hp + 4 * i); ss += (hv[i].x * hv[i].x + hv[i].y * hv[i].y) + (hv[i].z * hv[i].z + hv[i].w * hv[i].w); }
            ss += __shfl_xor(ss, 1); ss += __shfl_xor(ss, 2); ss += __shfl_xor(ss, 4);
            const float den = sDi[nrow] + sInter[par * 64 + nrow] * sQn[nrow];
            const float dn = fmaxf(fabsf(den), __expf(-sMt[par * 64 + nrow]));
            const float rstd = rsqrtf(ss * (1.0f / 128.0f) + EPS * dn * dn);
            const unsigned ogw[8] = {og0.x, og0.y, og0.z, og0.w, og1.x, og1.y, og1.z, og1.w};
            unsigned outw[8];
#pragma unroll
            for (int i = 0; i < 4; ++i) { const f32x4 gv = *(const f32x4*)(gml + 16 * nseg + 4 * i);
                const float o0 = bf_lo(ogw[2 * i]), o1 = bf_hi(ogw[2 * i]), o2 = bf_lo(ogw[2 * i + 1]), o3 = bf_hi(ogw[2 * i + 1]);
                const float y0 = hv[i].x * rstd * gv.x * fast_rcp(1.0f + __expf(-o0)), y1 = hv[i].y * rstd * gv.y * fast_rcp(1.0f + __expf(-o1));
                const float y2 = hv[i].z * rstd * gv.z * fast_rcp(1.0f + __expf(-o2)), y3 = hv[i].w * rstd * gv.w * fast_rcp(1.0f + __expf(-o3));
                outw[2 * i] = cvt_pk_bf16(y0, y1); outw[2 * i + 1] = cvt_pk_bf16(y2, y3); }
            bf16_t* op = CAT + (rowbase + 64 * c + nrow) * DM + 128 * h + 16 * nseg;
            *(u32x4*)op = (u32x4){outw[0], outw[1], outw[2], outw[3]}; *(u32x4*)(op + 8) = (u32x4){outw[4], outw[5], outw[6], outw[7]};
        }
        if (c + 1 < 32) ML_SCALARS(par ^ 1);
        VM_WAIT(); LDS_WAIT();
#if ML_TOUCH
        asm volatile("" :: "v"(touch));
        if (c + 4 < 32 && tid < 384) { const int tl_ = tid >> 7, r_ = (tid & 127) >> 1, hf_ = tid & 1;
            const bf16_t* p_ = (tl_ == 2) ? (Z + (rowbase + 64 * (c + 4) + r_) * NZ + ZC_MLV + 128 * h + 64 * hf_) : (QKC + (rowbase + 64 * (c + 4) + r_) * DM + 512 * tl_ + 128 * h + 64 * hf_);
            touch = *(const volatile unsigned*)p_; }
#endif
        __syncthreads();
    }
#undef ML_DMA
#undef ML_GATES
#undef ML_SCALARS
}
#ifndef PROBE_HALF
#define PROBE_HALF 0
#endif
#ifndef Q_LPT
#define Q_LPT 0
#endif
#ifndef Q_PAIRED
#define Q_PAIRED 0
#endif
#if Q_PAIRED
#define QN_ATT 64
#else
#define QN_ATT 128
#endif
#ifndef ATT_MODE
#define ATT_MODE 0
#endif
#ifndef REPSUB
#define REPSUB 3
#endif
#ifndef PE_TOUCH
#define PE_TOUCH 0
#endif
#ifndef PE_VDOT
#define PE_VDOT 1
#endif
#ifndef PE_VMFMA
#define PE_VMFMA 0
#endif
#ifndef PE_XV
#define PE_XV 0
#endif
#ifndef PE_XP
#define PE_XP 0
#endif
#ifndef PE_XU
#define PE_XU 0
#endif
#ifndef P7REP
#define P7REP 0
#endif
constexpr size_t WS_US = WS_END;
constexpr int PE_REP = 132;
constexpr int PE_CS = 2 * 128 * PE_REP * 4, PE_SS = PE_CS + 512;
constexpr int PE_RE = 0, PE_RG = 128 * PE_REP * 4;

__device__ __forceinline__ unsigned enc_f(float f) { const unsigned b = __float_as_uint(f); return b ^ ((unsigned)((int)b >> 31) | 0x80000000u); }
__device__ __forceinline__ float dec_f(unsigned e) { return __uint_as_float(e ^ ((~(unsigned)((int)e >> 31)) | 0x80000000u)); }
__device__ __forceinline__ unsigned umax3(unsigned a, unsigned b, unsigned c) { return max(max(a, b), c); }

#define CE_DESC(x, y) do { const unsigned hi_ = max((x), (y)), lo_ = min((x), (y)); (x) = hi_; (y) = lo_; } while (0)
__device__ __forceinline__ void sort16_desc(unsigned (&a)[16]) {
#define C2(x, y) CE_DESC(a[x], a[y])
    C2(0, 13); C2(1, 12); C2(2, 15); C2(3, 14); C2(4, 8); C2(5, 6); C2(7, 11); C2(9, 10);
    C2(0, 5); C2(1, 7); C2(2, 9); C2(3, 4); C2(6, 13); C2(8, 14); C2(10, 15); C2(11, 12);
    C2(0, 1); C2(2, 3); C2(4, 5); C2(6, 8); C2(7, 9); C2(10, 11); C2(12, 13); C2(14, 15);
    C2(0, 2); C2(1, 3); C2(4, 10); C2(5, 11); C2(6, 7); C2(8, 9); C2(12, 14); C2(13, 15);
    C2(1, 2); C2(3, 12); C2(4, 6); C2(5, 7); C2(8, 10); C2(9, 11); C2(13, 14);
    C2(1, 4); C2(2, 6); C2(5, 8); C2(7, 10); C2(9, 13); C2(11, 14);
    C2(2, 4); C2(3, 6); C2(9, 12); C2(11, 13);
    C2(3, 5); C2(6, 8); C2(7, 9); C2(10, 12);
    C2(3, 4); C2(5, 6); C2(7, 8); C2(9, 10); C2(11, 12);
    C2(6, 7); C2(8, 9);
#undef C2
}
__device__ __forceinline__ void bitonic_merge16_desc(unsigned (&a)[16]) {
#pragma unroll
    for (int j = 8; j > 0; j >>= 1)
#pragma unroll
        for (int i = 0; i < 16; ++i) { const int l = i ^ j; if (l > i) CE_DESC(a[i], a[l]); }
}
__device__ __forceinline__ void bitonic_merge8_desc(unsigned (&a)[8]) {
#pragma unroll
    for (int j = 4; j > 0; j >>= 1)
#pragma unroll
        for (int i = 0; i < 8; ++i) { const int l = i ^ j; if (l > i) CE_DESC(a[i], a[l]); }
}
__device__ __forceinline__ void merge_top16(unsigned (&a)[16], const unsigned (&b)[16]) {
#pragma unroll
    for (int i = 0; i < 16; ++i) a[i] = max(a[i], b[15 - i]);
    bitonic_merge16_desc(a);
}
template <bool PAIR>
__device__ __forceinline__ void top16_of64(const unsigned (&key)[64], unsigned (&top)[16]) {
    unsigned q1[16], q2[16], q3[16];
#pragma unroll
    for (int i = 0; i < 16; ++i) { top[i] = key[i]; q1[i] = key[16 + i]; q2[i] = key[32 + i]; q3[i] = key[48 + i]; }
    sort16_desc(top); sort16_desc(q1); merge_top16(top, q1);
    sort16_desc(q2); sort16_desc(q3); merge_top16(q2, q3);
    merge_top16(top, q2);
    if (PAIR) {
        unsigned o[16];
#pragma unroll
        for (int i = 0; i < 16; ++i) o[i] = (unsigned)__shfl_xor((int)top[i], 32);
        merge_top16(top, o);
    }
}

__device__ __forceinline__ float gelu_exact(float v) { return 0.5f * v * (1.0f + erff(v * 0.70710678118654752f)); }
typedef __bf16 bf16x2_t __attribute__((ext_vector_type(2)));
__device__ __forceinline__ float dot2bf(unsigned a, unsigned b, float c) { return __builtin_amdgcn_fdot2_f32_bf16(__builtin_bit_cast(bf16x2_t, a), __builtin_bit_cast(bf16x2_t, b), c, false); }
__device__ __forceinline__ float dot8(const u32x4 a, const u32x4 b) { return dot2bf(a.x, b.x, dot2bf(a.y, b.y, dot2bf(a.z, b.z, dot2bf(a.w, b.w, 0.f)))); }
__device__ __forceinline__ float dpp_xor1(float v) { return __int_as_float(__builtin_amdgcn_update_dpp(0, __float_as_int(v), 0xB1, 0xF, 0xF, true)); }
__device__ __forceinline__ float dpp_xor2(float v) { return __int_as_float(__builtin_amdgcn_update_dpp(0, __float_as_int(v), 0x4E, 0xF, 0xF, true)); }
__device__ __forceinline__ float dpp_xor4(float v) { const int m = __builtin_amdgcn_update_dpp(0, __float_as_int(v), 0x141, 0xF, 0xF, true); return __int_as_float(__builtin_amdgcn_update_dpp(0, m, 0x1B, 0xF, 0xF, true)); }
__device__ __forceinline__ float reduce8x8(const float (&p)[8], const int j) {
    float r[4], q[2];
#pragma unroll
    for (int i = 0; i < 4; ++i) { const float keep = (j & 4) ? p[i + 4] : p[i], send = (j & 4) ? p[i] : p[i + 4]; r[i] = keep + __shfl_xor(send, 4); }
#pragma unroll
    for (int i = 0; i < 2; ++i) { const float keep = (j & 2) ? r[i + 2] : r[i], send = (j & 2) ? r[i] : r[i + 2]; q[i] = keep + __shfl_xor(send, 2); }
    const float keep = (j & 1) ? q[1] : q[0], send = (j & 1) ? q[0] : q[1];
    return keep + __shfl_xor(send, 1);
}

__device__ __forceinline__ int reduce8x8i(const float (&p)[8], const int j) {
    int r[4], q[2];
#pragma unroll
    for (int i = 0; i < 4; ++i) { const int keep = __float_as_int((j & 4) ? p[i + 4] : p[i]), send = __float_as_int((j & 4) ? p[i] : p[i + 4]); r[i] = keep + __shfl_xor(send, 4); }
#pragma unroll
    for (int i = 0; i < 2; ++i) { const int keep = (j & 2) ? r[i + 2] : r[i], send = (j & 2) ? r[i] : r[i + 2]; q[i] = keep + __shfl_xor(send, 2); }
    const int keep = (j & 1) ? q[1] : q[0], send = (j & 1) ? q[0] : q[1];
    return keep + __shfl_xor(send, 1);
}
constexpr size_t WS_VS8 = WS_US + 16 * MiB, WS_SINV = WS_US + 32 * MiB;
__device__ __forceinline__ void peer_convert_rows(Frame& F, const int item) {
    const Args& A = *F.a;
    int lane_l = threadIdx.x & 63; asm volatile("" : "+v"(lane_l));
    const int lane = lane_l;
    float* SINV = (float*)(F.ws + WS_SINV);
    f32x4 gq[4];
    { const float* gp = A.in[I_GFFN] + 16 * lane; gq[0] = *(const f32x4*)gp; gq[1] = *(const f32x4*)(gp + 4); gq[2] = *(const f32x4*)(gp + 8); gq[3] = *(const f32x4*)(gp + 12); }
    const int base = 256 * item + 32 * F.wave;
    const int tb = base >> 14;
    const float* tsrc = (tb ? A.in[I_PV] : A.in[I_PU]) + 16 * lane;
#define PC_LOAD(buf_, c_) do { _Pragma("unroll") for (int r = 0; r < 4; ++r) { const int e_ = (base + 4 * (c_) + r) & 16383; const float* src_ = tsrc + (size_t)e_ * DM; \
            _Pragma("unroll") for (int q = 0; q < 4; ++q) (buf_)[r][q] = *(const f32x4*)(src_ + 4 * q); } } while (0)
#define PC_PROC(buf_, c_) do { _Pragma("unroll") for (int r = 0; r < 4; ++r) { const int e = (base + 4 * (c_) + r) & 16383; \
            if (tb == 0) { _Pragma("unroll") for (int q = 0; q < 4; ++q) (buf_)[r][q] = (buf_)[r][q] * gq[q]; }            \
            float mx = 0.f; \
            _Pragma("unroll") for (int q = 0; q < 4; ++q) mx = fmaxf(mx, fmaxf(fmaxf(fabsf((buf_)[r][q].x), fabsf((buf_)[r][q].y)), fmaxf(fabsf((buf_)[r][q].z), fabsf((buf_)[r][q].w)))); \
            _Pragma("unroll") for (int o = 1; o < 64; o <<= 1) mx = fmaxf(mx, __shfl_xor(mx, o)); \
            unsigned ow[4]; float sinv; \
            if (tb == 0 || PE_VMFMA || PE_VDOT) {                                   \
                const float sc = (mx > 0.f) ? 127.0f / mx : 0.f; sinv = mx * (1.0f / 127.0f); \
                _Pragma("unroll") for (int q = 0; q < 4; ++q) { const int q0 = __float2int_rn((buf_)[r][q].x * sc), q1 = __float2int_rn((buf_)[r][q].y * sc), q2 = __float2int_rn((buf_)[r][q].z * sc), q3 = __float2int_rn((buf_)[r][q].w * sc); \
                    ow[q] = (unsigned)(q0 & 255) | ((unsigned)(q1 & 255) << 8) | ((unsigned)(q2 & 255) << 16) | ((unsigned)(q3 & 255) << 24); } \
            } else {                                                                \
                int k = (mx > 0.f) ? (int)floorf(log2f(416.0f / mx)) : 0; k = k > 60 ? 60 : (k < -60 ? -60 : k); \
                const float sc = exp2f((float)k); sinv = exp2f((float)-k); \
                _Pragma("unroll") for (int q = 0; q < 4; ++q) { int wd = __builtin_amdgcn_cvt_pk_fp8_f32((buf_)[r][q].x * sc, (buf_)[r][q].y * sc, 0, false); wd = __builtin_amdgcn_cvt_pk_fp8_f32((buf_)[r][q].z * sc, (buf_)[r][q].w * sc, wd, true); ow[q] = (unsigned)wd; } \
            } \
            unsigned char* dst = (unsigned char*)(F.ws + (tb ? WS_VS8 : WS_US)) + ((size_t)(lane >> 3) * 16384 + e) * 128 + 16 * (lane & 7); \
            *(u32x4*)dst = (u32x4){ow[0], ow[1], ow[2], ow[3]}; \
            if (lane == 0) SINV[tb * 16384 + e] = sinv; } } while (0)
    f32x4 b0[4][4], b1[4][4];
    PC_LOAD(b0, 0);
#pragma unroll 1
    for (int c = 0; c < 8; c += 2) {
        PC_LOAD(b1, c + 1);
        PC_PROC(b0, c);
        if (c + 2 < 8) PC_LOAD(b0, c + 2);
        PC_PROC(b1, c + 1);
    }
#undef PC_LOAD
#undef PC_PROC
}

template <bool DRY>
__device__ __forceinline__ void peer_tile(Frame& F, const int tile) {
    const Args& A = *F.a;
    const bf16_t* QP = (const bf16_t*)(F.ws + WS_BUFA); const bf16_t* XG = (const bf16_t*)(F.ws + WS_BUFB); bf16_t* XGW = (bf16_t*)(F.ws + WS_BUFB); const bf16_t* SK = (const bf16_t*)(F.ws + WS_SK);
    const float* rss2 = (const float*)(F.ctl + CW_RSS2);
    LAS unsigned* RE = (LAS unsigned*)(F.lds + PE_RE); LAS float* RG = (LAS float*)(F.lds + PE_RG);
    const int w = F.wave;
    {
        int lane = F.lane; asm volatile("" : "+v"(lane));
        const int tg = w & 3, hh = w >> 2, n = lane & 31, h2 = lane >> 5;
        const int tok = 32 * tg + n; const size_t trow = (size_t)tile * 128 + tok;
        for (int rrep = 0; rrep < ((P7REP & 1) ? 2 : 1); ++rrep)
        for (int hd = 4 * hh; hd < 4 * hh + 4; ++hd) {
            unsigned T2[2][16];
#pragma unroll
            for (int cc = 0; cc < 2; ++cc) {
                const int grp = 2 * hd + cc;
                bf16x8 Qf[4];
#pragma unroll
                for (int kk = 0; kk < 4; ++kk) Qf[kk] = *(const bf16x8*)(QP + trow * DM + 64 * grp + 16 * kk + 8 * h2);
                unsigned key[64];
                unsigned lowbase = 127u - 4u * (unsigned)h2; asm volatile("" : "+v"(lowbase));
#pragma unroll
                for (int kb = 0; kb < 4; ++kb) {
                    f32x16 S;
#pragma unroll
                    for (int e = 0; e < 16; ++e) S[e] = 0.f;
#pragma unroll
                    for (int kk = 0; kk < 4; ++kk) { const bf16x8 a = *(const bf16x8*)(SK + ((size_t)(grp * 128 + 32 * kb + n)) * 64 + 16 * kk + 8 * h2); S = __builtin_amdgcn_mfma_f32_32x32x16_bf16(a, Qf[kk], S, 0, 0, 0); }
#pragma unroll
                    for (int e = 0; e < 16; ++e) { const int idx0 = 32 * kb + (e & 3) + 8 * (e >> 2); key[16 * kb + e] = ((enc_f(S[e]) & ~127u) | lowbase) - (unsigned)idx0; }
                }
                top16_of64<true>(key, T2[cc]);
            }
            float va[16], vb[16];
#pragma unroll
            for (int i = 0; i < 16; ++i) { va[i] = dec_f(T2[0][i] & ~127u); vb[i] = dec_f(T2[1][i] & ~127u); }
#define CKEY(i_, j_) ((enc_f(va[i_] + vb[j_]) & ~255u) | (unsigned)(255 - (16 * (i_) + (j_))))
            unsigned best[16];
            {
                unsigned c0[16];
#pragma unroll
                for (int q = 0; q < 16; ++q) best[q] = CKEY(0, q);
#pragma unroll
                for (int q = 1; q < 16; ++q) c0[q - 1] = CKEY(q, 0);
                c0[15] = 0u;
                merge_top16(best, c0);
                unsigned y1[16];
#pragma unroll
                for (int q = 1; q < 8; ++q) y1[q - 1] = CKEY(1, q);
                y1[7] = 0u; y1[8] = 0u; y1[9] = 0u;
#pragma unroll
                for (int q = 2; q < 8; ++q) y1[17 - q] = CKEY(q, 1);
                bitonic_merge16_desc(y1);
                unsigned y2[8];
                unsigned b1 = CKEY(3, 3), b2 = CKEY(4, 2); CE_DESC(b1, b2);
                y2[0] = CKEY(2, 2); y2[1] = CKEY(2, 3); y2[2] = CKEY(2, 4); y2[3] = 0u; y2[4] = 0u; y2[5] = b2; y2[6] = b1; y2[7] = CKEY(3, 2);
                bitonic_merge8_desc(y2);
#pragma unroll
                for (int q = 8; q < 16; ++q) y1[q] = max(y1[q], y2[15 - q]);
                bitonic_merge16_desc(y1);
                merge_top16(best, y1);
            }
#undef CKEY
            const float v0 = dec_f(best[0] & ~255u);
            float gw[16], zs = 0.f;
#pragma unroll
            for (int k = 0; k < 16; ++k) { gw[k] = __expf(dec_f(best[k] & ~255u) - v0); zs += gw[k]; }
            const float zinv = 1.0f / zs;
            unsigned TA[4], TB[4];
#pragma unroll
            for (int d = 0; d < 4; ++d) {
                TA[d] = 0x7F7F7F7Fu - ((T2[0][4 * d] & 127u) | ((T2[0][4 * d + 1] & 127u) << 8) | ((T2[0][4 * d + 2] & 127u) << 16) | ((T2[0][4 * d + 3] & 127u) << 24));
                TB[d] = 0x7F7F7F7Fu - ((T2[1][4 * d] & 127u) | ((T2[1][4 * d + 1] & 127u) << 8) | ((T2[1][4 * d + 2] & 127u) << 16) | ((T2[1][4 * d + 3] & 127u) << 24)); }
#pragma unroll
            for (int kk = 0; kk < 8; ++kk) {
                const unsigned bk = h2 ? best[8 + kk] : best[kk]; const float gk = h2 ? gw[8 + kk] : gw[kk];
                const unsigned code = 255u - (bk & 255u); const unsigned ci = code >> 4, cj = code & 15u;
                const unsigned sa = (ci & 7u) | 0x0C0C0C00u, sb = (cj & 7u) | 0x0C0C0C00u;
                const unsigned ia = (ci & 8u) ? __builtin_amdgcn_perm(TA[3], TA[2], sa) : __builtin_amdgcn_perm(TA[1], TA[0], sa);
                const unsigned ib = (cj & 8u) ? __builtin_amdgcn_perm(TB[3], TB[2], sb) : __builtin_amdgcn_perm(TB[1], TB[0], sb);
                RE[tok * PE_REP + hd * 16 + 8 * h2 + kk] = (ia * 128u + ib) << 7; RG[tok * PE_REP + hd * 16 + 8 * h2 + kk] = gk * zinv;
            }
        }
    }
    __syncthreads();
    {
        int lane = F.lane; asm volatile("" : "+v"(lane));
        const unsigned char* US = (const unsigned char*)(F.ws + WS_US); const unsigned char* VS = (const unsigned char*)(F.ws + WS_VS8); const float* SINV = (const float*)(F.ws + WS_SINV);
        const int j = lane & 7, gid = 8 * w + (lane >> 3);
        const int tA = gid, tB = 64 + gid; const size_t rowA = (size_t)tile * 128 + tA, rowB = (size_t)tile * 128 + tB;
        const LAS unsigned* reA = RE + tA * PE_REP; const LAS unsigned* reB = RE + tB * PE_REP;
        LAS float* cfA = RG + tA * PE_REP; LAS float* cfB = RG + tB * PE_REP;
        float accA[16], accB[16];
#pragma unroll
        for (int i = 0; i < 16; ++i) { accA[i] = 0.f; accB[i] = 0.f; }
#define PE_DEC16P(w4, f2) do { (f2)[0] = __builtin_amdgcn_cvt_pk_f32_fp8((int)(w4).x, false); (f2)[1] = __builtin_amdgcn_cvt_pk_f32_fp8((int)(w4).x, true); (f2)[2] = __builtin_amdgcn_cvt_pk_f32_fp8((int)(w4).y, false); (f2)[3] = __builtin_amdgcn_cvt_pk_f32_fp8((int)(w4).y, true); \
            (f2)[4] = __builtin_amdgcn_cvt_pk_f32_fp8((int)(w4).z, false); (f2)[5] = __builtin_amdgcn_cvt_pk_f32_fp8((int)(w4).z, true); (f2)[6] = __builtin_amdgcn_cvt_pk_f32_fp8((int)(w4).w, false); (f2)[7] = __builtin_amdgcn_cvt_pk_f32_fp8((int)(w4).w, true); } while (0)
#define PE_ISSUE(buf_, re_, kb_, base_) do { const u32x4 e4a = *(const LAS u32x4*)((re_) + 8 * (kb_)), e4b = *(const LAS u32x4*)((re_) + 8 * (kb_) + 4); const unsigned ew[8] = {e4a.x, e4a.y, e4a.z, e4a.w, e4b.x, e4b.y, e4b.z, e4b.w}; \
                _Pragma("unroll") for (int i = 0; i < 8; ++i) (buf_)[i] = *(const u32x4*)((base_) + (size_t)ew[i]); } while (0)
        float sxA, sxB, isxA, isxB;
        { float mA = 0.f, mB = 0.f;
#pragma unroll
          for (int s = 0; s < 8; ++s) { const u32x4 a0 = *(const u32x4*)(XG + rowA * DM + 128 * s + 16 * j), a1 = *(const u32x4*)(XG + rowA * DM + 128 * s + 16 * j + 8), b0 = *(const u32x4*)(XG + rowB * DM + 128 * s + 16 * j), b1 = *(const u32x4*)(XG + rowB * DM + 128 * s + 16 * j + 8);
              const unsigned aw[8] = {a0.x, a0.y, a0.z, a0.w, a1.x, a1.y, a1.z, a1.w}, bw[8] = {b0.x, b0.y, b0.z, b0.w, b1.x, b1.y, b1.z, b1.w};
#pragma unroll
              for (int i = 0; i < 8; ++i) { mA = fmaxf(mA, fmaxf(fabsf(bf_lo(aw[i])), fabsf(bf_hi(aw[i])))); mB = fmaxf(mB, fmaxf(fabsf(bf_lo(bw[i])), fabsf(bf_hi(bw[i])))); } }
          mA = fmaxf(mA, __shfl_xor(mA, 1)); mA = fmaxf(mA, __shfl_xor(mA, 2)); mA = fmaxf(mA, __shfl_xor(mA, 4));
          mB = fmaxf(mB, __shfl_xor(mB, 1)); mB = fmaxf(mB, __shfl_xor(mB, 2)); mB = fmaxf(mB, __shfl_xor(mB, 4));
          sxA = (mA > 0.f) ? 127.0f / mA : 0.f; sxB = (mB > 0.f) ? 127.0f / mB : 0.f; isxA = mA * (1.0f / 127.0f); isxB = mB * (1.0f / 127.0f); }
        u32x4 xra0 = *(const u32x4*)(XG + rowA * DM + 16 * j), xra1 = *(const u32x4*)(XG + rowA * DM + 16 * j + 8), xrb0 = *(const u32x4*)(XG + rowB * DM + 16 * j), xrb1 = *(const u32x4*)(XG + rowB * DM + 16 * j + 8);
        u32x4 bufA[8], bufB[8];
        PE_ISSUE(bufA, reA, 0, US + 16 * j);
#pragma unroll 1
        for (int s2 = 0; s2 < ((P7REP & 2) ? 16 : 8); ++s2) {
            const int s = s2 & 7;
            if (s2 == 8) {
#pragma unroll
                for (int i = 0; i < 16; ++i) { accA[i] = 0.f; accB[i] = 0.f; } }
            int dmu = 0;
            unsigned xa[4], xb[4];
            { const unsigned aw[8] = {xra0.x, xra0.y, xra0.z, xra0.w, xra1.x, xra1.y, xra1.z, xra1.w}, bw[8] = {xrb0.x, xrb0.y, xrb0.z, xrb0.w, xrb1.x, xrb1.y, xrb1.z, xrb1.w};
#pragma unroll
              for (int i = 0; i < 4; ++i) { const int a0_ = __float2int_rn(bf_lo(aw[2 * i]) * sxA), a1_ = __float2int_rn(bf_hi(aw[2 * i]) * sxA), a2_ = __float2int_rn(bf_lo(aw[2 * i + 1]) * sxA), a3_ = __float2int_rn(bf_hi(aw[2 * i + 1]) * sxA);
                  const int b0_ = __float2int_rn(bf_lo(bw[2 * i]) * sxB), b1_ = __float2int_rn(bf_hi(bw[2 * i]) * sxB), b2_ = __float2int_rn(bf_lo(bw[2 * i + 1]) * sxB), b3_ = __float2int_rn(bf_hi(bw[2 * i + 1]) * sxB);
                  xa[i] = (unsigned)(a0_ & 255) | ((unsigned)(a1_ & 255) << 8) | ((unsigned)(a2_ & 255) << 16) | ((unsigned)(a3_ & 255) << 24);
                  xb[i] = (unsigned)(b0_ & 255) | ((unsigned)(b1_ & 255) << 8) | ((unsigned)(b2_ & 255) << 16) | ((unsigned)(b3_ & 255) << 24); } }
            { const int sn = (s + 1) & 7;
              xra0 = *(const u32x4*)(XG + rowA * DM + 128 * sn + 16 * j); xra1 = *(const u32x4*)(XG + rowA * DM + 128 * sn + 16 * j + 8); xrb0 = *(const u32x4*)(XG + rowB * DM + 128 * sn + 16 * j); xrb1 = *(const u32x4*)(XG + rowB * DM + 128 * sn + 16 * j + 8); }
            const unsigned char* Us = US + (size_t)s * (16384 * 128) + 16 * j; const unsigned char* Usn = US + (size_t)((s + 1) & 7) * (16384 * 128) + 16 * j;
#if PE_TOUCH
            const unsigned tchu = *(const volatile unsigned*)(US + (size_t)((s + 1) & 7) * (16384 * 128) + ((size_t)(((blockIdx.x >> 3) & 31) * 512 + F.tid)) * 128);
#endif
#define PE_UCOMP(buf_, x_, acc_, kb_) do { float pp[8]; _Pragma("unroll") for (int i = 0; i < 8; ++i) { int d_ = __builtin_amdgcn_sdot4((int)(buf_)[i].x, (int)(x_)[0], 0, false); d_ = __builtin_amdgcn_sdot4((int)(buf_)[i].y, (int)(x_)[1], d_, false); d_ = __builtin_amdgcn_sdot4((int)(buf_)[i].z, (int)(x_)[2], d_, false); d_ = __builtin_amdgcn_sdot4((int)(buf_)[i].w, (int)(x_)[3], d_, false); pp[i] = __int_as_float(d_); \
                    if (PE_XU) { _Pragma("unroll") for (int q = 0; q < PE_XU; ++q) dmu = __builtin_amdgcn_sdot4((int)(buf_)[i].x, (int)(x_)[q & 3], dmu, false); } } \
                (acc_)[kb_] += (float)reduce8x8i(pp, j); asm volatile("" : "+v"((acc_)[kb_]) :: "memory"); } while (0)
#pragma unroll
            for (int kb = 0; kb < 16; ++kb) {
                PE_ISSUE(bufB, reB, kb, Us);
                PE_UCOMP(bufA, xa, accA, kb);
                if (kb + 1 < 16) PE_ISSUE(bufA, reA, kb + 1, Us); else PE_ISSUE(bufA, reA, 0, Usn);
                PE_UCOMP(bufB, xb, accB, kb);
            }
            if (PE_XU) asm volatile("" :: "v"(dmu));
#if PE_TOUCH
            asm volatile("" :: "v"(tchu));
#endif
        }
#undef PE_UCOMP
#if PE_VDOT
        float csA, csB;
        {
            const float rsA = rsqrtf(rss2[rowA] * (1.0f / DM) + EPS), rsB = rsqrtf(rss2[rowB] * (1.0f / DM) + EPS);
            float mA = 0.f, mB = 0.f;
#pragma unroll
            for (int kb = 0; kb < 16; ++kb) { const int eA = (int)(reA[8 * kb + j] >> 7), eB = (int)(reB[8 * kb + j] >> 7);
                accA[kb] = cfA[8 * kb + j] * gelu_exact(accA[kb] * (rsA * isxA) * SINV[eA]) * SINV[16384 + eA]; accB[kb] = cfB[8 * kb + j] * gelu_exact(accB[kb] * (rsB * isxB) * SINV[eB]) * SINV[16384 + eB];
                mA = fmaxf(mA, fabsf(accA[kb])); mB = fmaxf(mB, fabsf(accB[kb])); }
            mA = fmaxf(mA, __shfl_xor(mA, 1)); mA = fmaxf(mA, __shfl_xor(mA, 2)); mA = fmaxf(mA, __shfl_xor(mA, 4));
            mB = fmaxf(mB, __shfl_xor(mB, 1)); mB = fmaxf(mB, __shfl_xor(mB, 2)); mB = fmaxf(mB, __shfl_xor(mB, 4));
            const float qA = (mA > 0.f) ? 127.0f / mA : 0.f, qB = (mB > 0.f) ? 127.0f / mB : 0.f;
            csA = mA * (1.0f / 127.0f); csB = mB * (1.0f / 127.0f);
            asm volatile("" ::: "memory");
#pragma unroll
            for (int kb = 0; kb < 16; ++kb) { ((LAS unsigned char*)cfA)[8 * kb + j] = (unsigned char)(__float2int_rn(accA[kb] * qA) & 255); ((LAS unsigned char*)cfB)[8 * kb + j] = (unsigned char)(__float2int_rn(accB[kb] * qB) & 255); }
        }
        LDS_WAIT();
        float ssA = 0.f, ssB = 0.f;
        float* xoA = A.out + rowA * DM + 16 * j; float* xoB = A.out + rowB * DM + 16 * j;
        const LAS unsigned char* cqA = (const LAS unsigned char*)cfA; const LAS unsigned char* cqB = (const LAS unsigned char*)cfB;
        PE_ISSUE(bufA, reA, 0, VS + 16 * j);
#pragma unroll 1
        for (int s2 = 0; s2 < ((P7REP & 4) ? 16 : 8); ++s2) {
            const int s = s2 & 7; const bool dry = (P7REP & 4) && s2 < 8;
            const unsigned char* Vs = VS + (size_t)s * (16384 * 128) + 16 * j; const unsigned char* Vsn = VS + (size_t)((s + 1) & 7) * (16384 * 128) + 16 * j;
            u32x2 x2a[4], x2b[4];
#pragma unroll
            for (int q = 0; q < 4; ++q) { x2a[q] = *(const u32x2*)(XG + rowA * DM + 128 * s + 16 * j + 4 * q); x2b[q] = *(const u32x2*)(XG + rowB * DM + 128 * s + 16 * j + 4 * q); }
            int oa[16], ob[16];
#pragma unroll
            for (int i = 0; i < 16; ++i) { oa[i] = 0; ob[i] = 0; }
#define PE_VCOMP(buf_, cq_, o_, kb_) do { const u32x2 q2_ = *(const LAS u32x2*)((cq_) + 8 * (kb_)); \
                _Pragma("unroll") for (int g = 0; g < 2; ++g) { const int qg_ = (int)(g ? q2_.y : q2_.x); \
                    const unsigned r0_[4] = {(buf_)[4 * g].x, (buf_)[4 * g].y, (buf_)[4 * g].z, (buf_)[4 * g].w}, r1_[4] = {(buf_)[4 * g + 1].x, (buf_)[4 * g + 1].y, (buf_)[4 * g + 1].z, (buf_)[4 * g + 1].w}; \
                    const unsigned r2_[4] = {(buf_)[4 * g + 2].x, (buf_)[4 * g + 2].y, (buf_)[4 * g + 2].z, (buf_)[4 * g + 2].w}, r3_[4] = {(buf_)[4 * g + 3].x, (buf_)[4 * g + 3].y, (buf_)[4 * g + 3].z, (buf_)[4 * g + 3].w}; \
                    _Pragma("unroll") for (int d = 0; d < 4; ++d) { \
                        const unsigned a_ = __builtin_amdgcn_perm(r1_[d], r0_[d], 0x05010400u), b_ = __builtin_amdgcn_perm(r1_[d], r0_[d], 0x07030602u); \
                        const unsigned c_ = __builtin_amdgcn_perm(r3_[d], r2_[d], 0x05010400u), e_ = __builtin_amdgcn_perm(r3_[d], r2_[d], 0x07030602u); \
                        (o_)[4 * d + 0] = __builtin_amdgcn_sdot4((int)__builtin_amdgcn_perm(c_, a_, 0x05040100u), qg_, (o_)[4 * d + 0], false); \
                        (o_)[4 * d + 1] = __builtin_amdgcn_sdot4((int)__builtin_amdgcn_perm(c_, a_, 0x07060302u), qg_, (o_)[4 * d + 1], false); \
                        (o_)[4 * d + 2] = __builtin_amdgcn_sdot4((int)__builtin_amdgcn_perm(e_, b_, 0x05040100u), qg_, (o_)[4 * d + 2], false); \
                        (o_)[4 * d + 3] = __builtin_amdgcn_sdot4((int)__builtin_amdgcn_perm(e_, b_, 0x07060302u), qg_, (o_)[4 * d + 3], false); } } \
                asm volatile("" : "+v"((o_)[0]), "+v"((o_)[1]), "+v"((o_)[2]), "+v"((o_)[3]), "+v"((o_)[4]), "+v"((o_)[5]), "+v"((o_)[6]), "+v"((o_)[7]), "+v"((o_)[8]), "+v"((o_)[9]), "+v"((o_)[10]), "+v"((o_)[11]), "+v"((o_)[12]), "+v"((o_)[13]), "+v"((o_)[14]), "+v"((o_)[15]) :: "memory"); } while (0)
#pragma unroll
            for (int kb = 0; kb < 16; ++kb) {
                PE_ISSUE(bufB, reB, kb, Vs);
                PE_VCOMP(bufA, cqA, oa, kb);
                if (kb + 1 < 16) PE_ISSUE(bufA, reA, kb + 1, Vs); else PE_ISSUE(bufA, reA, 0, Vsn);
                PE_VCOMP(bufB, cqB, ob, kb);
            }
#undef PE_VCOMP
#pragma unroll
            for (int q = 0; q < 4; ++q) {
                const u32x2 xa2 = x2a[q], xb2 = x2b[q];
                f32x4 a0 = (f32x4){bf_lo(xa2.x), bf_hi(xa2.x), bf_lo(xa2.y), bf_hi(xa2.y)}, b0 = (f32x4){bf_lo(xb2.x), bf_hi(xb2.x), bf_lo(xb2.y), bf_hi(xb2.y)};
                a0 = a0 + (f32x4){(float)oa[4 * q], (float)oa[4 * q + 1], (float)oa[4 * q + 2], (float)oa[4 * q + 3]} * csA; b0 = b0 + (f32x4){(float)ob[4 * q], (float)ob[4 * q + 1], (float)ob[4 * q + 2], (float)ob[4 * q + 3]} * csB;
                if (!dry && !DRY) { ssA += (a0.x * a0.x + a0.y * a0.y) + (a0.z * a0.z + a0.w * a0.w); ssB += (b0.x * b0.x + b0.y * b0.y) + (b0.z * b0.z + b0.w * b0.w);
                u32x2 pa, pb; pa.x = cvt_pk_bf16(a0.x, a0.y); pa.y = cvt_pk_bf16(a0.z, a0.w); pb.x = cvt_pk_bf16(b0.x, b0.y); pb.y = cvt_pk_bf16(b0.z, b0.w);
                *(u32x2*)(XGW + rowA * DM + 128 * s + 16 * j + 4 * q) = pa; *(u32x2*)(XGW + rowB * DM + 128 * s + 16 * j + 4 * q) = pb; } }
        }
#undef PE_DEC16P
#undef PE_ISSUE
        ssA += __shfl_xor(ssA, 1); ssA += __shfl_xor(ssA, 2); ssA += __shfl_xor(ssA, 4);
        ssB += __shfl_xor(ssB, 1); ssB += __shfl_xor(ssB, 2); ssB += __shfl_xor(ssB, 4);
        const float rfA = rsqrtf(ssA * (1.0f / DM) + EPS), rfB = rsqrtf(ssB * (1.0f / DM) + EPS);
#elif PE_VMFMA
        LAS float* csc = (LAS float*)(F.lds + PE_CS); LAS float* ssb = (LAS float*)(F.lds + PE_SS);
        {
            const float rsA = rsqrtf(rss2[rowA] * (1.0f / DM) + EPS), rsB = rsqrtf(rss2[rowB] * (1.0f / DM) + EPS);
            float mA = 0.f, mB = 0.f;
#pragma unroll
            for (int kb = 0; kb < 16; ++kb) { const int eA = (int)(reA[8 * kb + j] >> 7), eB = (int)(reB[8 * kb + j] >> 7);
                accA[kb] = cfA[8 * kb + j] * gelu_exact(accA[kb] * (rsA * isxA) * SINV[eA]) * SINV[16384 + eA]; accB[kb] = cfB[8 * kb + j] * gelu_exact(accB[kb] * (rsB * isxB) * SINV[eB]) * SINV[16384 + eB];
                mA = fmaxf(mA, fabsf(accA[kb])); mB = fmaxf(mB, fabsf(accB[kb])); }
            mA = fmaxf(mA, __shfl_xor(mA, 1)); mA = fmaxf(mA, __shfl_xor(mA, 2)); mA = fmaxf(mA, __shfl_xor(mA, 4));
            mB = fmaxf(mB, __shfl_xor(mB, 1)); mB = fmaxf(mB, __shfl_xor(mB, 2)); mB = fmaxf(mB, __shfl_xor(mB, 4));
            const float qA = (mA > 0.f) ? 127.0f / mA : 0.f, qB = (mB > 0.f) ? 127.0f / mB : 0.f;
#pragma unroll
            for (int kb = 0; kb < 16; ++kb) { ((LAS unsigned*)cfA)[8 * kb + j] = (unsigned)(__float2int_rn(accA[kb] * qA) & 255) * 0x01010101u; ((LAS unsigned*)cfB)[8 * kb + j] = (unsigned)(__float2int_rn(accB[kb] * qB) & 255) * 0x01010101u; }
            if (j == 0) { csc[tA] = mA * (1.0f / 127.0f); csc[tB] = mB * (1.0f / 127.0f); ssb[tA] = 0.f; ssb[tB] = 0.f; }
        }
        LDS_WAIT();
        {
            const int g16 = lane & 15, kg = lane >> 4, w8 = 8 * w;
            const unsigned m0 = (g16 < 4) ? (0xFFu << (8 * (g16 & 3))) : 0u, m1 = (g16 >= 4 && g16 < 8) ? (0xFFu << (8 * (g16 & 3))) : 0u;
            const int ecol = 8 * (lane & 15) + 4 * ((lane >> 4) & 1);
            const LAS unsigned* RQ = (const LAS unsigned*)RG;
#define PV_ISSUE(buf_, qb_, t_, n0_, base_) do { u32x2 of_[8]; \
                _Pragma("unroll") for (int n = 0; n < 8; ++n) { of_[n] = *(const LAS u32x2*)(RE + (t_) * PE_REP + 8 * ((n0_) + n) + 2 * kg); (qb_)[n] = *(const LAS u32x2*)(RQ + (t_) * PE_REP + 8 * ((n0_) + n) + 2 * kg); } \
                asm volatile("" ::: "memory"); \
                _Pragma("unroll") for (int n = 0; n < 8; ++n) { (buf_)[2 * n] = *(const u32x2*)((base_) + (of_[n].x + lofs)); (buf_)[2 * n + 1] = *(const u32x2*)((base_) + (of_[n].y + lofs)); } \
                asm volatile("" ::: "memory"); } while (0)
#define PV_COMP(buf_, qb_) do { _Pragma("unroll") for (int n = 0; n < 8; ++n) { \
                const i32x4 sel_ = (i32x4){(int)((qb_)[n].x & m0), (int)((qb_)[n].x & m1), (int)((qb_)[n].y & m0), (int)((qb_)[n].y & m1)}; \
                const i32x4 dat_ = (i32x4){(int)(buf_)[2 * n].x, (int)(buf_)[2 * n].y, (int)(buf_)[2 * n + 1].x, (int)(buf_)[2 * n + 1].y}; \
                if (n & 1) acc1 = __builtin_amdgcn_mfma_i32_16x16x64_i8(sel_, dat_, acc1, 0, 0, 0); else acc0 = __builtin_amdgcn_mfma_i32_16x16x64_i8(sel_, dat_, acc0, 0, 0, 0); } } while (0)
            const unsigned lofs = 8u * (unsigned)g16;
            u32x2 bufA[16], bufB[16], qA8[8], qB8[8];
            PV_ISSUE(bufA, qA8, w8, 0, VS);
#pragma unroll 1
            for (int un = 0; un < 128; ++un) {
                const int s = un >> 4, tk = un & 15, t = w8 + (tk & 7) + ((tk & 8) << 3);
                const int u2 = un + 1, sn = (u2 >> 4) & 7, tkn = u2 & 15, tn = w8 + (tkn & 7) + ((tkn & 8) << 3);
                const unsigned char* Vs = VS + (size_t)s * (16384 * 128); const unsigned char* Vsn = VS + (size_t)sn * (16384 * 128);
                const size_t xoff = ((size_t)tile * 128 + t) * DM + 128 * s + ecol;
                const u32x2 xr = *(const u32x2*)(XG + xoff);
                i32x4 acc0 = (i32x4){0, 0, 0, 0}, acc1 = (i32x4){0, 0, 0, 0};
                PV_ISSUE(bufB, qB8, t, 8, Vs);
                PV_COMP(bufA, qA8);
                PV_ISSUE(bufA, qA8, tn, 0, Vsn);
                PV_COMP(bufB, qB8);
                const float cs = csc[t];
                f32x4 a0 = (f32x4){bf_lo(xr.x), bf_hi(xr.x), bf_lo(xr.y), bf_hi(xr.y)};
                a0 = a0 + (f32x4){(float)(acc0.x + acc1.x), (float)(acc0.y + acc1.y), (float)(acc0.z + acc1.z), (float)(acc0.w + acc1.w)} * cs;
                const float ss = (a0.x * a0.x + a0.y * a0.y) + (a0.z * a0.z + a0.w * a0.w);
                if (!DRY) {
                    if (lane < 32) { __hip_atomic_fetch_add(ssb + t, ss, __ATOMIC_RELAXED, __HIP_MEMORY_SCOPE_WORKGROUP);   u32x2 pa; pa.x = cvt_pk_bf16(a0.x, a0.y); pa.y = cvt_pk_bf16(a0.z, a0.w); *(u32x2*)(XGW + xoff) = pa; } }
            }
#undef PV_ISSUE
#undef PV_COMP
        }
#undef PE_DEC16P
#undef PE_ISSUE
        LDS_WAIT();
        float ssA = ssb[tA], ssB = ssb[tB];
        float* xoA = A.out + rowA * DM + 16 * j; float* xoB = A.out + rowB * DM + 16 * j;
        const float rfA = rsqrtf(ssA * (1.0f / DM) + EPS), rfB = rsqrtf(ssB * (1.0f / DM) + EPS);
#else
        {
            const float rsA = rsqrtf(rss2[rowA] * (1.0f / DM) + EPS), rsB = rsqrtf(rss2[rowB] * (1.0f / DM) + EPS);
#pragma unroll
            for (int kb = 0; kb < 16; ++kb) { const int eA = (int)(reA[8 * kb + j] >> 7), eB = (int)(reB[8 * kb + j] >> 7);
                cfA[8 * kb + j] = cfA[8 * kb + j] * gelu_exact(accA[kb] * (rsA * isxA) * SINV[eA]) * SINV[16384 + eA]; cfB[8 * kb + j] = cfB[8 * kb + j] * gelu_exact(accB[kb] * (rsB * isxB) * SINV[eB]) * SINV[16384 + eB]; }
        }
        LDS_WAIT();
        float ssA = 0.f, ssB = 0.f;
        float* xoA = A.out + rowA * DM + 16 * j; float* xoB = A.out + rowB * DM + 16 * j;
        PE_ISSUE(bufA, reA, 0, VS + 16 * j);
#pragma unroll 1
        for (int s2 = 0; s2 < ((P7REP & 4) ? 16 : 8); ++s2) {
            const int s = s2 & 7; const bool dry = (P7REP & 4) && s2 < 8;
            const unsigned char* Vs = VS + (size_t)s * (16384 * 128) + 16 * j; const unsigned char* Vsn = VS + (size_t)((s + 1) & 7) * (16384 * 128) + 16 * j;
#if PE_TOUCH
            const unsigned tchv = *(const volatile unsigned*)(VS + (size_t)((s + 1) & 7) * (16384 * 128) + ((size_t)(((blockIdx.x >> 3) & 31) * 512 + F.tid)) * 128);
#endif
            u32x2 x2a[4], x2b[4];
#pragma unroll
            for (int q = 0; q < 4; ++q) { x2a[q] = *(const u32x2*)(XG + rowA * DM + 128 * s + 16 * j + 4 * q); x2b[q] = *(const u32x2*)(XG + rowB * DM + 128 * s + 16 * j + 4 * q); }
            f32x2 oa[8], ob[8];
            f32x2 dmy[2] = {(f32x2){0.f, 0.f}, (f32x2){0.f, 0.f}}; int dmi[4] = {0, 0, 0, 0};
#pragma unroll
            for (int i = 0; i < 8; ++i) { oa[i] = (f32x2){0.f, 0.f}; ob[i] = (f32x2){0.f, 0.f}; }
#define PE_VCOMP(buf_, cf_, o_, kb_) do { const f32x4 c0_ = *(const LAS f32x4*)((cf_) + 8 * (kb_)), c1_ = *(const LAS f32x4*)((cf_) + 8 * (kb_) + 4); const float cw_[8] = {c0_.x, c0_.y, c0_.z, c0_.w, c1_.x, c1_.y, c1_.z, c1_.w}; \
                _Pragma("unroll") for (int i = 0; i < 8; ++i) { const f32x2 c2 = (f32x2){cw_[i], cw_[i]}; f32x2 f2[8]; PE_DEC16P((buf_)[i], f2); _Pragma("unroll") for (int q = 0; q < 8; ++q) (o_)[q] = __builtin_elementwise_fma(c2, f2[q], (o_)[q]); \
                    if (PE_XV) { _Pragma("unroll") for (int q = 0; q < PE_XV; ++q) dmy[q & 1] = __builtin_elementwise_fma(c2, f2[q], dmy[q & 1]); } \
                    if (PE_XP) { _Pragma("unroll") for (int q = 0; q < PE_XP; ++q) { dmi[q & 1] = (int)__builtin_amdgcn_perm((buf_)[i].x, (unsigned)dmi[q & 1], 0x05010400u + (unsigned)q); dmi[2 + (q & 1)] = __builtin_amdgcn_sdot4((int)(buf_)[i].y, dmi[q & 1], dmi[2 + (q & 1)], false); } } } \
                asm volatile("" : "+v"((o_)[0]), "+v"((o_)[1]), "+v"((o_)[2]), "+v"((o_)[3]), "+v"((o_)[4]), "+v"((o_)[5]), "+v"((o_)[6]), "+v"((o_)[7]) :: "memory"); } while (0)
#pragma unroll
            for (int kb = 0; kb < 16; ++kb) {
                PE_ISSUE(bufB, reB, kb, Vs);
                PE_VCOMP(bufA, cfA, oa, kb);
                if (kb + 1 < 16) PE_ISSUE(bufA, reA, kb + 1, Vs); else PE_ISSUE(bufA, reA, 0, Vsn);
                PE_VCOMP(bufB, cfB, ob, kb);
            }
#if PE_TOUCH
            asm volatile("" :: "v"(tchv));
#endif
#undef PE_VCOMP
            if (PE_XV) asm volatile("" :: "v"(dmy[0]), "v"(dmy[1]));
            if (PE_XP) asm volatile("" :: "v"(dmi[2]), "v"(dmi[3]));
#pragma unroll
            for (int q = 0; q < 4; ++q) {
                const u32x2 xa2 = x2a[q], xb2 = x2b[q];
                f32x4 a0 = (f32x4){bf_lo(xa2.x), bf_hi(xa2.x), bf_lo(xa2.y), bf_hi(xa2.y)}, b0 = (f32x4){bf_lo(xb2.x), bf_hi(xb2.x), bf_lo(xb2.y), bf_hi(xb2.y)};
                a0 = a0 + (f32x4){oa[2 * q].x, oa[2 * q].y, oa[2 * q + 1].x, oa[2 * q + 1].y}; b0 = b0 + (f32x4){ob[2 * q].x, ob[2 * q].y, ob[2 * q + 1].x, ob[2 * q + 1].y};
                if (!dry && !DRY) { ssA += (a0.x * a0.x + a0.y * a0.y) + (a0.z * a0.z + a0.w * a0.w); ssB += (b0.x * b0.x + b0.y * b0.y) + (b0.z * b0.z + b0.w * b0.w);
                u32x2 pa, pb; pa.x = cvt_pk_bf16(a0.x, a0.y); pa.y = cvt_pk_bf16(a0.z, a0.w); pb.x = cvt_pk_bf16(b0.x, b0.y); pb.y = cvt_pk_bf16(b0.z, b0.w);
                *(u32x2*)(XGW + rowA * DM + 128 * s + 16 * j + 4 * q) = pa; *(u32x2*)(XGW + rowB * DM + 128 * s + 16 * j + 4 * q) = pb; } }
        }
#undef PE_DEC16P
#undef PE_ISSUE
        ssA += __shfl_xor(ssA, 1); ssA += __shfl_xor(ssA, 2); ssA += __shfl_xor(ssA, 4);
        ssB += __shfl_xor(ssB, 1); ssB += __shfl_xor(ssB, 2); ssB += __shfl_xor(ssB, 4);
        const float rfA = rsqrtf(ssA * (1.0f / DM) + EPS), rfB = rsqrtf(ssB * (1.0f / DM) + EPS);
#endif
        VM_WAIT();
        __builtin_amdgcn_fence(__ATOMIC_ACQUIRE, "agent");
        VM_WAIT();
        const float* gfin = A.in[I_GFIN] + 16 * j;
#pragma unroll 2
        for (int s = 0; s < 8; ++s)
#pragma unroll
            for (int q = 0; q < 4; ++q) {
                const f32x4 g0 = *(const f32x4*)(gfin + 128 * s + 4 * q);
                const u32x2 xa2 = *(const u32x2*)(XGW + rowA * DM + 128 * s + 16 * j + 4 * q), xb2 = *(const u32x2*)(XGW + rowB * DM + 128 * s + 16 * j + 4 * q);
                const f32x4 a0 = (f32x4){bf_lo(xa2.x), bf_hi(xa2.x), bf_lo(xa2.y), bf_hi(xa2.y)}, b0 = (f32x4){bf_lo(xb2.x), bf_hi(xb2.x), bf_lo(xb2.y), bf_hi(xb2.y)};
                if (!DRY) { *(f32x4*)(xoA + 128 * s + 4 * q) = a0 * rfA * g0; *(f32x4*)(xoB + 128 * s + 4 * q) = b0 * rfB * g0; } else { asm volatile("" :: "v"(a0 * rfA * g0), "v"(b0 * rfB * g0)); } }
    }
    __syncthreads();
}

#ifndef USE_COOP_LAUNCH
#define USE_COOP_LAUNCH 1
#endif
#ifndef USE_CG_SYNC
#define USE_CG_SYNC 0
#endif
#ifndef DBG_SRC
#define DBG_SRC 0
#endif
#ifndef DBG_ZC
#define DBG_ZC 0
#endif
#ifndef DBG_C0
#define DBG_C0 0
#endif
#ifndef DBG_C1
#define DBG_C1 1024
#endif
__global__ void __launch_bounds__(512, 2) mk_fwd(Args args) {
    extern __shared__ __attribute__((aligned(16))) unsigned char lds_raw[];
    Frame F;
    F.lds = (LAS unsigned char*)lds_raw;
    F.tid = threadIdx.x; F.lane = F.tid & 63; F.wave = __builtin_amdgcn_readfirstlane(F.tid >> 6);
    F.G = gridDim.x; { const int bx = blockIdx.x; F.vcu = (F.G % 8 == 0) ? (bx % 8) * (F.G / 8) + bx / 8 : bx; }
    F.a = &args; F.ws = args.ws; F.ctl = (unsigned*)(args.ws + WS_CTL);
    const int lo = args.ph_lo, hi = args.ph_hi;
#if USE_CG_SYNC
    cg::grid_group grid = cg::this_grid();
#define GRID_BAR() grid.sync()
#else
    { volatile LAS unsigned* st0 = (volatile LAS unsigned*)(F.lds + MISC_OFF); if (F.tid < 8) st0[F.tid] = 0u; }
    __syncthreads();
    XcdBarrier xbar; xbar.bar = F.ctl + CW_BAR; xbar.x = 0; xbar.st = nullptr;
    if (hi - lo > 1) xbar = xcd_barrier_post(F.ctl + CW_BAR, (volatile LAS unsigned*)(F.lds + MISC_OFF));
#define GRID_BAR() xcd_barrier(xbar)
#endif
#define IN(k) (lo <= (k) && (k) < hi)
#ifndef PHMASK
#define PHMASK 0x1FF
#endif
#ifndef P2SUB
#define P2SUB 7
#endif
#ifndef Q_FILL_LAST
#define Q_FILL_LAST 1
#endif
#ifndef REPFILL
#define REPFILL 0
#endif
#ifndef P1PROBE
#define P1PROBE 0
#endif
#define PHON(k) (((PHMASK) >> (k)) & 1)
#ifndef REPMASK
#define REPMASK 0
#endif
#define NREP(k) ((((REPMASK) >> (k)) & 1) ? 2 : 1)
#define PHASE_BEGIN() do { int t_ = threadIdx.x; asm volatile("" : "+v"(t_)); F.tid = t_; F.lane = t_ & 63; } while (0)
#define SEAM(k) do { if (IN(k) && IN((k) + 1)) GRID_BAR(); } while (0)
    unsigned char* ws = args.ws;
    const int bx = blockIdx.x;

    if (PHON(0) && IN(0)) { for (int rep = 0; rep < NREP(0); ++rep) { PHASE_BEGIN(); p0_prologue(F); } }
    SEAM(0);
    if (PHON(1) && IN(1)) for (int rep = 0; rep < NREP(1); ++rep) {
        PHASE_BEGIN();
        { pg8::Sched S{0, T_TOK / 256, NZ / 256, (T_TOK / 256) * (NZ / 256), F.G, bx, 1, (const char*)(ws + WS_BUFA), (const char*)(ws + WS_WIN), (char*)(ws + WS_Z), (size_t)256 * DM, (size_t)256 * DM, 0, 2};
          pg8::EpiBf16 E{NZ, 1.0f, nullptr, (const float*)(F.ctl + CW_WSC), (const float*)(F.ctl + CW_HSC), (P1PROBE && rep + 1 < NREP(1)) ? (P1PROBE & 3) : 0};
          pg8::gemm_phase<pg8::EpiBf16, pg8::Sched, true>(F.lds, DM / 2, DM / 2, DM / 2, S, E); }
        if (!((P1PROBE & 4) && rep + 1 < NREP(1)))
        { pg8::Sched S{0, TMEM / 256, 2048 / 256, (TMEM / 256) * (2048 / 256), F.G, bx, 1, (const char*)(ws + WS_MEMN), (const char*)(ws + WS_WKV), (char*)(ws + WS_KV), (size_t)256 * DM * 2, (size_t)256 * DM * 2, 0, 2};
          pg8::EpiBf16 E{2048, 1.0f, nullptr, nullptr};
          pg8::gemm_phase(F.lds, DM, DM, DM, S, E); }
    }
    SEAM(1);
    if (PHON(2) && IN(2)) for (int rep = 0; rep < NREP(2); ++rep) {
        PHASE_BEGIN();
        conv_prepass(F);
    }
    SEAM(2);
    if (PHON(3) && IN(3)) for (int rep = 0; rep < NREP(3); ++rep) {
        PHASE_BEGIN();
        float lam;
        { float s1 = 0.f, s2 = 0.f;
          for (int i = 0; i < 64; ++i) { s1 += args.in[I_LQ1][i] * args.in[I_LK1][i]; s2 += args.in[I_LQ2][i] * args.in[I_LK2][i]; }
          lam = __expf(s1) - __expf(s2) + 0.2f; }
        LAS int* qslot = (LAS int*)(F.lds + MISC_OFF + 16);
        int qx = bx & 7, tried = 0;
        for (;;) {
            if (F.tid == 0) *qslot = (int)atomicAdd(F.ctl + CW_Q2 + 64 * (qx + 8 * rep), 1u);
            __syncthreads();
            const int u = *qslot;
            __syncthreads();
            if (u >= 8 + 160) { if (++tried == 8) break; qx = (qx + 1) & 7; continue; }
            const int submask = (rep + 1 < NREP(3)) ? (REPSUB) : (P2SUB);
#if Q_FILL_LAST
            const int v_ = u - 8; const bool isfill_ = (v_ >= 128); const int fi_ = isfill_ ? v_ - 128 : v_;
#else
            const int v_ = u - 8, g5_ = v_ / 5, r5_ = v_ - 5 * g5_;
            const bool isfill_ = (r5_ == 4); const int fi_ = isfill_ ? g5_ : 4 * g5_ + r5_;
#endif
            if (u < 8) { const int p = qx + 8 * u; if ((submask & 1) && !((rep + 1 < NREP(3)) && (PROBE_HALF & 1) && u >= 4)) mlstm_unit(F, p >> 2, p & 3); }
            else if (isfill_ && fi_ < 16) { if (rep + 1 == NREP(3) || (REPFILL & 1)) peer_convert_rows(F, qx + 8 * fi_); }
            else if (isfill_) { if (rep + 1 == NREP(3) || (REPFILL & 2)) {
                const int gi = qx + 8 * (fi_ - 16);
                if (gi < 64) { pg8::Sched S{1, 0, 0, 4 * gi + 4, 1, 4 * gi, 1, (const char*)(ws + WS_KV), (const char*)(ws + WS_WCQ), (char*)(ws + WS_MB), 0, 0, 0, 2};
                    pg8::EpiBf16 E{DM, 0.0625f, nullptr, args.in[I_GCA]};
                    pg8::gemm_phase(F.lds, 256, 2048, DM, S, E); }
                else { pg8::Sched S{2, 0, 0, 4 * (gi - 64) + 4, 1, 4 * (gi - 64), 1, (const char*)(ws + WS_WCO), (const char*)(ws + WS_KV), (char*)(ws + WS_VWB), 0, 0, 0, 2};
                    pg8::EpiBf16 E{DM, 1.0f, nullptr, nullptr};
                    pg8::gemm_phase(F.lds, 256, DM, 2048, S, E); } } }
            else if ((submask & 2) && !((rep + 1 < NREP(3)) && (PROBE_HALF & 2) && (fi_ >> 4) >= 4)) { const int j = fi_;
#if Q_PAIRED
                { const int p = qx + 8 * (j >> 3), g_ = j & 7;
#pragma unroll 1
                  for (int hf = 0; hf < 2; ++hf) { const int qt_ = hf ? g_ : 15 - g_;
                      if (rep + 1 < NREP(3)) attn_unit<ATT_MODE>(F, p >> 2, p & 3, qt_, lam); else attn_unit<0>(F, p >> 2, p & 3, qt_, lam); } }
#elif Q_LPT
                const int p = qx + 8 * (j & 7), qt_ = 15 - (j >> 3);
#else
                const int i_ = j >> 4, qt_ = 15 - (j & 15);
                const int p = 4 * (qx + 8 * (i_ >> 2)) + (3 - (i_ & 3));
#endif
#if !Q_PAIRED
                if (rep + 1 < NREP(3)) attn_unit<ATT_MODE>(F, p >> 2, p & 3, qt_, lam); else attn_unit<0>(F, p >> 2, p & 3, qt_, lam);
#endif
            }
        }
    }
    SEAM(3);
    if (PHON(4) && IN(4)) for (int rep = 0; rep < NREP(4); ++rep) {
        PHASE_BEGIN();
        pg8::Sched S{0, T_TOK / 256, 4, (T_TOK / 256) * 4, F.G, bx, 1, (const char*)(ws + WS_BUFA), (const char*)(ws + WS_WOUT), nullptr, (size_t)256 * DM * 2, (size_t)256 * DM * 2, 0, 2};
        pg8::EpiResidB<false> E{args.in[I_X], (bf16_t*)(ws + WS_BUFB), (float*)(F.ctl + ((rep + 1 < NREP(4)) ? CW_DUMMY : CW_RSS1))};
        pg8::gemm_phase(F.lds, DM, DM, DM, S, E);
    }
    SEAM(4);
    if (PHON(5) && IN(5)) for (int rep = 0; rep < NREP(5); ++rep) {
        PHASE_BEGIN();
        pg8::Sched S{0, T_TOK / 256, 4, (T_TOK / 256) * 4, F.G, bx, 8, (const char*)(ws + WS_BUFB), (const char*)(ws + WS_MB), nullptr, (size_t)256 * DM * 2, (size_t)256 * DM * 2, (size_t)DM * DM * 2, 2};
        pg8::EpiSoftmax E{(const float*)(F.ctl + CW_RSS1), (bf16_t*)(ws + WS_BUFA)};
        pg8::gemm_phase(F.lds, DM, DM, DM, S, E);
    }
    SEAM(5);
    if (PHON(6) && IN(6)) {
        PHASE_BEGIN();
        pg8::Sched S{0, T_TOK / 256, 4, (T_TOK / 256) * 4, F.G, bx, 8, (const char*)(ws + WS_BUFA), (const char*)(ws + WS_VWB), nullptr, (size_t)256 * DM * 2, (size_t)256 * DM * 2, (size_t)DM * DM * 2, 2};
        pg8::EpiResidB<true> E{(const void*)(ws + WS_BUFB), (bf16_t*)(ws + WS_BUFB), (float*)(F.ctl + CW_RSS2)};
        pg8::gemm_phase(F.lds, DM, DM, DM, S, E);
    }
    SEAM(6);
    if (PHON(7) && IN(7)) for (int rep = 0; rep < NREP(7); ++rep) {
        PHASE_BEGIN();
        pg8::Sched S{0, T_TOK / 256, 4, (T_TOK / 256) * 4, F.G, bx, 1, (const char*)(ws + WS_BUFB), (const char*)(ws + WS_WPQ), (char*)(ws + WS_BUFA), (size_t)256 * DM * 2, (size_t)256 * DM * 2, 0, 2};
        pg8::EpiBf16 E{DM, 1.0f, (const float*)(F.ctl + CW_RSS2), nullptr};
        pg8::gemm_phase(F.lds, DM, DM, DM, S, E);
    }
    SEAM(7);
    if (PHON(8) && IN(8)) {
        PHASE_BEGIN();
        if (NREP(8) > 1) { for (int tile = bx; tile < T_TOK / 128; tile += F.G) peer_tile<true>(F, tile); }
        for (int tile = bx; tile < T_TOK / 128; tile += F.G) peer_tile<false>(F, tile);
    }
    if (lo <= 9 && 9 < hi) {
        const bf16_t* src = (const bf16_t*)(ws + (DBG_SRC ? WS_Z : WS_BUFA));
        for (size_t i = (size_t)bx * 512 + F.tid; i < (size_t)T_TOK * DM / 2; i += (size_t)F.G * 512) { const size_t row_ = (2 * i) >> 10, col_ = (2 * i) & 1023; const unsigned u = DBG_SRC ? *(const unsigned*)(src + row_ * NZ + DBG_ZC + col_) : ((const unsigned*)src)[i]; const int col = (int)((2 * i) & 1023); const bool on = (col >= DBG_C0 && col < DBG_C1); args.out[2 * i] = on ? bf_lo(u) : 0.f; args.out[2 * i + 1] = on ? bf_hi(u) : 0.f; }
    }
#undef IN
#undef SEAM
}

#ifndef MK_N_LAUNCHES
#define MK_N_LAUNCHES 1
#endif
extern "C" void kernel_launch(void* const* d_in, const int* in_sizes, int n_in, void* d_out, int out_size, void* d_ws, size_t ws_size, hipStream_t stream) {
    static int grid = 0;
    if (grid == 0) {
        if (n_in != 26 || out_size != T_TOK * DM || ws_size < WS_END + 34 * MiB) { fprintf(stderr, "kernel_launch: unexpected shapes (n_in %d out %d ws %zu)\n", n_in, out_size, ws_size); grid = -1; return; }
        int dev = 0, cus = 0, per_cu = 0;
        hipGetDevice(&dev); hipDeviceGetAttribute(&cus, hipDeviceAttributeMultiprocessorCount, dev);
        if (hipFuncSetAttribute((const void*)mk_fwd, hipFuncAttributeMaxDynamicSharedMemorySize, LDS_BYTES) != hipSuccess) { fprintf(stderr, "kernel_launch: hipFuncSetAttribute failed\n"); grid = -1; return; }
        if (hipOccupancyMaxActiveBlocksPerMultiprocessor(&per_cu, (const void*)mk_fwd, 512, LDS_BYTES) != hipSuccess || per_cu < 1) { fprintf(stderr, "kernel_launch: occupancy query says %d\n", per_cu); per_cu = 1; }
        (void)hipGetLastError();
        grid = cus;
    }
    if (grid < 0) return;
    hipMemsetAsync((char*)d_ws + WS_CTL, 0, CTL_BYTES, stream);
    Args a{};
    for (int i = 0; i < 26; ++i) a.in[i] = (const float*)d_in[i];
    a.out = (float*)d_out; a.ws = (unsigned char*)d_ws;
    if (MK_N_LAUNCHES == 1) {
        a.ph_lo = 0; a.ph_hi = 9;
        void* kargs[] = {&a};
#if USE_COOP_LAUNCH
        hipError_t e = hipLaunchCooperativeKernel((const void*)mk_fwd, dim3(grid), dim3(512), kargs, LDS_BYTES, stream);
        if (e != hipSuccess) fprintf(stderr, "cooperative launch failed: %s (grid %d)\n", hipGetErrorString(e), grid);
#else
        (void)kargs; hipLaunchKernelGGL(mk_fwd, dim3(grid), dim3(512), LDS_BYTES, stream, a);
#endif
    } else {
#ifndef DBG_STOP
#define DBG_STOP 9
#endif
#ifndef DBG_DUMP
#define DBG_DUMP 0
#endif
        for (int p = 0; p < DBG_STOP; ++p) { a.ph_lo = p; a.ph_hi = p + 1; hipLaunchKernelGGL(mk_fwd, dim3(grid), dim3(512), LDS_BYTES, stream, a); }
        if (DBG_DUMP) { a.ph_lo = 9; a.ph_hi = 10; hipLaunchKernelGGL(mk_fwd, dim3(grid), dim3(512), LDS_BYTES, stream, a); }
    }
}
```

```cpp
#include <hip/hip_runtime.h>
#include <hip/hip_cooperative_groups.h>
#include <cstdio>
#include <cstdint>
namespace cg = cooperative_groups;

#define GAS __attribute__((address_space(1)))
#define LAS __attribute__((address_space(3)))
typedef unsigned short bf16_t;
typedef short bf16x8 __attribute__((ext_vector_type(8)));
typedef short s16x4 __attribute__((ext_vector_type(4)));
typedef float f32x4 __attribute__((ext_vector_type(4)));
typedef float f32x2 __attribute__((ext_vector_type(2)));
typedef float f32x16 __attribute__((ext_vector_type(16)));
typedef unsigned u32x4 __attribute__((ext_vector_type(4)));
typedef unsigned u32x2 __attribute__((ext_vector_type(2)));
typedef int i32x4 __attribute__((ext_vector_type(4)));
typedef unsigned short u16x2 __attribute__((ext_vector_type(2)));
typedef long i64x2 __attribute__((ext_vector_type(2)));

constexpr int T_TOK = 32768, DM = 1024, NB = 16, SEQ = 2048, NZ = 3584, INW = 3592, MEML = 256, TMEM = NB * MEML;
constexpr float EPS = 1e-6f;
constexpr float LOG2E = 1.4426950408889634f;
constexpr int ZC_MLQ = 0, ZC_MLK = 512, ZC_MLV = 1024, ZC_MLO = 1536, ZC_DAQ = 2048, ZC_DAK = 2560, ZC_DAV = 3072;

constexpr size_t MiB = 1u << 20;
constexpr size_t WS_CTL = 0, CTL_BYTES = 1 * MiB;
constexpr size_t WS_WIN = 1 * MiB, WS_WOUT = 8 * MiB, WS_WCQ = 10 * MiB, WS_WKV = 12 * MiB, WS_WCO = 16 * MiB, WS_WPQ = 18 * MiB, WS_SK = 20 * MiB;
constexpr size_t WS_GATES = 21 * MiB, WS_MEMN = 22 * MiB, WS_KV = 30 * MiB, WS_MB = 46 * MiB, WS_VWB = 78 * MiB;
constexpr size_t WS_BUFA = 110 * MiB, WS_BUFB = 174 * MiB, WS_Z = 238 * MiB, WS_END = 462 * MiB;
constexpr int CW_Q2 = 64;
constexpr int CW_RSS1 = 16384;
constexpr int CW_WSC = 49152;
constexpr int CW_KMAX = 53248;
constexpr int CW_RSS2 = 65536;
constexpr int CW_HSC = 98304;
constexpr int CW_BAR = 131072;
constexpr int CW_DUMMY = 180224;
constexpr int CW_AMAX = 212992;

constexpr int LDS_BYTES = 148480;
constexpr int XCH_OFF = 131072;
constexpr int MISC_OFF = LDS_BYTES - 256;

__device__ __forceinline__ unsigned cvt_pk_bf16(float lo, float hi) { unsigned r; asm("v_cvt_pk_bf16_f32 %0, %1, %2" : "=v"(r) : "v"(lo), "v"(hi)); return r; }
__device__ __forceinline__ float bf_lo(unsigned u) { return __uint_as_float(u << 16); }
__device__ __forceinline__ float bf_hi(unsigned u) { return __uint_as_float(u & 0xffff0000u); }
__device__ __forceinline__ float wave_sum(float v) {
#pragma unroll
    for (int o = 1; o < 64; o <<= 1) v += __shfl_xor(v, o);
    return v;
}
__device__ __forceinline__ float fast_exp2(float x) { return __builtin_amdgcn_exp2f(x); }
__device__ __forceinline__ float fast_rcp(float x) { return __builtin_amdgcn_rcpf(x); }
#define LDS_WAIT() asm volatile("s_waitcnt lgkmcnt(0)" ::: "memory")
#define VM_WAIT() asm volatile("s_waitcnt vmcnt(0)" ::: "memory")

namespace pg8 {
#ifndef TR_IN_P1
#define TR_IN_P1 1
#endif
constexpr int BM = 256, BK = 64, HALF = 128, HTB = HALF * BK * 2, STAGE_BYTES = 8 * HTB;
constexpr int CWS = 64, CBJ = 32;
__device__ __forceinline__ int lds_byte(int r, int c) { const int st = (r >> 4) * 2 + (c >> 5), rr = r & 15, cc = c & 31, ob = rr * 64 + cc * 2; return st * 1024 + (ob ^ (((ob >> 9) & 1) << 5)); }
__device__ __forceinline__ void stage_rc(int b, int& R, int& C) { const int st = b / 1024, sb = b % 1024, swz = sb ^ (((sb >> 9) & 1) << 5); R = (st >> 1) * 16 + swz / 64; C = (st & 1) * 32 + (swz % 64) / 2; }
__device__ __forceinline__ int perm32(int rho) { const int n = rho >> 4, i = rho & 15; return 8 * (i >> 2) + 4 * n + (i & 3); }

struct Unit { const char* A; const char* B; char* O; int row0, col0, scol; };

template <class Epi, class Sched, bool I8 = false, bool F8 = false>
__device__ __forceinline__ void gemm_phase(LAS unsigned char* lds, const int K, const int lda, const int ldb, const Sched& S, const Epi& E) {
    int tid_l = threadIdx.x; asm volatile("" : "+v"(tid_l));
    const int tid = tid_l, wid = __builtin_amdgcn_readfirstlane(tid >> 6), lane = tid & 63, wr = wid >> 2, wc = wid & 3, fr = lane & 15, fq = lane >> 4;
    const int nt = K / BK;
    unsigned voffA[2], voffB[2];
#pragma unroll
    for (int i = 0; i < 2; ++i) { int R, C; stage_rc(tid * 16 + i * 8192, R, C); const int Rb = Epi::PERM ? (CWS * (R >> 5) + perm32(R & 31)) : R;
        voffA[i] = (unsigned)(R * lda + C) * 2u; voffB[i] = (unsigned)(Rb * ldb + C) * 2u; }
    const size_t kstep = (size_t)(BK * 2);
    const size_t hstepA = (size_t)HALF * lda * 2, hstepB = (size_t)(Epi::PERM ? CBJ : HALF) * ldb * 2;
    const unsigned ldsw = (unsigned)wid * 1024u;
    const int aoff = lds_byte(wr * 64 + fr, fq * 8), boff = lds_byte(wc * 32 + fr, fq * 8);
#define PG8_SA(b, h) (((b) * 2 + (h)) * HTB)
#define PG8_SB(b, h) ((4 + (b) * 2 + (h)) * HTB)
#define PG8_STAGE(bufoff, gbase, voff) do { _Pragma("unroll") for (int _i = 0; _i < 2; ++_i) \
        __builtin_amdgcn_global_load_lds((const unsigned*)((const char*)(gbase) + (voff)[_i]), (LAS unsigned*)(lds + (bufoff) + ldsw + _i * 8192), 16, 0, 0); } while (0)
#define PG8_LDA(dst, b, h) do { _Pragma("unroll") for (int m = 0; m < 4; ++m) _Pragma("unroll") for (int k = 0; k < 2; ++k) dst[m][k] = *(const LAS bf16x8*)(lds + PG8_SA(b, h) + aoff + m * 2048 + k * 1024); } while (0)
#define PG8_LDB(dst, b, h) do { _Pragma("unroll") for (int n = 0; n < 2; ++n) _Pragma("unroll") for (int k = 0; k < 2; ++k) dst[n][k] = *(const LAS bf16x8*)(lds + PG8_SB(b, h) + boff + n * 2048 + k * 1024); } while (0)
#define PG8_MMA(ai, bj, At, Bt) do { __builtin_amdgcn_s_setprio(1); _Pragma("unroll") for (int m = 0; m < 4; ++m) _Pragma("unroll") for (int n = 0; n < 2; ++n) _Pragma("unroll") for (int k = 0; k < 2; ++k) \
        { if (F8) { const i64x2 b2_ = __builtin_bit_cast(i64x2, Bt[n][k]), a2_ = __builtin_bit_cast(i64x2, At[m][k]); \
                    acc[ai][bj][m][n] = __builtin_amdgcn_mfma_f32_16x16x32_fp8_fp8(b2_.x, a2_.x, acc[ai][bj][m][n], 0, 0, 0); acc[ai][bj][m][n] = __builtin_amdgcn_mfma_f32_16x16x32_fp8_fp8(b2_.y, a2_.y, acc[ai][bj][m][n], 0, 0, 0); } \
          else if (I8) acc[ai][bj][m][n] = __builtin_bit_cast(f32x4, __builtin_amdgcn_mfma_i32_16x16x64_i8(__builtin_bit_cast(i32x4, Bt[n][k]), __builtin_bit_cast(i32x4, At[m][k]), __builtin_bit_cast(i32x4, acc[ai][bj][m][n]), 0, 0, 0)); \
          else acc[ai][bj][m][n] = __builtin_amdgcn_mfma_f32_16x16x32_bf16(Bt[n][k], At[m][k], acc[ai][bj][m][n], 0, 0, 0); } __builtin_amdgcn_s_setprio(0); } while (0)
#define PG8_WAIT_V(n) asm volatile("s_waitcnt vmcnt(" #n ")" ::: "memory")
#define PG8_WAIT_L(n) asm volatile("s_waitcnt lgkmcnt(" #n ")" ::: "memory")
#define PG8_BAR __builtin_amdgcn_s_barrier()
#define PG8_SCHED __builtin_amdgcn_sched_barrier(0)
    Unit cur, nxt; int ui = 0;
    if (!S.next(0, cur)) return;
    f32x4 acc[2][2][4][2];
#pragma unroll
    for (int a = 0; a < 2; ++a)
#pragma unroll
        for (int b = 0; b < 2; ++b)
#pragma unroll
            for (int m = 0; m < 4; ++m)
#pragma unroll
                for (int n = 0; n < 2; ++n) acc[a][b][m][n] = (f32x4){0.f, 0.f, 0.f, 0.f};
    bf16x8 At[4][2], B0[2][2], B1[2][2];
    const char* cA = cur.A; const char* cB = cur.B;
    PG8_STAGE(PG8_SB(0, 0), cB, voffB); PG8_STAGE(PG8_SA(0, 0), cA, voffA); PG8_STAGE(PG8_SB(0, 1), cB + hstepB, voffB); PG8_STAGE(PG8_SA(0, 1), cA + hstepA, voffA);
    if (wr == 1) PG8_BAR;
    PG8_WAIT_V(4); PG8_BAR;
    PG8_STAGE(PG8_SB(1, 0), cB + kstep, voffB); PG8_STAGE(PG8_SA(1, 0), cA + kstep, voffA); PG8_STAGE(PG8_SB(1, 1), cB + hstepB + kstep, voffB);
    PG8_WAIT_V(6); PG8_BAR;
    for (;;) {
        const bool has_next = S.next(ui + 1, nxt);
        const char* nA = has_next ? nxt.A : cA; const char* nB = has_next ? nxt.B : cB;
        for (int t = 0; t < nt; t += 2) {
            const bool last = (t == nt - 2);
            const char* a1 = cA + (size_t)(t + 1) * kstep;
            const char* a2 = last ? nA : cA + (size_t)(t + 2) * kstep; const char* b2 = last ? nB : cB + (size_t)(t + 2) * kstep;
            const char* a3 = a2 + kstep; const char* b3 = b2 + kstep;
            PG8_LDB(B0, 0, 0); PG8_SCHED; PG8_LDA(At, 0, 0); PG8_STAGE(PG8_SA(1, 1), a1 + hstepA, voffA);
            PG8_WAIT_L(8); PG8_BAR; PG8_WAIT_L(0); PG8_MMA(0, 0, At, B0); PG8_BAR; PG8_SCHED;
            PG8_LDB(B1, 0, 1); PG8_STAGE(PG8_SB(0, 0), b2, voffB);
            PG8_BAR; PG8_WAIT_L(0); PG8_MMA(0, 1, At, B1); PG8_BAR;
            PG8_LDA(At, 0, 1); PG8_STAGE(PG8_SA(0, 0), a2, voffA);
            PG8_BAR; PG8_WAIT_L(0); PG8_MMA(1, 0, At, B0); PG8_BAR; PG8_SCHED;
            PG8_STAGE(PG8_SB(0, 1), b2 + hstepB, voffB);
            PG8_WAIT_V(6); PG8_BAR; PG8_MMA(1, 1, At, B1); PG8_BAR;
            PG8_LDB(B0, 1, 0); PG8_SCHED; PG8_LDA(At, 1, 0); PG8_STAGE(PG8_SA(0, 1), a2 + hstepA, voffA);
            PG8_WAIT_L(8); PG8_BAR; PG8_WAIT_L(0); PG8_MMA(0, 0, At, B0); PG8_BAR; PG8_SCHED;
            PG8_LDB(B1, 1, 1); PG8_STAGE(PG8_SB(1, 0), b3, voffB);
            PG8_BAR; PG8_WAIT_L(0); PG8_MMA(0, 1, At, B1); PG8_BAR;
            PG8_LDA(At, 1, 1); PG8_STAGE(PG8_SA(1, 0), a3, voffA);
            PG8_BAR; PG8_WAIT_L(0); PG8_MMA(1, 0, At, B0); PG8_BAR; PG8_SCHED;
            PG8_STAGE(PG8_SB(1, 1), b3 + hstepB, voffB);
            PG8_WAIT_V(6); PG8_BAR; PG8_MMA(1, 1, At, B1); PG8_BAR;
        }
        if (I8) {
#pragma unroll
            for (int a = 0; a < 2; ++a)
#pragma unroll
                for (int b = 0; b < 2; ++b)
#pragma unroll
                    for (int m = 0; m < 4; ++m)
#pragma unroll
                        for (int n = 0; n < 2; ++n)
#pragma unroll
                            for (int e = 0; e < 4; ++e) acc[a][b][m][n][e] = (float)__float_as_int(acc[a][b][m][n][e]);
        }
        if (!E.skip()) E(acc, cur, wr, wc, fr, fq, lds);
        else {
#pragma unroll
            for (int a = 0; a < 2; ++a)
#pragma unroll
                for (int b = 0; b < 2; ++b)
#pragma unroll
                    for (int m = 0; m < 4; ++m)
#pragma unroll
                        for (int n = 0; n < 2; ++n) asm volatile("" :: "v"(acc[a][b][m][n]));
        }
        if (!has_next) break;
#pragma unroll
        for (int a = 0; a < 2; ++a)
#pragma unroll
            for (int b = 0; b < 2; ++b)
#pragma unroll
                for (int m = 0; m < 4; ++m)
#pragma unroll
                    for (int n = 0; n < 2; ++n) acc[a][b][m][n] = (f32x4){0.f, 0.f, 0.f, 0.f};
        cur = nxt; cA = nA; cB = nB; ++ui;
    }
    PG8_WAIT_V(0);
    if (wr == 0) PG8_BAR;
    PG8_BAR;
#undef PG8_SA
#undef PG8_SB
#undef PG8_STAGE
#undef PG8_LDA
#undef PG8_LDB
#undef PG8_MMA
#undef PG8_WAIT_V
#undef PG8_WAIT_L
#undef PG8_BAR
#undef PG8_SCHED
}

struct Sched {
    int mode, nM, nN, nwg, G, c, tpb; const char* baseA; const char* baseB; char* baseO; size_t strideA, strideB, bstrideB; int ldo_bytes_per_el;
    __device__ __forceinline__ bool next(int i, Unit& u) const {
        const long L = (long)i * G + c; if (L >= nwg) return false;
        if (mode == 0) {
            int wgid = (int)L; { const int q = nwg / 8, r = nwg % 8, xcd = wgid % 8, off = wgid / 8; wgid = (xcd < r ? xcd * (q + 1) : r * (q + 1) + (xcd - r) * q) + off; }
            const int nig = 8 * nN, gid = wgid / nig, fm = gid * 8, gsz = (nM - fm) < 8 ? (nM - fm) : 8;
            const int pm = fm + ((wgid % nig) % gsz), pn = (wgid % nig) / gsz;
            u.A = baseA + (size_t)pm * strideA; u.B = baseB + (size_t)pn * strideB + (size_t)(pm / tpb) * bstrideB; u.O = baseO; u.row0 = pm * 256; u.col0 = pn * 256; u.scol = pn * 256;
        } else if (mode == 1) {
            const int l = (int)L, b = l >> 4, h = (l >> 2) & 3, kt = l & 3;
            u.A = baseA + ((size_t)(b * 256) * 2048 + h * 256) * 2; u.B = baseB + ((size_t)(kt * 256) * 1024 + h * 256) * 2;
            u.O = baseO + ((size_t)b * 1048576 + (size_t)(h * 256) * 1024 + kt * 256) * 2; u.row0 = 0; u.col0 = 0; u.scol = kt * 256;
        } else if (mode == 3) {
            const int l = (int)L, sel = l >> 6, h = (l >> 4) & 3, it = (l >> 2) & 3, jt = l & 3;
            u.A = (sel ? (const char*)strideA : baseA) + ((size_t)(it * 256) * 1024 + h * 256) * 2; u.B = baseB + (size_t)sel * (1024 * 1024 * 2) + ((size_t)(jt * 256) * 1024 + h * 256) * 2;
            u.O = baseO + ((size_t)(sel * 4 + h) * 1048576 + (size_t)(it * 256) * 1024 + jt * 256) * 2; u.row0 = 0; u.col0 = 0; u.scol = 0;
        } else if (mode == 4) {
            const int l = (int)L, b = l >> 4, h = (l >> 2) & 3, xt = l & 3;
            u.A = baseA + (size_t)(b * 256) * 1024 * 2; u.B = baseB + ((size_t)h * 1048576 + (size_t)(xt * 256) * 1024) * 2;
            u.O = baseO + ((size_t)b * 1048576 + (size_t)(h * 256) * 1024 + xt * 256) * 2; u.row0 = 0; u.col0 = 0; u.scol = xt * 256;
        } else if (mode == 5) {
            const int l = (int)L, b = l >> 4, h = (l >> 2) & 3, ot = l & 3;
            u.A = baseA + ((size_t)(4 + h) * 1048576 + (size_t)(ot * 256) * 1024) * 2; u.B = baseB + (size_t)(b * 256) * 1024 * 2;
            u.O = baseO + ((size_t)b * 1048576 + (size_t)(ot * 256) * 1024 + h * 256) * ldo_bytes_per_el; u.row0 = 0; u.col0 = 0; u.scol = 0;
        } else {
            const int l = (int)L, b = l >> 4, h = (l >> 2) & 3, ntile = l & 3;
            u.A = baseA + ((size_t)(ntile * 256) * 1024 + h * 256) * 2; u.B = baseB + ((size_t)(b * 256) * 2048 + 1024 + h * 256) * 2;
            u.O = baseO + ((size_t)b * 1048576 + (size_t)(ntile * 256) * 1024 + h * 256) * 2; u.row0 = 0; u.col0 = 0; u.scol = 0;
        }
        return true;
    }
};

struct EpiBf16 {
    static constexpr bool PERM = true;
    int ldc; float scale; const float* rss; const float* colscale; const float* rowscale; int probe; int f8out;
    __device__ __forceinline__ bool skip() const { return probe == 2; }
    __device__ __forceinline__ void operator()(const f32x4 (&acc)[2][2][4][2], const Unit& u, int wr, int wc, int fr, int fq, LAS unsigned char* lds) const {
        bf16_t* base = (bf16_t*)u.O;
        f32x4 cs[2][2];
#pragma unroll
        for (int bj = 0; bj < 2; ++bj)
#pragma unroll
            for (int n = 0; n < 2; ++n) cs[bj][n] = colscale ? *(const f32x4*)(colscale + u.scol + wc * CWS + 8 * fq + bj * CBJ + 4 * n) : (f32x4){1.f, 1.f, 1.f, 1.f};
        float scv[2][4];
#pragma unroll
        for (int ai = 0; ai < 2; ++ai)
#pragma unroll
            for (int m = 0; m < 4; ++m) { const int row = u.row0 + ai * HALF + wr * 64 + m * 16 + fr;
                float sc = scale; if (rss) sc *= rsqrtf(rss[row] * (1.0f / 1024.0f) + EPS); if (rowscale) sc *= rowscale[row]; scv[ai][m] = sc; }
        asm volatile("" ::: "memory");
        if (f8out) {
            unsigned char* b8 = (unsigned char*)u.O;
#pragma unroll
            for (int ai = 0; ai < 2; ++ai)
#pragma unroll
                for (int m = 0; m < 4; ++m) { const float sc = scv[ai][m]; const int row = u.row0 + ai * HALF + wr * 64 + m * 16 + fr;
#pragma unroll
                    for (int bj = 0; bj < 2; ++bj) { const f32x4 v0 = acc[ai][bj][m][0] * sc * cs[bj][0], v1 = acc[ai][bj][m][1] * sc * cs[bj][1];
                        int w0 = __builtin_amdgcn_cvt_pk_fp8_f32(v0[0], v0[1], 0, false); w0 = __builtin_amdgcn_cvt_pk_fp8_f32(v0[2], v0[3], w0, true);
                        int w1 = __builtin_amdgcn_cvt_pk_fp8_f32(v1[0], v1[1], 0, false); w1 = __builtin_amdgcn_cvt_pk_fp8_f32(v1[2], v1[3], w1, true);
                        *(u32x2*)(b8 + (size_t)row * ldc + u.col0 + wc * CWS + bj * CBJ + 8 * fq) = (u32x2){(unsigned)w0, (unsigned)w1}; } }
            return;
        }
        const int lane = fr + 16 * fq, wid8 = wr * 4 + wc;
        LAS unsigned char* scr = lds + XCH_OFF + wid8 * 2048;
        const int rr = lane >> 3, cc = lane & 7;
#pragma unroll
        for (int ai = 0; ai < 2; ++ai)
#pragma unroll
            for (int m = 0; m < 4; ++m) {
                const float sc = scv[ai][m];
#pragma unroll
                for (int bj = 0; bj < 2; ++bj) { const f32x4 v0 = acc[ai][bj][m][0] * sc * cs[bj][0], v1 = acc[ai][bj][m][1] * sc * cs[bj][1];
                    u32x4 w; w.x = cvt_pk_bf16(v0[0], v0[1]); w.y = cvt_pk_bf16(v0[2], v0[3]); w.z = cvt_pk_bf16(v1[0], v1[1]); w.w = cvt_pk_bf16(v1[2], v1[3]);
                    *(LAS u32x4*)(scr + fr * 128 + (((4 * bj + fq) ^ (fr & 7)) << 4)) = w; }
                LDS_WAIT(); asm volatile("" ::: "memory");
                const u32x4 o0 = *(const LAS u32x4*)(scr + rr * 128 + ((cc ^ (rr & 7)) << 4)), o1 = *(const LAS u32x4*)(scr + (rr + 8) * 128 + ((cc ^ (rr & 7)) << 4));
                LDS_WAIT(); asm volatile("" ::: "memory");
                const int row0 = u.row0 + ai * HALF + wr * 64 + m * 16;
                bf16_t* cp = base + (size_t)(row0 + rr) * ldc + u.col0 + wc * CWS + 8 * cc;
                *(u32x4*)cp = o0; *(u32x4*)(cp + (size_t)8 * ldc) = o1;
            }
    }
};
struct EpiResid {
    static constexpr bool PERM = false;
    const float* base; float* out; bf16_t* xg; const float* g; float* rss;
    __device__ __forceinline__ void operator()(const f32x4 (&acc)[2][2][4][2], const Unit& u, int wr, int wc, int fr, int fq, LAS unsigned char*) const {
        const int colb = u.col0 + wc * 32 + 4 * fq;
#pragma unroll
        for (int ai = 0; ai < 2; ++ai)
#pragma unroll
            for (int m = 0; m < 4; ++m) {
                const int row = u.row0 + ai * HALF + wr * 64 + m * 16 + fr; const size_t off = (size_t)row * DM + colb; float ss = 0.f;
#pragma unroll
                for (int bj = 0; bj < 2; ++bj)
#pragma unroll
                    for (int n = 0; n < 2; ++n) { const int co = bj * HALF + n * 16;
                        const f32x4 bs = *(const f32x4*)(base + off + co); const f32x4 v = bs + acc[ai][bj][m][n];
                        *(f32x4*)(out + off + co) = v; const f32x4 gv = *(const f32x4*)(g + colb + co); const f32x4 w = v * gv;
                        u32x2 pk; pk.x = cvt_pk_bf16(w[0], w[1]); pk.y = cvt_pk_bf16(w[2], w[3]); *(u32x2*)(xg + off + co) = pk;
                        ss += (v[0] * v[0] + v[1] * v[1]) + (v[2] * v[2] + v[3] * v[3]); }
                ss += __shfl_xor(ss, 16); ss += __shfl_xor(ss, 32);
                if (fq == 0) atomicAdd(rss + row, ss);
                asm volatile("" ::: "memory"); }
    }
};
template <bool BASE_BF16>
struct EpiResidB {
    static constexpr bool PERM = true;
    const void* base; bf16_t* out; float* rss; unsigned* amax; float ascale;
    __device__ __forceinline__ bool skip() const { return false; }
    __device__ __forceinline__ void load_raw(f32x4 (&raw)[2][2], const size_t off) const {
#pragma unroll
        for (int bj = 0; bj < 2; ++bj) {
            if (BASE_BF16) { const u32x4 b4 = *(const u32x4*)((const bf16_t*)base + off + bj * CBJ); raw[bj][0] = (f32x4){__uint_as_float(b4.x), __uint_as_float(b4.y), __uint_as_float(b4.z), __uint_as_float(b4.w)}; }
            else { raw[bj][0] = *(const f32x4*)((const float*)base + off + bj * CBJ); raw[bj][1] = *(const f32x4*)((const float*)base + off + bj * CBJ + 4); } }
    }
    __device__ __forceinline__ void operator()(const f32x4 (&acc)[2][2][4][2], const Unit& u, int wr, int wc, int fr, int fq, LAS unsigned char*) const {
        const int colb = u.col0 + wc * CWS + 8 * fq;
        const int rowb = u.row0 + wr * 64 + fr;
        f32x4 cur[2][2], nxt[2][2];
        load_raw(cur, (size_t)rowb * DM + colb);
#pragma unroll
        for (int it = 0; it < 8; ++it) {
            const int ai = it >> 2, m = it & 3;
            const int row = rowb + ai * HALF + m * 16; const size_t off = (size_t)row * DM + colb; float ss = 0.f; u16x2 mx2 = (u16x2){0, 0};
            if (it + 1 < 8) load_raw(nxt, (size_t)(rowb + ((it + 1) >> 2) * HALF + ((it + 1) & 3) * 16) * DM + colb);
            asm volatile("" ::: "memory");
#pragma unroll
            for (int bj = 0; bj < 2; ++bj) {
                f32x4 b0, b1;
                if (BASE_BF16) { const unsigned w0 = __float_as_uint(cur[bj][0].x), w1 = __float_as_uint(cur[bj][0].y), w2 = __float_as_uint(cur[bj][0].z), w3 = __float_as_uint(cur[bj][0].w);
                    b0 = (f32x4){bf_lo(w0), bf_hi(w0), bf_lo(w1), bf_hi(w1)}; b1 = (f32x4){bf_lo(w2), bf_hi(w2), bf_lo(w3), bf_hi(w3)}; }
                else { b0 = cur[bj][0]; b1 = cur[bj][1]; }
                const f32x4 v0 = b0 + (ascale != 0.f ? acc[ai][bj][m][0] * ascale : acc[ai][bj][m][0]), v1 = b1 + (ascale != 0.f ? acc[ai][bj][m][1] * ascale : acc[ai][bj][m][1]);
                u32x4 pk; pk.x = cvt_pk_bf16(v0[0], v0[1]); pk.y = cvt_pk_bf16(v0[2], v0[3]); pk.z = cvt_pk_bf16(v1[0], v1[1]); pk.w = cvt_pk_bf16(v1[2], v1[3]);
                *(u32x4*)(out + off + bj * CBJ) = pk;
                if (amax) { const u16x2 a0 = __builtin_bit_cast(u16x2, pk.x & 0x7fff7fffu), a1 = __builtin_bit_cast(u16x2, pk.y & 0x7fff7fffu), a2 = __builtin_bit_cast(u16x2, pk.z & 0x7fff7fffu), a3 = __builtin_bit_cast(u16x2, pk.w & 0x7fff7fffu);
                    mx2 = __builtin_elementwise_max(mx2, __builtin_elementwise_max(__builtin_elementwise_max(a0, a1), __builtin_elementwise_max(a2, a3))); }
                ss += ((v0[0] * v0[0] + v0[1] * v0[1]) + (v0[2] * v0[2] + v0[3] * v0[3])) + ((v1[0] * v1[0] + v1[1] * v1[1]) + (v1[2] * v1[2] + v1[3] * v1[3])); }
            ss += __shfl_xor(ss, 16); ss += __shfl_xor(ss, 32);
            unsigned mxb = 0u;
            if (amax) { mxb = max((unsigned)mx2.x, (unsigned)mx2.y); mxb = max(mxb, (unsigned)__shfl_xor((int)mxb, 16)); mxb = max(mxb, (unsigned)__shfl_xor((int)mxb, 32)); }
            if (fq == 0) { atomicAdd(rss + row, ss); if (amax) atomicMax(amax + row, mxb << 16); }
            asm volatile("" ::: "memory");
#pragma unroll
            for (int bj = 0; bj < 2; ++bj)
#pragma unroll
                for (int n = 0; n < 2; ++n) cur[bj][n] = nxt[bj][n];
        }
    }
};
struct EpiSoftmax {
    static constexpr bool PERM = true;
    const float* rss; bf16_t* P; unsigned char* P8;
    __device__ __forceinline__ bool skip() const { return false; }
    __device__ __forceinline__ void operator()(f32x4 (&acc)[2][2][4][2], const Unit& u, int wr, int wc, int fr, int fq, LAS unsigned char* lds) const {
        LAS f32x2* X = (LAS f32x2*)(lds + XCH_OFF);
        float ml[2][4];
#pragma unroll
        for (int ai = 0; ai < 2; ++ai)
#pragma unroll
            for (int m = 0; m < 4; ++m) {
                const int r = ai * HALF + wr * 64 + m * 16 + fr;
                const float sc = rsqrtf(rss[u.row0 + r] * (1.0f / 1024.0f) + EPS) * LOG2E;
                float mx = -3.0e38f;
#pragma unroll
                for (int bj = 0; bj < 2; ++bj)
#pragma unroll
                    for (int n = 0; n < 2; ++n) { f32x4 v = acc[ai][bj][m][n] * sc; acc[ai][bj][m][n] = v; mx = fmaxf(mx, fmaxf(fmaxf(v[0], v[1]), fmaxf(v[2], v[3]))); }
                mx = fmaxf(mx, __shfl_xor(mx, 16)); mx = fmaxf(mx, __shfl_xor(mx, 32));
                float sm = 0.f;
#pragma unroll
                for (int bj = 0; bj < 2; ++bj)
#pragma unroll
                    for (int n = 0; n < 2; ++n) { f32x4 v = acc[ai][bj][m][n]; v[0] = fast_exp2(v[0] - mx); v[1] = fast_exp2(v[1] - mx); v[2] = fast_exp2(v[2] - mx); v[3] = fast_exp2(v[3] - mx);
                        acc[ai][bj][m][n] = v; sm += (v[0] + v[1]) + (v[2] + v[3]); }
                sm += __shfl_xor(sm, 16); sm += __shfl_xor(sm, 32);
                ml[ai][m] = mx;
                if (fq == 0) X[r * 4 + wc] = (f32x2){mx, sm};
            }
        LDS_WAIT(); __builtin_amdgcn_s_barrier(); asm volatile("" ::: "memory");
#pragma unroll
        for (int ai = 0; ai < 2; ++ai)
#pragma unroll
            for (int m = 0; m < 4; ++m) {
                const int r = ai * HALF + wr * 64 + m * 16 + fr;
                const f32x2 a = X[r * 4 + 0], b = X[r * 4 + 1], c = X[r * 4 + 2], d = X[r * 4 + 3];
                const float mg = fmaxf(fmaxf(a.x, b.x), fmaxf(c.x, d.x));
                const float lg = a.y * fast_exp2(a.x - mg) + b.y * fast_exp2(b.x - mg) + c.y * fast_exp2(c.x - mg) + d.y * fast_exp2(d.x - mg);
                const float f = fast_exp2(ml[ai][m] - mg) / lg;
                if (P8) { const float f8 = f * 256.0f;
                    LAS unsigned char* scr8 = lds + XCH_OFF + 8192 + (wr * 4 + wc) * 1024; const int ln = fr + 16 * fq;
#pragma unroll
                    for (int bj = 0; bj < 2; ++bj) { const f32x4 v0 = acc[ai][bj][m][0] * f8, v1 = acc[ai][bj][m][1] * f8;
                        int w0 = __builtin_amdgcn_cvt_pk_fp8_f32(v0[0], v0[1], 0, false); w0 = __builtin_amdgcn_cvt_pk_fp8_f32(v0[2], v0[3], w0, true);
                        int w1 = __builtin_amdgcn_cvt_pk_fp8_f32(v1[0], v1[1], 0, false); w1 = __builtin_amdgcn_cvt_pk_fp8_f32(v1[2], v1[3], w1, true);
                        *(LAS u32x2*)(scr8 + fr * 64 + bj * CBJ + 8 * fq) = (u32x2){(unsigned)w0, (unsigned)w1}; }
                    LDS_WAIT(); asm volatile("" ::: "memory");
                    const u32x4 o8 = *(const LAS u32x4*)(scr8 + (ln >> 2) * 64 + (ln & 3) * 16);
                    LDS_WAIT(); asm volatile("" ::: "memory");
                    *(u32x4*)(P8 + (size_t)(u.row0 + ai * HALF + wr * 64 + m * 16 + (ln >> 2)) * DM + u.col0 + wc * CWS + 16 * (ln & 3)) = o8;
                    continue; }
                bf16_t* rowp = P + (size_t)(u.row0 + r) * DM + u.col0 + wc * CWS + 8 * fq;
#pragma unroll
                for (int bj = 0; bj < 2; ++bj) { const f32x4 v0 = acc[ai][bj][m][0] * f, v1 = acc[ai][bj][m][1] * f;
                    u32x4 w; w.x = cvt_pk_bf16(v0[0], v0[1]); w.y = cvt_pk_bf16(v0[2], v0[3]); w.z = cvt_pk_bf16(v1[0], v1[1]); w.w = cvt_pk_bf16(v1[2], v1[3]);
                    *(u32x4*)(rowp + bj * CBJ) = w; } }
        LDS_WAIT();
    }
};
}
struct Args { const float* in[26]; float* out; unsigned char* ws; int ph_lo, ph_hi; };
enum { I_X = 0, I_MEM, I_GMIX, I_WIN, I_CONVW, I_BI, I_BF, I_GML, I_LQ1, I_LK1, I_LQ2, I_LK2, I_GDA, I_WOUT, I_GCA, I_GMEM, I_WCQ, I_WCK, I_WCV, I_WCO, I_GFFN, I_WPQ, I_SUBK, I_PU, I_PV, I_GFIN };

struct Frame {
    LAS unsigned char* lds;
    int tid, lane, wave, G, vcu;
    const Args* a;
    unsigned char* ws;
    unsigned* ctl;
};


#define XB_TMO      128
#define XB_XCNT(j)  (256  + 64 * (j))
#define XB_XSUB(j)  (1280 + 64 * (j))
#define XB_XGEN(j)  (2304 + 64 * (j))
#define XB_TOP      3328
#define XB_TOPGEN   3392
#define XCD_BAR_WORDS 3456
#define XB_SPIN_CAP (1u << 18)
__device__ __forceinline__ unsigned xb_ld(unsigned* p)              { return __hip_atomic_load(p, __ATOMIC_RELAXED, __HIP_MEMORY_SCOPE_AGENT); }
__device__ __forceinline__ unsigned xb_add(unsigned* p, unsigned v) { return __hip_atomic_fetch_add(p, v, __ATOMIC_RELAXED, __HIP_MEMORY_SCOPE_AGENT); }
__device__ __forceinline__ unsigned xb_xcc_id() { return (unsigned)__builtin_amdgcn_s_getreg((3 << 11) | 20) & 0xFu; }
#define XB_SPIN(cond, bar) do { unsigned _sp = 0; while (cond) { __builtin_amdgcn_s_sleep(1); \
    if ((++_sp & 255u) == 0u) { if (xb_ld(&(bar)[XB_TMO])) break; if (_sp > XB_SPIN_CAP) { atomicAdd(&(bar)[XB_TMO], 1u); break; } } } } while (0)
struct XcdBarrier { unsigned* bar; unsigned x; volatile LAS unsigned* st; };
__device__ __forceinline__ XcdBarrier xcd_barrier_post(unsigned* bar, volatile LAS unsigned* st) {
    XcdBarrier b; b.bar = bar; b.x = xb_xcc_id(); b.st = st;
    if (threadIdx.x == 0) (void)xb_add(&bar[XB_XCNT(b.x)], 1u);
    return b;
}
__device__ __forceinline__ void xcd_barrier_complete(unsigned* bar, unsigned x, unsigned& nloc, unsigned& nx) {
    const unsigned G = gridDim.x * gridDim.y * gridDim.z;
    unsigned sum, cnt, mine, sp = 0u;
    for (;;) {
        sum = 0u; cnt = 0u; mine = 0u;
#pragma unroll
        for (unsigned j = 0; j < 16; ++j) { const unsigned c = xb_ld(&bar[XB_XCNT(j)]); sum += c; cnt += (c > 0u) ? 1u : 0u; mine = (j == x) ? c : mine; }
        if (sum == G) break;
        __builtin_amdgcn_s_sleep(1);
        if ((++sp & 255u) == 0u) { if (xb_ld(&bar[XB_TMO])) break; if (sp > XB_SPIN_CAP) { atomicAdd(&bar[XB_TMO], 1u); break; } }
    }
    nloc = mine > 0u ? mine : 1u; nx = cnt > 0u ? cnt : 1u;
}
__device__ __forceinline__ void xcd_barrier(const XcdBarrier& b) {
    asm volatile("s_waitcnt vmcnt(0)" ::: "memory");
    __syncthreads();
    if (threadIdx.x == 0) {
        unsigned* bar = b.bar;
        __builtin_amdgcn_s_waitcnt(0);
        unsigned nloc = b.st[0], nx = b.st[1];
        if (nloc == 0u) { xcd_barrier_complete(bar, b.x, nloc, nx); b.st[0] = nloc; b.st[1] = nx; }
        const unsigned old = xb_add(&bar[XB_XSUB(b.x)], 1u);
        const unsigned gen = old / nloc;
        if (old + 1u == (gen + 1u) * nloc) {
            __builtin_amdgcn_fence(__ATOMIC_RELEASE, "agent");
            asm volatile("s_waitcnt vmcnt(0)" ::: "memory");
            const unsigned og = xb_add(&bar[XB_TOP], 1u);
            const unsigned tg = og / nx;
            if (og + 1u == (tg + 1u) * nx) xb_add(&bar[XB_TOPGEN], 1u);
            else XB_SPIN(xb_ld(&bar[XB_TOPGEN]) == tg, bar);
            __builtin_amdgcn_fence(__ATOMIC_ACQUIRE, "agent");
            xb_add(&bar[XB_XGEN(b.x)], 1u);
            asm volatile("s_waitcnt vmcnt(0)" ::: "memory");
        } else {
            XB_SPIN(xb_ld(&bar[XB_XGEN(b.x)]) == gen, bar);
            __builtin_amdgcn_fence(__ATOMIC_ACQUIRE, "agent");
            asm volatile("s_waitcnt vmcnt(0)" ::: "memory");
        }
    }
    __syncthreads();
}

__device__ __forceinline__ void p0_transpose_item(const float* W, int Nsrc, int K, int kb, int src_col0, bf16_t* WT, int dst_row0, LAS float* scr, int lane, const float* kscale = nullptr) {
    const int k0 = 64 * kb;
    float wl[32];
#pragma unroll
    for (int i = 0; i < 32; ++i) wl[i] = W[(size_t)(k0 + 2 * i + (lane >> 5)) * Nsrc + src_col0 + (lane & 31)];
#pragma unroll
    for (int i = 0; i < 32; ++i) { const int kk = 2 * i + (lane >> 5); float wv = wl[i]; if (kscale) wv *= kscale[k0 + kk]; scr[kk * 33 + (lane & 31)] = wv; }
    LDS_WAIT(); asm volatile("" ::: "memory");
    const int c = lane & 7;
#pragma unroll
    for (int j = 0; j < 4; ++j) { const int n = (lane >> 3) + 8 * j; const LAS float* s = scr + (8 * c) * 33 + n;
        u32x4 o; o.x = cvt_pk_bf16(s[0 * 33], s[1 * 33]); o.y = cvt_pk_bf16(s[2 * 33], s[3 * 33]); o.z = cvt_pk_bf16(s[4 * 33], s[5 * 33]); o.w = cvt_pk_bf16(s[6 * 33], s[7 * 33]);
        *(u32x4*)(WT + (size_t)(dst_row0 + n) * K + k0 + 8 * c) = o; }
    LDS_WAIT(); asm volatile("" ::: "memory");
}
__device__ __forceinline__ void rms_row_to_bf16(const float* xrow, const float* g, bf16_t* orow, int lane, f32x4 (&v)[4]) {
    const f32x4* xr = (const f32x4*)xrow + lane; float s = 0.f;
#pragma unroll
    for (int j = 0; j < 4; ++j) { v[j] = xr[64 * j]; s += (v[j].x * v[j].x + v[j].y * v[j].y) + (v[j].z * v[j].z + v[j].w * v[j].w); }
    const float rstd = rsqrtf(wave_sum(s) * (1.f / DM) + EPS);
    u32x2* o8 = (u32x2*)orow + lane;
#pragma unroll
    for (int j = 0; j < 4; ++j) { const f32x4 gv = *((const f32x4*)g + lane + 64 * j); v[j] = v[j] * rstd * gv; u32x2 pk; pk.x = cvt_pk_bf16(v[j].x, v[j].y); pk.y = cvt_pk_bf16(v[j].z, v[j].w); o8[64 * j] = pk; }
}

__device__ __forceinline__ float rms_row_to_i8(const float* g, unsigned char* orow, int lane, f32x4 (&v)[4]) {
    float s = 0.f;
#pragma unroll
    for (int j = 0; j < 4; ++j) s += (v[j].x * v[j].x + v[j].y * v[j].y) + (v[j].z * v[j].z + v[j].w * v[j].w);
    const float rstd = rsqrtf(wave_sum(s) * (1.f / DM) + EPS);
    float mx = 0.f;
#pragma unroll
    for (int j = 0; j < 4; ++j) { const f32x4 gv = *((const f32x4*)g + lane + 64 * j); v[j] = v[j] * rstd * gv; mx = fmaxf(mx, fmaxf(fmaxf(fabsf(v[j].x), fabsf(v[j].y)), fmaxf(fabsf(v[j].z), fabsf(v[j].w)))); }
#pragma unroll
    for (int o = 32; o >= 1; o >>= 1) mx = fmaxf(mx, __shfl_xor(mx, o));
    const float qs = (mx > 0.f) ? 127.0f / mx : 0.f;
    unsigned* o4 = (unsigned*)orow + lane;
#pragma unroll
    for (int j = 0; j < 4; ++j) { const int a = __float2int_rn(v[j].x * qs), b = __float2int_rn(v[j].y * qs), c = __float2int_rn(v[j].z * qs), d = __float2int_rn(v[j].w * qs);
        o4[64 * j] = (unsigned)(a & 255) | ((unsigned)(b & 255) << 8) | ((unsigned)(c & 255) << 16) | ((unsigned)(d & 255) << 24); }
    return mx * (1.0f / 127.0f);
}

__device__ __forceinline__ void p0_prologue(Frame& F) {
    const Args& A = *F.a;
    LAS float* scr = (LAS float*)(F.lds + F.wave * 8448);
    LAS float* sG = (LAS float*)(F.lds + 67584);
    for (int k = F.tid; k < DM; k += 512) { const f32x4 w0 = *(const f32x4*)(A.in[I_WIN] + (size_t)k * INW + 2048), w1 = *(const f32x4*)(A.in[I_WIN] + (size_t)k * INW + 2052);
        sG[0 * DM + k] = w0.x; sG[1 * DM + k] = w0.y; sG[2 * DM + k] = w0.z; sG[3 * DM + k] = w0.w; sG[4 * DM + k] = w1.x; sG[5 * DM + k] = w1.y; sG[6 * DM + k] = w1.z; sG[7 * DM + k] = w1.w; }
    __syncthreads();
    {
        LAS float* cmax = (LAS float*)(F.lds + 67584 + 32768);
        unsigned char* Win8 = (unsigned char*)(F.ws + WS_WIN); float* wsc = (float*)(F.ctl + CW_WSC);
        const int lane = F.lane, w = F.wave, nl = lane & 31, kh = lane >> 5;
        for (int strip = F.vcu; strip < NZ / 32; strip += F.G) {
            const int n0 = strip * 32, src0 = n0 + (n0 >= 2048 ? 8 : 0);
            const float* Wc = A.in[I_WIN] + src0 + nl;
            float wv[64];
#pragma unroll
            for (int i = 0; i < 64; ++i) wv[i] = Wc[(size_t)(128 * w + 2 * i + kh) * INW];
            float mx = 0.f;
#pragma unroll
            for (int i = 0; i < 64; ++i) mx = fmaxf(mx, fabsf(wv[i]));
            mx = fmaxf(mx, __shfl_xor(mx, 32));
            if (lane < 32) cmax[w * 32 + lane] = mx;
            __syncthreads();
            float cm = 0.f;
#pragma unroll
            for (int ww = 0; ww < 8; ++ww) cm = fmaxf(cm, cmax[ww * 32 + nl]);
            const float qs = (cm > 0.f) ? 127.0f / cm : 0.f;
            if (w == 0 && lane < 32) wsc[n0 + lane] = cm * (1.0f / 127.0f);
#pragma unroll
            for (int kb2 = 0; kb2 < 2; ++kb2) {
                const int k0 = 128 * w + 64 * kb2;
#pragma unroll
                for (int i = 0; i < 32; ++i) { const int kk = 2 * i + kh; scr[kk * 33 + nl] = wv[32 * kb2 + i] * qs; }
                LDS_WAIT(); asm volatile("" ::: "memory");
                const int c = lane & 3;
#pragma unroll
                for (int j = 0; j < 2; ++j) { const int n = (lane >> 2) + 16 * j; const LAS float* sp = scr + (16 * c) * 33 + n;
                    unsigned o[4];
#pragma unroll
                    for (int q = 0; q < 4; ++q) { const int a = __float2int_rn(sp[(4 * q + 0) * 33]), b = __float2int_rn(sp[(4 * q + 1) * 33]), cc = __float2int_rn(sp[(4 * q + 2) * 33]), d = __float2int_rn(sp[(4 * q + 3) * 33]);
                        o[q] = (unsigned)(a & 255) | ((unsigned)(b & 255) << 8) | ((unsigned)(cc & 255) << 16) | ((unsigned)(d & 255) << 24); }
                    *(u32x4*)(Win8 + (size_t)(n0 + n) * DM + k0 + 16 * c) = (u32x4){o[0], o[1], o[2], o[3]}; }
                LDS_WAIT(); asm volatile("" ::: "memory");
            }
            __syncthreads();
        }
    }
    const int gw = F.vcu * 8 + F.wave, NGW = F.G * 8;
    constexpr int KB = DM / 64;
    constexpr int I_SQ = KB * (DM / 32);
    constexpr int NITEMS = TR_IN_P1 ? I_SQ : 3 * I_SQ;
    bf16_t* WoutT = (bf16_t*)(F.ws + WS_WOUT); bf16_t* WcoT = (bf16_t*)(F.ws + WS_WCO); bf16_t* WpqT = (bf16_t*)(F.ws + WS_WPQ);
    for (int it = gw; it < NITEMS; it += NGW) {
        int r = it;
        const int which = TR_IN_P1 ? 1 : r / I_SQ; if (!TR_IN_P1) r -= which * I_SQ; const int kb = r / (DM / 32), n0 = (r % (DM / 32)) * 32;
        if (which == 0) p0_transpose_item(A.in[I_WOUT], DM, DM, kb, n0, WoutT, n0, scr, F.lane);
        else if (which == 1) p0_transpose_item(A.in[I_WCO], DM, DM, kb, n0, WcoT, n0, scr, F.lane);
        else p0_transpose_item(A.in[I_WPQ], DM, DM, kb, n0, WpqT, n0, scr, F.lane, A.in[I_GFFN]);
    }
    {
        const int gt = F.vcu * 512 + F.tid, NT = F.G * 512;
        const f32x4* s0 = (const f32x4*)A.in[I_WCQ]; u32x2* d0 = (u32x2*)(F.ws + WS_WCQ);
#pragma unroll 2
        for (int i = gt; i < DM * DM / 4; i += NT) { const f32x4 v = s0[i]; u32x2 pk; pk.x = cvt_pk_bf16(v.x, v.y); pk.y = cvt_pk_bf16(v.z, v.w); d0[i] = pk; }
        const f32x4* sk = (const f32x4*)A.in[I_WCK]; const f32x4* sv = (const f32x4*)A.in[I_WCV]; u32x2* dkv = (u32x2*)(F.ws + WS_WKV);
#pragma unroll 2
        for (int i = gt; i < DM * DM / 4; i += NT) { const f32x4 v = sk[i], w = sv[i]; u32x2 pk, pw; pk.x = cvt_pk_bf16(v.x, v.y); pk.y = cvt_pk_bf16(v.z, v.w); pw.x = cvt_pk_bf16(w.x, w.y); pw.y = cvt_pk_bf16(w.z, w.w);
            dkv[i] = pk; dkv[DM * DM / 4 + i] = pw; }
        const f32x4* s1 = (const f32x4*)A.in[I_SUBK]; u32x2* d1 = (u32x2*)(F.ws + WS_SK);
        for (int i = gt; i < 16 * 128 * 64 / 4; i += NT) { const f32x4 v = s1[i]; u32x2 pk; pk.x = cvt_pk_bf16(v.x, v.y); pk.y = cvt_pk_bf16(v.z, v.w); d1[i] = pk; }
    }
    {
        unsigned char* HN = (unsigned char*)(F.ws + WS_BUFA); float* GT = (float*)(F.ws + WS_GATES); float* hsc = (float*)(F.ctl + CW_HSC);
        f32x4 nx[4];
        if (gw < T_TOK) {
#pragma unroll
            for (int j = 0; j < 4; ++j) nx[j] = *((const f32x4*)(A.in[I_X] + (size_t)gw * DM) + F.lane + 64 * j); }
        for (int m = gw; m < T_TOK; m += NGW) {
            f32x4 v[4];
#pragma unroll
            for (int j = 0; j < 4; ++j) v[j] = nx[j];
            { const int mn = (m + NGW < T_TOK) ? m + NGW : m;
#pragma unroll
              for (int j = 0; j < 4; ++j) nx[j] = *((const f32x4*)(A.in[I_X] + (size_t)mn * DM) + F.lane + 64 * j); }
            const float hs = rms_row_to_i8(A.in[I_GMIX], HN + (size_t)m * DM, F.lane, v);
            if (F.lane == 0) hsc[m] = hs;
            float gacc[8];
#pragma unroll
            for (int j = 0; j < 8; ++j) gacc[j] = 0.f;
#pragma unroll
            for (int jj = 0; jj < 4; ++jj)
#pragma unroll
                for (int j = 0; j < 8; ++j) { const f32x4 wv = *(const LAS f32x4*)(sG + j * DM + 4 * F.lane + 256 * jj); gacc[j] += (v[jj].x * wv.x + v[jj].y * wv.y) + (v[jj].z * wv.z + v[jj].w * wv.w); }
            float r4[4], r2[2], r1;
            { const bool hi = (F.lane & 32) != 0;
#pragma unroll
              for (int i = 0; i < 4; ++i) { const float keep = hi ? gacc[i + 4] : gacc[i], send = hi ? gacc[i] : gacc[i + 4]; r4[i] = keep + __shfl_xor(send, 32); } }
            { const bool hi = (F.lane & 16) != 0;
#pragma unroll
              for (int i = 0; i < 2; ++i) { const float keep = hi ? r4[i + 2] : r4[i], send = hi ? r4[i] : r4[i + 2]; r2[i] = keep + __shfl_xor(send, 16); } }
            { const bool hi = (F.lane & 8) != 0; const float keep = hi ? r2[1] : r2[0], send = hi ? r2[0] : r2[1]; r1 = keep + __shfl_xor(send, 8); }
            r1 += __shfl_xor(r1, 4); r1 += __shfl_xor(r1, 2); r1 += __shfl_xor(r1, 1);
            if ((F.lane & 7) == 0) GT[(size_t)m * 8 + 4 * (F.lane >> 5) + 2 * ((F.lane >> 4) & 1) + ((F.lane >> 3) & 1)] = r1;
        }
        bf16_t* MN = (bf16_t*)(F.ws + WS_MEMN);
        for (int m = gw; m < TMEM; m += NGW) { f32x4 v[4]; rms_row_to_bf16(A.in[I_MEM] + (size_t)m * DM, A.in[I_GMEM], MN + (size_t)m * DM, F.lane, v); }
    }
}
#ifndef AT_DEPTH
#define AT_DEPTH 3
#endif
constexpr int AT_STAGE = 32768, AT_NST = 4;
__device__ __forceinline__ int swzf(int r) { return ((r & 3) << 2) | ((r >> 2) & 3); }

__device__ __forceinline__ void glds16_asm(const void* gsrc, unsigned lds_dst) {
    unsigned keep;
    asm volatile("s_mov_b32 %0, m0\n\ts_mov_b32 m0, %2\n\ts_nop 0\n\tglobal_load_lds_dwordx4 %1, off\n\ts_mov_b32 m0, %0" : "=&s"(keep) : "v"(gsrc), "s"(lds_dst) : "memory");
}

__device__ __forceinline__ s16x4 tr16(const LAS unsigned char* p) { return __builtin_amdgcn_ds_read_tr16_b64_v4i16((LAS s16x4*)p); }
__device__ __forceinline__ bf16x8 cat8(s16x4 lo, s16x4 hi) { return __builtin_shufflevector(lo, hi, 0, 1, 2, 3, 4, 5, 6, 7); }

template <int MODE>
__device__ __forceinline__ void attn_unit(Frame& F, const int b, const int h, const int qt, const float lam) {
    const Args& A = *F.a;
    const bf16_t* Z = (const bf16_t*)(F.ws + WS_Z);
    bf16_t* CAT = (bf16_t*)(F.ws + WS_BUFA);
    LAS unsigned char* lds = F.lds;
    int tid_l = F.tid; asm volatile("" : "+v"(tid_l));
    const int tid = tid_l, lane = tid & 63, w = F.wave, c = w & 1, qb = w >> 1, n = lane & 31, h2 = lane >> 5;
    const int q0 = qt * 128, r0 = q0 + 32 * qb, ntiles = 2 * qt + 2;
    const size_t rowbase = (size_t)b * SEQ;
    const float slope2 = __uint_as_float((unsigned)(127 - 2 * (h + 1)) << 23) * LOG2E, c1 = 0.125f * LOG2E;
    const float slope_hi = __uint_as_float(__float_as_uint(slope2) & 0xffff0000u), slope_lo = slope2 - slope_hi;
    bf16x8 Qf[4];
    { const bf16_t* qp = Z + (rowbase + r0 + n) * NZ + ZC_DAQ + h * 128 + c * 64 + 8 * h2;
#pragma unroll
      for (int kk = 0; kk < 4; ++kk) { const u32x4 q4_ = *(const u32x4*)(qp + 16 * kk); u32x4 o_;
          o_.x = cvt_pk_bf16(bf_lo(q4_.x) * c1, bf_hi(q4_.x) * c1); o_.y = cvt_pk_bf16(bf_lo(q4_.y) * c1, bf_hi(q4_.y) * c1); o_.z = cvt_pk_bf16(bf_lo(q4_.z) * c1, bf_hi(q4_.z) * c1); o_.w = cvt_pk_bf16(bf_lo(q4_.w) * c1, bf_hi(q4_.w) * c1);
          Qf[kk] = __builtin_bit_cast(bf16x8, o_); } }
    bf16x8 Qx, Kx[2];
    { u32x4 o_ = (u32x4){0u, 0u, 0u, 0u}; if (h2 == 0) o_.x = cvt_pk_bf16(slope_hi, slope_lo); Qx = __builtin_bit_cast(bf16x8, o_);
#pragma unroll
      for (int kb = 0; kb < 2; ++kb) { u32x4 k_ = (u32x4){0u, 0u, 0u, 0u}; if (h2 == 0) k_.x = cvt_pk_bf16((float)(32 * kb + n), (float)(32 * kb + n)); Kx[kb] = __builtin_bit_cast(bf16x8, k_); } }
    f32x16 O[4];
#pragma unroll
    for (int i = 0; i < 4; ++i)
#pragma unroll
        for (int j = 0; j < 16; ++j) O[i][j] = 0.f;
    float mrun = -3.0e38f, lsum = 0.f;
    float Bn;
    { float qs = 0.f;
#pragma unroll
      for (int kk = 0; kk < 4; ++kk) { const u32x4 q4_ = __builtin_bit_cast(u32x4, Qf[kk]);
          qs += (bf_lo(q4_.x) * bf_lo(q4_.x) + bf_hi(q4_.x) * bf_hi(q4_.x)) + (bf_lo(q4_.y) * bf_lo(q4_.y) + bf_hi(q4_.y) * bf_hi(q4_.y)) + (bf_lo(q4_.z) * bf_lo(q4_.z) + bf_hi(q4_.z) * bf_hi(q4_.z)) + (bf_lo(q4_.w) * bf_lo(q4_.w) + bf_hi(q4_.w) * bf_hi(q4_.w)); }
      qs += __shfl_xor(qs, 32);
      const float k2 = __uint_as_float(*(const volatile unsigned*)(F.ctl + CW_KMAX + b * 8 + h * 2 + c));
      Bn = sqrtf(qs * k2) * 1.001f + 0.01f; }
    volatile LAS int* dflag = (volatile LAS int*)(lds + MISC_OFF + 64);
    const unsigned ldsbase = (unsigned)(size_t)lds;
#define AT_DMA(j_) do { if (MODE & 2) break; const int jj_ = ntiles - 1 - ((j_) < ntiles ? (j_) : ntiles - 1);     \
        _Pragma("unroll") for (int m_ = 0; m_ < 4; ++m_) { const int i_ = w + 8 * m_, r_ = 4 * (i_ & 15) + (lane >> 4), gch_ = (lane & 15) ^ swzf(r_); \
            const bf16_t* src_ = Z + (rowbase + 64 * jj_ + r_) * NZ + ((i_ >= 16) ? ZC_DAV : ZC_DAK) + h * 128 + 8 * gch_; \
            glds16_asm(src_, ldsbase + (unsigned)(((j_) & 3) * AT_STAGE + i_ * 1024)); } } while (0)
#if AT_DEPTH == 3
    AT_DMA(0); AT_DMA(1); AT_DMA(2);
    asm volatile("s_waitcnt vmcnt(4)" ::: "memory");
#else
    AT_DMA(0); AT_DMA(1);
    VM_WAIT();
#endif
    __syncthreads();
    const int i16 = lane & 15, q4 = i16 >> 2, p4 = i16 & 3, blk = (lane >> 4) & 1;
#define AT_QK(S_, j_) do { const LAS unsigned char* Ks_ = lds + ((j_) & 3) * AT_STAGE; bf16x8 kf_[8]; \
        _Pragma("unroll") for (int kb = 0; kb < 2; ++kb) _Pragma("unroll") for (int kk = 0; kk < 4; ++kk) kf_[4 * kb + kk] = *(const LAS bf16x8*)(Ks_ + (32 * kb + n) * 256 + (((8 * c + 2 * kk + h2) ^ swzf(n)) << 4)); \
        _Pragma("unroll") for (int e = 0; e < 16; ++e) { (S_)[0][e] = 0.f; (S_)[1][e] = 0.f; } \
        _Pragma("unroll") for (int kb = 0; kb < 2; ++kb) { _Pragma("unroll") for (int kk = 0; kk < 4; ++kk) (S_)[kb] = __builtin_amdgcn_mfma_f32_32x32x16_bf16(kf_[4 * kb + kk], Qf[kk], (S_)[kb], 0, 0, 0); \
            (S_)[kb] = __builtin_amdgcn_mfma_f32_32x32x16_bf16(Kx[kb], Qx, (S_)[kb], 0, 0, 0); } } while (0)
#define AT_LOADV(buf_, dvb_) do { _Pragma("unroll") for (int kb = 0; kb < 2; ++kb) _Pragma("unroll") for (int s = 0; s < 2; ++s) { const int ch_ = 4 * (dvb_) + 2 * blk + (p4 >> 1); \
        const LAS unsigned char* vp = Vs + (32 * kb + 16 * s + 4 * h2 + q4) * 256 + 8 * (p4 & 1); \
        (buf_)[2 * kb + s] = cat8(tr16(vp + ((ch_ ^ swzf(4 * h2 + q4)) << 4)), tr16(vp + 8 * 256 + ((ch_ ^ swzf(8 + 4 * h2 + q4)) << 4))); } } while (0)
#define AT_PV(buf_, dvb_) do { \
        _Pragma("unroll") for (int kb = 0; kb < 2; ++kb) _Pragma("unroll") for (int s = 0; s < 2; ++s) O[dvb_] = __builtin_amdgcn_mfma_f32_32x32x16_bf16((buf_)[2 * kb + s], Pf[kb][s], O[dvb_], 0, 0, 0); } while (0)
#define AT_TILE(Sc_, Sn_, j_) do { \
        AT_DMA((j_) + AT_DEPTH); \
        const int k0 = 64 * (ntiles - 1 - (j_)); \
        if (!(MODE & 1) && (j_) + 1 < ntiles && k0 - 64 <= r0 + 31) AT_QK(Sn_, (j_) + 1); \
        if (!(MODE & 1) && k0 <= r0 + 31) { \
            const LAS unsigned char* Vs = lds + ((j_) & 3) * AT_STAGE + 16384; \
            bf16x8 va[4], vb[4]; \
            const float D0 = (float)(r0 + n - k0 - 4 * h2); \
            const float tcon = slope2 * (float)(k0 - r0 - n);            \
            float mloc = -3.0e38f; \
            if (k0 + 63 > r0) { \
                _Pragma("unroll") for (int kb = 0; kb < 2; ++kb) _Pragma("unroll") for (int e = 0; e < 16; ++e) { const float off = (float)(32 * kb + (e & 3) + 8 * (e >> 2)); \
                    const float v = (off > D0) ? -INFINITY : (Sc_)[kb][e]; (Sc_)[kb][e] = v; mloc = fmaxf(mloc, v); } \
            } else { \
                _Pragma("unroll") for (int kb = 0; kb < 2; ++kb) _Pragma("unroll") for (int e = 0; e < 16; ++e) mloc = fmaxf(mloc, (Sc_)[kb][e]); \
            } \
            mloc = fmaxf(mloc, __shfl_xor(mloc, 32)) + tcon; \
              \
            if (__builtin_amdgcn_ballot_w64(mloc > mrun - 40.0f) != 0ull) { \
            AT_LOADV(va, 0); \
              \
            if (__builtin_amdgcn_ballot_w64(mloc > mrun + 8.0f) != 0ull) { \
                const float mnew = fmaxf(mrun, mloc), alpha = fast_exp2(mrun - mnew); \
                mrun = mnew; lsum *= alpha; \
                _Pragma("unroll") for (int dvb = 0; dvb < 4; ++dvb) _Pragma("unroll") for (int e = 0; e < 16; ++e) O[dvb][e] *= alpha; \
            } \
            const float mm = mrun - tcon; \
            float ps = 0.f; \
            _Pragma("unroll") for (int kb = 0; kb < 2; ++kb) _Pragma("unroll") for (int e = 0; e < 16; ++e) { const float pv = fast_exp2((Sc_)[kb][e] - mm); (Sc_)[kb][e] = pv; ps += pv; } \
            lsum += ps; \
            bf16x8 Pf[2][2]; \
            _Pragma("unroll") for (int kb = 0; kb < 2; ++kb) _Pragma("unroll") for (int s = 0; s < 2; ++s) { u32x4 pk; pk.x = cvt_pk_bf16((Sc_)[kb][8 * s + 0], (Sc_)[kb][8 * s + 1]); pk.y = cvt_pk_bf16((Sc_)[kb][8 * s + 2], (Sc_)[kb][8 * s + 3]); \
                pk.z = cvt_pk_bf16((Sc_)[kb][8 * s + 4], (Sc_)[kb][8 * s + 5]); pk.w = cvt_pk_bf16((Sc_)[kb][8 * s + 6], (Sc_)[kb][8 * s + 7]); Pf[kb][s] = __builtin_bit_cast(bf16x8, pk); } \
            AT_LOADV(vb, 1); AT_PV(va, 0); \
            AT_LOADV(va, 2); AT_PV(vb, 1); \
            AT_LOADV(vb, 3); AT_PV(va, 2); \
            AT_PV(vb, 3); \
            } \
        } \
        if (AT_DEPTH == 3) asm volatile("s_waitcnt vmcnt(4)" ::: "memory"); else asm volatile("s_waitcnt vmcnt(0)" ::: "memory"); \
        __syncthreads(); } while (0)
    f32x16 SA[2], SB[2];
    if (64 * (ntiles - 1) <= r0 + 31) AT_QK(SA, 0);
    for (int j = 0; j < ntiles; j += 2) {
        AT_TILE(SA, SB, j);
        { const float kr = (float)(64 * (ntiles - 2 - j));
          const bool live = !(Bn - slope2 * ((float)(r0 + n) - kr + 1.0f) < mrun - 40.0f);
          const bool wdone = __builtin_amdgcn_ballot_w64(live) == 0ull;
          if (lane == 0) dflag[w] = wdone ? 1 : 0; }
        AT_TILE(SB, SA, j + 1);
        { int alld = 1;
#pragma unroll
          for (int ww = 0; ww < 8; ++ww) alld &= dflag[ww];
          if (alld) break; }
    }
#undef AT_TILE
#undef AT_PV
#undef AT_LOADV
#undef AT_QK
    VM_WAIT();
    __syncthreads();
    { const float lt = lsum + __shfl_xor(lsum, 32); const float inv = (c == 0 ? 1.0f : lam) / lt;
#pragma unroll
      for (int dvb = 0; dvb < 4; ++dvb)
#pragma unroll
          for (int e = 0; e < 16; ++e) O[dvb][e] *= inv; }
    LAS float* cb = (LAS float*)lds + qb * 4096;
    if (c == 1) {
#pragma unroll
        for (int dvb = 0; dvb < 4; ++dvb)
#pragma unroll
            for (int e = 0; e < 16; ++e) cb[(dvb * 16 + e) * 64 + lane] = O[dvb][e];
    }
    __syncthreads();
    if (c == 0 && MODE == 0) {
        float ss = 0.f;
#pragma unroll
        for (int dvb = 0; dvb < 4; ++dvb)
#pragma unroll
            for (int e = 0; e < 16; ++e) { const float o = O[dvb][e] - cb[(dvb * 16 + e) * 64 + lane]; O[dvb][e] = o; ss += o * o; }
        ss += __shfl_xor(ss, 32);
        const float rstd = rsqrtf(ss * (1.0f / 128.0f) + EPS) * 0.8f;
        const float* g = A.in[I_GDA] + h * 128;
        bf16_t* op = CAT + (rowbase + r0 + n) * DM + 512 + h * 128;
#pragma unroll
        for (int dvb = 0; dvb < 4; ++dvb) {
            u32x2 pk[4];
#pragma unroll
            for (int e4 = 0; e4 < 4; ++e4) { const int dv = 32 * dvb + 8 * e4 + 4 * h2; const f32x4 gv = *(const f32x4*)(g + dv);
                pk[e4].x = cvt_pk_bf16(O[dvb][4 * e4 + 0] * rstd * gv.x, O[dvb][4 * e4 + 1] * rstd * gv.y); pk[e4].y = cvt_pk_bf16(O[dvb][4 * e4 + 2] * rstd * gv.z, O[dvb][4 * e4 + 3] * rstd * gv.w); }
            const u32x2 s0 = h2 ? pk[0] : pk[1], s1 = h2 ? pk[2] : pk[3];
            u32x2 r0, r1;
            r0.x = (unsigned)__shfl_xor((int)s0.x, 32); r0.y = (unsigned)__shfl_xor((int)s0.y, 32); r1.x = (unsigned)__shfl_xor((int)s1.x, 32); r1.y = (unsigned)__shfl_xor((int)s1.y, 32);
            const u32x4 w0 = h2 ? (u32x4){r0.x, r0.y, pk[1].x, pk[1].y} : (u32x4){pk[0].x, pk[0].y, r0.x, r0.y};
            const u32x4 w1 = h2 ? (u32x4){r1.x, r1.y, pk[3].x, pk[3].y} : (u32x4){pk[2].x, pk[2].y, r1.x, r1.y};
            *(u32x4*)(op + 32 * dvb + 8 * h2) = w0; *(u32x4*)(op + 32 * dvb + 16 + 8 * h2) = w1;
        }
    }
    __syncthreads();
#undef AT_DMA
}
__device__ __forceinline__ void conv_prepass(Frame& F) {
    const Args& A = *F.a;
    const bf16_t* Z = (const bf16_t*)(F.ws + WS_Z);
    bf16_t* QKC = (bf16_t*)(F.ws + WS_BUFB);
    const int gt = F.vcu * 512 + F.tid, NT = F.G * 512;
    float cw[4][8];
    { const int c0 = 8 * (gt & 127);
#pragma unroll
      for (int tp = 0; tp < 4; ++tp) { const f32x4 w0 = *(const f32x4*)(A.in[I_CONVW] + tp * 1024 + c0), w1 = *(const f32x4*)(A.in[I_CONVW] + tp * 1024 + c0 + 4);
          cw[tp][0] = w0.x; cw[tp][1] = w0.y; cw[tp][2] = w0.z; cw[tp][3] = w0.w; cw[tp][4] = w1.x; cw[tp][5] = w1.y; cw[tp][6] = w1.z; cw[tp][7] = w1.w; } }
#pragma unroll 2
    for (int it = gt; it < (T_TOK / 4) * 128; it += NT) {
        const int cg = it & 127, rb = it >> 7, row0 = 4 * rb, tl = row0 & (SEQ - 1), c0 = 8 * cg;
        u32x4 raw[7];
#pragma unroll
        for (int i = 0; i < 7; ++i) raw[i] = (tl - 3 + i >= 0) ? *(const u32x4*)(Z + (size_t)(row0 - 3 + i) * NZ + c0) : (u32x4){0u, 0u, 0u, 0u};
        const float ksc = (c0 >= 512) ? 0.08838834764831845f : 1.0f;
#pragma unroll
        for (int r = 0; r < 4; ++r) {
            float y[8];
#pragma unroll
            for (int ch = 0; ch < 8; ++ch) y[ch] = 0.f;
#pragma unroll
            for (int tp = 0; tp < 4; ++tp) { const u32x4 rv = raw[r + tp];
                y[0] += cw[tp][0] * bf_lo(rv.x); y[1] += cw[tp][1] * bf_hi(rv.x); y[2] += cw[tp][2] * bf_lo(rv.y); y[3] += cw[tp][3] * bf_hi(rv.y);
                y[4] += cw[tp][4] * bf_lo(rv.z); y[5] += cw[tp][5] * bf_hi(rv.z); y[6] += cw[tp][6] * bf_lo(rv.w); y[7] += cw[tp][7] * bf_hi(rv.w); }
#pragma unroll
            for (int ch = 0; ch < 8; ++ch) y[ch] = y[ch] * fast_rcp(1.0f + __expf(-y[ch])) * ksc;
            u32x4 pk; pk.x = cvt_pk_bf16(y[0], y[1]); pk.y = cvt_pk_bf16(y[2], y[3]); pk.z = cvt_pk_bf16(y[4], y[5]); pk.w = cvt_pk_bf16(y[6], y[7]);
            *(u32x4*)(QKC + (size_t)(row0 + r) * DM + c0) = pk;
        }
    }
    {
        unsigned* kmax = F.ctl + CW_KMAX;
        const int lane = F.tid & 63, gw = F.vcu * 8 + F.wave, NGW = F.G * 8;
        for (int rb = gw; rb < T_TOK / 16; rb += NGW) {
            float mx = 0.f;
#pragma unroll 4
            for (int r = 0; r < 16; ++r) { const u32x4 v = *(const u32x4*)(Z + (size_t)(rb * 16 + r) * NZ + ZC_DAK + 8 * lane);
                float ss = (bf_lo(v.x) * bf_lo(v.x) + bf_hi(v.x) * bf_hi(v.x)) + (bf_lo(v.y) * bf_lo(v.y) + bf_hi(v.y) * bf_hi(v.y)) + (bf_lo(v.z) * bf_lo(v.z) + bf_hi(v.z) * bf_hi(v.z)) + (bf_lo(v.w) * bf_lo(v.w) + bf_hi(v.w) * bf_hi(v.w));
                ss += __shfl_xor(ss, 1); ss += __shfl_xor(ss, 2); ss += __shfl_xor(ss, 4);
                mx = fmaxf(mx, ss); }
            if ((lane & 7) == 0) atomicMax(kmax + ((rb * 16) >> 11) * 8 + (lane >> 3), __float_as_uint(mx));
        }
    }
}

#ifndef ML_TOUCH
#define ML_TOUCH 0
#endif
constexpr int ML_TB = 49152;
constexpr int ML_HB = 2 * ML_TB;
constexpr int ML_HP = 132;
constexpr int ML_SC = ML_HB + 64 * ML_HP * 4;

#define MFMA16(a, b, c) __builtin_amdgcn_mfma_f32_16x16x32_bf16((a), (b), (c), 0, 0, 0)

__device__ __forceinline__ void mlstm_unit(Frame& F, const int b, const int h) {
    const Args& A = *F.a;
    const bf16_t* Z = (const bf16_t*)(F.ws + WS_Z);
    const bf16_t* QKC = (const bf16_t*)(F.ws + WS_BUFB);
    const float* GT = (const float*)(F.ws + WS_GATES);
    bf16_t* CAT = (bf16_t*)(F.ws + WS_BUFA);
    LAS unsigned char* lds = F.lds;
    int tid_l = F.tid; asm volatile("" : "+v"(tid_l));
    const int tid = tid_l, lane = tid & 63, w = F.wave, n = lane & 15, g = lane >> 4, q4 = n >> 2, p4 = n & 3;
    const size_t rowbase = (size_t)b * SEQ;
    LAS float* sc = (LAS float*)(lds + ML_SC);
    LAS float* sA = sc; LAS float* sM = sc + 128; LAS float* sInter = sc + 256; LAS float* sMt = sc + 384; LAS float* sW = sc + 512; LAS float* sDi = sc + 640; LAS float* sQn = sc + 704; LAS float* sN = sc + 768;
    if (tid < 128) sN[tid] = 0.f;
    const unsigned ldsbase = (unsigned)(size_t)lds;
    const float bi = A.in[I_BI][h], bfg = A.in[I_BF][h];
    float gi_r, gf_r;
#define ML_DMA(cc, par_) do { const int t0_ = 64 * (cc); \
        _Pragma("unroll") for (int m_ = 0; m_ < 6; ++m_) { const int i_ = w + 8 * m_, tile_ = i_ >> 4, r_ = 4 * (i_ & 15) + (lane >> 4), gch_ = (lane & 15) ^ swzf(r_); \
            const bf16_t* src_ = (tile_ == 2) ? (Z + (rowbase + t0_ + r_) * NZ + ZC_MLV + 128 * h + 8 * gch_) : (QKC + (rowbase + t0_ + r_) * DM + 512 * tile_ + 128 * h + 8 * gch_); \
            glds16_asm(src_, ldsbase + (unsigned)((par_) * ML_TB + i_ * 1024)); } } while (0)
#define ML_GATES(cc) do { gi_r = GT[(rowbase + 64 * (cc) + lane) * 8 + h]; gf_r = GT[(rowbase + 64 * (cc) + lane) * 8 + 4 + h]; } while (0)
    float m_st = 0.f, decay_c = 1.f;
#define ML_SCALARS(par_) do { \
        const float gi = gi_r + bi, gfv = gf_r + bfg; \
        const float lf = fminf(gfv, 0.f) - __logf(1.0f + __expf(-fabsf(gfv))); \
        float bc = lf; \
        _Pragma("unroll") for (int o = 1; o < 64; o <<= 1) { const float t_ = __shfl_up(bc, o); if (lane >= o) bc += t_; } \
        const float av = gi - bc; float pm = av; \
        _Pragma("unroll") for (int o = 1; o < 64; o <<= 1) { const float t_ = __shfl_up(pm, o); if (lane >= o) pm = fmaxf(pm, t_); } \
        const float Mv = fmaxf(m_st, pm), inter = __expf(m_st - Mv), mt = bc + Mv; \
        const float M63 = __shfl(Mv, 63), bc63 = __shfl(bc, 63); \
        const float wg = __expf(av - M63); \
        decay_c = __shfl(inter, 63); m_st = bc63 + M63; \
        if (w == 0) { sA[(par_) * 64 + lane] = av; sM[(par_) * 64 + lane] = Mv; sInter[(par_) * 64 + lane] = inter; sMt[(par_) * 64 + lane] = mt; sW[(par_) * 64 + lane] = wg; } \
    } while (0)

    f32x4 Cacc[8];
#pragma unroll
    for (int dt = 0; dt < 8; ++dt) Cacc[dt] = (f32x4){0.f, 0.f, 0.f, 0.f};
    ML_GATES(0);
    ML_DMA(0, 0);
    ML_SCALARS(0);
    VM_WAIT(); LDS_WAIT();
    __syncthreads();
    const float* gml = A.in[I_GML] + 128 * h;
    const int e0 = 16 * w;
    unsigned touch = 0u;
#pragma unroll 1
    for (int c = 0; c < 32; ++c) {
        const float decay = decay_c; const int par = c & 1;
        const LAS unsigned char* TQ = lds + par * ML_TB; const LAS unsigned char* TK = TQ + 16384; const LAS unsigned char* TV = TQ + 32768;
        if (c + 1 < 32) { ML_DMA(c + 1, par ^ 1); ML_GATES(c + 1); }
        const int nrow = tid >> 3, nseg = tid & 7;
        { const int rr = 8 * w + (lane >> 3), seg = lane & 7, x = swzf(rr);
          const u32x4 qa = *(const LAS u32x4*)(TQ + rr * 256 + (((2 * seg) ^ x) << 4)), qb = *(const LAS u32x4*)(TQ + rr * 256 + (((2 * seg + 1) ^ x) << 4));
          const f32x4 n0 = *(const LAS f32x4*)(sN + 16 * seg), n1 = *(const LAS f32x4*)(sN + 16 * seg + 4), n2 = *(const LAS f32x4*)(sN + 16 * seg + 8), n3 = *(const LAS f32x4*)(sN + 16 * seg + 12);
          float d = bf_lo(qa.x) * n0.x + bf_hi(qa.x) * n0.y + bf_lo(qa.y) * n0.z + bf_hi(qa.y) * n0.w + bf_lo(qa.z) * n1.x + bf_hi(qa.z) * n1.y + bf_lo(qa.w) * n1.z + bf_hi(qa.w) * n1.w
                  + bf_lo(qb.x) * n2.x + bf_hi(qb.x) * n2.y + bf_lo(qb.y) * n2.z + bf_hi(qb.y) * n2.w + bf_lo(qb.z) * n3.x + bf_hi(qb.z) * n3.y + bf_lo(qb.w) * n3.z + bf_hi(qb.w) * n3.w;
          d += __shfl_xor(d, 1); d += __shfl_xor(d, 2); d += __shfl_xor(d, 4);
          if (seg == 0) sQn[rr] = d; }
        bf16x8 Vf[2], Cf[4];
#pragma unroll
        for (int ks = 0; ks < 2; ++ks) {
            const LAS unsigned char* vp = TV + (32 * ks + 4 * g + q4) * 256 + (((2 * w + (p4 >> 1)) ^ swzf(4 * g + q4)) << 4) + 8 * (p4 & 1);
            Vf[ks] = cat8(tr16(vp), tr16(vp + 16 * 256));
        }
#pragma unroll
        for (int kd = 0; kd < 4; ++kd) { const f32x4 c0 = Cacc[2 * kd], c1 = Cacc[2 * kd + 1]; u32x4 pk; pk.x = cvt_pk_bf16(c0[0], c0[1]); pk.y = cvt_pk_bf16(c0[2], c0[3]); pk.z = cvt_pk_bf16(c1[0], c1[1]); pk.w = cvt_pk_bf16(c1[2], c1[3]); Cf[kd] = __builtin_bit_cast(bf16x8, pk); }
#pragma unroll 1
        for (int lb = 0; lb < 4; ++lb) {
            u32x4 pk[2]; pk[0] = (u32x4){0u, 0u, 0u, 0u}; pk[1] = (u32x4){0u, 0u, 0u, 0u};
            float di = 0.f;
            const LAS unsigned char* qrow = TQ + (16 * lb + n) * 256;
            {
                bf16x8 Qf[4];
#pragma unroll
                for (int kk = 0; kk < 4; ++kk) Qf[kk] = *(const LAS bf16x8*)(qrow + (((4 * kk + g) ^ swzf(n)) << 4));
                const float Ml = sM[par * 64 + 16 * lb + n];
#pragma unroll
                for (int sb = 0; sb < 4; ++sb) if (sb <= lb) {
                    f32x4 acc = (f32x4){0.f, 0.f, 0.f, 0.f};
#pragma unroll
                    for (int kk = 0; kk < 4; ++kk) { const bf16x8 kf = *(const LAS bf16x8*)(TK + (16 * sb + n) * 256 + (((4 * kk + g) ^ swzf(n)) << 4)); acc = MFMA16(kf, Qf[kk], acc); }
                    const f32x4 av4 = *(const LAS f32x4*)(sA + par * 64 + 16 * sb + 4 * g);
                    float pv[4];
#pragma unroll
                    for (int r = 0; r < 4; ++r) { float e = acc[r] * fast_exp2((av4[r] - Ml) * LOG2E); if (sb == lb && (4 * g + r > n)) e = 0.f; pv[r] = e; di += e; }
                    const unsigned u0 = cvt_pk_bf16(pv[0], pv[1]), u1 = cvt_pk_bf16(pv[2], pv[3]);
                    if ((sb & 1) == 0) { pk[sb >> 1].x = u0; pk[sb >> 1].y = u1; } else { pk[sb >> 1].z = u0; pk[sb >> 1].w = u1; }
                }
            }
            di += __shfl_xor(di, 16); di += __shfl_xor(di, 32);
            if (w == 0 && g == 0) sDi[16 * lb + n] = di;
            f32x4 numI = (f32x4){0.f, 0.f, 0.f, 0.f}, accI = (f32x4){0.f, 0.f, 0.f, 0.f};
            numI = MFMA16(__builtin_bit_cast(bf16x8, pk[0]), Vf[0], numI);
            if (lb >= 2) numI = MFMA16(__builtin_bit_cast(bf16x8, pk[1]), Vf[1], numI);
#pragma unroll
            for (int kd = 0; kd < 4; ++kd) { const s16x4 lo = *(const LAS s16x4*)(qrow + (((4 * kd + (g >> 1)) ^ swzf(n)) << 4) + 8 * (g & 1)), hi = *(const LAS s16x4*)(qrow + (((4 * kd + 2 + (g >> 1)) ^ swzf(n)) << 4) + 8 * (g & 1));
                accI = MFMA16(cat8(lo, hi), Cf[kd], accI); }
            const f32x4 in4 = *(const LAS f32x4*)(sInter + par * 64 + 16 * lb + 4 * g);
#pragma unroll
            for (int r = 0; r < 4; ++r) *(LAS float*)(lds + ML_HB + ((16 * lb + 4 * g + r) * ML_HP + e0 + n) * 4) = numI[r] + in4[r] * accI[r];
            asm volatile("" ::: "memory");
        }
        const u32x4 og0 = *(const u32x4*)(Z + (rowbase + 64 * c + nrow) * NZ + ZC_MLO + 128 * h + 16 * nseg), og1 = *(const u32x4*)(Z + (rowbase + 64 * c + nrow) * NZ + ZC_MLO + 128 * h + 16 * nseg + 8);
        bf16x8 Vw[2], Wf[2];
#pragma unroll
        for (int ks = 0; ks < 2; ++ks) {
            const f32x4 wl = *(const LAS f32x4*)(sW + par * 64 + 32 * ks + 4 * g), wh = *(const LAS f32x4*)(sW + par * 64 + 32 * ks + 16 + 4 * g);
            const u32x4 v4 = __builtin_bit_cast(u32x4, Vf[ks]);
            u32x4 pw; pw.x = cvt_pk_bf16(bf_lo(v4.x) * wl.x, bf_hi(v4.x) * wl.y); pw.y = cvt_pk_bf16(bf_lo(v4.y) * wl.z, bf_hi(v4.y) * wl.w); pw.z = cvt_pk_bf16(bf_lo(v4.z) * wh.x, bf_hi(v4.z) * wh.y); pw.w = cvt_pk_bf16(bf_lo(v4.w) * wh.z, bf_hi(v4.w) * wh.w);
            Vw[ks] = __builtin_bit_cast(bf16x8, pw);
            u32x4 pf; pf.x = cvt_pk_bf16(wl.x, wl.y); pf.y = cvt_pk_bf16(wl.z, wl.w); pf.z = cvt_pk_bf16(wh.x, wh.y); pf.w = cvt_pk_bf16(wh.z, wh.w);
            if (n != 0) pf = (u32x4){0u, 0u, 0u, 0u};
            Wf[ks] = __builtin_bit_cast(bf16x8, pf);
        }
        f32x4 cn = (f32x4){0.f, 0.f, 0.f, 0.f};
#pragma unroll
        for (int dt = 0; dt < 8; ++dt) {
            f32x4 cacc = Cacc[dt] * decay;
#pragma unroll
            for (int ks = 0; ks < 2; ++ks) { const LAS unsigned char* kp = TK + (32 * ks + 4 * g + q4) * 256 + (((2 * dt + (p4 >> 1)) ^ swzf(4 * g + q4)) << 4) + 8 * (p4 & 1);
                const bf16x8 kt = cat8(tr16(kp), tr16(kp + 16 * 256)); cacc = MFMA16(kt, Vw[ks], cacc); if (dt == w) cn = MFMA16(kt, Wf[ks], cn); }
            Cacc[dt] = cacc;
        }
        LDS_WAIT();
        __syncthreads();
        if (n == 0) {
#pragma unroll
            for (int r = 0; r < 4; ++r) sN[16 * w + 4 * g + r] = decay * sN[16 * w + 4 * g + r] + cn[r]; }
        {
            const LAS float* hp = (const LAS float*)(lds + ML_HB) + nrow * ML_HP + 16 * nseg;
            f32x4 hv[4]; float ss = 0.f;
#pragma unroll
            for (int i = 0; i < 4; ++i) { hv[i] = *(const LAS f32x4*)(hp + 4 * i); ss += (hv[i].x * hv[i].x + hv[i].y * hv[i].y) + (hv[i].z * hv[i].z + hv[i].w * hv[i].w); }
            ss += __shfl_xor(ss, 1); ss += __shfl_xor(ss, 2); ss += __shfl_xor(ss, 4);
            const float den = sDi[nrow] + sInter[par * 64 + nrow] * sQn[nrow];
            const float dn = fmaxf(fabsf(den), __expf(-sMt[par * 64 + nrow]));
            const float rstd = rsqrtf(ss * (1.0f / 128.0f) + EPS * dn * dn);
            const unsigned ogw[8] = {og0.x, og0.y, og0.z, og0.w, og1.x, og1.y, og1.z, og1.w};
            unsigned outw[8];
#pragma unroll
            for (int i = 0; i < 4; ++i) { const f32x4 gv = *(const f32x4*)(gml + 16 * nseg + 4 * i);
                const float o0 = bf_lo(ogw[2 * i]), o1 = bf_hi(ogw[2 * i]), o2 = bf_lo(ogw[2 * i + 1]), o3 = bf_hi(ogw[2 * i + 1]);
                const float y0 = hv[i].x * rstd * gv.x * fast_rcp(1.0f + __expf(-o0)), y1 = hv[i].y * rstd * gv.y * fast_rcp(1.0f + __expf(-o1));
                const float y2 = hv[i].z * rstd * gv.z * fast_rcp(1.0f + __expf(-o2)), y3 = hv[i].w * rstd * gv.w * fast_rcp(1.0f + __expf(-o3));
                outw[2 * i] = cvt_pk_bf16(y0, y1); outw[2 * i + 1] = cvt_pk_bf16(y2, y3); }
            bf16_t* op = CAT + (rowbase + 64 * c + nrow) * DM + 128 * h + 16 * nseg;
            *(u32x4*)op = (u32x4){outw[0], outw[1], outw[2], outw[3]}; *(u32x4*)(op + 8) = (u32x4){outw[4], outw[5], outw[6], outw[7]};
        }
        if (c + 1 < 32) ML_SCALARS(par ^ 1);
        VM_WAIT(); LDS_WAIT();
#if ML_TOUCH
        asm volatile("" :: "v"(touch));
        if (c + 4 < 32 && tid < 384) { const int tl_ = tid >> 7, r_ = (tid & 127) >> 1, hf_ = tid & 1;
            const bf16_t* p_ = (tl_ == 2) ? (Z + (rowbase + 64 * (c + 4) + r_) * NZ + ZC_MLV + 128 * h + 64 * hf_) : (QKC + (rowbase + 64 * (c + 4) + r_) * DM + 512 * tl_ + 128 * h + 64 * hf_);
            touch = *(const volatile unsigned*)p_; }
#endif
        __syncthreads();
    }
#undef ML_DMA
#undef ML_GATES
#undef ML_SCALARS
}
#ifndef PROBE_HALF
#define PROBE_HALF 0
#endif
#ifndef Q_LPT
#define Q_LPT 0
#endif
#ifndef Q_PAIRED
#define Q_PAIRED 0
#endif
#if Q_PAIRED
#define QN_ATT 64
#else
#define QN_ATT 128
#endif
#ifndef ATT_MODE
#define ATT_MODE 0
#endif
#ifndef REPSUB
#define REPSUB 3
#endif
#ifndef PE_TOUCH
#define PE_TOUCH 0
#endif
#ifndef PE_VDOT
#define PE_VDOT 1
#endif
#ifndef PE_VMFMA
#define PE_VMFMA 0
#endif
#ifndef PE_XV
#define PE_XV 0
#endif
#ifndef PE_XP
#define PE_XP 0
#endif
#ifndef PE_XU
#define PE_XU 0
#endif
#ifndef P7REP
#define P7REP 0
#endif
constexpr size_t WS_US = WS_END;
constexpr int PE_REP = 132;
constexpr int PE_CS = 2 * 128 * PE_REP * 4, PE_SS = PE_CS + 512;
constexpr int PE_RE = 0, PE_RG = 128 * PE_REP * 4;

constexpr float PE_OFS = 16.0f;
__device__ __forceinline__ unsigned enc_f(float f) { const unsigned b = __float_as_uint(f); return b ^ ((unsigned)((int)b >> 31) | 0x80000000u); }
__device__ __forceinline__ float dec_f(unsigned e) { return __uint_as_float(e ^ ((~(unsigned)((int)e >> 31)) | 0x80000000u)); }
__device__ __forceinline__ unsigned umax3(unsigned a, unsigned b, unsigned c) { return max(max(a, b), c); }

#define CE_DESC(x, y) do { const int hi_ = max((int)(x), (int)(y)), lo_ = min((int)(x), (int)(y)); (x) = (unsigned)hi_; (y) = (unsigned)lo_; } while (0)
__device__ __forceinline__ void sort16_desc(unsigned (&a)[16]) {
#define C2(x, y) CE_DESC(a[x], a[y])
    C2(0, 13); C2(1, 12); C2(2, 15); C2(3, 14); C2(4, 8); C2(5, 6); C2(7, 11); C2(9, 10);
    C2(0, 5); C2(1, 7); C2(2, 9); C2(3, 4); C2(6, 13); C2(8, 14); C2(10, 15); C2(11, 12);
    C2(0, 1); C2(2, 3); C2(4, 5); C2(6, 8); C2(7, 9); C2(10, 11); C2(12, 13); C2(14, 15);
    C2(0, 2); C2(1, 3); C2(4, 10); C2(5, 11); C2(6, 7); C2(8, 9); C2(12, 14); C2(13, 15);
    C2(1, 2); C2(3, 12); C2(4, 6); C2(5, 7); C2(8, 10); C2(9, 11); C2(13, 14);
    C2(1, 4); C2(2, 6); C2(5, 8); C2(7, 10); C2(9, 13); C2(11, 14);
    C2(2, 4); C2(3, 6); C2(9, 12); C2(11, 13);
    C2(3, 5); C2(6, 8); C2(7, 9); C2(10, 12);
    C2(3, 4); C2(5, 6); C2(7, 8); C2(9, 10); C2(11, 12);
    C2(6, 7); C2(8, 9);
#undef C2
}
__device__ __forceinline__ void bitonic_merge16_desc(unsigned (&a)[16]) {
#pragma unroll
    for (int j = 8; j > 0; j >>= 1)
#pragma unroll
        for (int i = 0; i < 16; ++i) { const int l = i ^ j; if (l > i) CE_DESC(a[i], a[l]); }
}
__device__ __forceinline__ void bitonic_merge8_desc(unsigned (&a)[8]) {
#pragma unroll
    for (int j = 4; j > 0; j >>= 1)
#pragma unroll
        for (int i = 0; i < 8; ++i) { const int l = i ^ j; if (l > i) CE_DESC(a[i], a[l]); }
}
__device__ __forceinline__ void merge_top16(unsigned (&a)[16], const unsigned (&b)[16]) {
#pragma unroll
    for (int i = 0; i < 16; ++i) a[i] = (unsigned)max((int)a[i], (int)b[15 - i]);
    bitonic_merge16_desc(a);
}
template <bool PAIR>
__device__ __forceinline__ void top16_of64(const unsigned (&key)[64], unsigned (&top)[16]) {
    unsigned q1[16], q2[16], q3[16];
#pragma unroll
    for (int i = 0; i < 16; ++i) { top[i] = key[i]; q1[i] = key[16 + i]; q2[i] = key[32 + i]; q3[i] = key[48 + i]; }
    sort16_desc(top); sort16_desc(q1); merge_top16(top, q1);
    sort16_desc(q2); sort16_desc(q3); merge_top16(q2, q3);
    merge_top16(top, q2);
    if (PAIR) {
        unsigned o[16];
#pragma unroll
        for (int i = 0; i < 16; ++i) o[i] = (unsigned)__shfl_xor((int)top[i], 32);
        merge_top16(top, o);
    }
}

__device__ __forceinline__ float gelu_exact(float v) { return 0.5f * v * (1.0f + erff(v * 0.70710678118654752f)); }
typedef __bf16 bf16x2_t __attribute__((ext_vector_type(2)));
__device__ __forceinline__ float dot2bf(unsigned a, unsigned b, float c) { return __builtin_amdgcn_fdot2_f32_bf16(__builtin_bit_cast(bf16x2_t, a), __builtin_bit_cast(bf16x2_t, b), c, false); }
__device__ __forceinline__ float dot8(const u32x4 a, const u32x4 b) { return dot2bf(a.x, b.x, dot2bf(a.y, b.y, dot2bf(a.z, b.z, dot2bf(a.w, b.w, 0.f)))); }
__device__ __forceinline__ float dpp_xor1(float v) { return __int_as_float(__builtin_amdgcn_update_dpp(0, __float_as_int(v), 0xB1, 0xF, 0xF, true)); }
__device__ __forceinline__ float dpp_xor2(float v) { return __int_as_float(__builtin_amdgcn_update_dpp(0, __float_as_int(v), 0x4E, 0xF, 0xF, true)); }
__device__ __forceinline__ float dpp_xor4(float v) { const int m = __builtin_amdgcn_update_dpp(0, __float_as_int(v), 0x141, 0xF, 0xF, true); return __int_as_float(__builtin_amdgcn_update_dpp(0, m, 0x1B, 0xF, 0xF, true)); }
__device__ __forceinline__ float reduce8x8(const float (&p)[8], const int j) {
    float r[4], q[2];
#pragma unroll
    for (int i = 0; i < 4; ++i) { const float keep = (j & 4) ? p[i + 4] : p[i], send = (j & 4) ? p[i] : p[i + 4]; r[i] = keep + __shfl_xor(send, 4); }
#pragma unroll
    for (int i = 0; i < 2; ++i) { const float keep = (j & 2) ? r[i + 2] : r[i], send = (j & 2) ? r[i] : r[i + 2]; q[i] = keep + __shfl_xor(send, 2); }
    const float keep = (j & 1) ? q[1] : q[0], send = (j & 1) ? q[0] : q[1];
    return keep + __shfl_xor(send, 1);
}

__device__ __forceinline__ int reduce8x8i(const float (&p)[8], const int j) {
    int r[4], q[2];
#pragma unroll
    for (int i = 0; i < 4; ++i) { const int keep = __float_as_int((j & 4) ? p[i + 4] : p[i]), send = __float_as_int((j & 4) ? p[i] : p[i + 4]); r[i] = keep + __shfl_xor(send, 4); }
#pragma unroll
    for (int i = 0; i < 2; ++i) { const int keep = (j & 2) ? r[i + 2] : r[i], send = (j & 2) ? r[i] : r[i + 2]; q[i] = keep + __shfl_xor(send, 2); }
    const int keep = (j & 1) ? q[1] : q[0], send = (j & 1) ? q[0] : q[1];
    return keep + __shfl_xor(send, 1);
}
constexpr size_t WS_VS8 = WS_US + 16 * MiB, WS_SINV = WS_US + 32 * MiB;
__device__ __forceinline__ void peer_convert_rows(Frame& F, const int item) {
    const Args& A = *F.a;
    int lane_l = threadIdx.x & 63; asm volatile("" : "+v"(lane_l));
    const int lane = lane_l;
    float* SINV = (float*)(F.ws + WS_SINV);
    f32x4 gq[4];
    { const float* gp = A.in[I_GFFN] + 16 * lane; gq[0] = *(const f32x4*)gp; gq[1] = *(const f32x4*)(gp + 4); gq[2] = *(const f32x4*)(gp + 8); gq[3] = *(const f32x4*)(gp + 12); }
    const int base = 256 * item + 32 * F.wave;
    const int tb = base >> 14;
    const float* tsrc = (tb ? A.in[I_PV] : A.in[I_PU]) + 16 * lane;
#define PC_LOAD(buf_, c_) do { _Pragma("unroll") for (int r = 0; r < 4; ++r) { const int e_ = (base + 4 * (c_) + r) & 16383; const float* src_ = tsrc + (size_t)e_ * DM; \
            _Pragma("unroll") for (int q = 0; q < 4; ++q) (buf_)[r][q] = *(const f32x4*)(src_ + 4 * q); } } while (0)
#define PC_PROC(buf_, c_) do { _Pragma("unroll") for (int r = 0; r < 4; ++r) { const int e = (base + 4 * (c_) + r) & 16383; \
            if (tb == 0) { _Pragma("unroll") for (int q = 0; q < 4; ++q) (buf_)[r][q] = (buf_)[r][q] * gq[q]; }            \
            float mx = 0.f; \
            _Pragma("unroll") for (int q = 0; q < 4; ++q) mx = fmaxf(mx, fmaxf(fmaxf(fabsf((buf_)[r][q].x), fabsf((buf_)[r][q].y)), fmaxf(fabsf((buf_)[r][q].z), fabsf((buf_)[r][q].w)))); \
            _Pragma("unroll") for (int o = 1; o < 64; o <<= 1) mx = fmaxf(mx, __shfl_xor(mx, o)); \
            unsigned ow[4]; float sinv; \
            if (tb == 0 || PE_VMFMA || PE_VDOT) {                                   \
                const float sc = (mx > 0.f) ? 127.0f / mx : 0.f; sinv = mx * (1.0f / 127.0f); \
                _Pragma("unroll") for (int q = 0; q < 4; ++q) { const int q0 = __float2int_rn((buf_)[r][q].x * sc), q1 = __float2int_rn((buf_)[r][q].y * sc), q2 = __float2int_rn((buf_)[r][q].z * sc), q3 = __float2int_rn((buf_)[r][q].w * sc); \
                    ow[q] = (unsigned)(q0 & 255) | ((unsigned)(q1 & 255) << 8) | ((unsigned)(q2 & 255) << 16) | ((unsigned)(q3 & 255) << 24); } \
            } else {                                                                \
                int k = (mx > 0.f) ? (int)floorf(log2f(416.0f / mx)) : 0; k = k > 60 ? 60 : (k < -60 ? -60 : k); \
                const float sc = exp2f((float)k); sinv = exp2f((float)-k); \
                _Pragma("unroll") for (int q = 0; q < 4; ++q) { int wd = __builtin_amdgcn_cvt_pk_fp8_f32((buf_)[r][q].x * sc, (buf_)[r][q].y * sc, 0, false); wd = __builtin_amdgcn_cvt_pk_fp8_f32((buf_)[r][q].z * sc, (buf_)[r][q].w * sc, wd, true); ow[q] = (unsigned)wd; } \
            } \
            unsigned char* dst = (unsigned char*)(F.ws + (tb ? WS_VS8 : WS_US)) + ((size_t)(lane >> 3) * 16384 + e) * 128 + 16 * (lane & 7); \
            *(u32x4*)dst = (u32x4){ow[0], ow[1], ow[2], ow[3]}; \
            if (lane == 0) SINV[tb * 16384 + e] = sinv; } } while (0)
    f32x4 b0[4][4], b1[4][4];
    PC_LOAD(b0, 0);
#pragma unroll 1
    for (int c = 0; c < 8; c += 2) {
        PC_LOAD(b1, c + 1);
        PC_PROC(b0, c);
        if (c + 2 < 8) PC_LOAD(b0, c + 2);
        PC_PROC(b1, c + 1);
    }
#undef PC_LOAD
#undef PC_PROC
}

template <bool DRY>
__device__ __forceinline__ void peer_tile(Frame& F, const int tile) {
    const Args& A = *F.a;
    const bf16_t* QP = (const bf16_t*)(F.ws + WS_BUFA); const bf16_t* XG = (const bf16_t*)(F.ws + WS_BUFB); bf16_t* XGW = (bf16_t*)(F.ws + WS_BUFB); const bf16_t* SK = (const bf16_t*)(F.ws + WS_SK);
    const float* rss2 = (const float*)(F.ctl + CW_RSS2);
    LAS unsigned* RE = (LAS unsigned*)(F.lds + PE_RE); LAS float* RG = (LAS float*)(F.lds + PE_RG);
    const int w = F.wave;
    {
        int lane = F.lane; asm volatile("" : "+v"(lane));
        const int tg = w & 3, hh = w >> 2, n = lane & 31, h2 = lane >> 5;
        const int tok = 32 * tg + n; const size_t trow = (size_t)tile * 128 + tok;
        for (int rrep = 0; rrep < ((P7REP & 1) ? 2 : 1); ++rrep) {
        bf16x8 Qn[2][4];
#pragma unroll
        for (int cc = 0; cc < 2; ++cc)
#pragma unroll
            for (int kk = 0; kk < 4; ++kk) Qn[cc][kk] = *(const bf16x8*)(QP + trow * DM + 64 * (8 * hh + cc) + 16 * kk + 8 * h2);
        for (int hd = 4 * hh; hd < 4 * hh + 4; ++hd) {
            unsigned T2[2][16];
            bf16x8 Qc[2][4];
#pragma unroll
            for (int cc = 0; cc < 2; ++cc)
#pragma unroll
                for (int kk = 0; kk < 4; ++kk) Qc[cc][kk] = Qn[cc][kk];
            { const int hn_ = (hd + 1 < 4 * hh + 4) ? hd + 1 : hd;
#pragma unroll
              for (int cc = 0; cc < 2; ++cc)
#pragma unroll
                  for (int kk = 0; kk < 4; ++kk) Qn[cc][kk] = *(const bf16x8*)(QP + trow * DM + 64 * (2 * hn_ + cc) + 16 * kk + 8 * h2); }
#pragma unroll
            for (int cc = 0; cc < 2; ++cc) {
                const int grp = 2 * hd + cc;
                bf16x8 Qf[4];
#pragma unroll
                for (int kk = 0; kk < 4; ++kk) Qf[kk] = Qc[cc][kk];
                unsigned key[64];
                unsigned lowbase = 127u - 4u * (unsigned)h2; asm volatile("" : "+v"(lowbase));
#pragma unroll
                for (int kb = 0; kb < 4; ++kb) {
                    f32x16 S;
#pragma unroll
                    for (int e = 0; e < 16; ++e) S[e] = PE_OFS;
#pragma unroll
                    for (int kk = 0; kk < 4; ++kk) { const bf16x8 a = *(const bf16x8*)(SK + ((size_t)(grp * 128 + 32 * kb + n)) * 64 + 16 * kk + 8 * h2); S = __builtin_amdgcn_mfma_f32_32x32x16_bf16(a, Qf[kk], S, 0, 0, 0); }
#pragma unroll
                    for (int e = 0; e < 16; ++e) { const int idx0 = 32 * kb + (e & 3) + 8 * (e >> 2); key[16 * kb + e] = ((__float_as_uint(S[e]) & ~127u) | lowbase) - (unsigned)idx0; }
                }
                top16_of64<true>(key, T2[cc]);
            }
            float va[16], vb[16];
#pragma unroll
            for (int i = 0; i < 16; ++i) { va[i] = __uint_as_float(T2[0][i] & ~127u); vb[i] = __uint_as_float(T2[1][i] & ~127u); }
#define CKEY(i_, j_) ((__float_as_uint(va[i_] + vb[j_]) & ~255u) | (unsigned)(255 - (16 * (i_) + (j_))))
            unsigned best[16];
            {
                unsigned c0[16];
#pragma unroll
                for (int q = 0; q < 16; ++q) best[q] = CKEY(0, q);
#pragma unroll
                for (int q = 1; q < 16; ++q) c0[q - 1] = CKEY(q, 0);
                c0[15] = 0u;
                merge_top16(best, c0);
                unsigned y1[16];
#pragma unroll
                for (int q = 1; q < 8; ++q) y1[q - 1] = CKEY(1, q);
                y1[7] = 0u; y1[8] = 0u; y1[9] = 0u;
#pragma unroll
                for (int q = 2; q < 8; ++q) y1[17 - q] = CKEY(q, 1);
                bitonic_merge16_desc(y1);
                unsigned y2[8];
                unsigned b1 = CKEY(3, 3), b2 = CKEY(4, 2); CE_DESC(b1, b2);
                y2[0] = CKEY(2, 2); y2[1] = CKEY(2, 3); y2[2] = CKEY(2, 4); y2[3] = 0u; y2[4] = 0u; y2[5] = b2; y2[6] = b1; y2[7] = CKEY(3, 2);
                bitonic_merge8_desc(y2);
#pragma unroll
                for (int q = 8; q < 16; ++q) y1[q] = (unsigned)max((int)y1[q], (int)y2[15 - q]);
                bitonic_merge16_desc(y1);
                merge_top16(best, y1);
            }
#undef CKEY
            const float v0 = __uint_as_float(best[0] & ~255u);
            float gw[16], zs = 0.f;
#pragma unroll
            for (int k = 0; k < 16; ++k) { gw[k] = __expf(__uint_as_float(best[k] & ~255u) - v0); zs += gw[k]; }
            const float zinv = 1.0f / zs;
            unsigned TA[4], TB[4];
#pragma unroll
            for (int d = 0; d < 4; ++d) {
                TA[d] = 0x7F7F7F7Fu - ((T2[0][4 * d] & 127u) | ((T2[0][4 * d + 1] & 127u) << 8) | ((T2[0][4 * d + 2] & 127u) << 16) | ((T2[0][4 * d + 3] & 127u) << 24));
                TB[d] = 0x7F7F7F7Fu - ((T2[1][4 * d] & 127u) | ((T2[1][4 * d + 1] & 127u) << 8) | ((T2[1][4 * d + 2] & 127u) << 16) | ((T2[1][4 * d + 3] & 127u) << 24)); }
#pragma unroll
            for (int kk = 0; kk < 8; ++kk) {
                const unsigned bk = h2 ? best[8 + kk] : best[kk]; const float gk = h2 ? gw[8 + kk] : gw[kk];
                const unsigned code = 255u - (bk & 255u); const unsigned ci = code >> 4, cj = code & 15u;
                const unsigned sa = (ci & 7u) | 0x0C0C0C00u, sb = (cj & 7u) | 0x0C0C0C00u;
                const unsigned ia = (ci & 8u) ? __builtin_amdgcn_perm(TA[3], TA[2], sa) : __builtin_amdgcn_perm(TA[1], TA[0], sa);
                const unsigned ib = (cj & 8u) ? __builtin_amdgcn_perm(TB[3], TB[2], sb) : __builtin_amdgcn_perm(TB[1], TB[0], sb);
                RE[tok * PE_REP + hd * 16 + 8 * h2 + kk] = (ia * 128u + ib) << 7; RG[tok * PE_REP + hd * 16 + 8 * h2 + kk] = gk * zinv;
            }
        }
        }
    }
    __syncthreads();
    {
        int lane = F.lane; asm volatile("" : "+v"(lane));
        const unsigned char* US = (const unsigned char*)(F.ws + WS_US); const unsigned char* VS = (const unsigned char*)(F.ws + WS_VS8); const float* SINV = (const float*)(F.ws + WS_SINV);
        const int j = lane & 7, gid = 8 * w + (lane >> 3);
        const int tA = gid, tB = 64 + gid; const size_t rowA = (size_t)tile * 128 + tA, rowB = (size_t)tile * 128 + tB;
        const LAS unsigned* reA = RE + tA * PE_REP; const LAS unsigned* reB = RE + tB * PE_REP;
        LAS float* cfA = RG + tA * PE_REP; LAS float* cfB = RG + tB * PE_REP;
        float accA[16], accB[16];
#pragma unroll
        for (int i = 0; i < 16; ++i) { accA[i] = 0.f; accB[i] = 0.f; }
#define PE_DEC16P(w4, f2) do { (f2)[0] = __builtin_amdgcn_cvt_pk_f32_fp8((int)(w4).x, false); (f2)[1] = __builtin_amdgcn_cvt_pk_f32_fp8((int)(w4).x, true); (f2)[2] = __builtin_amdgcn_cvt_pk_f32_fp8((int)(w4).y, false); (f2)[3] = __builtin_amdgcn_cvt_pk_f32_fp8((int)(w4).y, true); \
            (f2)[4] = __builtin_amdgcn_cvt_pk_f32_fp8((int)(w4).z, false); (f2)[5] = __builtin_amdgcn_cvt_pk_f32_fp8((int)(w4).z, true); (f2)[6] = __builtin_amdgcn_cvt_pk_f32_fp8((int)(w4).w, false); (f2)[7] = __builtin_amdgcn_cvt_pk_f32_fp8((int)(w4).w, true); } while (0)
#define PE_ISSUE(buf_, re_, kb_, base_) do { const u32x4 e4a = *(const LAS u32x4*)((re_) + 8 * (kb_)), e4b = *(const LAS u32x4*)((re_) + 8 * (kb_) + 4); const unsigned ew[8] = {e4a.x, e4a.y, e4a.z, e4a.w, e4b.x, e4b.y, e4b.z, e4b.w}; \
                _Pragma("unroll") for (int i = 0; i < 8; ++i) (buf_)[i] = *(const u32x4*)((base_) + (size_t)ew[i]); } while (0)
        float sxA, sxB, isxA, isxB;
        { const float mA = __uint_as_float(F.ctl[CW_AMAX + rowA]), mB = __uint_as_float(F.ctl[CW_AMAX + rowB]);
          sxA = (mA > 0.f) ? 127.0f / mA : 0.f; sxB = (mB > 0.f) ? 127.0f / mB : 0.f; isxA = mA * (1.0f / 127.0f); isxB = mB * (1.0f / 127.0f); }
        u32x4 xra0 = *(const u32x4*)(XG + rowA * DM + 16 * j), xra1 = *(const u32x4*)(XG + rowA * DM + 16 * j + 8), xrb0 = *(const u32x4*)(XG + rowB * DM + 16 * j), xrb1 = *(const u32x4*)(XG + rowB * DM + 16 * j + 8);
        u32x4 bufA[8], bufB[8];
        PE_ISSUE(bufA, reA, 0, US + 16 * j);
#pragma unroll 1
        for (int s2 = 0; s2 < ((P7REP & 2) ? 16 : 8); ++s2) {
            const int s = s2 & 7;
            if (s2 == 8) {
#pragma unroll
                for (int i = 0; i < 16; ++i) { accA[i] = 0.f; accB[i] = 0.f; } }
            int dmu = 0;
            unsigned xa[4], xb[4];
            { const unsigned aw[8] = {xra0.x, xra0.y, xra0.z, xra0.w, xra1.x, xra1.y, xra1.z, xra1.w}, bw[8] = {xrb0.x, xrb0.y, xrb0.z, xrb0.w, xrb1.x, xrb1.y, xrb1.z, xrb1.w};
#pragma unroll
              for (int i = 0; i < 4; ++i) { const int a0_ = __float2int_rn(bf_lo(aw[2 * i]) * sxA), a1_ = __float2int_rn(bf_hi(aw[2 * i]) * sxA), a2_ = __float2int_rn(bf_lo(aw[2 * i + 1]) * sxA), a3_ = __float2int_rn(bf_hi(aw[2 * i + 1]) * sxA);
                  const int b0_ = __float2int_rn(bf_lo(bw[2 * i]) * sxB), b1_ = __float2int_rn(bf_hi(bw[2 * i]) * sxB), b2_ = __float2int_rn(bf_lo(bw[2 * i + 1]) * sxB), b3_ = __float2int_rn(bf_hi(bw[2 * i + 1]) * sxB);
                  xa[i] = (unsigned)(a0_ & 255) | ((unsigned)(a1_ & 255) << 8) | ((unsigned)(a2_ & 255) << 16) | ((unsigned)(a3_ & 255) << 24);
                  xb[i] = (unsigned)(b0_ & 255) | ((unsigned)(b1_ & 255) << 8) | ((unsigned)(b2_ & 255) << 16) | ((unsigned)(b3_ & 255) << 24); } }
            { const int sn = (s + 1) & 7;
              xra0 = *(const u32x4*)(XG + rowA * DM + 128 * sn + 16 * j); xra1 = *(const u32x4*)(XG + rowA * DM + 128 * sn + 16 * j + 8); xrb0 = *(const u32x4*)(XG + rowB * DM + 128 * sn + 16 * j); xrb1 = *(const u32x4*)(XG + rowB * DM + 128 * sn + 16 * j + 8); }
            const unsigned char* Us = US + (size_t)s * (16384 * 128) + 16 * j; const unsigned char* Usn = US + (size_t)((s + 1) & 7) * (16384 * 128) + 16 * j;
#if PE_TOUCH
            const unsigned tchu = *(const volatile unsigned*)(US + (size_t)((s + 1) & 7) * (16384 * 128) + ((size_t)(((blockIdx.x >> 3) & 31) * 512 + F.tid)) * 128);
#endif
#define PE_UCOMP(buf_, x_, acc_, kb_) do { float pp[8]; _Pragma("unroll") for (int i = 0; i < 8; ++i) { int d_ = __builtin_amdgcn_sdot4((int)(buf_)[i].x, (int)(x_)[0], 0, false); d_ = __builtin_amdgcn_sdot4((int)(buf_)[i].y, (int)(x_)[1], d_, false); d_ = __builtin_amdgcn_sdot4((int)(buf_)[i].z, (int)(x_)[2], d_, false); d_ = __builtin_amdgcn_sdot4((int)(buf_)[i].w, (int)(x_)[3], d_, false); pp[i] = __int_as_float(d_); \
                    if (PE_XU) { _Pragma("unroll") for (int q = 0; q < PE_XU; ++q) dmu = __builtin_amdgcn_sdot4((int)(buf_)[i].x, (int)(x_)[q & 3], dmu, false); } } \
                (acc_)[kb_] += (float)reduce8x8i(pp, j); asm volatile("" : "+v"((acc_)[kb_]) :: "memory"); } while (0)
#pragma unroll
            for (int kb = 0; kb < 16; ++kb) {
                PE_ISSUE(bufB, reB, kb, Us);
                PE_UCOMP(bufA, xa, accA, kb);
                if (kb + 1 < 16) PE_ISSUE(bufA, reA, kb + 1, Us); else PE_ISSUE(bufA, reA, 0, Usn);
                PE_UCOMP(bufB, xb, accB, kb);
            }
            if (PE_XU) asm volatile("" :: "v"(dmu));
#if PE_TOUCH
            asm volatile("" :: "v"(tchu));
#endif
        }
#undef PE_UCOMP
#if PE_VDOT
        float csA, csB;
        {
            const float rsA = rsqrtf(rss2[rowA] * (1.0f / DM) + EPS), rsB = rsqrtf(rss2[rowB] * (1.0f / DM) + EPS);
            float mA = 0.f, mB = 0.f;
#pragma unroll
            for (int kb = 0; kb < 16; ++kb) { const int eA = (int)(reA[8 * kb + j] >> 7), eB = (int)(reB[8 * kb + j] >> 7);
                accA[kb] = cfA[8 * kb + j] * gelu_exact(accA[kb] * (rsA * isxA) * SINV[eA]) * SINV[16384 + eA]; accB[kb] = cfB[8 * kb + j] * gelu_exact(accB[kb] * (rsB * isxB) * SINV[eB]) * SINV[16384 + eB];
                mA = fmaxf(mA, fabsf(accA[kb])); mB = fmaxf(mB, fabsf(accB[kb])); }
            mA = fmaxf(mA, __shfl_xor(mA, 1)); mA = fmaxf(mA, __shfl_xor(mA, 2)); mA = fmaxf(mA, __shfl_xor(mA, 4));
            mB = fmaxf(mB, __shfl_xor(mB, 1)); mB = fmaxf(mB, __shfl_xor(mB, 2)); mB = fmaxf(mB, __shfl_xor(mB, 4));
            const float qA = (mA > 0.f) ? 127.0f / mA : 0.f, qB = (mB > 0.f) ? 127.0f / mB : 0.f;
            csA = mA * (1.0f / 127.0f); csB = mB * (1.0f / 127.0f);
            asm volatile("" ::: "memory");
#pragma unroll
            for (int kb = 0; kb < 16; ++kb) { ((LAS unsigned char*)cfA)[8 * kb + j] = (unsigned char)(__float2int_rn(accA[kb] * qA) & 255); ((LAS unsigned char*)cfB)[8 * kb + j] = (unsigned char)(__float2int_rn(accB[kb] * qB) & 255); }
        }
        LDS_WAIT();
        float ssA = 0.f, ssB = 0.f;
        float* xoA = A.out + rowA * DM + 16 * j; float* xoB = A.out + rowB * DM + 16 * j;
        const LAS unsigned char* cqA = (const LAS unsigned char*)cfA; const LAS unsigned char* cqB = (const LAS unsigned char*)cfB;
        PE_ISSUE(bufA, reA, 0, VS + 16 * j);
#pragma unroll 1
        for (int s2 = 0; s2 < ((P7REP & 4) ? 16 : 8); ++s2) {
            const int s = s2 & 7; const bool dry = (P7REP & 4) && s2 < 8;
            const unsigned char* Vs = VS + (size_t)s * (16384 * 128) + 16 * j; const unsigned char* Vsn = VS + (size_t)((s + 1) & 7) * (16384 * 128) + 16 * j;
            u32x2 x2a[4], x2b[4];
#pragma unroll
            for (int q = 0; q < 4; ++q) { x2a[q] = *(const u32x2*)(XG + rowA * DM + 128 * s + 16 * j + 4 * q); x2b[q] = *(const u32x2*)(XG + rowB * DM + 128 * s + 16 * j + 4 * q); }
            int oa[16], ob[16];
#pragma unroll
            for (int i = 0; i < 16; ++i) { oa[i] = 0; ob[i] = 0; }
#define PE_VCOMP(buf_, cq_, o_, kb_) do { const u32x2 q2_ = *(const LAS u32x2*)((cq_) + 8 * (kb_)); \
                _Pragma("unroll") for (int g = 0; g < 2; ++g) { const int qg_ = (int)(g ? q2_.y : q2_.x); \
                    const unsigned r0_[4] = {(buf_)[4 * g].x, (buf_)[4 * g].y, (buf_)[4 * g].z, (buf_)[4 * g].w}, r1_[4] = {(buf_)[4 * g + 1].x, (buf_)[4 * g + 1].y, (buf_)[4 * g + 1].z, (buf_)[4 * g + 1].w}; \
                    const unsigned r2_[4] = {(buf_)[4 * g + 2].x, (buf_)[4 * g + 2].y, (buf_)[4 * g + 2].z, (buf_)[4 * g + 2].w}, r3_[4] = {(buf_)[4 * g + 3].x, (buf_)[4 * g + 3].y, (buf_)[4 * g + 3].z, (buf_)[4 * g + 3].w}; \
                    _Pragma("unroll") for (int d = 0; d < 4; ++d) { \
                        const unsigned a_ = __builtin_amdgcn_perm(r1_[d], r0_[d], 0x05010400u), b_ = __builtin_amdgcn_perm(r1_[d], r0_[d], 0x07030602u); \
                        const unsigned c_ = __builtin_amdgcn_perm(r3_[d], r2_[d], 0x05010400u), e_ = __builtin_amdgcn_perm(r3_[d], r2_[d], 0x07030602u); \
                        (o_)[4 * d + 0] = __builtin_amdgcn_sdot4((int)__builtin_amdgcn_perm(c_, a_, 0x05040100u), qg_, (o_)[4 * d + 0], false); \
                        (o_)[4 * d + 1] = __builtin_amdgcn_sdot4((int)__builtin_amdgcn_perm(c_, a_, 0x07060302u), qg_, (o_)[4 * d + 1], false); \
                        (o_)[4 * d + 2] = __builtin_amdgcn_sdot4((int)__builtin_amdgcn_perm(e_, b_, 0x05040100u), qg_, (o_)[4 * d + 2], false); \
                        (o_)[4 * d + 3] = __builtin_amdgcn_sdot4((int)__builtin_amdgcn_perm(e_, b_, 0x07060302u), qg_, (o_)[4 * d + 3], false); } } \
                asm volatile("" : "+v"((o_)[0]), "+v"((o_)[1]), "+v"((o_)[2]), "+v"((o_)[3]), "+v"((o_)[4]), "+v"((o_)[5]), "+v"((o_)[6]), "+v"((o_)[7]), "+v"((o_)[8]), "+v"((o_)[9]), "+v"((o_)[10]), "+v"((o_)[11]), "+v"((o_)[12]), "+v"((o_)[13]), "+v"((o_)[14]), "+v"((o_)[15]) :: "memory"); } while (0)
#pragma unroll
            for (int kb = 0; kb < 16; ++kb) {
                PE_ISSUE(bufB, reB, kb, Vs);
                PE_VCOMP(bufA, cqA, oa, kb);
                if (kb + 1 < 16) PE_ISSUE(bufA, reA, kb + 1, Vs); else PE_ISSUE(bufA, reA, 0, Vsn);
                PE_VCOMP(bufB, cqB, ob, kb);
            }
#undef PE_VCOMP
#pragma unroll
            for (int q = 0; q < 4; ++q) {
                const u32x2 xa2 = x2a[q], xb2 = x2b[q];
                f32x4 a0 = (f32x4){bf_lo(xa2.x), bf_hi(xa2.x), bf_lo(xa2.y), bf_hi(xa2.y)}, b0 = (f32x4){bf_lo(xb2.x), bf_hi(xb2.x), bf_lo(xb2.y), bf_hi(xb2.y)};
                a0 = a0 + (f32x4){(float)oa[4 * q], (float)oa[4 * q + 1], (float)oa[4 * q + 2], (float)oa[4 * q + 3]} * csA; b0 = b0 + (f32x4){(float)ob[4 * q], (float)ob[4 * q + 1], (float)ob[4 * q + 2], (float)ob[4 * q + 3]} * csB;
                if (!dry && !DRY) { ssA += (a0.x * a0.x + a0.y * a0.y) + (a0.z * a0.z + a0.w * a0.w); ssB += (b0.x * b0.x + b0.y * b0.y) + (b0.z * b0.z + b0.w * b0.w);
                u32x2 pa, pb; pa.x = cvt_pk_bf16(a0.x, a0.y); pa.y = cvt_pk_bf16(a0.z, a0.w); pb.x = cvt_pk_bf16(b0.x, b0.y); pb.y = cvt_pk_bf16(b0.z, b0.w);
                *(u32x2*)(XGW + rowA * DM + 128 * s + 16 * j + 4 * q) = pa; *(u32x2*)(XGW + rowB * DM + 128 * s + 16 * j + 4 * q) = pb; } }
        }
#undef PE_DEC16P
#undef PE_ISSUE
        ssA += __shfl_xor(ssA, 1); ssA += __shfl_xor(ssA, 2); ssA += __shfl_xor(ssA, 4);
        ssB += __shfl_xor(ssB, 1); ssB += __shfl_xor(ssB, 2); ssB += __shfl_xor(ssB, 4);
        const float rfA = rsqrtf(ssA * (1.0f / DM) + EPS), rfB = rsqrtf(ssB * (1.0f / DM) + EPS);
#elif PE_VMFMA
        LAS float* csc = (LAS float*)(F.lds + PE_CS); LAS float* ssb = (LAS float*)(F.lds + PE_SS);
        {
            const float rsA = rsqrtf(rss2[rowA] * (1.0f / DM) + EPS), rsB = rsqrtf(rss2[rowB] * (1.0f / DM) + EPS);
            float mA = 0.f, mB = 0.f;
#pragma unroll
            for (int kb = 0; kb < 16; ++kb) { const int eA = (int)(reA[8 * kb + j] >> 7), eB = (int)(reB[8 * kb + j] >> 7);
                accA[kb] = cfA[8 * kb + j] * gelu_exact(accA[kb] * (rsA * isxA) * SINV[eA]) * SINV[16384 + eA]; accB[kb] = cfB[8 * kb + j] * gelu_exact(accB[kb] * (rsB * isxB) * SINV[eB]) * SINV[16384 + eB];
                mA = fmaxf(mA, fabsf(accA[kb])); mB = fmaxf(mB, fabsf(accB[kb])); }
            mA = fmaxf(mA, __shfl_xor(mA, 1)); mA = fmaxf(mA, __shfl_xor(mA, 2)); mA = fmaxf(mA, __shfl_xor(mA, 4));
            mB = fmaxf(mB, __shfl_xor(mB, 1)); mB = fmaxf(mB, __shfl_xor(mB, 2)); mB = fmaxf(mB, __shfl_xor(mB, 4));
            const float qA = (mA > 0.f) ? 127.0f / mA : 0.f, qB = (mB > 0.f) ? 127.0f / mB : 0.f;
#pragma unroll
            for (int kb = 0; kb < 16; ++kb) { ((LAS unsigned*)cfA)[8 * kb + j] = (unsigned)(__float2int_rn(accA[kb] * qA) & 255) * 0x01010101u; ((LAS unsigned*)cfB)[8 * kb + j] = (unsigned)(__float2int_rn(accB[kb] * qB) & 255) * 0x01010101u; }
            if (j == 0) { csc[tA] = mA * (1.0f / 127.0f); csc[tB] = mB * (1.0f / 127.0f); ssb[tA] = 0.f; ssb[tB] = 0.f; }
        }
        LDS_WAIT();
        {
            const int g16 = lane & 15, kg = lane >> 4, w8 = 8 * w;
            const unsigned m0 = (g16 < 4) ? (0xFFu << (8 * (g16 & 3))) : 0u, m1 = (g16 >= 4 && g16 < 8) ? (0xFFu << (8 * (g16 & 3))) : 0u;
            const int ecol = 8 * (lane & 15) + 4 * ((lane >> 4) & 1);
            const LAS unsigned* RQ = (const LAS unsigned*)RG;
#define PV_ISSUE(buf_, qb_, t_, n0_, base_) do { u32x2 of_[8]; \
                _Pragma("unroll") for (int n = 0; n < 8; ++n) { of_[n] = *(const LAS u32x2*)(RE + (t_) * PE_REP + 8 * ((n0_) + n) + 2 * kg); (qb_)[n] = *(const LAS u32x2*)(RQ + (t_) * PE_REP + 8 * ((n0_) + n) + 2 * kg); } \
                asm volatile("" ::: "memory"); \
                _Pragma("unroll") for (int n = 0; n < 8; ++n) { (buf_)[2 * n] = *(const u32x2*)((base_) + (of_[n].x + lofs)); (buf_)[2 * n + 1] = *(const u32x2*)((base_) + (of_[n].y + lofs)); } \
                asm volatile("" ::: "memory"); } while (0)
#define PV_COMP(buf_, qb_) do { _Pragma("unroll") for (int n = 0; n < 8; ++n) { \
                const i32x4 sel_ = (i32x4){(int)((qb_)[n].x & m0), (int)((qb_)[n].x & m1), (int)((qb_)[n].y & m0), (int)((qb_)[n].y & m1)}; \
                const i32x4 dat_ = (i32x4){(int)(buf_)[2 * n].x, (int)(buf_)[2 * n].y, (int)(buf_)[2 * n + 1].x, (int)(buf_)[2 * n + 1].y}; \
                if (n & 1) acc1 = __builtin_amdgcn_mfma_i32_16x16x64_i8(sel_, dat_, acc1, 0, 0, 0); else acc0 = __builtin_amdgcn_mfma_i32_16x16x64_i8(sel_, dat_, acc0, 0, 0, 0); } } while (0)
            const unsigned lofs = 8u * (unsigned)g16;
            u32x2 bufA[16], bufB[16], qA8[8], qB8[8];
            PV_ISSUE(bufA, qA8, w8, 0, VS);
#pragma unroll 1
            for (int un = 0; un < 128; ++un) {
                const int s = un >> 4, tk = un & 15, t = w8 + (tk & 7) + ((tk & 8) << 3);
                const int u2 = un + 1, sn = (u2 >> 4) & 7, tkn = u2 & 15, tn = w8 + (tkn & 7) + ((tkn & 8) << 3);
                const unsigned char* Vs = VS + (size_t)s * (16384 * 128); const unsigned char* Vsn = VS + (size_t)sn * (16384 * 128);
                const size_t xoff = ((size_t)tile * 128 + t) * DM + 128 * s + ecol;
                const u32x2 xr = *(const u32x2*)(XG + xoff);
                i32x4 acc0 = (i32x4){0, 0, 0, 0}, acc1 = (i32x4){0, 0, 0, 0};
                PV_ISSUE(bufB, qB8, t, 8, Vs);
                PV_COMP(bufA, qA8);
                PV_ISSUE(bufA, qA8, tn, 0, Vsn);
                PV_COMP(bufB, qB8);
                const float cs = csc[t];
                f32x4 a0 = (f32x4){bf_lo(xr.x), bf_hi(xr.x), bf_lo(xr.y), bf_hi(xr.y)};
                a0 = a0 + (f32x4){(float)(acc0.x + acc1.x), (float)(acc0.y + acc1.y), (float)(acc0.z + acc1.z), (float)(acc0.w + acc1.w)} * cs;
                const float ss = (a0.x * a0.x + a0.y * a0.y) + (a0.z * a0.z + a0.w * a0.w);
                if (!DRY) {
                    if (lane < 32) { __hip_atomic_fetch_add(ssb + t, ss, __ATOMIC_RELAXED, __HIP_MEMORY_SCOPE_WORKGROUP);   u32x2 pa; pa.x = cvt_pk_bf16(a0.x, a0.y); pa.y = cvt_pk_bf16(a0.z, a0.w); *(u32x2*)(XGW + xoff) = pa; } }
            }
#undef PV_ISSUE
#undef PV_COMP
        }
#undef PE_DEC16P
#undef PE_ISSUE
        LDS_WAIT();
        float ssA = ssb[tA], ssB = ssb[tB];
        float* xoA = A.out + rowA * DM + 16 * j; float* xoB = A.out + rowB * DM + 16 * j;
        const float rfA = rsqrtf(ssA * (1.0f / DM) + EPS), rfB = rsqrtf(ssB * (1.0f / DM) + EPS);
#else
        {
            const float rsA = rsqrtf(rss2[rowA] * (1.0f / DM) + EPS), rsB = rsqrtf(rss2[rowB] * (1.0f / DM) + EPS);
#pragma unroll
            for (int kb = 0; kb < 16; ++kb) { const int eA = (int)(reA[8 * kb + j] >> 7), eB = (int)(reB[8 * kb + j] >> 7);
                cfA[8 * kb + j] = cfA[8 * kb + j] * gelu_exact(accA[kb] * (rsA * isxA) * SINV[eA]) * SINV[16384 + eA]; cfB[8 * kb + j] = cfB[8 * kb + j] * gelu_exact(accB[kb] * (rsB * isxB) * SINV[eB]) * SINV[16384 + eB]; }
        }
        LDS_WAIT();
        float ssA = 0.f, ssB = 0.f;
        float* xoA = A.out + rowA * DM + 16 * j; float* xoB = A.out + rowB * DM + 16 * j;
        PE_ISSUE(bufA, reA, 0, VS + 16 * j);
#pragma unroll 1
        for (int s2 = 0; s2 < ((P7REP & 4) ? 16 : 8); ++s2) {
            const int s = s2 & 7; const bool dry = (P7REP & 4) && s2 < 8;
            const unsigned char* Vs = VS + (size_t)s * (16384 * 128) + 16 * j; const unsigned char* Vsn = VS + (size_t)((s + 1) & 7) * (16384 * 128) + 16 * j;
#if PE_TOUCH
            const unsigned tchv = *(const volatile unsigned*)(VS + (size_t)((s + 1) & 7) * (16384 * 128) + ((size_t)(((blockIdx.x >> 3) & 31) * 512 + F.tid)) * 128);
#endif
            u32x2 x2a[4], x2b[4];
#pragma unroll
            for (int q = 0; q < 4; ++q) { x2a[q] = *(const u32x2*)(XG + rowA * DM + 128 * s + 16 * j + 4 * q); x2b[q] = *(const u32x2*)(XG + rowB * DM + 128 * s + 16 * j + 4 * q); }
            f32x2 oa[8], ob[8];
            f32x2 dmy[2] = {(f32x2){0.f, 0.f}, (f32x2){0.f, 0.f}}; int dmi[4] = {0, 0, 0, 0};
#pragma unroll
            for (int i = 0; i < 8; ++i) { oa[i] = (f32x2){0.f, 0.f}; ob[i] = (f32x2){0.f, 0.f}; }
#define PE_VCOMP(buf_, cf_, o_, kb_) do { const f32x4 c0_ = *(const LAS f32x4*)((cf_) + 8 * (kb_)), c1_ = *(const LAS f32x4*)((cf_) + 8 * (kb_) + 4); const float cw_[8] = {c0_.x, c0_.y, c0_.z, c0_.w, c1_.x, c1_.y, c1_.z, c1_.w}; \
                _Pragma("unroll") for (int i = 0; i < 8; ++i) { const f32x2 c2 = (f32x2){cw_[i], cw_[i]}; f32x2 f2[8]; PE_DEC16P((buf_)[i], f2); _Pragma("unroll") for (int q = 0; q < 8; ++q) (o_)[q] = __builtin_elementwise_fma(c2, f2[q], (o_)[q]); \
                    if (PE_XV) { _Pragma("unroll") for (int q = 0; q < PE_XV; ++q) dmy[q & 1] = __builtin_elementwise_fma(c2, f2[q], dmy[q & 1]); } \
                    if (PE_XP) { _Pragma("unroll") for (int q = 0; q < PE_XP; ++q) { dmi[q & 1] = (int)__builtin_amdgcn_perm((buf_)[i].x, (unsigned)dmi[q & 1], 0x05010400u + (unsigned)q); dmi[2 + (q & 1)] = __builtin_amdgcn_sdot4((int)(buf_)[i].y, dmi[q & 1], dmi[2 + (q & 1)], false); } } } \
                asm volatile("" : "+v"((o_)[0]), "+v"((o_)[1]), "+v"((o_)[2]), "+v"((o_)[3]), "+v"((o_)[4]), "+v"((o_)[5]), "+v"((o_)[6]), "+v"((o_)[7]) :: "memory"); } while (0)
#pragma unroll
            for (int kb = 0; kb < 16; ++kb) {
                PE_ISSUE(bufB, reB, kb, Vs);
                PE_VCOMP(bufA, cfA, oa, kb);
                if (kb + 1 < 16) PE_ISSUE(bufA, reA, kb + 1, Vs); else PE_ISSUE(bufA, reA, 0, Vsn);
                PE_VCOMP(bufB, cfB, ob, kb);
            }
#if PE_TOUCH
            asm volatile("" :: "v"(tchv));
#endif
#undef PE_VCOMP
            if (PE_XV) asm volatile("" :: "v"(dmy[0]), "v"(dmy[1]));
            if (PE_XP) asm volatile("" :: "v"(dmi[2]), "v"(dmi[3]));
#pragma unroll
            for (int q = 0; q < 4; ++q) {
                const u32x2 xa2 = x2a[q], xb2 = x2b[q];
                f32x4 a0 = (f32x4){bf_lo(xa2.x), bf_hi(xa2.x), bf_lo(xa2.y), bf_hi(xa2.y)}, b0 = (f32x4){bf_lo(xb2.x), bf_hi(xb2.x), bf_lo(xb2.y), bf_hi(xb2.y)};
                a0 = a0 + (f32x4){oa[2 * q].x, oa[2 * q].y, oa[2 * q + 1].x, oa[2 * q + 1].y}; b0 = b0 + (f32x4){ob[2 * q].x, ob[2 * q].y, ob[2 * q + 1].x, ob[2 * q + 1].y};
                if (!dry && !DRY) { ssA += (a0.x * a0.x + a0.y * a0.y) + (a0.z * a0.z + a0.w * a0.w); ssB += (b0.x * b0.x + b0.y * b0.y) + (b0.z * b0.z + b0.w * b0.w);
                u32x2 pa, pb; pa.x = cvt_pk_bf16(a0.x, a0.y); pa.y = cvt_pk_bf16(a0.z, a0.w); pb.x = cvt_pk_bf16(b0.x, b0.y); pb.y = cvt_pk_bf16(b0.z, b0.w);
                *(u32x2*)(XGW + rowA * DM + 128 * s + 16 * j + 4 * q) = pa; *(u32x2*)(XGW + rowB * DM + 128 * s + 16 * j + 4 * q) = pb; } }
        }
#undef PE_DEC16P
#undef PE_ISSUE
        ssA += __shfl_xor(ssA, 1); ssA += __shfl_xor(ssA, 2); ssA += __shfl_xor(ssA, 4);
        ssB += __shfl_xor(ssB, 1); ssB += __shfl_xor(ssB, 2); ssB += __shfl_xor(ssB, 4);
        const float rfA = rsqrtf(ssA * (1.0f / DM) + EPS), rfB = rsqrtf(ssB * (1.0f / DM) + EPS);
#endif
        VM_WAIT();
        __builtin_amdgcn_fence(__ATOMIC_ACQUIRE, "agent");
        VM_WAIT();
        {
            f32x4 gv[4];
#pragma unroll
            for (int c = 0; c < 4; ++c) gv[c] = *(const f32x4*)(A.in[I_GFIN] + 256 * c + 4 * lane);
#pragma unroll 2
            for (int rr = 0; rr < 16; ++rr) {
                const int g = rr & 7;
                const float rf = __shfl((rr >= 8) ? rfB : rfA, 8 * g);
                const size_t row = (size_t)tile * 128 + ((rr >= 8) ? 64 : 0) + 8 * w + g;
                u32x2 xr[4];
#pragma unroll
                for (int c = 0; c < 4; ++c) xr[c] = *(const u32x2*)(XGW + row * DM + 256 * c + 4 * lane);
#pragma unroll
                for (int c = 0; c < 4; ++c) { const f32x4 a0 = (f32x4){bf_lo(xr[c].x), bf_hi(xr[c].x), bf_lo(xr[c].y), bf_hi(xr[c].y)};
                    if (!DRY) *(f32x4*)(A.out + row * DM + 256 * c + 4 * lane) = a0 * rf * gv[c]; else asm volatile("" :: "v"(a0 * rf * gv[c])); }
            }
        }
    }
    __syncthreads();
}

#ifndef USE_COOP_LAUNCH
#define USE_COOP_LAUNCH 1
#endif
#ifndef USE_CG_SYNC
#define USE_CG_SYNC 0
#endif
#ifndef DBG_SRC
#define DBG_SRC 0
#endif
#ifndef DBG_ZC
#define DBG_ZC 0
#endif
#ifndef DBG_C0
#define DBG_C0 0
#endif
#ifndef DBG_C1
#define DBG_C1 1024
#endif
__global__ void __launch_bounds__(512, 2) mk_fwd(Args args) {
    extern __shared__ __attribute__((aligned(16))) unsigned char lds_raw[];
    Frame F;
    F.lds = (LAS unsigned char*)lds_raw;
    F.tid = threadIdx.x; F.lane = F.tid & 63; F.wave = __builtin_amdgcn_readfirstlane(F.tid >> 6);
    F.G = gridDim.x; { const int bx = blockIdx.x; F.vcu = (F.G % 8 == 0) ? (bx % 8) * (F.G / 8) + bx / 8 : bx; }
    F.a = &args; F.ws = args.ws; F.ctl = (unsigned*)(args.ws + WS_CTL);
    const int lo = args.ph_lo, hi = args.ph_hi;
#if USE_CG_SYNC
    cg::grid_group grid = cg::this_grid();
#define GRID_BAR() grid.sync()
#else
    { volatile LAS unsigned* st0 = (volatile LAS unsigned*)(F.lds + MISC_OFF); if (F.tid < 8) st0[F.tid] = 0u; }
    __syncthreads();
    XcdBarrier xbar; xbar.bar = F.ctl + CW_BAR; xbar.x = 0; xbar.st = nullptr;
    if (hi - lo > 1) xbar = xcd_barrier_post(F.ctl + CW_BAR, (volatile LAS unsigned*)(F.lds + MISC_OFF));
#define GRID_BAR() xcd_barrier(xbar)
#endif
#define IN(k) (lo <= (k) && (k) < hi)
#ifndef PHMASK
#define PHMASK 0x1FF
#endif
#ifndef P2SUB
#define P2SUB 7
#endif
#ifndef PV_FP8
#define PV_FP8 1
#endif
#ifndef Q_FILL_LAST
#define Q_FILL_LAST 1
#endif
#ifndef REPFILL
#define REPFILL 0
#endif
#ifndef P1PROBE
#define P1PROBE 0
#endif
#define PHON(k) (((PHMASK) >> (k)) & 1)
#ifndef REPMASK
#define REPMASK 0
#endif
#define NREP(k) ((((REPMASK) >> (k)) & 1) ? 2 : 1)
#define PHASE_BEGIN() do { int t_ = threadIdx.x; asm volatile("" : "+v"(t_)); F.tid = t_; F.lane = t_ & 63; } while (0)
#define SEAM(k) do { if (IN(k) && IN((k) + 1)) GRID_BAR(); } while (0)
    unsigned char* ws = args.ws;
    const int bx = blockIdx.x;

    if (PHON(0) && IN(0)) { for (int rep = 0; rep < NREP(0); ++rep) { PHASE_BEGIN(); p0_prologue(F); } }
    SEAM(0);
    if (PHON(1) && IN(1)) for (int rep = 0; rep < NREP(1); ++rep) {
        PHASE_BEGIN();
        { pg8::Sched S{0, T_TOK / 256, NZ / 256, (T_TOK / 256) * (NZ / 256), F.G, bx, 1, (const char*)(ws + WS_BUFA), (const char*)(ws + WS_WIN), (char*)(ws + WS_Z), (size_t)256 * DM, (size_t)256 * DM, 0, 2};
          pg8::EpiBf16 E{NZ, 1.0f, nullptr, (const float*)(F.ctl + CW_WSC), (const float*)(F.ctl + CW_HSC), (P1PROBE && rep + 1 < NREP(1)) ? (P1PROBE & 3) : 0};
          pg8::gemm_phase<pg8::EpiBf16, pg8::Sched, true>(F.lds, DM / 2, DM / 2, DM / 2, S, E); }
        if (!((P1PROBE & 4) && rep + 1 < NREP(1)))
        { pg8::Sched S{3, 0, 0, 128, F.G, bx, 1, (const char*)(ws + WS_WCQ), (const char*)(ws + WS_WKV), (char*)(ws + WS_KV), (size_t)(ws + WS_WCO), 0, 0, 2};
          pg8::EpiBf16 E{DM, 1.0f, nullptr, nullptr};
          pg8::gemm_phase(F.lds, 256, DM, DM, S, E); }
#if TR_IN_P1
        if (rep + 1 == NREP(1) && bx >= 128) {
            LAS float* scr = (LAS float*)(F.lds + F.wave * 8448);
            const int nfree = (F.G - 128) * 8;
            for (int it = (bx - 128) * 8 + F.wave; it < 1024; it += nfree) {
                const int which = it >> 9, r = it & 511, kb = r >> 5, n0 = (r & 31) * 32;
                if (which == 0) p0_transpose_item(args.in[I_WOUT], DM, DM, kb, n0, (bf16_t*)(ws + WS_WOUT), n0, scr, F.lane);
                else p0_transpose_item(args.in[I_WPQ], DM, DM, kb, n0, (bf16_t*)(ws + WS_WPQ), n0, scr, F.lane, args.in[I_GFFN]);
            }
        }
#endif
    }
    SEAM(1);
    if (PHON(2) && IN(2)) for (int rep = 0; rep < NREP(2); ++rep) {
        PHASE_BEGIN();
        conv_prepass(F);
    }
    SEAM(2);
    if (PHON(3) && IN(3)) for (int rep = 0; rep < NREP(3); ++rep) {
        PHASE_BEGIN();
        float lam;
        { float s1 = 0.f, s2 = 0.f;
          for (int i = 0; i < 64; ++i) { s1 += args.in[I_LQ1][i] * args.in[I_LK1][i]; s2 += args.in[I_LQ2][i] * args.in[I_LK2][i]; }
          lam = __expf(s1) - __expf(s2) + 0.2f; }
        LAS int* qslot = (LAS int*)(F.lds + MISC_OFF + 16);
        int qx = bx & 7, tried = 0;
        for (;;) {
            if (F.tid == 0) *qslot = (int)atomicAdd(F.ctl + CW_Q2 + 64 * (qx + 8 * rep), 1u);
            __syncthreads();
            const int u = *qslot;
            __syncthreads();
            if (u >= 8 + 128 + 48) { if (++tried == 8) break; qx = (qx + 1) & 7; continue; }
            const int submask = (rep + 1 < NREP(3)) ? (REPSUB) : (P2SUB);
#if Q_FILL_LAST
            const int v_ = u - 8; const bool isfill_ = (v_ >= 128); const int fi_ = isfill_ ? v_ - 128 : v_;
#else
            const int v_ = u - 8, g5_ = v_ / 5, r5_ = v_ - 5 * g5_;
            const bool isfill_ = (r5_ == 4); const int fi_ = isfill_ ? g5_ : 4 * g5_ + r5_;
#endif
            if (u < 8) { const int p = qx + 8 * u; if ((submask & 1) && !((rep + 1 < NREP(3)) && (PROBE_HALF & 1) && u >= 4)) mlstm_unit(F, p >> 2, p & 3); }
            else if (isfill_ && fi_ < 16) { if (rep + 1 == NREP(3) || (REPFILL & 1)) peer_convert_rows(F, qx + 8 * fi_); }
            else if (isfill_) { if (rep + 1 == NREP(3) || (REPFILL & 2)) {
                const int gi = qx + 8 * (fi_ - 16);
                if (gi < 128) { pg8::Sched S{4, 0, 0, 2 * gi + 2, 1, 2 * gi, 1, (const char*)(ws + WS_MEMN), (const char*)(ws + WS_KV), (char*)(ws + WS_MB), 0, 0, 0, 2};
                    pg8::EpiBf16 E{DM, 0.0625f, nullptr, args.in[I_GCA]};
                    pg8::gemm_phase(F.lds, DM, DM, DM, S, E); }
                else { pg8::Sched S{5, 0, 0, 2 * (gi - 128) + 2, 1, 2 * (gi - 128), 1, (const char*)(ws + WS_KV), (const char*)(ws + WS_MEMN), (char*)(ws + WS_VWB), 0, 0, 0, PV_FP8 ? 1 : 2};
                    pg8::EpiBf16 E{DM, 1.0f, nullptr, nullptr, nullptr, 0, PV_FP8};
                    pg8::gemm_phase(F.lds, DM, DM, DM, S, E); } } }
            else if ((submask & 2) && !((rep + 1 < NREP(3)) && (PROBE_HALF & 2) && (fi_ >> 4) >= 4)) { const int j = fi_;
#if Q_PAIRED
                { const int p = qx + 8 * (j >> 3), g_ = j & 7;
#pragma unroll 1
                  for (int hf = 0; hf < 2; ++hf) { const int qt_ = hf ? g_ : 15 - g_;
                      if (rep + 1 < NREP(3)) attn_unit<ATT_MODE>(F, p >> 2, p & 3, qt_, lam); else attn_unit<0>(F, p >> 2, p & 3, qt_, lam); } }
#elif Q_LPT
                const int p = qx + 8 * (j & 7), qt_ = 15 - (j >> 3);
#else
                const int i_ = j >> 4, qt_ = 15 - (j & 15);
                const int p = 4 * (qx + 8 * (i_ >> 2)) + (3 - (i_ & 3));
#endif
#if !Q_PAIRED
                if (rep + 1 < NREP(3)) attn_unit<ATT_MODE>(F, p >> 2, p & 3, qt_, lam); else attn_unit<0>(F, p >> 2, p & 3, qt_, lam);
#endif
            }
        }
    }
    SEAM(3);
    if (PHON(4) && IN(4)) for (int rep = 0; rep < NREP(4); ++rep) {
        PHASE_BEGIN();
        pg8::Sched S{0, T_TOK / 256, 4, (T_TOK / 256) * 4, F.G, bx, 1, (const char*)(ws + WS_BUFA), (const char*)(ws + WS_WOUT), nullptr, (size_t)256 * DM * 2, (size_t)256 * DM * 2, 0, 2};
        pg8::EpiResidB<false> E{args.in[I_X], (bf16_t*)(ws + WS_BUFB), (float*)(F.ctl + ((rep + 1 < NREP(4)) ? CW_DUMMY : CW_RSS1))};
        pg8::gemm_phase(F.lds, DM, DM, DM, S, E);
    }
    SEAM(4);
    if (PHON(5) && IN(5)) for (int rep = 0; rep < NREP(5); ++rep) {
        PHASE_BEGIN();
        pg8::Sched S{0, T_TOK / 256, 4, (T_TOK / 256) * 4, F.G, bx, 8, (const char*)(ws + WS_BUFB), (const char*)(ws + WS_MB), nullptr, (size_t)256 * DM * 2, (size_t)256 * DM * 2, (size_t)DM * DM * 2, 2};
        pg8::EpiSoftmax E{(const float*)(F.ctl + CW_RSS1), (bf16_t*)(ws + WS_BUFA), PV_FP8 ? (unsigned char*)(ws + WS_BUFA) : nullptr};
        pg8::gemm_phase(F.lds, DM, DM, DM, S, E);
    }
    SEAM(5);
    if (PHON(6) && IN(6)) {
        PHASE_BEGIN();
#if PV_FP8
        pg8::Sched S{0, T_TOK / 256, 4, (T_TOK / 256) * 4, F.G, bx, 8, (const char*)(ws + WS_BUFA), (const char*)(ws + WS_VWB), nullptr, (size_t)256 * DM, (size_t)256 * DM, (size_t)DM * DM, 2};
        pg8::EpiResidB<true> E{(const void*)(ws + WS_BUFB), (bf16_t*)(ws + WS_BUFB), (float*)(F.ctl + CW_RSS2), F.ctl + CW_AMAX, 1.0f / 256.0f};
        pg8::gemm_phase<pg8::EpiResidB<true>, pg8::Sched, false, true>(F.lds, DM / 2, DM / 2, DM / 2, S, E);
#else
        pg8::Sched S{0, T_TOK / 256, 4, (T_TOK / 256) * 4, F.G, bx, 8, (const char*)(ws + WS_BUFA), (const char*)(ws + WS_VWB), nullptr, (size_t)256 * DM * 2, (size_t)256 * DM * 2, (size_t)DM * DM * 2, 2};
        pg8::EpiResidB<true> E{(const void*)(ws + WS_BUFB), (bf16_t*)(ws + WS_BUFB), (float*)(F.ctl + CW_RSS2), F.ctl + CW_AMAX};
        pg8::gemm_phase(F.lds, DM, DM, DM, S, E);
#endif
    }
    SEAM(6);
    if (PHON(7) && IN(7)) for (int rep = 0; rep < NREP(7); ++rep) {
        PHASE_BEGIN();
        pg8::Sched S{0, T_TOK / 256, 4, (T_TOK / 256) * 4, F.G, bx, 1, (const char*)(ws + WS_BUFB), (const char*)(ws + WS_WPQ), (char*)(ws + WS_BUFA), (size_t)256 * DM * 2, (size_t)256 * DM * 2, 0, 2};
        pg8::EpiBf16 E{DM, 1.0f, (const float*)(F.ctl + CW_RSS2), nullptr};
        pg8::gemm_phase(F.lds, DM, DM, DM, S, E);
    }
    SEAM(7);
    if (PHON(8) && IN(8)) {
        PHASE_BEGIN();
        if (NREP(8) > 1) { for (int tile = bx; tile < T_TOK / 128; tile += F.G) peer_tile<true>(F, tile); }
        for (int tile = bx; tile < T_TOK / 128; tile += F.G) peer_tile<false>(F, tile);
    }
    if (lo <= 9 && 9 < hi) {
        const bf16_t* src = (const bf16_t*)(ws + (DBG_SRC ? WS_Z : WS_BUFA));
        for (size_t i = (size_t)bx * 512 + F.tid; i < (size_t)T_TOK * DM / 2; i += (size_t)F.G * 512) { const size_t row_ = (2 * i) >> 10, col_ = (2 * i) & 1023; const unsigned u = DBG_SRC ? *(const unsigned*)(src + row_ * NZ + DBG_ZC + col_) : ((const unsigned*)src)[i]; const int col = (int)((2 * i) & 1023); const bool on = (col >= DBG_C0 && col < DBG_C1); args.out[2 * i] = on ? bf_lo(u) : 0.f; args.out[2 * i + 1] = on ? bf_hi(u) : 0.f; }
    }
#undef IN
#undef SEAM
}

#ifndef MK_N_LAUNCHES
#define MK_N_LAUNCHES 1
#endif
extern "C" void kernel_launch(void* const* d_in, const int* in_sizes, int n_in, void* d_out, int out_size, void* d_ws, size_t ws_size, hipStream_t stream) {
    static int grid = 0;
    if (grid == 0) {
        if (n_in != 26 || out_size != T_TOK * DM || ws_size < WS_END + 34 * MiB) { fprintf(stderr, "kernel_launch: unexpected shapes (n_in %d out %d ws %zu)\n", n_in, out_size, ws_size); grid = -1; return; }
        int dev = 0, cus = 0, per_cu = 0;
        hipGetDevice(&dev); hipDeviceGetAttribute(&cus, hipDeviceAttributeMultiprocessorCount, dev);
        if (hipFuncSetAttribute((const void*)mk_fwd, hipFuncAttributeMaxDynamicSharedMemorySize, LDS_BYTES) != hipSuccess) { fprintf(stderr, "kernel_launch: hipFuncSetAttribute failed\n"); grid = -1; return; }
        if (hipOccupancyMaxActiveBlocksPerMultiprocessor(&per_cu, (const void*)mk_fwd, 512, LDS_BYTES) != hipSuccess || per_cu < 1) { fprintf(stderr, "kernel_launch: occupancy query says %d\n", per_cu); per_cu = 1; }
        (void)hipGetLastError();
        grid = cus;
    }
    if (grid < 0) return;
    hipMemsetAsync((char*)d_ws + WS_CTL, 0, CTL_BYTES, stream);
    Args a{};
    for (int i = 0; i < 26; ++i) a.in[i] = (const float*)d_in[i];
    a.out = (float*)d_out; a.ws = (unsigned char*)d_ws;
    if (MK_N_LAUNCHES == 1) {
        a.ph_lo = 0; a.ph_hi = 9;
        void* kargs[] = {&a};
#if USE_COOP_LAUNCH
        hipError_t e = hipLaunchCooperativeKernel((const void*)mk_fwd, dim3(grid), dim3(512), kargs, LDS_BYTES, stream);
        if (e != hipSuccess) fprintf(stderr, "cooperative launch failed: %s (grid %d)\n", hipGetErrorString(e), grid);
#else
        (void)kargs; hipLaunchKernelGGL(mk_fwd, dim3(grid), dim3(512), LDS_BYTES, stream, a);
#endif
    } else {
#ifndef DBG_STOP
#define DBG_STOP 9
#endif
#ifndef DBG_DUMP
#define DBG_DUMP 0
#endif
        for (int p = 0; p < DBG_STOP; ++p) { a.ph_lo = p; a.ph_hi = p + 1; hipLaunchKernelGGL(mk_fwd, dim3(grid), dim3(512), LDS_BYTES, stream, a); }
        if (DBG_DUMP) { a.ph_lo = 9; a.ph_hi = 10; hipLaunchKernelGGL(mk_fwd, dim3(grid), dim3(512), LDS_BYTES, stream, a); }
    }
}
```
